# Optimizing an MI355X kernel written in HIP

```python
import jax, jax.numpy as jnp
from jax import lax
import numpy as np

D_MODEL = 1024
BATCH = 8
SEQ = 4096
DEPTH = 4

HEAD_DIM = 128
EPS = 1e-6
ROPE_THETA = 500000.0
ROT_DIM = HEAD_DIM // 4
N_MEM = 256
MEM_HEADS = 4
DIL_GROUPS = ((128, 1), (512, 4), (2048, 16))
A_HEADS = 4
POOL_SIZES = (2, 4, 8, 16)
POOL_CH = 128
CHUNK = 128
C_GROUPS = 8
C_CH = 128

A_WIDTH = A_HEADS * HEAD_DIM
B_WIDTH = len(POOL_SIZES) * POOL_CH
C_WIDTH = C_GROUPS * C_CH
M_WIDTH = MEM_HEADS * HEAD_DIM
EVEN_MIX = A_WIDTH + B_WIDTH + M_WIDTH
ODD_MIX = C_WIDTH + M_WIDTH
A_QK_WIDTH = 2 * len(DIL_GROUPS) * A_WIDTH
EVEN_IN = A_QK_WIDTH + A_WIDTH + B_WIDTH + M_WIDTH + EVEN_MIX
ODD_IN = 2 * C_WIDTH + M_WIDTH + ODD_MIX
N_EVEN = (DEPTH + 1) // 2
N_ODD = DEPTH // 2

kernel_name = "hybrid_dilated_pool_gmlp_trunk"


def rmsnorm(x, g):
    xf = x.astype(jnp.float32)
    y = xf * lax.rsqrt(jnp.mean(xf * xf, axis=-1, keepdims=True) + EPS)
    return (y * g.astype(jnp.float32)).astype(x.dtype)


def layernorm(x, g, b):
    xf = x.astype(jnp.float32)
    mu = jnp.mean(xf, axis=-1, keepdims=True)
    xc = xf - mu
    y = xc * lax.rsqrt(jnp.mean(xc * xc, axis=-1, keepdims=True) + EPS)
    return (y * g.astype(jnp.float32) + b.astype(jnp.float32)).astype(x.dtype)


def rope_tables(positions):
    pos = positions.astype(jnp.float32)
    inv = ROPE_THETA ** (-jnp.arange(0, ROT_DIM, 2, dtype=jnp.float32) / ROT_DIM)
    ang = pos[..., None] * inv
    return jnp.cos(ang), jnp.sin(ang)


def apply_partial_rope(x, cos, sin):
    half = ROT_DIM // 2
    xr = x[..., :ROT_DIM].astype(jnp.float32)
    x1, x2 = xr[..., :half], xr[..., half:]
    c, s = cos[:, :, None, :], sin[:, :, None, :]
    rot = jnp.concatenate([x1 * c - x2 * s, x2 * c + x1 * s], axis=-1).astype(x.dtype)
    return jnp.concatenate([rot, x[..., ROT_DIM:]], axis=-1)


def _to_strided(x, dil, blk):
    b, s, h, d = x.shape
    unit = dil * blk
    lp = -(-s // unit) * unit
    x = jnp.pad(x, ((0, 0), (0, lp - s), (0, 0), (0, 0)))
    x = x.reshape(b, lp // dil, dil, h, d).transpose(0, 2, 1, 3, 4)
    return x.reshape(b, dil, lp // unit, blk, h, d)


def _from_strided(x, seq):
    b, dil, nb, blk = x.shape[:4]
    rest = x.shape[4:]
    x = jnp.moveaxis(x.reshape((b, dil, nb * blk) + rest), 1, 2)
    return x.reshape((b, nb * blk * dil) + rest)[:, :seq]


def dilated_window_group(q, k, v, window, dil):
    span = window // dil
    blk = span
    seq = q.shape[1]
    qb, kb, vb = (_to_strided(t, dil, blk) for t in (q, k, v))
    nb = qb.shape[2]

    def with_prev(t):
        prev = jnp.concatenate([jnp.zeros_like(t[:, :, :1]), t[:, :, :-1]], axis=2)
        return jnp.concatenate([prev, t], axis=3)

    kk, vv = with_prev(kb), with_prev(vb)
    scores = jnp.einsum('brnqhd,brnkhd->brnhqk', qb, kk,
                        preferred_element_type=jnp.float32) * (HEAD_DIM ** -0.5)
    qi = jnp.arange(blk)[:, None]
    kj = jnp.arange(2 * blk)[None, :]
    off = blk + qi - kj
    band = (off >= 0) & (off <= span)
    not_before_start = (jnp.arange(nb)[:, None, None] > 0) | (kj[None] >= blk)
    valid = band[None] & not_before_start
    scores = jnp.where(valid[None, None, :, None], scores, -jnp.inf)
    m = jnp.max(scores, axis=-1)
    p = jnp.exp(scores - m[..., None])
    den = jnp.sum(p, axis=-1)
    num = jnp.einsum('brnhqk,brnkhd->brnqhd', p, vv.astype(jnp.float32))
    m = jnp.swapaxes(m, 3, 4)
    den = jnp.swapaxes(den, 3, 4)
    return _from_strided(num, seq), _from_strided(m, seq), _from_strided(den, seq)


def dilated_attention_mixer(qk, v_a, cos, sin):
    nums, ms, dens = [], [], []
    for gi, (window, dil) in enumerate(DIL_GROUPS):
        q = apply_partial_rope(qk[:, :, gi, 0], cos, sin)
        k = apply_partial_rope(qk[:, :, gi, 1], cos, sin)
        num, m, den = dilated_window_group(q, k, v_a, window, dil)
        nums.append(num); ms.append(m); dens.append(den)
    ms = jnp.stack(ms)
    wts = jnp.exp(ms - jnp.max(ms, axis=0, keepdims=True))
    num = sum(wts[g][..., None] * nums[g] for g in range(len(DIL_GROUPS)))
    den = jnp.sum(wts * jnp.stack(dens), axis=0)
    out = num / den[..., None]
    b, s = out.shape[:2]
    return out.reshape(b, s, A_WIDTH).astype(v_a.dtype)


def multiscale_pool(xp, w_pool, scale):
    b, s, _ = xp.shape
    xg = xp.reshape(b, s, len(POOL_SIZES), POOL_CH).astype(jnp.float32)
    c = jnp.cumsum(xg, axis=1)
    t = jnp.arange(s)
    outs = []
    for gi, w in enumerate(POOL_SIZES):
        cg = c[:, :, gi]
        lag = jnp.pad(cg, ((0, 0), (w, 0), (0, 0)))[:, :s]
        cnt = jnp.minimum(t + 1, w).astype(jnp.float32)[None, :, None]
        outs.append((cg - lag) / cnt - xg[:, :, gi])
    pooled = jnp.stack(outs, axis=2)
    y = jnp.einsum('bsgc,gcd->bsgd', pooled, w_pool.astype(jnp.float32))
    return (y.reshape(b, s, B_WIDTH) * scale.astype(jnp.float32)).astype(xp.dtype)


def chunked_spatial_gating(u, v, ln_g, ln_b, w_s, b_s):
    b, s, _ = u.shape
    vn = layernorm(v, ln_g, ln_b)
    vc = vn.reshape(b, s // CHUNK, CHUNK, C_GROUPS, C_CH)
    tril = jnp.tril(jnp.ones((CHUNK, CHUNK), dtype=bool))
    ws = jnp.where(tril[None], w_s, jnp.zeros_like(w_s))
    mixed = jnp.einsum('gts,bnsgc->bntgc', ws, vc) + b_s.T[None, None, :, :, None]
    return u * mixed.reshape(b, s, C_WIDTH)


def memory_attention(q_m, mem_n, w_mem_kv):
    b, s = q_m.shape[:2]
    q = q_m.reshape(b, s, MEM_HEADS, HEAD_DIM)
    mk, mv = jnp.split(mem_n @ w_mem_kv, 2, axis=-1)
    mk = mk.reshape(b, -1, MEM_HEADS, HEAD_DIM)
    mv = mv.reshape(b, -1, MEM_HEADS, HEAD_DIM)
    sc = jnp.einsum('bshd,bmhd->bhsm', q, mk,
                    preferred_element_type=jnp.float32) * (HEAD_DIM ** -0.5)
    p = jax.nn.softmax(sc, axis=-1)
    out = jnp.einsum('bhsm,bmhd->bshd', p, mv.astype(jnp.float32))
    return out.reshape(b, s, M_WIDTH).astype(q_m.dtype)


def even_layer(x, cos, sin, mem_n, g_norm, w_in, w_pool, pool_scale, w_mem_kv, w_out):
    b, s, _ = x.shape
    h = rmsnorm(x, g_norm)
    proj = h @ w_in
    cuts = np.cumsum([A_QK_WIDTH, A_WIDTH, B_WIDTH, M_WIDTH]).tolist()
    qk, v_a, x_b, q_m, z = jnp.split(proj, cuts, axis=-1)
    qk = qk.reshape(b, s, len(DIL_GROUPS), 2, A_HEADS, HEAD_DIM)
    v_a = v_a.reshape(b, s, A_HEADS, HEAD_DIM)
    a_out = dilated_attention_mixer(qk, v_a, cos, sin)
    b_out = multiscale_pool(x_b, w_pool, pool_scale)
    m_out = memory_attention(q_m, mem_n, w_mem_kv)
    y = jnp.concatenate([a_out, b_out, m_out], axis=-1) * jax.nn.silu(z)
    return x + y @ w_out


def odd_layer(x, mem_n, g_norm, w_in, ln_g, ln_b, w_s, b_s, w_mem_kv, w_out):
    h = rmsnorm(x, g_norm)
    proj = h @ w_in
    cuts = np.cumsum([C_WIDTH, C_WIDTH, M_WIDTH]).tolist()
    u, v, q_m, z = jnp.split(proj, cuts, axis=-1)
    c_out = chunked_spatial_gating(u, v, ln_g, ln_b, w_s, b_s)
    m_out = memory_attention(q_m, mem_n, w_mem_kv)
    y = jnp.concatenate([c_out, m_out], axis=-1) * jax.nn.silu(z)
    return x + y @ w_out


def setup_inputs(seed: int = 0) -> dict:
    key = jax.random.key(seed)
    ks = jax.random.split(key, 24)
    nrm = jax.random.normal
    f32 = jnp.float32
    offs = jax.random.randint(ks[2], (BATCH, 1), 0, 1024)
    positions = (jnp.arange(SEQ, dtype=jnp.int32)[None, :] + offs).astype(jnp.int32)
    return {
        "x": nrm(ks[0], (BATCH, SEQ, D_MODEL), f32),
        "mem": nrm(ks[1], (BATCH, N_MEM, D_MODEL), f32),
        "positions": positions,
        "g_mem": 1.0 + 0.02 * nrm(ks[3], (D_MODEL,), f32),
        "even_norm_g": 1.0 + 0.02 * nrm(ks[4], (N_EVEN, D_MODEL), f32),
        "even_w_in": nrm(ks[5], (N_EVEN, D_MODEL, EVEN_IN), f32) * D_MODEL ** -0.5,
        "even_w_pool": nrm(ks[6], (N_EVEN, len(POOL_SIZES), POOL_CH, POOL_CH), f32) * POOL_CH ** -0.5,
        "even_pool_scale": 1.0 + 0.02 * nrm(ks[7], (N_EVEN, B_WIDTH), f32),
        "even_w_mem_kv": nrm(ks[8], (N_EVEN, D_MODEL, 2 * M_WIDTH), f32) * D_MODEL ** -0.5,
        "even_w_out": nrm(ks[9], (N_EVEN, EVEN_MIX, D_MODEL), f32) * EVEN_MIX ** -0.5,
        "odd_norm_g": 1.0 + 0.02 * nrm(ks[10], (N_ODD, D_MODEL), f32),
        "odd_w_in": nrm(ks[11], (N_ODD, D_MODEL, ODD_IN), f32) * D_MODEL ** -0.5,
        "odd_ln_g": 1.0 + 0.02 * nrm(ks[12], (N_ODD, C_WIDTH), f32),
        "odd_ln_b": 0.02 * nrm(ks[13], (N_ODD, C_WIDTH), f32),
        "odd_w_s": nrm(ks[14], (N_ODD, C_GROUPS, CHUNK, CHUNK), f32) * CHUNK ** -0.5,
        "odd_b_s": 1.0 + 0.02 * nrm(ks[15], (N_ODD, C_GROUPS, CHUNK), f32),
        "odd_w_mem_kv": nrm(ks[16], (N_ODD, D_MODEL, 2 * M_WIDTH), f32) * D_MODEL ** -0.5,
        "odd_w_out": nrm(ks[17], (N_ODD, ODD_MIX, D_MODEL), f32) * ODD_MIX ** -0.5,
        "final_norm_g": 1.0 + 0.02 * nrm(ks[18], (D_MODEL,), f32),
    }


def reference(x, mem, positions, g_mem, even_norm_g, even_w_in, even_w_pool, even_pool_scale,
              even_w_mem_kv, even_w_out, odd_norm_g, odd_w_in, odd_ln_g, odd_ln_b, odd_w_s,
              odd_b_s, odd_w_mem_kv, odd_w_out, final_norm_g):
    cos, sin = rope_tables(positions)
    mem_n = rmsnorm(mem, g_mem)
    for layer in range(DEPTH):
        i = layer // 2
        if layer % 2 == 0:
            x = even_layer(x, cos, sin, mem_n, even_norm_g[i], even_w_in[i], even_w_pool[i],
                           even_pool_scale[i], even_w_mem_kv[i], even_w_out[i])
        else:
            x = odd_layer(x, mem_n, odd_norm_g[i], odd_w_in[i], odd_ln_g[i], odd_ln_b[i],
                          odd_w_s[i], odd_b_s[i], odd_w_mem_kv[i], odd_w_out[i])
    return rmsnorm(x, final_norm_g)
```

```cpp
#include <hip/hip_runtime.h>
#include <cstdint>
#include <cstdio>

typedef unsigned short bf16_t;

constexpr int NB = 8, SEQ = 4096, DM = 1024, NT = NB * SEQ;
constexpr int HD = 128, NMEM = 256;
constexpr int EP = 6144, OP = 4096, MIX = 1536;
constexpr int E_VA = 3072, E_XB = 3584, E_QM = 4096, E_Z = 4608;
constexpr int O_U = 0, O_V = 1024, O_QM = 2048, O_Z = 2560;
constexpr float EPS = 1e-6f;
constexpr float ATT_SCALE = 0.08838834764831845f;

constexpr size_t MiB = 1u << 20;
constexpr size_t OFF_CTL = 0;
constexpr size_t OFF_PROJ = 1 * MiB;
constexpr size_t OFF_XB = 385 * MiB;
constexpr size_t OFF_WIN = 449 * MiB;
constexpr size_t OFF_WOUT = 461 * MiB;
constexpr size_t OFF_MEMKV = 464 * MiB;
constexpr size_t OFF_RINV = 480 * MiB;
constexpr size_t OFF_LNST = 481 * MiB;
constexpr size_t OFF_ROPE = 484 * MiB;
constexpr size_t WS_END = 489 * MiB;
constexpr size_t DO_MEMN = 0;
constexpr size_t DO_WMKV = 4 * MiB;

__device__ __forceinline__ float bf2f(bf16_t h) { return __uint_as_float((unsigned)h << 16); }
__device__ __forceinline__ bf16_t f2bf(float f) { unsigned u = __float_as_uint(f); return (bf16_t)((u + 0x7fffu + ((u >> 16) & 1u)) >> 16); }
__device__ __forceinline__ float wave_sum(float v) {
#pragma unroll
    for (int o = 1; o < 64; o <<= 1) v += __shfl_xor(v, o);
    return v;
}
__device__ __forceinline__ float wave_max(float v) {
#pragma unroll
    for (int o = 1; o < 64; o <<= 1) v = fmaxf(v, __shfl_xor(v, o));
    return v;
}
__device__ __forceinline__ float silu(float z) { return z / (1.f + __expf(-z)); }

__constant__ float c_inv_freq[16] = {1.0f, 0.44036659598350525f, 0.1939227432012558f, 0.08539710193872452f, 0.03760603070259094f, 0.01656043902039528f,
    0.007292664609849453f, 0.0032114458736032248f, 0.0014142135623842478f, 0.000622772378847003f, 0.00027424818836152554f, 0.00012076973507646471f,
    5.318296098266728e-05f, 2.34199997066753e-05f, 1.0313386155758053e-05f, 4.541670477919979e-06f};

__global__ void k_convert_wT(const float* __restrict__ W, int K, int N, bf16_t* __restrict__ WT, const float* __restrict__ g) {
    __shared__ float tile[32][33];
    const int nb = N / 32, kb = K / 32, tx = threadIdx.x & 31, ty = threadIdx.x >> 5;
    for (int t = blockIdx.x; t < nb * kb; t += gridDim.x) {
        const int k0 = (t / nb) * 32, n0 = (t % nb) * 32;
        for (int i = ty; i < 32; i += 8) tile[i][tx] = W[(size_t)(k0 + i) * N + n0 + tx] * (g ? g[k0 + i] : 1.f);
        __syncthreads();
        for (int i = ty; i < 32; i += 8) WT[(size_t)(n0 + i) * K + k0 + tx] = f2bf(tile[tx][i]);
        __syncthreads();
    }
}

__global__ void k_rowrms(const float* __restrict__ x, bf16_t* __restrict__ xb, float* __restrict__ rinv, int rows) {
    const int lane = threadIdx.x & 63, gw = (blockIdx.x * blockDim.x + threadIdx.x) >> 6, nw = (gridDim.x * blockDim.x) >> 6;
    for (int r = gw; r < rows; r += nw) {
        const float* xr = x + (size_t)r * DM; float s = 0.f;
        for (int j = lane; j < DM; j += 64) { const float v = xr[j]; s += v * v; if (xb) xb[(size_t)r * DM + j] = f2bf(v); }
        s = wave_sum(s);
        if (lane == 0) rinv[r] = rsqrtf(s * (1.f / DM) + EPS);
    }
}
template <bool OUT_BF16>
__global__ void k_rmsnorm(const float* x, const float* __restrict__ g, void* out, int rows) {
    const int lane = threadIdx.x & 63, gw = (blockIdx.x * blockDim.x + threadIdx.x) >> 6, nw = (gridDim.x * blockDim.x) >> 6;
    for (int r = gw; r < rows; r += nw) {
        const float* xr = x + (size_t)r * DM; float v[16]; float s = 0.f;
#pragma unroll
        for (int j = 0; j < 16; ++j) { v[j] = xr[lane + 64 * j]; s += v[j] * v[j]; }
        s = wave_sum(s); const float ri = rsqrtf(s * (1.f / DM) + EPS);
#pragma unroll
        for (int j = 0; j < 16; ++j) { const float o = v[j] * ri * g[lane + 64 * j];
            if (OUT_BF16) ((bf16_t*)out)[(size_t)r * DM + lane + 64 * j] = f2bf(o); else ((float*)out)[(size_t)r * DM + lane + 64 * j] = o; }
    }
}
__global__ void k_rope_table(const int* __restrict__ pos, float2* __restrict__ tab) {
    const int i = blockIdx.x * blockDim.x + threadIdx.x; if (i >= NT * 16) return;
    const int tok = i >> 4, f = i & 15;
    const float ang = (float)pos[tok] * c_inv_freq[f];
    const double rev = (double)ang * 0.15915494309189535; const float fr = (float)(rev - rint(rev));
    tab[i] = make_float2(__builtin_amdgcn_cosf(fr), __builtin_amdgcn_sinf(fr));
}

template <int MODE>
__global__ void __launch_bounds__(256) k_gemm_naive(const bf16_t* __restrict__ A, int lda, const bf16_t* __restrict__ Bt, int M, int N, int K,
                                                    bf16_t* Cb, int ldc, const float* __restrict__ rscale, const float* R, float* Cf) {
    __shared__ float As[32][65], Bs[32][65];
    const int tid = threadIdx.x, tx = tid & 15, ty = tid >> 4, ntn = N / 64, ntm = M / 64;
    for (int tile = blockIdx.x; tile < ntn * ntm; tile += gridDim.x) {
        const int m0 = (tile / ntn) * 64, n0 = (tile % ntn) * 64;
        float acc[4][4] = {};
        for (int k0 = 0; k0 < K; k0 += 32) {
            { const int r = tid >> 2, c = (tid & 3) * 8;
              const uint4 va = *(const uint4*)(A + (size_t)(m0 + r) * lda + k0 + c), vb = *(const uint4*)(Bt + (size_t)(n0 + r) * K + k0 + c);
              const unsigned wa[4] = {va.x, va.y, va.z, va.w}, wb[4] = {vb.x, vb.y, vb.z, vb.w};
#pragma unroll
              for (int j = 0; j < 4; ++j) { As[c + 2 * j][r] = __uint_as_float(wa[j] << 16); As[c + 2 * j + 1][r] = __uint_as_float(wa[j] & 0xffff0000u);
                                            Bs[c + 2 * j][r] = __uint_as_float(wb[j] << 16); Bs[c + 2 * j + 1][r] = __uint_as_float(wb[j] & 0xffff0000u); } }
            __syncthreads();
#pragma unroll 8
            for (int k = 0; k < 32; ++k) { float a[4], b[4];
#pragma unroll
                for (int i = 0; i < 4; ++i) { a[i] = As[k][ty * 4 + i]; b[i] = Bs[k][tx * 4 + i]; }
#pragma unroll
                for (int i = 0; i < 4; ++i)
#pragma unroll
                    for (int j = 0; j < 4; ++j) acc[i][j] += a[i] * b[j]; }
            __syncthreads();
        }
#pragma unroll
        for (int i = 0; i < 4; ++i) { const int row = m0 + ty * 4 + i;
#pragma unroll
            for (int j = 0; j < 4; ++j) { const int col = n0 + tx * 4 + j;
                if (MODE == 0) Cb[(size_t)row * ldc + col] = f2bf(acc[i][j] * (rscale ? rscale[row] : 1.f));
                else Cf[(size_t)row * DM + col] = R[(size_t)row * DM + col] + acc[i][j]; } }
    }
}

__global__ void k_rope(bf16_t* __restrict__ proj, const float2* __restrict__ tab) {
    const long n = (long)NT * 3 * 2 * 4 * 16;
    for (long it = (long)blockIdx.x * blockDim.x + threadIdx.x; it < n; it += (long)gridDim.x * blockDim.x) {
        const int i = it & 15, h = (it >> 4) & 3, qk = (it >> 6) & 1, g = (int)((it >> 7) % 3); const int tok = (int)(it / (16 * 4 * 2 * 3));
        bf16_t* p = proj + (size_t)tok * EP + g * 1024 + qk * 512 + h * 128;
        const float2 cs = tab[tok * 16 + i]; const float x1 = bf2f(p[i]), x2 = bf2f(p[i + 16]);
        p[i] = f2bf(x1 * cs.x - x2 * cs.y); p[i + 16] = f2bf(x2 * cs.x + x1 * cs.y);
    }
}

__global__ void __launch_bounds__(256) k_attnA_naive(bf16_t* proj) {
    __shared__ float q_s[4][3][128]; __shared__ float p_s[4][448];
    const int lane = threadIdx.x & 63, w = threadIdx.x >> 6, gw = blockIdx.x * 4 + w, nw = gridDim.x * 4;
    for (int item = gw; item < NT * 4; item += nw) {
        const int tok = item >> 2, h = item & 3, b = tok / SEQ, t = tok % SEQ;
        for (int j = lane; j < 384; j += 64) { const int g = j >> 7, d = j & 127; q_s[w][g][d] = bf2f(proj[(size_t)tok * EP + g * 1024 + h * 128 + d]); }
        __syncthreads();
        float sc[7]; float mx = -INFINITY;
#pragma unroll
        for (int i = 0; i < 7; ++i) { const int kk = lane + 64 * i; sc[i] = -INFINITY;
            if (kk < 387) { const int g = kk / 129, off = kk % 129, dil = (g == 0) ? 1 : (g == 1 ? 4 : 16), kpos = t - off * dil;
                if (kpos >= 0) { const bf16_t* kr = proj + (size_t)(b * SEQ + kpos) * EP + g * 1024 + 512 + h * 128; float s = 0.f;
                    for (int d = 0; d < 128; d += 8) { const uint4 v = *(const uint4*)(kr + d); const unsigned wv[4] = {v.x, v.y, v.z, v.w};
#pragma unroll
                        for (int j = 0; j < 4; ++j) s += q_s[w][g][d + 2 * j] * __uint_as_float(wv[j] << 16) + q_s[w][g][d + 2 * j + 1] * __uint_as_float(wv[j] & 0xffff0000u); }
                    sc[i] = s * ATT_SCALE; } }
            mx = fmaxf(mx, sc[i]); }
        mx = wave_max(mx); float l = 0.f;
#pragma unroll
        for (int i = 0; i < 7; ++i) { const float p = __expf(sc[i] - mx); l += p; p_s[w][lane + 64 * i] = p; }
        l = wave_sum(l);
        __syncthreads();
        float a0 = 0.f, a1 = 0.f;
        for (int kk = 0; kk < 387; ++kk) { const int g = kk / 129, off = kk % 129, dil = (g == 0) ? 1 : (g == 1 ? 4 : 16), kpos = t - off * dil;
            if (kpos >= 0) { const float p = p_s[w][kk]; const unsigned v = *(const unsigned*)(proj + (size_t)(b * SEQ + kpos) * EP + E_VA + h * 128 + 2 * lane);
                a0 += p * __uint_as_float(v << 16); a1 += p * __uint_as_float(v & 0xffff0000u); } }
        const float il = 1.f / l; bf16_t* zp = proj + (size_t)tok * EP + E_Z + h * 128 + 2 * lane;
        const float z0 = bf2f(zp[0]), z1 = bf2f(zp[1]);
        zp[0] = f2bf(a0 * il * silu(z0)); zp[1] = f2bf(a1 * il * silu(z1));
        __syncthreads();
    }
}
__global__ void __launch_bounds__(256) k_attnM_naive(bf16_t* proj, int ld, int qcol, int zcol, const bf16_t* __restrict__ mkv) {
    __shared__ float q_s[4][128]; __shared__ float p_s[4][256];
    const int lane = threadIdx.x & 63, w = threadIdx.x >> 6, gw = blockIdx.x * 4 + w, nw = gridDim.x * 4;
    for (int item = gw; item < NT * 4; item += nw) {
        const int tok = item >> 2, h = item & 3, b = tok / SEQ;
        for (int j = lane; j < 128; j += 64) q_s[w][j] = bf2f(proj[(size_t)tok * ld + qcol + h * 128 + j]);
        __syncthreads();
        float sc[4]; float mx = -INFINITY;
#pragma unroll
        for (int i = 0; i < 4; ++i) { const int kk = lane + 64 * i; const bf16_t* kr = mkv + (size_t)(b * NMEM + kk) * 1024 + h * 128; float s = 0.f;
            for (int d = 0; d < 128; d += 8) { const uint4 v = *(const uint4*)(kr + d); const unsigned wv[4] = {v.x, v.y, v.z, v.w};
#pragma unroll
                for (int j = 0; j < 4; ++j) s += q_s[w][d + 2 * j] * __uint_as_float(wv[j] << 16) + q_s[w][d + 2 * j + 1] * __uint_as_float(wv[j] & 0xffff0000u); }
            sc[i] = s * ATT_SCALE; mx = fmaxf(mx, sc[i]); }
        mx = wave_max(mx); float l = 0.f;
#pragma unroll
        for (int i = 0; i < 4; ++i) { const float p = __expf(sc[i] - mx); l += p; p_s[w][lane + 64 * i] = p; }
        l = wave_sum(l);
        __syncthreads();
        float a0 = 0.f, a1 = 0.f;
        for (int kk = 0; kk < 256; ++kk) { const float p = p_s[w][kk]; const unsigned v = *(const unsigned*)(mkv + (size_t)(b * NMEM + kk) * 1024 + 512 + h * 128 + 2 * lane);
            a0 += p * __uint_as_float(v << 16); a1 += p * __uint_as_float(v & 0xffff0000u); }
        const float il = 1.f / l; bf16_t* zp = proj + (size_t)tok * ld + zcol + h * 128 + 2 * lane;
        const float z0 = bf2f(zp[0]), z1 = bf2f(zp[1]);
        zp[0] = f2bf(a0 * il * silu(z0)); zp[1] = f2bf(a1 * il * silu(z1));
        __syncthreads();
    }
}
__global__ void __launch_bounds__(512) k_pool_naive(bf16_t* proj, const float* __restrict__ wpool  , const float* __restrict__ scale  ) {
    __shared__ float pooled[4][128];
    const int tid = threadIdx.x, gi = tid >> 7, c = tid & 127;
    for (int tok = blockIdx.x; tok < NT; tok += gridDim.x) {
        const int t = tok % SEQ, w = 2 << gi, cnt = (t + 1 < w) ? t + 1 : w;
        float s = 0.f;
        for (int j = 0; j < cnt; ++j) s += bf2f(proj[(size_t)(tok - j) * EP + E_XB + gi * 128 + c]);
        pooled[gi][c] = s / (float)cnt - bf2f(proj[(size_t)tok * EP + E_XB + gi * 128 + c]);
        __syncthreads();
        float y = 0.f;
        for (int cc = 0; cc < 128; ++cc) y += pooled[gi][cc] * wpool[(gi * 128 + cc) * 128 + c];
        bf16_t* zp = proj + (size_t)tok * EP + E_Z + 512 + gi * 128 + c;
        *zp = f2bf(y * scale[gi * 128 + c] * silu(bf2f(*zp)));
        __syncthreads();
    }
}
__global__ void __launch_bounds__(512) k_cmix_naive(bf16_t* proj, const float* __restrict__ ln_g, const float* __restrict__ ln_b,
                                                    const float* __restrict__ w_s  , const float* __restrict__ b_s  ) {
    extern __shared__ float smem[];
    float* vn = smem; float* mu = smem + 128 * 128; float* rstd = mu + 128;
    const int tid = threadIdx.x, lane = tid & 63, wv = tid >> 6;
    for (int ch = blockIdx.x; ch < NT / 128; ch += gridDim.x) {
        const size_t row0 = (size_t)ch * 128;
        for (int r = wv; r < 128; r += 8) { const bf16_t* vr = proj + (row0 + r) * OP + O_V; float s = 0.f, s2 = 0.f;
            for (int j = lane; j < 1024; j += 64) { const float v = bf2f(vr[j]); s += v; }
            s = wave_sum(s); const float m = s * (1.f / 1024.f);
            for (int j = lane; j < 1024; j += 64) { const float v = bf2f(vr[j]) - m; s2 += v * v; }
            s2 = wave_sum(s2);
            if (lane == 0) { mu[r] = m; rstd[r] = rsqrtf(s2 * (1.f / 1024.f) + EPS); } }
        __syncthreads();
        for (int g = 0; g < 8; ++g) {
            for (int i = tid; i < 128 * 128; i += 512) { const int s = i >> 7, c = i & 127;
                vn[i] = (bf2f(proj[(row0 + s) * OP + O_V + g * 128 + c]) - mu[s]) * rstd[s] * ln_g[g * 128 + c] + ln_b[g * 128 + c]; }
            __syncthreads();
            const int c = tid & 127, tq = tid >> 7;
            for (int t = tq * 32; t < tq * 32 + 32; ++t) { float acc = 0.f; const float* wr = w_s + ((size_t)g * 128 + t) * 128;
                for (int s = 0; s <= t; ++s) acc += wr[s] * vn[s * 128 + c];
                const float mixed = acc + b_s[g * 128 + t];
                const float u = bf2f(proj[(row0 + t) * OP + O_U + g * 128 + c]);
                bf16_t* zp = proj + (row0 + t) * OP + O_Z + g * 128 + c;
                *zp = f2bf(u * mixed * silu(bf2f(*zp))); }
            __syncthreads();
        }
    }
}

extern "C" void kernel_launch(void* const* d_in, const int* in_sizes, int n_in, void* d_out, int out_size, void* d_ws, size_t ws_size, hipStream_t stream) {
    if (n_in != 19 || in_sizes[0] != NT * DM || out_size != NT * DM || ws_size < WS_END) {
        fprintf(stderr, "kernel_launch: unexpected shapes (n_in %d, in0 %d, out %d, ws %zu; need ws >= %zu)\n", n_in, n_in > 0 ? in_sizes[0] : -1, out_size, ws_size, (size_t)WS_END);
        return;
    }
    static bool attr = false;
    if (!attr) { attr = true; (void)hipFuncSetAttribute((const void*)k_cmix_naive, hipFuncAttributeMaxDynamicSharedMemorySize, (128 * 128 + 256) * 4); }
    const float* x = (const float*)d_in[0]; const float* mem = (const float*)d_in[1]; const int* pos = (const int*)d_in[2]; const float* g_mem = (const float*)d_in[3];
    const float* e_ng = (const float*)d_in[4]; const float* e_win = (const float*)d_in[5]; const float* e_wpool = (const float*)d_in[6]; const float* e_pscale = (const float*)d_in[7];
    const float* e_wmkv = (const float*)d_in[8]; const float* e_wout = (const float*)d_in[9];
    const float* o_ng = (const float*)d_in[10]; const float* o_win = (const float*)d_in[11]; const float* o_lng = (const float*)d_in[12]; const float* o_lnb = (const float*)d_in[13];
    const float* o_ws = (const float*)d_in[14]; const float* o_bs = (const float*)d_in[15]; const float* o_wmkv = (const float*)d_in[16]; const float* o_wout = (const float*)d_in[17];
    const float* f_g = (const float*)d_in[18];
    unsigned char* ws = (unsigned char*)d_ws; float* out = (float*)d_out;
    bf16_t* proj = (bf16_t*)(ws + OFF_PROJ); bf16_t* xb = (bf16_t*)(ws + OFF_XB); bf16_t* win = (bf16_t*)(ws + OFF_WIN); bf16_t* wout = (bf16_t*)(ws + OFF_WOUT);
    bf16_t* memkv = (bf16_t*)(ws + OFF_MEMKV); float* rinv = (float*)(ws + OFF_RINV); float2* rope = (float2*)(ws + OFF_ROPE);
    bf16_t* memn = (bf16_t*)((unsigned char*)d_out + DO_MEMN); bf16_t* wmkv = (bf16_t*)((unsigned char*)d_out + DO_WMKV);
    const int G = 2048;
    k_rmsnorm<true><<<G, 256, 0, stream>>>(mem, g_mem, memn, NB * NMEM);
    k_rope_table<<<(NT * 16 + 255) / 256, 256, 0, stream>>>(pos, rope);
    for (int l = 0; l < 4; ++l) {
        const float* w = (l & 1) ? o_wmkv + (size_t)(l >> 1) * 1024 * 1024 : e_wmkv + (size_t)(l >> 1) * 1024 * 1024;
        k_convert_wT<<<G, 256, 0, stream>>>(w, 1024, 1024, wmkv + (size_t)l * 1024 * 1024, nullptr);
        k_gemm_naive<0><<<G, 256, 0, stream>>>(memn, 1024, wmkv + (size_t)l * 1024 * 1024, NB * NMEM, 1024, 1024, memkv + (size_t)l * 2048 * 1024, 1024, nullptr, nullptr, nullptr);
    }
    for (int l = 0; l < 4; ++l) {
        const int i = l >> 1; const bool odd = l & 1; const int NP = odd ? OP : EP;
        const float* xin = (l == 0) ? x : out;
        k_rowrms<<<G, 256, 0, stream>>>(xin, xb, rinv, NT);
        k_convert_wT<<<G, 256, 0, stream>>>(odd ? o_win + (size_t)i * DM * OP : e_win + (size_t)i * DM * EP, DM, NP, win, odd ? o_ng + i * DM : e_ng + i * DM);
        k_convert_wT<<<G, 256, 0, stream>>>(odd ? o_wout + (size_t)i * MIX * DM : e_wout + (size_t)i * MIX * DM, MIX, DM, wout, nullptr);
        k_gemm_naive<0><<<G, 256, 0, stream>>>(xb, DM, win, NT, NP, DM, proj, NP, rinv, nullptr, nullptr);
        if (!odd) {
            k_rope<<<G, 256, 0, stream>>>(proj, rope);
            k_attnA_naive<<<G, 256, 0, stream>>>(proj);
            k_pool_naive<<<G, 512, 0, stream>>>(proj, e_wpool + (size_t)i * 4 * 128 * 128, e_pscale + i * 512);
            k_attnM_naive<<<G, 256, 0, stream>>>(proj, EP, E_QM, E_Z + 1024, memkv + (size_t)l * 2048 * 1024);
            k_gemm_naive<1><<<G, 256, 0, stream>>>(proj + E_Z, EP, wout, NT, DM, MIX, nullptr, 0, nullptr, xin, out);
        } else {
            k_cmix_naive<<<256, 512, (128 * 128 + 256) * 4, stream>>>(proj, o_lng + i * 1024, o_lnb + i * 1024, o_ws + (size_t)i * 8 * 128 * 128, o_bs + i * 8 * 128);
            k_attnM_naive<<<G, 256, 0, stream>>>(proj, OP, O_QM, O_Z + 1024, memkv + (size_t)l * 2048 * 1024);
            k_gemm_naive<1><<<G, 256, 0, stream>>>(proj + O_Z, OP, wout, NT, DM, MIX, nullptr, 0, nullptr, xin, out);
        }
    }
    k_rmsnorm<false><<<G, 256, 0, stream>>>(out, f_g, out, NT);
}
```

```cpp
#include <hip/hip_runtime.h>
#include <cstdint>
#include <cstdio>

typedef unsigned short bf16_t;
#define LAS __attribute__((address_space(3)))
#define GAS __attribute__((address_space(1)))
typedef short bf16x8 __attribute__((ext_vector_type(8)));
typedef float f32x4 __attribute__((ext_vector_type(4)));
typedef unsigned u32x4 __attribute__((ext_vector_type(4)));
typedef unsigned u32x2 __attribute__((ext_vector_type(2)));

constexpr int NB = 8, SEQ = 4096, DM = 1024, NT = NB * SEQ;
constexpr int HD = 128, NMEM = 256;
constexpr int EP = 6144, OP = 4096, MIX = 1536;
constexpr int E_VA = 3072, E_XB = 3584, E_QM = 4096, E_Z = 4608;
constexpr int O_U = 0, O_V = 1024, O_QM = 2048, O_Z = 2560;
constexpr float EPS = 1e-6f;
constexpr float ATT_SCALE = 0.08838834764831845f;
constexpr int NWAVES = 8, NTHREADS = 512;

constexpr size_t MiB = 1u << 20;
constexpr size_t OFF_CTL = 0, CTL_ZERO_BYTES = 1 * MiB;
constexpr size_t OFF_PROJ = 1 * MiB;
constexpr size_t OFF_XB = 385 * MiB;
constexpr size_t OFF_WIN = 449 * MiB;
constexpr size_t OFF_WOUT = 461 * MiB;
constexpr size_t OFF_MEMKV = 467 * MiB;
constexpr size_t OFF_ROWSS = 483 * MiB;
constexpr size_t OFF_ROPE = 489 * MiB;
constexpr size_t WS_END = 496 * MiB;
constexpr size_t DO_MEMN = 0;
constexpr size_t DO_WMKV = 4 * MiB;
constexpr int CW_BAR = 4096;

constexpr int RING_BYTES = 131072, LDSCTL_OFF = RING_BYTES, MISC_OFF = LDSCTL_OFF + 320, LDS_BYTES = 147456;

__device__ __forceinline__ float bf2f(bf16_t h) { return __uint_as_float((unsigned)h << 16); }
__device__ __forceinline__ unsigned f2bf(float f) { unsigned u = __float_as_uint(f); return (u + 0x7fffu + ((u >> 16) & 1u)) >> 16; }
__device__ __forceinline__ unsigned pk2(float lo, float hi) { return f2bf(lo) | (f2bf(hi) << 16); }
__device__ __forceinline__ float wave_sum(float v) {
#pragma unroll
    for (int o = 1; o < 64; o <<= 1) v += __shfl_xor(v, o);
    return v;
}
__device__ __forceinline__ float wave_max(float v) {
#pragma unroll
    for (int o = 1; o < 64; o <<= 1) v = fmaxf(v, __shfl_xor(v, o));
    return v;
}
__device__ __forceinline__ float silu(float z) { return z / (1.f + __expf(-z)); }

__constant__ float c_inv_freq[16] = {1.0f, 0.44036659598350525f, 0.1939227432012558f, 0.08539710193872452f, 0.03760603070259094f, 0.01656043902039528f,
    0.007292664609849453f, 0.0032114458736032248f, 0.0014142135623842478f, 0.000622772378847003f, 0.00027424818836152554f, 0.00012076973507646471f,
    5.318296098266728e-05f, 2.34199997066753e-05f, 1.0313386155758053e-05f, 4.541670477919979e-06f};

namespace pg8 {
constexpr int BM = 256, BK = 64, HALF = 128, HTB = HALF * BK * 2, STAGE_BYTES = 8 * HTB, NXCD = 8, WGM = 8;
__host__ __device__ __forceinline__ int lds_byte(int r, int c) { const int st = (r >> 4) * 2 + (c >> 5), rr = r & 15, cc = c & 31, ob = rr * 64 + cc * 2; return st * 1024 + (ob ^ (((ob >> 9) & 1) << 5)); }
__host__ __device__ __forceinline__ void stage_rc(int b, int& R, int& C) { const int st = b / 1024, sb = b % 1024, swz = sb ^ (((sb >> 9) & 1) << 5); R = (st >> 1) * 16 + swz / 64; C = (st & 1) * 32 + (swz % 64) / 2; }
__host__ __device__ __forceinline__ int perm32(int rho) { const int n = rho >> 4, i = rho & 15; return 8 * (i >> 2) + 4 * n + (i & 3); }
struct Unit { int pm, pn; };
struct Gemm { const bf16_t* A; const bf16_t* Bt; int M, N, K, lda; };
struct StaticOrder {
    int nM, nN, nwg, G, c;
    __host__ __device__ void init(int M, int N, int G_, int c_) { nM = M / BM; nN = N / BM; nwg = nM * nN; G = G_; c = c_; }
    __host__ __device__ bool next(int i, Unit& u) const {
        const long L = (long)i * G + c; if (L >= nwg) return false;
        int wgid = (int)L; { const int q = nwg / NXCD, r = nwg % NXCD, xcd = wgid % NXCD, off = wgid / NXCD; wgid = (xcd < r ? xcd * (q + 1) : r * (q + 1) + (xcd - r) * q) + off; }
        const int nig = WGM * nN, gid = wgid / nig, fm = gid * WGM, gsz = (nM - fm) < WGM ? (nM - fm) : WGM;
        u.pm = fm + ((wgid % nig) % gsz); u.pn = (wgid % nig) / gsz; return true;
    }
    __device__ __forceinline__ void a_ready(const Unit&) const {}
    __device__ __forceinline__ void done(const Unit&) const {}
};
__device__ __forceinline__ unsigned cvt_pk_bf16(float lo, float hi) { unsigned r; asm volatile("v_cvt_pk_bf16_f32 %0, %1, %2" : "=v"(r) : "v"(lo), "v"(hi)); return r; }

struct EpiIn {
    static constexpr bool PERM = true, AFTER_DRAIN = false;
    bf16_t* O; int ldc; const float* rowss; const float2* rope; int nrope;
    __device__ __forceinline__ void operator()(const f32x4 (&acc)[2][2][4][2], const Unit& u, int wr, int wc, int fr, int fq) const {
        const int row0 = u.pm * BM + wr * 64 + fr, col0 = u.pn * BM + wc * 32 + 8 * fq;
        const bool rp = (u.pn < nrope) && (wc == 0);
#pragma unroll
        for (int ai = 0; ai < 2; ++ai)
#pragma unroll
            for (int m = 0; m < 4; ++m) { const int row = row0 + ai * HALF + m * 16; float r = 1.f;
                if (rowss) { const f32x4 p = *(const f32x4*)(rowss + (size_t)row * 16 + 4 * fq); float s = (p[0] + p[1]) + (p[2] + p[3]);
                    s += __shfl_xor(s, 16); s += __shfl_xor(s, 32); r = rsqrtf(s * (1.f / DM) + EPS); }
                bf16_t* rowp = O + (size_t)row * ldc + col0;
#pragma unroll
                for (int bj = 0; bj < 2; ++bj) { float v[8];
#pragma unroll
                    for (int j = 0; j < 4; ++j) { v[j] = acc[ai][bj][m][0][j] * r; v[4 + j] = acc[ai][bj][m][1][j] * r; }
                    if (rp) { const float2* cs = rope + (size_t)row * 16 + 8 * (fq & 1);
#pragma unroll
                        for (int j = 0; j < 8; ++j) { const float pv = __shfl_xor(v[j], 32); const float2 c = cs[j];
                            v[j] = (fq < 2) ? (v[j] * c.x - pv * c.y) : (v[j] * c.x + pv * c.y); } }
                    u32x4 w; w.x = cvt_pk_bf16(v[0], v[1]); w.y = cvt_pk_bf16(v[2], v[3]); w.z = cvt_pk_bf16(v[4], v[5]); w.w = cvt_pk_bf16(v[6], v[7]);
                    *(u32x4*)(rowp + bj * HALF) = w; } }
    }
};
struct EpiOut {
    static constexpr bool PERM = false, AFTER_DRAIN = false;
    const float* base; float* out; bf16_t* xb; float* rowss;
    __device__ __forceinline__ void operator()(const f32x4 (&acc)[2][2][4][2], const Unit& u, int wr, int wc, int fr, int fq) const {
        const int row0 = u.pm * BM + wr * 64 + fr, col0 = u.pn * BM + wc * 32 + 4 * fq;
#pragma unroll
        for (int ai = 0; ai < 2; ++ai)
#pragma unroll
            for (int m = 0; m < 4; ++m) { const int row = row0 + ai * HALF + m * 16; const size_t off = (size_t)row * DM + col0; float ss = 0.f;
#pragma unroll
                for (int bj = 0; bj < 2; ++bj)
#pragma unroll
                    for (int n = 0; n < 2; ++n) { const f32x4 o = *(const f32x4*)(base + off + bj * HALF + n * 16) + acc[ai][bj][m][n];
                        *(f32x4*)(out + off + bj * HALF + n * 16) = o; ss += (o[0] * o[0] + o[1] * o[1]) + (o[2] * o[2] + o[3] * o[3]);
                        u32x2 w; w.x = cvt_pk_bf16(o[0], o[1]); w.y = cvt_pk_bf16(o[2], o[3]); *(u32x2*)(xb + off + bj * HALF + n * 16) = w; }
                ss += __shfl_xor(ss, 16); ss += __shfl_xor(ss, 32);
                if (fq == 0) rowss[(size_t)row * 16 + u.pn * 4 + wc] = ss; }
    }
};

template <class Epi, class Sched, bool ALIGN_EPI = false, bool SP2 = false>
__device__ __forceinline__ void gemm_phase(LAS unsigned char* lds, const Gemm g, const Sched& S, const Epi& E) {
    int tid_ = threadIdx.x; asm volatile("" : "+v"(tid_));
    const int tid = tid_, wid = __builtin_amdgcn_readfirstlane(tid >> 6), lane = tid & 63, wr = wid >> 2, wc = wid & 3, fr = lane & 15, fq = lane >> 4;
    const int K = g.K, nt = K / BK, lda = g.lda;
    unsigned voffA[2], voffB[2];
#pragma unroll
    for (int i = 0; i < 2; ++i) { int R, C; stage_rc(tid * 16 + i * 8192, R, C); const int Rb = Epi::PERM ? ((R & ~31) + perm32(R & 31)) : R;
        voffA[i] = (unsigned)(R * lda + C) * 2u; voffB[i] = (unsigned)(Rb * K + C) * 2u; }
    const size_t kstep = (size_t)(BK * 2);
    const size_t hstepA = (size_t)HALF * lda * 2, hstepB = (size_t)HALF * K * 2;
    const size_t tstepA = 2 * hstepA, tstepB = 2 * hstepB;
    const unsigned ldsw = (unsigned)wid * 1024u;
    const int aoff = lds_byte(wr * 64 + fr, fq * 8), boff = lds_byte(wc * 32 + fr, fq * 8);
#define PG8_SA(b, h) (((b) * 2 + (h)) * HTB)
#define PG8_SB(b, h) ((4 + (b) * 2 + (h)) * HTB)
#define PG8_STAGE(bufoff, gbase, voff) do { _Pragma("unroll") for (int _i = 0; _i < 2; ++_i) \
        __builtin_amdgcn_global_load_lds((const unsigned*)((const char*)(gbase) + (voff)[_i]), (LAS unsigned*)(lds + (bufoff) + ldsw + _i * 8192), 16, 0, 0); } while (0)
#define PG8_LDA(dst, b, h) do { _Pragma("unroll") for (int m = 0; m < 4; ++m) _Pragma("unroll") for (int k = 0; k < 2; ++k) dst[m][k] = *(const LAS bf16x8*)(lds + PG8_SA(b, h) + aoff + m * 2048 + k * 1024); } while (0)
#define PG8_LDB(dst, b, h) do { _Pragma("unroll") for (int n = 0; n < 2; ++n) _Pragma("unroll") for (int k = 0; k < 2; ++k) dst[n][k] = *(const LAS bf16x8*)(lds + PG8_SB(b, h) + boff + n * 2048 + k * 1024); } while (0)
#define PG8_MMA(ai, bj, At, Bt) do { __builtin_amdgcn_s_setprio(1); _Pragma("unroll") for (int m = 0; m < 4; ++m) _Pragma("unroll") for (int n = 0; n < 2; ++n) _Pragma("unroll") for (int k = 0; k < 2; ++k) \
        acc[ai][bj][m][n] = __builtin_amdgcn_mfma_f32_16x16x32_bf16(Bt[n][k], At[m][k], acc[ai][bj][m][n], 0, 0, 0); __builtin_amdgcn_s_setprio(0); } while (0)
#define PG8_WAIT_V(n) asm volatile("s_waitcnt vmcnt(" #n ")" ::: "memory")
#define PG8_WAIT_L(n) asm volatile("s_waitcnt lgkmcnt(" #n ")" ::: "memory")
#define PG8_BAR __builtin_amdgcn_s_barrier()
#define PG8_SCHED __builtin_amdgcn_sched_barrier(0)
    Unit cur, nxt; int ui = 0;
    if (!S.next(0, cur)) return;
    f32x4 acc[2][2][4][2];
#pragma unroll
    for (int a = 0; a < 2; ++a)
#pragma unroll
        for (int b = 0; b < 2; ++b)
#pragma unroll
            for (int m = 0; m < 4; ++m)
#pragma unroll
                for (int n = 0; n < 2; ++n) acc[a][b][m][n] = (f32x4){0.f, 0.f, 0.f, 0.f};
    bf16x8 At[4][2], B0[2][2], B1[2][2];
    const char* cA = (const char*)g.A + (size_t)cur.pm * tstepA; const char* cB = (const char*)g.Bt + (size_t)cur.pn * tstepB;
    S.a_ready(cur);
    if constexpr (SP2) {
        PG8_STAGE(PG8_SB(0, 0), cB, voffB); PG8_STAGE(PG8_SB(0, 1), cB + hstepB, voffB); PG8_STAGE(PG8_SA(0, 0), cA, voffA); PG8_STAGE(PG8_SA(0, 1), cA + hstepA, voffA);
        if (wr == 1) PG8_BAR;
        PG8_WAIT_V(2); PG8_BAR;
        PG8_STAGE(PG8_SB(1, 0), cB + kstep, voffB); PG8_STAGE(PG8_SA(1, 0), cA + kstep, voffA); PG8_STAGE(PG8_SB(1, 1), cB + hstepB + kstep, voffB);
        PG8_WAIT_V(6); PG8_BAR;
    } else {
        PG8_STAGE(PG8_SB(0, 0), cB, voffB); PG8_STAGE(PG8_SA(0, 0), cA, voffA); PG8_STAGE(PG8_SB(0, 1), cB + hstepB, voffB); PG8_STAGE(PG8_SA(0, 1), cA + hstepA, voffA);
        if (wr == 1) PG8_BAR;
        PG8_WAIT_V(4); PG8_BAR;
        PG8_STAGE(PG8_SB(1, 0), cB + kstep, voffB); PG8_STAGE(PG8_SA(1, 0), cA + kstep, voffA); PG8_STAGE(PG8_SB(1, 1), cB + hstepB + kstep, voffB);
        PG8_WAIT_V(6); PG8_BAR;
    }
    for (;;) {
        const bool has_next = S.next(ui + 1, nxt);
        const char* nA = has_next ? (const char*)g.A + (size_t)nxt.pm * tstepA : cA; const char* nB = has_next ? (const char*)g.Bt + (size_t)nxt.pn * tstepB : cB;
        for (int t = 0; t < nt; t += 2) {
            const bool last = (t == nt - 2);
            const char* a1 = cA + (size_t)(t + 1) * kstep;
            const char* a2 = last ? nA : cA + (size_t)(t + 2) * kstep; const char* b2 = last ? nB : cB + (size_t)(t + 2) * kstep;
            const char* a3 = a2 + kstep; const char* b3 = b2 + kstep;
            if (last && has_next) S.a_ready(nxt);
            if constexpr (SP2) {
            PG8_LDB(B0, 0, 0); PG8_LDB(B1, 0, 1); PG8_SCHED; PG8_LDA(At, 0, 0); PG8_STAGE(PG8_SA(1, 1), a1 + hstepA, voffA);
            PG8_WAIT_V(8); PG8_WAIT_L(0); PG8_BAR; PG8_MMA(0, 0, At, B0); PG8_MMA(0, 1, At, B1); PG8_BAR; PG8_SCHED;
            PG8_LDA(At, 0, 1); PG8_STAGE(PG8_SB(0, 0), b2, voffB); PG8_STAGE(PG8_SB(0, 1), b2 + hstepB, voffB); PG8_STAGE(PG8_SA(0, 0), a2, voffA);
            PG8_WAIT_V(8); PG8_WAIT_L(0); PG8_BAR; PG8_MMA(1, 0, At, B0); PG8_MMA(1, 1, At, B1); PG8_BAR; PG8_SCHED;
            PG8_LDB(B0, 1, 0); PG8_LDB(B1, 1, 1); PG8_SCHED; PG8_LDA(At, 1, 0); PG8_STAGE(PG8_SA(0, 1), a2 + hstepA, voffA);
            PG8_WAIT_V(8); PG8_WAIT_L(0); PG8_BAR; PG8_MMA(0, 0, At, B0); PG8_MMA(0, 1, At, B1); PG8_BAR; PG8_SCHED;
            PG8_LDA(At, 1, 1); PG8_STAGE(PG8_SB(1, 0), b3, voffB); PG8_STAGE(PG8_SB(1, 1), b3 + hstepB, voffB); PG8_STAGE(PG8_SA(1, 0), a3, voffA);
            PG8_WAIT_V(8); PG8_WAIT_L(0); PG8_BAR; PG8_MMA(1, 0, At, B0); PG8_MMA(1, 1, At, B1); PG8_BAR; PG8_SCHED;
            } else {
            PG8_LDB(B0, 0, 0); PG8_SCHED; PG8_LDA(At, 0, 0); PG8_STAGE(PG8_SA(1, 1), a1 + hstepA, voffA);
            PG8_WAIT_L(8); PG8_BAR; PG8_WAIT_L(0); PG8_MMA(0, 0, At, B0); PG8_BAR; PG8_SCHED;
            PG8_LDB(B1, 0, 1); PG8_STAGE(PG8_SB(0, 0), b2, voffB);
            PG8_BAR; PG8_WAIT_L(0); PG8_MMA(0, 1, At, B1); PG8_BAR;
            PG8_LDA(At, 0, 1); PG8_STAGE(PG8_SA(0, 0), a2, voffA);
            PG8_BAR; PG8_WAIT_L(0); PG8_MMA(1, 0, At, B0); PG8_BAR; PG8_SCHED;
            PG8_STAGE(PG8_SB(0, 1), b2 + hstepB, voffB);
            PG8_WAIT_V(6); PG8_BAR; PG8_MMA(1, 1, At, B1); PG8_BAR;
            PG8_LDB(B0, 1, 0); PG8_SCHED; PG8_LDA(At, 1, 0); PG8_STAGE(PG8_SA(0, 1), a2 + hstepA, voffA);
            PG8_WAIT_L(8); PG8_BAR; PG8_WAIT_L(0); PG8_MMA(0, 0, At, B0); PG8_BAR; PG8_SCHED;
            PG8_LDB(B1, 1, 1); PG8_STAGE(PG8_SB(1, 0), b3, voffB);
            PG8_BAR; PG8_WAIT_L(0); PG8_MMA(0, 1, At, B1); PG8_BAR;
            PG8_LDA(At, 1, 1); PG8_STAGE(PG8_SA(1, 0), a3, voffA);
            PG8_BAR; PG8_WAIT_L(0); PG8_MMA(1, 0, At, B0); PG8_BAR; PG8_SCHED;
            PG8_STAGE(PG8_SB(1, 1), b3 + hstepB, voffB);
            PG8_WAIT_V(6); PG8_BAR; PG8_MMA(1, 1, At, B1); PG8_BAR;
            }
        }
        if constexpr (ALIGN_EPI) { if (wr == 0) PG8_BAR; }
        if constexpr (!Epi::AFTER_DRAIN) { E(acc, cur, wr, wc, fr, fq); S.done(cur); }
        if (!has_next) break;
#pragma unroll
        for (int a = 0; a < 2; ++a)
#pragma unroll
            for (int b = 0; b < 2; ++b)
#pragma unroll
                for (int m = 0; m < 4; ++m)
#pragma unroll
                    for (int n = 0; n < 2; ++n) acc[a][b][m][n] = (f32x4){0.f, 0.f, 0.f, 0.f};
        cur = nxt; cA = nA; cB = nB; ++ui;
        if constexpr (ALIGN_EPI) { if (wr == 1) PG8_BAR; }
    }
    PG8_WAIT_V(0);
    if constexpr (!ALIGN_EPI) { if (wr == 0) PG8_BAR; }
    PG8_BAR;
#undef PG8_SA
#undef PG8_SB
#undef PG8_STAGE
#undef PG8_LDA
#undef PG8_LDB
#undef PG8_MMA
#undef PG8_WAIT_V
#undef PG8_WAIT_L
#undef PG8_BAR
#undef PG8_SCHED
}
}

typedef GAS unsigned gu32;
#define RLX_AGENT __ATOMIC_RELAXED, __HIP_MEMORY_SCOPE_AGENT
#define XB_TMO      128
#define XB_XCNT(j)  (256  + 64 * (j))
#define XB_XSUB(j)  (1280 + 64 * (j))
#define XB_XGEN(j)  (2304 + 64 * (j))
#define XB_TOP      3328
#define XB_TOPGEN   3392
#define XCD_BAR_WORDS 3456
#define XB_SPIN_CAP (1u << 18)
__device__ __forceinline__ unsigned xb_ld(unsigned* p)              { return __hip_atomic_load(p, __ATOMIC_RELAXED, __HIP_MEMORY_SCOPE_AGENT); }
__device__ __forceinline__ unsigned xb_add(unsigned* p, unsigned v) { return __hip_atomic_fetch_add(p, v, __ATOMIC_RELAXED, __HIP_MEMORY_SCOPE_AGENT); }
__device__ __forceinline__ unsigned xb_xcc_id() { return (unsigned)__builtin_amdgcn_s_getreg((3 << 11) | 20) & 0xFu; }
#define XB_SPIN(cond, bar) do { unsigned _sp = 0; while (cond) { __builtin_amdgcn_s_sleep(1); \
    if ((++_sp & 255u) == 0u) { if (xb_ld(&(bar)[XB_TMO])) break; if (_sp > XB_SPIN_CAP) { atomicAdd(&(bar)[XB_TMO], 1u); break; } } } } while (0)
struct XcdBarrier { unsigned* bar; unsigned x; volatile LAS unsigned* st; };
__device__ __forceinline__ XcdBarrier xcd_barrier_post(unsigned* bar, volatile LAS unsigned* st) {
    XcdBarrier b; b.bar = bar; b.x = xb_xcc_id(); b.st = st;
    if (threadIdx.x == 0) (void)xb_add(&bar[XB_XCNT(b.x)], 1u);
    return b;
}
__device__ __forceinline__ void xcd_barrier_complete(unsigned* bar, unsigned x, unsigned& nloc, unsigned& nx) {
    const unsigned G = gridDim.x * gridDim.y * gridDim.z;
    unsigned sum, cnt, mine, sp = 0u;
    for (;;) {
        sum = 0u; cnt = 0u; mine = 0u;
#pragma unroll
        for (unsigned j = 0; j < 16; ++j) { const unsigned c = xb_ld(&bar[XB_XCNT(j)]); sum += c; cnt += (c > 0u) ? 1u : 0u; mine = (j == x) ? c : mine; }
        if (sum == G) break;
        __builtin_amdgcn_s_sleep(1);
        if ((++sp & 255u) == 0u) { if (xb_ld(&bar[XB_TMO])) break; if (sp > XB_SPIN_CAP) { atomicAdd(&bar[XB_TMO], 1u); break; } }
    }
    nloc = mine > 0u ? mine : 1u; nx = cnt > 0u ? cnt : 1u;
}
__device__ __forceinline__ void xcd_barrier(const XcdBarrier& b) {
    asm volatile("s_waitcnt vmcnt(0)" ::: "memory");
    __syncthreads();
    if (threadIdx.x == 0) {
        unsigned* bar = b.bar;
        __builtin_amdgcn_s_waitcnt(0);
        unsigned nloc = b.st[0], nx = b.st[1];
        if (nloc == 0u) { xcd_barrier_complete(bar, b.x, nloc, nx); b.st[0] = nloc; b.st[1] = nx; }
        const unsigned old = xb_add(&bar[XB_XSUB(b.x)], 1u);
        const unsigned gen = old / nloc;
        if (old + 1u == (gen + 1u) * nloc) {
            __builtin_amdgcn_fence(__ATOMIC_RELEASE, "agent");
            asm volatile("s_waitcnt vmcnt(0)" ::: "memory");
            const unsigned og = xb_add(&bar[XB_TOP], 1u);
            const unsigned tg = og / nx;
            if (og + 1u == (tg + 1u) * nx) xb_add(&bar[XB_TOPGEN], 1u);
            else XB_SPIN(xb_ld(&bar[XB_TOPGEN]) == tg, bar);
            __builtin_amdgcn_fence(__ATOMIC_ACQUIRE, "agent");
            xb_add(&bar[XB_XGEN(b.x)], 1u);
            asm volatile("s_waitcnt vmcnt(0)" ::: "memory");
        } else {
            XB_SPIN(xb_ld(&bar[XB_XGEN(b.x)]) == gen, bar);
            __builtin_amdgcn_fence(__ATOMIC_ACQUIRE, "agent");
            asm volatile("s_waitcnt vmcnt(0)" ::: "memory");
        }
    }
    __syncthreads();
}

struct Frame {
    LAS unsigned char* lds;
    int tid, lane, wave, vcu, G;
};

__device__ __forceinline__ void transpose_item(const float* __restrict__ W, int K, int N, bf16_t* WT, int row_off, const float* __restrict__ g, LAS float* scr, int item, int lane) {
    const int nblk = N / 32, kb = item / nblk, nb = item % nblk, k0 = 64 * kb, n0 = 32 * nb;
#pragma unroll 8
    for (int i = 0; i < 32; ++i) { const int kk = 2 * i + (lane >> 5); float v = W[(size_t)(k0 + kk) * N + n0 + (lane & 31)]; if (g) v *= g[k0 + kk]; scr[kk * 33 + (lane & 31)] = v; }
    asm volatile("s_waitcnt lgkmcnt(0)" ::: "memory");
    const int c = lane & 7;
#pragma unroll
    for (int j = 0; j < 4; ++j) { const int n = (lane >> 3) + 8 * j; const LAS float* s = scr + (8 * c) * 33 + n;
        u32x4 o; o.x = pk2(s[0 * 33], s[1 * 33]); o.y = pk2(s[2 * 33], s[3 * 33]); o.z = pk2(s[4 * 33], s[5 * 33]); o.w = pk2(s[6 * 33], s[7 * 33]);
        *(u32x4*)(WT + (size_t)(row_off + n0 + n) * K + k0 + 8 * c) = o; }
    asm volatile("s_waitcnt lgkmcnt(0)" ::: "memory");
}
__device__ __forceinline__ void convert_weight(const Frame& F, const float* W, int K, int N, bf16_t* WT, int row_off, const float* g) {
    LAS float* scr = (LAS float*)(F.lds + F.wave * 16384);
    const int gw = F.vcu * NWAVES + F.wave, NGW = F.G * NWAVES, nitems = (K / 64) * (N / 32);
    for (int it = gw; it < nitems; it += NGW) transpose_item(W, K, N, WT, row_off, g, scr, it, F.lane);
}

__device__ __forceinline__ void attnA_naive(const Frame& F, bf16_t* proj) {
    LAS float* q_s = (LAS float*)(F.lds) + F.wave * 384; LAS float* p_s = (LAS float*)(F.lds + 16384) + F.wave * 448;
    const int lane = F.lane, gw = F.vcu * NWAVES + F.wave, nw = F.G * NWAVES;
    for (int item = gw; item < NT * 4; item += nw) {
        const int tok = item >> 2, h = item & 3, b = tok / SEQ, t = tok % SEQ;
        for (int j = lane; j < 384; j += 64) { const int g = j >> 7, d = j & 127; q_s[g * 128 + d] = bf2f(proj[(size_t)tok * EP + g * 1024 + h * 128 + d]); }
        asm volatile("s_waitcnt lgkmcnt(0)" ::: "memory");
        float sc[7]; float mx = -INFINITY;
#pragma unroll
        for (int i = 0; i < 7; ++i) { const int kk = lane + 64 * i; sc[i] = -INFINITY;
            if (kk < 387) { const int g = kk / 129, off = kk % 129, dil = (g == 0) ? 1 : (g == 1 ? 4 : 16), kpos = t - off * dil;
                if (kpos >= 0) { const bf16_t* kr = proj + (size_t)(b * SEQ + kpos) * EP + g * 1024 + 512 + h * 128; float s = 0.f;
                    for (int d = 0; d < 128; d += 8) { const uint4 v = *(const uint4*)(kr + d); const unsigned wv[4] = {v.x, v.y, v.z, v.w};
#pragma unroll
                        for (int j = 0; j < 4; ++j) s += q_s[g * 128 + d + 2 * j] * __uint_as_float(wv[j] << 16) + q_s[g * 128 + d + 2 * j + 1] * __uint_as_float(wv[j] & 0xffff0000u); }
                    sc[i] = s * ATT_SCALE; } }
            mx = fmaxf(mx, sc[i]); }
        mx = wave_max(mx); float l = 0.f;
#pragma unroll
        for (int i = 0; i < 7; ++i) { const float p = __expf(sc[i] - mx); l += p; p_s[lane + 64 * i] = p; }
        l = wave_sum(l);
        asm volatile("s_waitcnt lgkmcnt(0)" ::: "memory");
        float a0 = 0.f, a1 = 0.f;
        for (int kk = 0; kk < 387; ++kk) { const int g = kk / 129, off = kk % 129, dil = (g == 0) ? 1 : (g == 1 ? 4 : 16), kpos = t - off * dil;
            if (kpos >= 0) { const float p = p_s[kk]; const unsigned v = *(const unsigned*)(proj + (size_t)(b * SEQ + kpos) * EP + E_VA + h * 128 + 2 * lane);
                a0 += p * __uint_as_float(v << 16); a1 += p * __uint_as_float(v & 0xffff0000u); } }
        const float il = 1.f / l; bf16_t* zp = proj + (size_t)tok * EP + E_Z + h * 128 + 2 * lane;
        const unsigned zz = *(const unsigned*)zp;
        *(unsigned*)zp = pk2(a0 * il * silu(__uint_as_float(zz << 16)), a1 * il * silu(__uint_as_float(zz & 0xffff0000u)));
        asm volatile("s_waitcnt lgkmcnt(0)" ::: "memory");
    }
}
__device__ __forceinline__ void attnM_naive(const Frame& F, bf16_t* proj, int ld, int qcol, int zcol, const bf16_t* __restrict__ mkv  ) {
    LAS float* q_s = (LAS float*)(F.lds) + F.wave * 128; LAS float* p_s = (LAS float*)(F.lds + 16384) + F.wave * 256;
    const int lane = F.lane, gw = F.vcu * NWAVES + F.wave, nw = F.G * NWAVES;
    for (int item = gw; item < NT * 4; item += nw) {
        const int tok = item >> 2, h = item & 3, b = tok / SEQ;
        for (int j = lane; j < 128; j += 64) q_s[j] = bf2f(proj[(size_t)tok * ld + qcol + h * 128 + j]);
        asm volatile("s_waitcnt lgkmcnt(0)" ::: "memory");
        float sc[4]; float mx = -INFINITY;
#pragma unroll
        for (int i = 0; i < 4; ++i) { const int kk = lane + 64 * i; const bf16_t* kr = mkv + (size_t)(b * NMEM + kk) * 4096 + h * 128; float s = 0.f;
            for (int d = 0; d < 128; d += 8) { const uint4 v = *(const uint4*)(kr + d); const unsigned wv[4] = {v.x, v.y, v.z, v.w};
#pragma unroll
                for (int j = 0; j < 4; ++j) s += q_s[d + 2 * j] * __uint_as_float(wv[j] << 16) + q_s[d + 2 * j + 1] * __uint_as_float(wv[j] & 0xffff0000u); }
            sc[i] = s * ATT_SCALE; mx = fmaxf(mx, sc[i]); }
        mx = wave_max(mx); float l = 0.f;
#pragma unroll
        for (int i = 0; i < 4; ++i) { const float p = __expf(sc[i] - mx); l += p; p_s[lane + 64 * i] = p; }
        l = wave_sum(l);
        asm volatile("s_waitcnt lgkmcnt(0)" ::: "memory");
        float a0 = 0.f, a1 = 0.f;
        for (int kk = 0; kk < 256; ++kk) { const float p = p_s[kk]; const unsigned v = *(const unsigned*)(mkv + (size_t)(b * NMEM + kk) * 4096 + 512 + h * 128 + 2 * lane);
            a0 += p * __uint_as_float(v << 16); a1 += p * __uint_as_float(v & 0xffff0000u); }
        const float il = 1.f / l; bf16_t* zp = proj + (size_t)tok * ld + zcol + h * 128 + 2 * lane;
        const unsigned zz = *(const unsigned*)zp;
        *(unsigned*)zp = pk2(a0 * il * silu(__uint_as_float(zz << 16)), a1 * il * silu(__uint_as_float(zz & 0xffff0000u)));
        asm volatile("s_waitcnt lgkmcnt(0)" ::: "memory");
    }
}
__device__ __forceinline__ void pool_naive(const Frame& F, bf16_t* proj, const float* __restrict__ wpool, const float* __restrict__ scale) {
    LAS float* pooled = (LAS float*)(F.lds);
    const int tid = F.tid, gi = tid >> 7, c = tid & 127;
    for (int tok = F.vcu; tok < NT; tok += F.G) {
        const int t = tok % SEQ, w = 2 << gi, cnt = (t + 1 < w) ? t + 1 : w;
        float s = 0.f;
        for (int j = 0; j < cnt; ++j) s += bf2f(proj[(size_t)(tok - j) * EP + E_XB + gi * 128 + c]);
        pooled[gi * 128 + c] = s / (float)cnt - bf2f(proj[(size_t)tok * EP + E_XB + gi * 128 + c]);
        __syncthreads();
        float y = 0.f;
        for (int cc = 0; cc < 128; ++cc) y += pooled[gi * 128 + cc] * wpool[(gi * 128 + cc) * 128 + c];
        bf16_t* zp = proj + (size_t)tok * EP + E_Z + 512 + gi * 128 + c;
        *zp = (bf16_t)f2bf(y * scale[gi * 128 + c] * silu(bf2f(*zp)));
        __syncthreads();
    }
}
__device__ __forceinline__ void cmix_naive(const Frame& F, bf16_t* proj, const float* __restrict__ ln_g, const float* __restrict__ ln_b,
                                           const float* __restrict__ w_s, const float* __restrict__ b_s) {
    LAS float* vn = (LAS float*)(F.lds); LAS float* mu = vn + 128 * 128; LAS float* rstd = mu + 128;
    const int tid = F.tid, lane = F.lane, wv = F.wave;
    for (int ch = F.vcu; ch < NT / 128; ch += F.G) {
        const size_t row0 = (size_t)ch * 128;
        for (int r = wv; r < 128; r += 8) { const bf16_t* vr = proj + (row0 + r) * OP + O_V; float s = 0.f, s2 = 0.f;
            for (int j = lane; j < 1024; j += 64) { const float v = bf2f(vr[j]); s += v; }
            s = wave_sum(s); const float m = s * (1.f / 1024.f);
            for (int j = lane; j < 1024; j += 64) { const float v = bf2f(vr[j]) - m; s2 += v * v; }
            s2 = wave_sum(s2);
            if (lane == 0) { mu[r] = m; rstd[r] = rsqrtf(s2 * (1.f / 1024.f) + EPS); } }
        __syncthreads();
        for (int g = 0; g < 8; ++g) {
            for (int i = tid; i < 128 * 128; i += NTHREADS) { const int s = i >> 7, c = i & 127;
                vn[i] = (bf2f(proj[(row0 + s) * OP + O_V + g * 128 + c]) - mu[s]) * rstd[s] * ln_g[g * 128 + c] + ln_b[g * 128 + c]; }
            __syncthreads();
            const int c = tid & 127, tq = tid >> 7;
            for (int t = tq * 32; t < tq * 32 + 32; ++t) { float acc = 0.f; const float* wr = w_s + ((size_t)g * 128 + t) * 128;
                for (int s = 0; s <= t; ++s) acc += wr[s] * vn[s * 128 + c];
                const float mixed = acc + b_s[g * 128 + t];
                const float u = bf2f(proj[(row0 + t) * OP + O_U + g * 128 + c]);
                bf16_t* zp = proj + (row0 + t) * OP + O_Z + g * 128 + c;
                *zp = (bf16_t)f2bf(u * mixed * silu(bf2f(*zp))); }
            __syncthreads();
        }
    }
}

struct Args { const void* in[19]; float* out; unsigned char* ws; };
__global__ void __launch_bounds__(NTHREADS, 2) mega_fwd(Args args) {
    extern __shared__ __attribute__((aligned(16))) unsigned char lds_raw[];
    Frame F;
    F.lds = (LAS unsigned char*)lds_raw;
    F.tid = threadIdx.x; F.lane = F.tid & 63; F.wave = __builtin_amdgcn_readfirstlane(F.tid >> 6);
    F.G = gridDim.x; { const int bx = blockIdx.x; F.vcu = (F.G % 8 == 0) ? (bx % 8) * (F.G / 8) + bx / 8 : bx; }
    volatile LAS unsigned* MISC = (volatile LAS unsigned*)(F.lds + MISC_OFF);
    unsigned char* ws = args.ws;
    for (int u = F.tid; u < (LDS_BYTES - LDSCTL_OFF) / 4; u += NTHREADS) ((LAS unsigned*)(F.lds + LDSCTL_OFF))[u] = 0u;
    __syncthreads();
    XcdBarrier bar = xcd_barrier_post((unsigned*)(ws + OFF_CTL) + CW_BAR, MISC + 8);
#define GRID_BAR() xcd_barrier(bar)
#define REFRESH() do { int t_ = threadIdx.x; asm volatile("" : "+v"(t_)); F.tid = t_; F.lane = t_ & 63; F.wave = __builtin_amdgcn_readfirstlane(t_ >> 6); } while (0)

    const float* x = (const float*)args.in[0]; const float* mem = (const float*)args.in[1]; const int* pos = (const int*)args.in[2]; const float* g_mem = (const float*)args.in[3];
    const float* e_ng = (const float*)args.in[4]; const float* e_win = (const float*)args.in[5]; const float* e_wpool = (const float*)args.in[6]; const float* e_pscale = (const float*)args.in[7];
    const float* e_wmkv = (const float*)args.in[8]; const float* e_wout = (const float*)args.in[9];
    const float* o_ng = (const float*)args.in[10]; const float* o_win = (const float*)args.in[11]; const float* o_lng = (const float*)args.in[12]; const float* o_lnb = (const float*)args.in[13];
    const float* o_ws = (const float*)args.in[14]; const float* o_bs = (const float*)args.in[15]; const float* o_wmkv = (const float*)args.in[16]; const float* o_wout = (const float*)args.in[17];
    const float* f_g = (const float*)args.in[18];
    float* out = args.out;
    bf16_t* proj = (bf16_t*)(ws + OFF_PROJ); bf16_t* xb = (bf16_t*)(ws + OFF_XB); bf16_t* win = (bf16_t*)(ws + OFF_WIN); bf16_t* wout = (bf16_t*)(ws + OFF_WOUT);
    bf16_t* memkv = (bf16_t*)(ws + OFF_MEMKV); float* rowss = (float*)(ws + OFF_ROWSS); float2* rope = (float2*)(ws + OFF_ROPE);
    bf16_t* memn = (bf16_t*)((unsigned char*)args.out + DO_MEMN); bf16_t* wmkv = (bf16_t*)((unsigned char*)args.out + DO_WMKV);
    const int NGW = F.G * NWAVES;
    { const int gw = F.vcu * NWAVES + F.wave, lane = F.lane;

    convert_weight(F, e_win, DM, EP, win, 0, e_ng);
    convert_weight(F, e_wout, MIX, DM, wout, 0, nullptr);
    for (int l = 0; l < 4; ++l) convert_weight(F, ((l & 1) ? o_wmkv : e_wmkv) + (size_t)(l >> 1) * DM * 1024, DM, 1024, wmkv, l * 1024, nullptr);
    for (int r = gw; r < NT; r += NGW) {
        const float* xr = x + (size_t)r * DM; float s = 0.f;
#pragma unroll
        for (int j = 0; j < 4; ++j) { const f32x4 v = *(const f32x4*)(xr + 4 * lane + 256 * j); s += (v[0] * v[0] + v[1] * v[1]) + (v[2] * v[2] + v[3] * v[3]);
            u32x2 w; w.x = pk2(v[0], v[1]); w.y = pk2(v[2], v[3]); *(u32x2*)(xb + (size_t)r * DM + 4 * lane + 256 * j) = w; }
        s = wave_sum(s);
        if (lane < 16) rowss[(size_t)r * 16 + lane] = (lane == 0) ? s : 0.f;
    }
    for (int r = gw; r < NB * NMEM; r += NGW) {
        const float* xr = mem + (size_t)r * DM; f32x4 v[4]; float s = 0.f;
#pragma unroll
        for (int j = 0; j < 4; ++j) { v[j] = *(const f32x4*)(xr + 4 * lane + 256 * j); s += (v[j][0] * v[j][0] + v[j][1] * v[j][1]) + (v[j][2] * v[j][2] + v[j][3] * v[j][3]); }
        s = wave_sum(s); const float ri = rsqrtf(s * (1.f / DM) + EPS);
#pragma unroll
        for (int j = 0; j < 4; ++j) { const f32x4 gg = *(const f32x4*)(g_mem + 4 * lane + 256 * j);
            u32x2 w; w.x = pk2(v[j][0] * ri * gg[0], v[j][1] * ri * gg[1]); w.y = pk2(v[j][2] * ri * gg[2], v[j][3] * ri * gg[3]); *(u32x2*)(memn + (size_t)r * DM + 4 * lane + 256 * j) = w; }
    }
    for (int i = F.vcu * NTHREADS + F.tid; i < NT * 16; i += F.G * NTHREADS) {
        const int tok = i >> 4, f = i & 15; const float ang = (float)pos[tok] * c_inv_freq[f];
        const double rev = (double)ang * 0.15915494309189535; const float fr = (float)(rev - rint(rev));
        rope[i] = make_float2(__builtin_amdgcn_cosf(fr), __builtin_amdgcn_sinf(fr));
    }
    }
    GRID_BAR();

    { pg8::Gemm g{memn, wmkv, NB * NMEM, 4096, DM, DM}; pg8::StaticOrder S; S.init(NB * NMEM, 4096, F.G, (int)blockIdx.x);
      pg8::EpiIn E{memkv, 4096, nullptr, nullptr, 0};
      pg8::gemm_phase<pg8::EpiIn, pg8::StaticOrder, true, true>(F.lds, g, S, E); }

    for (int l = 0; l < 4; ++l) {
        const int i = l >> 1; const bool odd = l & 1; const int NP = odd ? OP : EP;
        { pg8::Gemm g{xb, win, NT, NP, DM, DM}; pg8::StaticOrder S; S.init(NT, NP, F.G, (int)blockIdx.x);
          pg8::EpiIn E{proj, NP, rowss, rope, odd ? 0 : 12};
          pg8::gemm_phase<pg8::EpiIn, pg8::StaticOrder, true, true>(F.lds, g, S, E); }
        GRID_BAR();
        REFRESH();
        if (l < 3) { const int l1 = l + 1, i1 = l1 >> 1;
            if (l1 & 1) { convert_weight(F, o_win + (size_t)i1 * DM * OP, DM, OP, win, 0, o_ng + i1 * DM); convert_weight(F, o_wout + (size_t)i1 * MIX * DM, MIX, DM, wout + (size_t)(l1 & 1) * DM * MIX, 0, nullptr); }
            else        { convert_weight(F, e_win + (size_t)i1 * DM * EP, DM, EP, win, 0, e_ng + i1 * DM); convert_weight(F, e_wout + (size_t)i1 * MIX * DM, MIX, DM, wout + (size_t)(l1 & 1) * DM * MIX, 0, nullptr); }
            __syncthreads(); }
        if (!odd) {
            REFRESH(); attnA_naive(F, proj); __syncthreads();
            REFRESH(); pool_naive(F, proj, e_wpool + (size_t)i * 4 * 128 * 128, e_pscale + i * 512); __syncthreads();
            REFRESH(); attnM_naive(F, proj, EP, E_QM, E_Z + 1024, memkv + l * 1024); __syncthreads();
        } else {
            REFRESH(); cmix_naive(F, proj, o_lng + i * 1024, o_lnb + i * 1024, o_ws + (size_t)i * 8 * 128 * 128, o_bs + i * 8 * 128); __syncthreads();
            REFRESH(); attnM_naive(F, proj, OP, O_QM, O_Z + 1024, memkv + l * 1024); __syncthreads();
        }
        GRID_BAR();
        { pg8::Gemm g{proj + (odd ? O_Z : E_Z), wout + (size_t)(l & 1) * DM * MIX, NT, DM, MIX, NP}; pg8::StaticOrder S; S.init(NT, DM, F.G, (int)blockIdx.x);
          pg8::EpiOut E{l == 0 ? x : out, out, xb, rowss};
          pg8::gemm_phase<pg8::EpiOut, pg8::StaticOrder, true, true>(F.lds, g, S, E); }
        GRID_BAR();
    }
    REFRESH();
    for (int r = F.vcu * NWAVES + F.wave; r < NT; r += NGW) { const int lane = F.lane;
        float* xr = out + (size_t)r * DM; f32x4 v[4]; float s = 0.f;
#pragma unroll
        for (int j = 0; j < 4; ++j) { v[j] = *(const f32x4*)(xr + 4 * lane + 256 * j); s += (v[j][0] * v[j][0] + v[j][1] * v[j][1]) + (v[j][2] * v[j][2] + v[j][3] * v[j][3]); }
        s = wave_sum(s); const float ri = rsqrtf(s * (1.f / DM) + EPS);
#pragma unroll
        for (int j = 0; j < 4; ++j) { const f32x4 gg = *(const f32x4*)(f_g + 4 * lane + 256 * j); *(f32x4*)(xr + 4 * lane + 256 * j) = v[j] * ri * gg; }
    }
}

extern "C" void kernel_launch(void* const* d_in, const int* in_sizes, int n_in, void* d_out, int out_size, void* d_ws, size_t ws_size, hipStream_t stream) {
    static int grid = 0;
    if (grid == 0) {
        if (n_in != 19 || in_sizes[0] != NT * DM || out_size != NT * DM || ws_size < WS_END) {
            fprintf(stderr, "kernel_launch: unexpected shapes (n_in %d, in0 %d, out %d, ws %zu; need ws >= %zu)\n", n_in, n_in > 0 ? in_sizes[0] : -1, out_size, ws_size, (size_t)WS_END);
            grid = -1; return; }
        int dev = 0, cus = 0;
        if (hipGetDevice(&dev) != hipSuccess || hipDeviceGetAttribute(&cus, hipDeviceAttributeMultiprocessorCount, dev) != hipSuccess) { grid = -1; return; }
        if (hipFuncSetAttribute((const void*)mega_fwd, hipFuncAttributeMaxDynamicSharedMemorySize, LDS_BYTES) != hipSuccess) { fprintf(stderr, "kernel_launch: hipFuncSetAttribute failed\n"); grid = -1; return; }
        int per_cu = 0;
        if (hipOccupancyMaxActiveBlocksPerMultiprocessor(&per_cu, (const void*)mega_fwd, NTHREADS, LDS_BYTES) != hipSuccess || per_cu < 1)
            fprintf(stderr, "kernel_launch: note: occupancy query reports %d workgroups per CU\n", per_cu);
        (void)hipGetLastError();
        grid = cus;
    }
    if (grid < 0) return;
    if (hipMemsetAsync((char*)d_ws + OFF_CTL, 0, CTL_ZERO_BYTES, stream) != hipSuccess) return;
    Args a{};
    for (int i = 0; i < 19; ++i) a.in[i] = d_in[i];
    a.out = (float*)d_out; a.ws = (unsigned char*)d_ws;
    hipLaunchKernelGGL(mega_fwd, dim3(grid), dim3(NTHREADS), LDS_BYTES, stream, a);
}
```

```cpp
#include <hip/hip_runtime.h>
#include <cstdint>
#include <cstdio>

typedef unsigned short bf16_t;
#define LAS __attribute__((address_space(3)))
#define GAS __attribute__((address_space(1)))
typedef short bf16x8 __attribute__((ext_vector_type(8)));
typedef float f32x4 __attribute__((ext_vector_type(4)));
typedef unsigned u32x4 __attribute__((ext_vector_type(4)));
typedef unsigned u32x2 __attribute__((ext_vector_type(2)));

constexpr int NB = 8, SEQ = 4096, DM = 1024, NT = NB * SEQ;
constexpr int HD = 128, NMEM = 256;
constexpr int EP = 6144, OP = 4096, MIX = 1536;
constexpr int E_VA = 3072, E_XB = 3584, E_QM = 4096, E_Z = 4608;
constexpr int O_U = 0, O_V = 1024, O_QM = 2048, O_Z = 2560;
constexpr float EPS = 1e-6f;
constexpr float ATT_SCALE = 0.08838834764831845f;
constexpr int NWAVES = 8, NTHREADS = 512;

constexpr size_t MiB = 1u << 20;
constexpr size_t OFF_CTL = 0, CTL_ZERO_BYTES = 1 * MiB;
constexpr size_t OFF_PROJ = 1 * MiB;
constexpr size_t OFF_XB = 385 * MiB;
constexpr size_t OFF_WIN = 449 * MiB;
constexpr size_t OFF_WOUT = 461 * MiB;
constexpr size_t OFF_MEMKV = 467 * MiB;
constexpr size_t OFF_ROWSS = 483 * MiB;
constexpr size_t OFF_ROPE = 489 * MiB;
constexpr size_t OFF_LSE = 493 * MiB;
constexpr size_t WS_END = 496 * MiB;
constexpr size_t DO_MEMN = 0;
constexpr size_t DO_WMKV = 4 * MiB;
constexpr int CW_BAR = 4096;

constexpr int RING_BYTES = 131072, LDSCTL_OFF = RING_BYTES, MISC_OFF = LDSCTL_OFF + 320, LDS_BYTES = 147456;

__device__ __forceinline__ float bf2f(bf16_t h) { return __uint_as_float((unsigned)h << 16); }
__device__ __forceinline__ unsigned f2bf(float f) { unsigned u = __float_as_uint(f); return (u + 0x7fffu + ((u >> 16) & 1u)) >> 16; }
__device__ __forceinline__ unsigned pk2(float lo, float hi) { return f2bf(lo) | (f2bf(hi) << 16); }
__device__ __forceinline__ float wave_sum(float v) {
#pragma unroll
    for (int o = 1; o < 64; o <<= 1) v += __shfl_xor(v, o);
    return v;
}
__device__ __forceinline__ float wave_max(float v) {
#pragma unroll
    for (int o = 1; o < 64; o <<= 1) v = fmaxf(v, __shfl_xor(v, o));
    return v;
}
__device__ __forceinline__ float silu(float z) { return z / (1.f + __expf(-z)); }

__constant__ float c_inv_freq[16] = {1.0f, 0.44036659598350525f, 0.1939227432012558f, 0.08539710193872452f, 0.03760603070259094f, 0.01656043902039528f,
    0.007292664609849453f, 0.0032114458736032248f, 0.0014142135623842478f, 0.000622772378847003f, 0.00027424818836152554f, 0.00012076973507646471f,
    5.318296098266728e-05f, 2.34199997066753e-05f, 1.0313386155758053e-05f, 4.541670477919979e-06f};

namespace pg8 {
constexpr int BM = 256, BK = 64, HALF = 128, HTB = HALF * BK * 2, STAGE_BYTES = 8 * HTB, NXCD = 8, WGM = 8;
__host__ __device__ __forceinline__ int lds_byte(int r, int c) { const int st = (r >> 4) * 2 + (c >> 5), rr = r & 15, cc = c & 31, ob = rr * 64 + cc * 2; return st * 1024 + (ob ^ (((ob >> 9) & 1) << 5)); }
__host__ __device__ __forceinline__ void stage_rc(int b, int& R, int& C) { const int st = b / 1024, sb = b % 1024, swz = sb ^ (((sb >> 9) & 1) << 5); R = (st >> 1) * 16 + swz / 64; C = (st & 1) * 32 + (swz % 64) / 2; }
__host__ __device__ __forceinline__ int perm32(int rho) { const int n = rho >> 4, i = rho & 15; return 8 * (i >> 2) + 4 * n + (i & 3); }
struct Unit { int pm, pn; };
struct Gemm { const bf16_t* A; const bf16_t* Bt; int M, N, K, lda; };
struct StaticOrder {
    int nM, nN, nwg, G, c;
    __host__ __device__ void init(int M, int N, int G_, int c_) { nM = M / BM; nN = N / BM; nwg = nM * nN; G = G_; c = c_; }
    __host__ __device__ bool next(int i, Unit& u) const {
        const long L = (long)i * G + c; if (L >= nwg) return false;
        int wgid = (int)L; { const int q = nwg / NXCD, r = nwg % NXCD, xcd = wgid % NXCD, off = wgid / NXCD; wgid = (xcd < r ? xcd * (q + 1) : r * (q + 1) + (xcd - r) * q) + off; }
        const int nig = WGM * nN, gid = wgid / nig, fm = gid * WGM, gsz = (nM - fm) < WGM ? (nM - fm) : WGM;
        u.pm = fm + ((wgid % nig) % gsz); u.pn = (wgid % nig) / gsz; return true;
    }
    __device__ __forceinline__ void a_ready(const Unit&) const {}
    __device__ __forceinline__ void done(const Unit&) const {}
};
__device__ __forceinline__ unsigned cvt_pk_bf16(float lo, float hi) { unsigned r; asm volatile("v_cvt_pk_bf16_f32 %0, %1, %2" : "=v"(r) : "v"(lo), "v"(hi)); return r; }

struct EpiIn {
    static constexpr bool PERM = true, AFTER_DRAIN = false;
    bf16_t* O; int ldc; const float* rowss; const float2* rope; int nrope;
    __device__ __forceinline__ void operator()(const f32x4 (&acc)[2][2][4][2], const Unit& u, int wr, int wc, int fr, int fq) const {
        const int row0 = u.pm * BM + wr * 64 + fr, col0 = u.pn * BM + wc * 32 + 8 * fq;
        const bool rp = (u.pn < nrope) && (wc == 0);
#pragma unroll
        for (int ai = 0; ai < 2; ++ai)
#pragma unroll
            for (int m = 0; m < 4; ++m) { const int row = row0 + ai * HALF + m * 16; float r = 1.f;
                if (rowss) { const f32x4 p = *(const f32x4*)(rowss + (size_t)row * 16 + 4 * fq); float s = (p[0] + p[1]) + (p[2] + p[3]);
                    s += __shfl_xor(s, 16); s += __shfl_xor(s, 32); r = rsqrtf(s * (1.f / DM) + EPS); }
                bf16_t* rowp = O + (size_t)row * ldc + col0;
#pragma unroll
                for (int bj = 0; bj < 2; ++bj) { float v[8];
#pragma unroll
                    for (int j = 0; j < 4; ++j) { v[j] = acc[ai][bj][m][0][j] * r; v[4 + j] = acc[ai][bj][m][1][j] * r; }
                    if (rp) { const float2* cs = rope + (size_t)row * 16 + 8 * (fq & 1);
#pragma unroll
                        for (int j = 0; j < 8; ++j) { const float pv = __shfl_xor(v[j], 32); const float2 c = cs[j];
                            v[j] = (fq < 2) ? (v[j] * c.x - pv * c.y) : (v[j] * c.x + pv * c.y); } }
                    u32x4 w; w.x = cvt_pk_bf16(v[0], v[1]); w.y = cvt_pk_bf16(v[2], v[3]); w.z = cvt_pk_bf16(v[4], v[5]); w.w = cvt_pk_bf16(v[6], v[7]);
                    *(u32x4*)(rowp + bj * HALF) = w; } }
    }
};
struct EpiOut {
    static constexpr bool PERM = false, AFTER_DRAIN = false;
    const float* base; float* out; bf16_t* xb; float* rowss;
    __device__ __forceinline__ void operator()(const f32x4 (&acc)[2][2][4][2], const Unit& u, int wr, int wc, int fr, int fq) const {
        const int row0 = u.pm * BM + wr * 64 + fr, col0 = u.pn * BM + wc * 32 + 4 * fq;
#pragma unroll
        for (int ai = 0; ai < 2; ++ai)
#pragma unroll
            for (int m = 0; m < 4; ++m) { const int row = row0 + ai * HALF + m * 16; const size_t off = (size_t)row * DM + col0; float ss = 0.f;
#pragma unroll
                for (int bj = 0; bj < 2; ++bj)
#pragma unroll
                    for (int n = 0; n < 2; ++n) { const f32x4 o = *(const f32x4*)(base + off + bj * HALF + n * 16) + acc[ai][bj][m][n];
                        *(f32x4*)(out + off + bj * HALF + n * 16) = o; ss += (o[0] * o[0] + o[1] * o[1]) + (o[2] * o[2] + o[3] * o[3]);
                        u32x2 w; w.x = cvt_pk_bf16(o[0], o[1]); w.y = cvt_pk_bf16(o[2], o[3]); *(u32x2*)(xb + off + bj * HALF + n * 16) = w; }
                ss += __shfl_xor(ss, 16); ss += __shfl_xor(ss, 32);
                if (fq == 0) rowss[(size_t)row * 16 + u.pn * 4 + wc] = ss; }
    }
};

template <class Epi, class Sched, bool ALIGN_EPI = false, bool SP2 = false>
__device__ __forceinline__ void gemm_phase(LAS unsigned char* lds, const Gemm g, const Sched& S, const Epi& E, int tid_in) {
    int tid_ = tid_in; asm volatile("" : "+v"(tid_));
    const int tid = tid_, wid = __builtin_amdgcn_readfirstlane(tid >> 6), lane = tid & 63, wr = wid >> 2, wc = wid & 3, fr = lane & 15, fq = lane >> 4;
    const int K = g.K, nt = K / BK, lda = g.lda;
    unsigned voffA[2], voffB[2];
#pragma unroll
    for (int i = 0; i < 2; ++i) { int R, C; stage_rc(tid * 16 + i * 8192, R, C); const int Rb = Epi::PERM ? ((R & ~31) + perm32(R & 31)) : R;
        voffA[i] = (unsigned)(R * lda + C) * 2u; voffB[i] = (unsigned)(Rb * K + C) * 2u; }
    const size_t kstep = (size_t)(BK * 2);
    const size_t hstepA = (size_t)HALF * lda * 2, hstepB = (size_t)HALF * K * 2;
    const size_t tstepA = 2 * hstepA, tstepB = 2 * hstepB;
    const unsigned ldsw = (unsigned)wid * 1024u;
    const int aoff = lds_byte(wr * 64 + fr, fq * 8), boff = lds_byte(wc * 32 + fr, fq * 8);
#define PG8_SA(b, h) (((b) * 2 + (h)) * HTB)
#define PG8_SB(b, h) ((4 + (b) * 2 + (h)) * HTB)
#define PG8_STAGE(bufoff, gbase, voff) do { _Pragma("unroll") for (int _i = 0; _i < 2; ++_i) \
        __builtin_amdgcn_global_load_lds((const unsigned*)((const char*)(gbase) + (voff)[_i]), (LAS unsigned*)(lds + (bufoff) + ldsw + _i * 8192), 16, 0, 0); } while (0)
#define PG8_LDA(dst, b, h) do { _Pragma("unroll") for (int m = 0; m < 4; ++m) _Pragma("unroll") for (int k = 0; k < 2; ++k) dst[m][k] = *(const LAS bf16x8*)(lds + PG8_SA(b, h) + aoff + m * 2048 + k * 1024); } while (0)
#define PG8_LDB(dst, b, h) do { _Pragma("unroll") for (int n = 0; n < 2; ++n) _Pragma("unroll") for (int k = 0; k < 2; ++k) dst[n][k] = *(const LAS bf16x8*)(lds + PG8_SB(b, h) + boff + n * 2048 + k * 1024); } while (0)
#define PG8_MMA(ai, bj, At, Bt) do { __builtin_amdgcn_s_setprio(1); _Pragma("unroll") for (int m = 0; m < 4; ++m) _Pragma("unroll") for (int n = 0; n < 2; ++n) _Pragma("unroll") for (int k = 0; k < 2; ++k) \
        acc[ai][bj][m][n] = __builtin_amdgcn_mfma_f32_16x16x32_bf16(Bt[n][k], At[m][k], acc[ai][bj][m][n], 0, 0, 0); __builtin_amdgcn_s_setprio(0); } while (0)
#define PG8_WAIT_V(n) asm volatile("s_waitcnt vmcnt(" #n ")" ::: "memory")
#define PG8_WAIT_L(n) asm volatile("s_waitcnt lgkmcnt(" #n ")" ::: "memory")
#define PG8_BAR __builtin_amdgcn_s_barrier()
#define PG8_SCHED __builtin_amdgcn_sched_barrier(0)
    Unit cur, nxt; int ui = 0;
    if (!S.next(0, cur)) return;
    f32x4 acc[2][2][4][2];
#pragma unroll
    for (int a = 0; a < 2; ++a)
#pragma unroll
        for (int b = 0; b < 2; ++b)
#pragma unroll
            for (int m = 0; m < 4; ++m)
#pragma unroll
                for (int n = 0; n < 2; ++n) acc[a][b][m][n] = (f32x4){0.f, 0.f, 0.f, 0.f};
    bf16x8 At[4][2], B0[2][2], B1[2][2];
    const char* cA = (const char*)g.A + (size_t)cur.pm * tstepA; const char* cB = (const char*)g.Bt + (size_t)cur.pn * tstepB;
    S.a_ready(cur);
    if constexpr (SP2) {
        PG8_STAGE(PG8_SB(0, 0), cB, voffB); PG8_STAGE(PG8_SB(0, 1), cB + hstepB, voffB); PG8_STAGE(PG8_SA(0, 0), cA, voffA); PG8_STAGE(PG8_SA(0, 1), cA + hstepA, voffA);
        if (wr == 1) PG8_BAR;
        PG8_WAIT_V(2); PG8_BAR;
        PG8_STAGE(PG8_SB(1, 0), cB + kstep, voffB); PG8_STAGE(PG8_SA(1, 0), cA + kstep, voffA); PG8_STAGE(PG8_SB(1, 1), cB + hstepB + kstep, voffB);
        PG8_WAIT_V(6); PG8_BAR;
    } else {
        PG8_STAGE(PG8_SB(0, 0), cB, voffB); PG8_STAGE(PG8_SA(0, 0), cA, voffA); PG8_STAGE(PG8_SB(0, 1), cB + hstepB, voffB); PG8_STAGE(PG8_SA(0, 1), cA + hstepA, voffA);
        if (wr == 1) PG8_BAR;
        PG8_WAIT_V(4); PG8_BAR;
        PG8_STAGE(PG8_SB(1, 0), cB + kstep, voffB); PG8_STAGE(PG8_SA(1, 0), cA + kstep, voffA); PG8_STAGE(PG8_SB(1, 1), cB + hstepB + kstep, voffB);
        PG8_WAIT_V(6); PG8_BAR;
    }
    for (;;) {
        const bool has_next = S.next(ui + 1, nxt);
        const char* nA = has_next ? (const char*)g.A + (size_t)nxt.pm * tstepA : cA; const char* nB = has_next ? (const char*)g.Bt + (size_t)nxt.pn * tstepB : cB;
        for (int t = 0; t < nt; t += 2) {
            const bool last = (t == nt - 2);
            const char* a1 = cA + (size_t)(t + 1) * kstep;
            const char* a2 = last ? nA : cA + (size_t)(t + 2) * kstep; const char* b2 = last ? nB : cB + (size_t)(t + 2) * kstep;
            const char* a3 = a2 + kstep; const char* b3 = b2 + kstep;
            if (last && has_next) S.a_ready(nxt);
            if constexpr (SP2) {
            PG8_LDB(B0, 0, 0); PG8_LDB(B1, 0, 1); PG8_SCHED; PG8_LDA(At, 0, 0); PG8_STAGE(PG8_SA(1, 1), a1 + hstepA, voffA);
            PG8_WAIT_V(8); PG8_WAIT_L(0); PG8_BAR; PG8_MMA(0, 0, At, B0); PG8_MMA(0, 1, At, B1); PG8_BAR; PG8_SCHED;
            PG8_LDA(At, 0, 1); PG8_STAGE(PG8_SB(0, 0), b2, voffB); PG8_STAGE(PG8_SB(0, 1), b2 + hstepB, voffB); PG8_STAGE(PG8_SA(0, 0), a2, voffA);
            PG8_WAIT_V(8); PG8_WAIT_L(0); PG8_BAR; PG8_MMA(1, 0, At, B0); PG8_MMA(1, 1, At, B1); PG8_BAR; PG8_SCHED;
            PG8_LDB(B0, 1, 0); PG8_LDB(B1, 1, 1); PG8_SCHED; PG8_LDA(At, 1, 0); PG8_STAGE(PG8_SA(0, 1), a2 + hstepA, voffA);
            PG8_WAIT_V(8); PG8_WAIT_L(0); PG8_BAR; PG8_MMA(0, 0, At, B0); PG8_MMA(0, 1, At, B1); PG8_BAR; PG8_SCHED;
            PG8_LDA(At, 1, 1); PG8_STAGE(PG8_SB(1, 0), b3, voffB); PG8_STAGE(PG8_SB(1, 1), b3 + hstepB, voffB); PG8_STAGE(PG8_SA(1, 0), a3, voffA);
            PG8_WAIT_V(8); PG8_WAIT_L(0); PG8_BAR; PG8_MMA(1, 0, At, B0); PG8_MMA(1, 1, At, B1); PG8_BAR; PG8_SCHED;
            } else {
            PG8_LDB(B0, 0, 0); PG8_SCHED; PG8_LDA(At, 0, 0); PG8_STAGE(PG8_SA(1, 1), a1 + hstepA, voffA);
            PG8_WAIT_L(8); PG8_BAR; PG8_WAIT_L(0); PG8_MMA(0, 0, At, B0); PG8_BAR; PG8_SCHED;
            PG8_LDB(B1, 0, 1); PG8_STAGE(PG8_SB(0, 0), b2, voffB);
            PG8_BAR; PG8_WAIT_L(0); PG8_MMA(0, 1, At, B1); PG8_BAR;
            PG8_LDA(At, 0, 1); PG8_STAGE(PG8_SA(0, 0), a2, voffA);
            PG8_BAR; PG8_WAIT_L(0); PG8_MMA(1, 0, At, B0); PG8_BAR; PG8_SCHED;
            PG8_STAGE(PG8_SB(0, 1), b2 + hstepB, voffB);
            PG8_WAIT_V(6); PG8_BAR; PG8_MMA(1, 1, At, B1); PG8_BAR;
            PG8_LDB(B0, 1, 0); PG8_SCHED; PG8_LDA(At, 1, 0); PG8_STAGE(PG8_SA(0, 1), a2 + hstepA, voffA);
            PG8_WAIT_L(8); PG8_BAR; PG8_WAIT_L(0); PG8_MMA(0, 0, At, B0); PG8_BAR; PG8_SCHED;
            PG8_LDB(B1, 1, 1); PG8_STAGE(PG8_SB(1, 0), b3, voffB);
            PG8_BAR; PG8_WAIT_L(0); PG8_MMA(0, 1, At, B1); PG8_BAR;
            PG8_LDA(At, 1, 1); PG8_STAGE(PG8_SA(1, 0), a3, voffA);
            PG8_BAR; PG8_WAIT_L(0); PG8_MMA(1, 0, At, B0); PG8_BAR; PG8_SCHED;
            PG8_STAGE(PG8_SB(1, 1), b3 + hstepB, voffB);
            PG8_WAIT_V(6); PG8_BAR; PG8_MMA(1, 1, At, B1); PG8_BAR;
            }
        }
        if constexpr (ALIGN_EPI) { if (wr == 0) PG8_BAR; }
        if constexpr (!Epi::AFTER_DRAIN) { E(acc, cur, wr, wc, fr, fq); S.done(cur); }
        if (!has_next) break;
#pragma unroll
        for (int a = 0; a < 2; ++a)
#pragma unroll
            for (int b = 0; b < 2; ++b)
#pragma unroll
                for (int m = 0; m < 4; ++m)
#pragma unroll
                    for (int n = 0; n < 2; ++n) acc[a][b][m][n] = (f32x4){0.f, 0.f, 0.f, 0.f};
        cur = nxt; cA = nA; cB = nB; ++ui;
        if constexpr (ALIGN_EPI) { if (wr == 1) PG8_BAR; }
    }
    PG8_WAIT_V(0);
    if constexpr (!ALIGN_EPI) { if (wr == 0) PG8_BAR; }
    PG8_BAR;
#undef PG8_SA
#undef PG8_SB
#undef PG8_STAGE
#undef PG8_LDA
#undef PG8_LDB
#undef PG8_MMA
#undef PG8_WAIT_V
#undef PG8_WAIT_L
#undef PG8_BAR
#undef PG8_SCHED
}
}


namespace att {
typedef short s16x4 __attribute__((ext_vector_type(4)));
typedef float f32x16 __attribute__((ext_vector_type(16)));
constexpr int D = 128, NW = 8, QBLK = 32, KVBLK = 64, QB = NW * QBLK;
constexpr int SHM_V = KVBLK * D * 2, SHM_K = KVBLK * D * 2;
constexpr int ATT_LDS_BYTES = 2 * SHM_V + 2 * SHM_K + NW * 64 * 4;
constexpr float SCALE = 0.08838834764831845f, THR = 8.f;
#define KSWZ(row, colB) ((row) * 256 + ((colB) ^ (((row) & 7) << 4)))
#define SBAR() __builtin_amdgcn_sched_barrier(0)
__device__ __forceinline__ int v_st(int k, int c) { const int kk = (k & ~0xC) | ((k & 4) << 1) | ((k & 8) >> 1); return ((kk >> 3) * 4 + (c >> 5)) * 512 + ((kk & 7) * 32 + (c & 31)) * 2; }
__device__ __forceinline__ int v_rd_base(int lane) { return ((lane & 3) << 3) | (((lane >> 2) & 3) << 6) | (((lane >> 4) & 1) << 5) | (((lane >> 5) & 1) << 8); }
constexpr int v_rd_off(int d0, int ks, int half) { return d0 * 512 + ks * 4096 + half * 2048; }
__device__ __forceinline__ int crow(int r, int hi) { return (r & 3) + 8 * (r >> 2) + 4 * hi; }
__device__ __forceinline__ unsigned cvtpk(float lo, float hi) { unsigned r; asm volatile("v_cvt_pk_bf16_f32 %0, %1, %2" : "=v"(r) : "v"(lo), "v"(hi)); return r; }
__device__ __forceinline__ bf16x8 load8(const bf16_t* p) { return *reinterpret_cast<const bf16x8*>(p); }
__device__ __forceinline__ void mask_tile(f32x16& p0, f32x16& p1, int dq, unsigned W) {
    const float NEG = -__builtin_inff();
#pragma unroll
    for (int r = 0; r < 16; ++r) { const int c = (r & 3) + 8 * (r >> 2);
        if ((unsigned)(dq - c) >= W) p0[r] = NEG;
        if ((unsigned)(dq - c - 32) >= W) p1[r] = NEG; }
}
__device__ __forceinline__ void partialSM(f32x16& p0, f32x16& p1, float& m_reg, float& mn, float& alpha) {
    float pmax = p0[0]; for (int r = 1; r < 16; ++r) pmax = fmaxf(pmax, p0[r]); for (int r = 0; r < 16; ++r) pmax = fmaxf(pmax, p1[r]);
    { auto rr = __builtin_amdgcn_permlane32_swap(__float_as_uint(pmax), __float_as_uint(pmax), false, false);
      pmax = fmaxf(__uint_as_float(rr[0]), __uint_as_float(rr[1])); }
    constexpr float C2 = 1.4426950408889634f * SCALE;
    if (__builtin_expect(__all((pmax - m_reg) * SCALE <= THR), 1)) { mn = m_reg; alpha = 1.f; }
    else { mn = fmaxf(m_reg, pmax); alpha = __builtin_amdgcn_exp2f((m_reg - mn) * C2); m_reg = mn; }
    const float mnL = -mn * C2;
    for (int r = 0; r < 16; ++r) p0[r] = fmaf(p0[r], C2, mnL); for (int r = 0; r < 16; ++r) p1[r] = fmaf(p1[r], C2, mnL);
    for (int r = 0; r < 16; ++r) p0[r] = __builtin_amdgcn_exp2f(p0[r]);
}
__device__ __forceinline__ void finishSM(f32x16& p0, f32x16& p1, float alpha, float& l_reg, bf16x8& pa0, bf16x8& pa1, bf16x8& pa2, bf16x8& pa3) {
    for (int r = 0; r < 16; ++r) p1[r] = __builtin_amdgcn_exp2f(p1[r]);
    float ps = 0; for (int r = 0; r < 16; ++r) ps += p0[r]; for (int r = 0; r < 16; ++r) ps += p1[r];
    { auto rr = __builtin_amdgcn_permlane32_swap(__float_as_uint(ps), __float_as_uint(ps), false, false);
      ps = __uint_as_float(rr[0]) + __uint_as_float(rr[1]); }
    l_reg = l_reg * alpha + ps;
#define PK4(P, B_, OUT) do { unsigned a0 = cvtpk(P[B_+0], P[B_+1]), a1 = cvtpk(P[B_+2], P[B_+3]);                          \
        unsigned b0 = cvtpk(P[B_+4], P[B_+5]), b1 = cvtpk(P[B_+6], P[B_+7]);                                             \
        auto r0 = __builtin_amdgcn_permlane32_swap(a0, b0, false, false); auto r1 = __builtin_amdgcn_permlane32_swap(a1, b1, false, false); \
        u32x4 w = {r0[0], r1[0], r0[1], r1[1]}; OUT = *reinterpret_cast<bf16x8*>(&w); } while (0)
    PK4(p0, 0, pa0); PK4(p0, 8, pa1); PK4(p1, 0, pa2); PK4(p1, 8, pa3);
#undef PK4
}
template <int KB>
__device__ __forceinline__ void qkt(f32x16& p0, f32x16& p1, const char* K_lds, int r32, int hi, const bf16x8* qr, bool act) {
    if (!act) { const float NEG = -__builtin_inff();
#pragma unroll
        for (int r = 0; r < 16; ++r) { p0[r] = NEG; p1[r] = NEG; } return; }
    p0 = f32x16{}; p1 = f32x16{};
    const char* kb[4];
#pragma unroll
    for (int dd = 0; dd < 4; ++dd) kb[dd] = K_lds + KB * SHM_K + KSWZ(r32, (dd * 16 + hi * 8) * 2);
#pragma unroll
    for (int d0 = 0; d0 < 8; ++d0) { const char* a = kb[d0 & 3] + (d0 >> 2) * 128;
        bf16x8 b0 = *reinterpret_cast<const bf16x8*>(a);
        bf16x8 b1 = *reinterpret_cast<const bf16x8*>(a + 32 * 256);
        p0 = __builtin_amdgcn_mfma_f32_32x32x16_bf16(b0, qr[d0], p0, 0, 0, 0);
        p1 = __builtin_amdgcn_mfma_f32_32x32x16_bf16(b1, qr[d0], p1, 0, 0, 0); }
}
template <int VB>
__device__ __forceinline__ void pv_tile(f32x16* o, int vb0, bf16x8 pa0, bf16x8 pa1, bf16x8 pa2, bf16x8 pa3, bool act) {
    if (!act) return;
#define TRRD(dst, off) asm volatile("ds_read_b64_tr_b16 %0, %1 offset:%2" : "=&v"(dst) : "v"(vb0), "i"(off) : "memory")
#define PV_D0(d0) do { s16x4 l0, l1, l2, l3, h0, h1, h2, h3; constexpr int b_ = VB * SHM_V + v_rd_off(d0, 0, 0); \
        TRRD(l0, b_); TRRD(h0, b_ + 2048); TRRD(l1, b_ + 4096); TRRD(h1, b_ + 6144); TRRD(l2, b_ + 8192); TRRD(h2, b_ + 10240); TRRD(l3, b_ + 12288); TRRD(h3, b_ + 14336); \
        asm volatile("s_waitcnt lgkmcnt(0)" ::: "memory"); SBAR();   \
        o[d0] = __builtin_amdgcn_mfma_f32_32x32x16_bf16(pa0, (bf16x8){l0[0], l0[1], l0[2], l0[3], h0[0], h0[1], h0[2], h0[3]}, o[d0], 0, 0, 0);   \
        o[d0] = __builtin_amdgcn_mfma_f32_32x32x16_bf16(pa1, (bf16x8){l1[0], l1[1], l1[2], l1[3], h1[0], h1[1], h1[2], h1[3]}, o[d0], 0, 0, 0);   \
        o[d0] = __builtin_amdgcn_mfma_f32_32x32x16_bf16(pa2, (bf16x8){l2[0], l2[1], l2[2], l2[3], h2[0], h2[1], h2[2], h2[3]}, o[d0], 0, 0, 0);   \
        o[d0] = __builtin_amdgcn_mfma_f32_32x32x16_bf16(pa3, (bf16x8){l3[0], l3[1], l3[2], l3[3], h3[0], h3[1], h3[2], h3[3]}, o[d0], 0, 0, 0); } while (0)
    PV_D0(0); PV_D0(1); PV_D0(2); PV_D0(3);
#undef PV_D0
#undef TRRD
}
struct BlockRef { const bf16_t* Q; const bf16_t* K; const bf16_t* V; bf16_t* O; float* lse; int P0, pq, pk, skv, W, lsep, mode; };
struct Seam { bf16x8 qr[8]; bf16x8 st_v0, st_v1, st_k0, st_k1; };
__device__ __forceinline__ int swa_jlo(int P0, int W) { const int lowk = P0 - W + 1; return lowk > 0 ? lowk / KVBLK : 0; }
#define ROWK(p, k0, rr, pk_) ((const bf16_t*)((const char*)(p) + (size_t)(unsigned)((((unsigned)((k0) + (rr))) * (unsigned)(pk_) + (unsigned)sc) * 2u)))
#define VMW() asm volatile("s_waitcnt vmcnt(0)" ::: "memory")
#define VMWN(n) asm volatile("s_waitcnt vmcnt(%0)" :: "i"(n) : "memory")
#define SLOAD_H(Kp, Vp, k0, pk_) do { S.st_v0 = load8(ROWK(Vp, k0, sr, pk_)); S.st_v1 = load8(ROWK(Vp, k0, 32 + sr, pk_));              \
                         S.st_k0 = load8(ROWK(Kp, k0, sr, pk_)); S.st_k1 = load8(ROWK(Kp, k0, 32 + sr, pk_)); } while (0)
#define SWRITE_HK(bf) do { *(bf16x8*)(K_lds + (bf) * SHM_K + kws) = S.st_k0; *(bf16x8*)(K_lds + (bf) * SHM_K + kws + 32 * 256) = S.st_k1; } while (0)
#define SWRITE_HV(bf) do { *(bf16x8*)(V_lds + (bf) * SHM_V + vst0) = S.st_v0; *(bf16x8*)(V_lds + (bf) * SHM_V + vst1) = S.st_v1; } while (0)
#define SWRITE_H(bf) do { SWRITE_HV(bf); SWRITE_HK(bf); } while (0)
__device__ __forceinline__ void swa_prime(const BlockRef& cur, char* lds, Seam& S, int tid) {
    const int wid = __builtin_amdgcn_readfirstlane(tid >> 6), lane = tid & 63, r32 = lane & 31, hi = lane >> 5;
    const int sr = tid >> 4, sc = (tid & 15) * 8, kws = KSWZ(sr, sc * 2); char* K_lds = lds + 2 * SHM_V;
    const int kb0 = swa_jlo(cur.P0, cur.W) * KVBLK;
    { const unsigned qoff = ((unsigned)(wid * QBLK + r32) * (unsigned)cur.pq + (unsigned)hi * 8u) * 2u;
      for (int d0 = 0; d0 < 8; ++d0) S.qr[d0] = *(const bf16x8*)((const char*)cur.Q + (size_t)qoff + d0 * 32); }
    SLOAD_H(cur.K, cur.V, kb0, cur.pk); VMW(); SWRITE_HK(0);
    __syncthreads();
}
__device__ __forceinline__ void swa_block(const BlockRef& cur, const BlockRef& nxt, char* lds, Seam& S, int tid) {
    const int wid = __builtin_amdgcn_readfirstlane(tid >> 6), lane = tid & 63, r32 = lane & 31, hi = lane >> 5;
    const int W = cur.W, pk = cur.pk;
    const int j_lo = swa_jlo(cur.P0, W);
    int j_hi = (cur.P0 + QB - 1) / KVBLK + 1; if (j_hi > cur.skv / KVBLK) j_hi = cur.skv / KVBLK;
    const int NT = j_hi - j_lo;
    const int kbn = swa_jlo(nxt.P0, nxt.W) * KVBLK;
    const int qlo = cur.P0 + wid * QBLK, qm = qlo + r32 - 4 * hi;
    char* V_lds = lds; char* K_lds = lds + 2 * SHM_V;
    float* ws = (float*)(lds + 2 * SHM_V + 2 * SHM_K) + wid * 64; float* li_l = ws, * al_l = ws + 32;
    float m_reg = -1e30f, l_reg = 0; f32x16 o[4] = {};
    const int sr = tid >> 4, sc = (tid & 15) * 8, vst0 = v_st(sr, sc), vst1 = v_st(32 + sr, sc), kws = KSWZ(sr, sc * 2);
    const int vb0 = (int)(uintptr_t)V_lds + v_rd_base(lane);
    const bf16_t* Kh = cur.K; const bf16_t* Vh = cur.V;
#define RESC(a) do { if (__any((a) < 1.f)) { if (hi == 0) al_l[r32] = (a); asm volatile("s_waitcnt lgkmcnt(0)" ::: "memory");              \
                     for (int d_ = 0; d_ < 4; ++d_) for (int r = 0; r < 16; ++r) o[d_][r] *= al_l[crow(r, hi)]; } } while (0)
#define KBASE(t) ((j_lo + (t)) * KVBLK)
#define ACT(t) (KBASE(t) <= qlo + QBLK - 1 && KBASE(t) + KVBLK - 1 >= qlo - W + 1)
#define MASKT(P0_, P1_, t) do { const int kb_ = KBASE(t); if (ACT(t) && (kb_ + KVBLK - 1 > qlo || kb_ <= qlo + QBLK - 1 - W)) mask_tile(P0_, P1_, qm - kb_, (unsigned)W); } while (0)
    constexpr int NQL = 8;
#define SEAM_K0() do { VMWN(NQL); SWRITE_HK(0); SBAR(); } while (0)
    f32x16 pA0, pA1, pB0, pB1; float mnA, mnB, alA, alB; bf16x8 pa0, pa1, pa2, pa3;
    SWRITE_HV(0); SBAR();
    if (NT > 1) { SLOAD_H(Kh, Vh, KBASE(1), pk); }
    SBAR(); qkt<0>(pA0, pA1, K_lds, r32, hi, S.qr, ACT(0));
    MASKT(pA0, pA1, 0); partialSM(pA0, pA1, m_reg, mnA, alA);
    if (NT > 1) { VMW(); SWRITE_H(1); }
    __syncthreads();
#define HALF_STEP(PX0, PX1, mnX, alX, PY0, PY1, alY, t, KB, VB, SB) do {                                                      \
        SBAR(); qkt<KB>(PX0, PX1, K_lds, r32, hi, S.qr, ACT(t));                                             \
        finishSM(PY0, PY1, alY, l_reg, pa0, pa1, pa2, pa3); SBAR();                                                           \
        if ((t) + 1 < NT) { SLOAD_H(Kh, Vh, KBASE((t) + 1), pk); SBAR(); }                                               \
        pv_tile<VB>(o, vb0, pa0, pa1, pa2, pa3, ACT((t) - 1)); MASKT(PX0, PX1, (t)); partialSM(PX0, PX1, m_reg, mnX, alX);                                        \
        __syncthreads();                                                                                                      \
        if ((t) + 1 < NT) { VMW(); SWRITE_H(SB); }                                                                          \
        RESC(alX); __syncthreads(); } while (0)
    for (int t = 1; t + 1 < NT; t += 2) {
        HALF_STEP(pB0, pB1, mnB, alB, pA0, pA1, alA, t, 1, 0, 0);
        HALF_STEP(pA0, pA1, mnA, alA, pB0, pB1, alB, t + 1, 0, 1, 1);
    }
    const bool even = (NT & 1) == 0;
    if (even) { SBAR(); qkt<1>(pB0, pB1, K_lds, r32, hi, S.qr, ACT(NT - 1)); SBAR(); }
    { SLOAD_H(nxt.K, nxt.V, kbn, nxt.pk); SBAR();
        const unsigned qoff = ((unsigned)(wid * QBLK + r32) * (unsigned)nxt.pq + (unsigned)hi * 8u) * 2u;
#pragma unroll
        for (int d0 = 0; d0 < 8; ++d0) S.qr[d0] = *(const bf16x8*)((const char*)nxt.Q + (size_t)qoff + d0 * 32); }
    SBAR();
    finishSM(pA0, pA1, alA, l_reg, pa0, pa1, pa2, pa3); SBAR();
    pv_tile<0>(o, vb0, pa0, pa1, pa2, pa3, ACT(even ? NT - 2 : NT - 1));
    if (even) { MASKT(pB0, pB1, NT - 1); partialSM(pB0, pB1, m_reg, mnB, alB); __syncthreads(); RESC(alB);
        finishSM(pB0, pB1, alB, l_reg, pa0, pa1, pa2, pa3); SBAR(); pv_tile<1>(o, vb0, pa0, pa1, pa2, pa3, ACT(NT - 1)); }
    SBAR(); SEAM_K0();
    if (hi == 0) li_l[r32] = l_reg; asm volatile("s_waitcnt lgkmcnt(0)" ::: "memory");
    float rli[16];
#pragma unroll
    for (int r = 0; r < 16; ++r) rli[r] = __builtin_amdgcn_rcpf(li_l[crow(r, hi)]);
    int r32e = r32, hie = hi; asm volatile("" : "+v"(r32e), "+v"(hie));
    bf16_t* Ow = cur.O + (size_t)(wid * QBLK) * cur.pq;
    const unsigned pqu = (unsigned)cur.pq, lane_off = (unsigned)(4 * hie) * pqu + (unsigned)r32e;
    if (cur.mode == 0) {
        if (hie == 0) cur.lse[(size_t)(wid * QBLK + r32e) * cur.lsep] = m_reg * SCALE + __logf(l_reg);
#pragma unroll
        for (int r = 0; r < 16; ++r) { const unsigned roff = lane_off + (unsigned)((r & 3) + 8 * (r >> 2)) * pqu;
#pragma unroll
            for (int d0 = 0; d0 < 4; ++d0) { const float v = o[d0][r] * rli[r]; const float vn = __shfl_xor(v, 1);
                if ((r32e & 1) == 0) *(unsigned*)(Ow + (size_t)(roff + d0 * 32)) = cvtpk(v, vn); } }
    } else {
#pragma unroll
        for (int r = 0; r < 16; ++r) { const unsigned roff = lane_off + (unsigned)((r & 3) + 8 * (r >> 2)) * pqu;
#pragma unroll
            for (int d0 = 0; d0 < 4; ++d0) { const float v = o[d0][r] * rli[r]; const float vn = __shfl_xor(v, 1);
                if ((r32e & 1) == 0) { unsigned* zp = (unsigned*)(Ow + (size_t)(roff + d0 * 32)); const unsigned zz = *zp;
                    *zp = cvtpk(v * silu(__uint_as_float(zz << 16)), vn * silu(__uint_as_float(zz & 0xffff0000u))); } } }
    }
    __syncthreads();
#undef RESC
#undef KBASE
#undef ACT
#undef MASKT
#undef SEAM_K0
#undef HALF_STEP
}
#undef ROWK
#undef VMW
#undef VMWN
#undef SLOAD_H
#undef SWRITE_HK
#undef SWRITE_HV
#undef SWRITE_H
#undef KSWZ
#undef SBAR
}

typedef GAS unsigned gu32;
#define RLX_AGENT __ATOMIC_RELAXED, __HIP_MEMORY_SCOPE_AGENT
#define XB_TMO      128
#define XB_XCNT(j)  (256  + 64 * (j))
#define XB_XSUB(j)  (1280 + 64 * (j))
#define XB_XGEN(j)  (2304 + 64 * (j))
#define XB_TOP      3328
#define XB_TOPGEN   3392
#define XCD_BAR_WORDS 3456
#define XB_SPIN_CAP (1u << 18)
__device__ __forceinline__ unsigned xb_ld(unsigned* p)              { return __hip_atomic_load(p, __ATOMIC_RELAXED, __HIP_MEMORY_SCOPE_AGENT); }
__device__ __forceinline__ unsigned xb_add(unsigned* p, unsigned v) { return __hip_atomic_fetch_add(p, v, __ATOMIC_RELAXED, __HIP_MEMORY_SCOPE_AGENT); }
__device__ __forceinline__ unsigned xb_xcc_id() { return (unsigned)__builtin_amdgcn_s_getreg((3 << 11) | 20) & 0xFu; }
#define XB_SPIN(cond, bar) do { unsigned _sp = 0; while (cond) { __builtin_amdgcn_s_sleep(1); \
    if ((++_sp & 255u) == 0u) { if (xb_ld(&(bar)[XB_TMO])) break; if (_sp > XB_SPIN_CAP) { atomicAdd(&(bar)[XB_TMO], 1u); break; } } } } while (0)
struct XcdBarrier { unsigned* bar; unsigned x; volatile LAS unsigned* st; };
__device__ __forceinline__ XcdBarrier xcd_barrier_post(unsigned* bar, volatile LAS unsigned* st, int tid) {
    XcdBarrier b; b.bar = bar; b.x = xb_xcc_id(); b.st = st;
    if (tid == 0) (void)xb_add(&bar[XB_XCNT(b.x)], 1u);
    return b;
}
__device__ __forceinline__ void xcd_barrier_complete(unsigned* bar, unsigned x, unsigned& nloc, unsigned& nx) {
    const unsigned G = gridDim.x * gridDim.y * gridDim.z;
    unsigned sum, cnt, mine, sp = 0u;
    for (;;) {
        sum = 0u; cnt = 0u; mine = 0u;
#pragma unroll
        for (unsigned j = 0; j < 16; ++j) { const unsigned c = xb_ld(&bar[XB_XCNT(j)]); sum += c; cnt += (c > 0u) ? 1u : 0u; mine = (j == x) ? c : mine; }
        if (sum == G) break;
        __builtin_amdgcn_s_sleep(1);
        if ((++sp & 255u) == 0u) { if (xb_ld(&bar[XB_TMO])) break; if (sp > XB_SPIN_CAP) { atomicAdd(&bar[XB_TMO], 1u); break; } }
    }
    nloc = mine > 0u ? mine : 1u; nx = cnt > 0u ? cnt : 1u;
}
__device__ __forceinline__ void xcd_barrier(const XcdBarrier& b, int tid) {
    asm volatile("s_waitcnt vmcnt(0)" ::: "memory");
    __syncthreads();
    if (tid == 0) {
        unsigned* bar = b.bar;
        __builtin_amdgcn_s_waitcnt(0);
        unsigned nloc = b.st[0], nx = b.st[1];
        if (nloc == 0u) { xcd_barrier_complete(bar, b.x, nloc, nx); b.st[0] = nloc; b.st[1] = nx; }
        const unsigned old = xb_add(&bar[XB_XSUB(b.x)], 1u);
        const unsigned gen = old / nloc;
        if (old + 1u == (gen + 1u) * nloc) {
            __builtin_amdgcn_fence(__ATOMIC_RELEASE, "agent");
            asm volatile("s_waitcnt vmcnt(0)" ::: "memory");
            const unsigned og = xb_add(&bar[XB_TOP], 1u);
            const unsigned tg = og / nx;
            if (og + 1u == (tg + 1u) * nx) xb_add(&bar[XB_TOPGEN], 1u);
            else XB_SPIN(xb_ld(&bar[XB_TOPGEN]) == tg, bar);
            __builtin_amdgcn_fence(__ATOMIC_ACQUIRE, "agent");
            xb_add(&bar[XB_XGEN(b.x)], 1u);
            asm volatile("s_waitcnt vmcnt(0)" ::: "memory");
        } else {
            XB_SPIN(xb_ld(&bar[XB_XGEN(b.x)]) == gen, bar);
            __builtin_amdgcn_fence(__ATOMIC_ACQUIRE, "agent");
            asm volatile("s_waitcnt vmcnt(0)" ::: "memory");
        }
    }
    __syncthreads();
}

__device__ __forceinline__ int lane_id_opaque() { int l; asm volatile("v_mbcnt_lo_u32_b32 %0, -1, 0\n\tv_mbcnt_hi_u32_b32 %0, -1, %0" : "=v"(l)); return l; }
struct Frame {
    LAS unsigned char* lds;
    int tid, lane, wave, vcu, G;
};

__device__ __forceinline__ void transpose_item(const float* __restrict__ W, int K, int N, bf16_t* WT, int row_off, const float* __restrict__ g, LAS float* scr, int item, int lane) {
    const int nblk = N / 32, kb = item / nblk, nb = item % nblk, k0 = 64 * kb, n0 = 32 * nb;
#pragma unroll 8
    for (int i = 0; i < 32; ++i) { const int kk = 2 * i + (lane >> 5); float v = W[(size_t)(k0 + kk) * N + n0 + (lane & 31)]; if (g) v *= g[k0 + kk]; scr[kk * 33 + (lane & 31)] = v; }
    asm volatile("s_waitcnt lgkmcnt(0)" ::: "memory");
    const int c = lane & 7;
#pragma unroll
    for (int j = 0; j < 4; ++j) { const int n = (lane >> 3) + 8 * j; const LAS float* s = scr + (8 * c) * 33 + n;
        u32x4 o; o.x = pk2(s[0 * 33], s[1 * 33]); o.y = pk2(s[2 * 33], s[3 * 33]); o.z = pk2(s[4 * 33], s[5 * 33]); o.w = pk2(s[6 * 33], s[7 * 33]);
        *(u32x4*)(WT + (size_t)(row_off + n0 + n) * K + k0 + 8 * c) = o; }
    asm volatile("s_waitcnt lgkmcnt(0)" ::: "memory");
}
__device__ __forceinline__ void convert_weight(const Frame& F, const float* W, int K, int N, bf16_t* WT, int row_off, const float* g) {
    LAS float* scr = (LAS float*)(F.lds + F.wave * 16384);
    const int gw = F.vcu * NWAVES + F.wave, NGW = F.G * NWAVES, nitems = (K / 64) * (N / 32);
    for (int it = gw; it < nitems; it += NGW) transpose_item(W, K, N, WT, row_off, g, scr, it, F.lane);
}

__device__ __forceinline__ void attnA_naive(const Frame& F, bf16_t* proj) {
    LAS float* q_s = (LAS float*)(F.lds) + F.wave * 384; LAS float* p_s = (LAS float*)(F.lds + 16384) + F.wave * 448;
    const int lane = F.lane, gw = F.vcu * NWAVES + F.wave, nw = F.G * NWAVES;
    for (int item = gw; item < NT * 4; item += nw) {
        const int tok = item >> 2, h = item & 3, b = tok / SEQ, t = tok % SEQ;
        for (int j = lane; j < 384; j += 64) { const int g = j >> 7, d = j & 127; q_s[g * 128 + d] = bf2f(proj[(size_t)tok * EP + g * 1024 + h * 128 + d]); }
        asm volatile("s_waitcnt lgkmcnt(0)" ::: "memory");
        float sc[7]; float mx = -INFINITY;
#pragma unroll
        for (int i = 0; i < 7; ++i) { const int kk = lane + 64 * i; sc[i] = -INFINITY;
            if (kk < 387) { const int g = kk / 129, off = kk % 129, dil = (g == 0) ? 1 : (g == 1 ? 4 : 16), kpos = t - off * dil;
                if (kpos >= 0) { const bf16_t* kr = proj + (size_t)(b * SEQ + kpos) * EP + g * 1024 + 512 + h * 128; float s = 0.f;
                    for (int d = 0; d < 128; d += 8) { const uint4 v = *(const uint4*)(kr + d); const unsigned wv[4] = {v.x, v.y, v.z, v.w};
#pragma unroll
                        for (int j = 0; j < 4; ++j) s += q_s[g * 128 + d + 2 * j] * __uint_as_float(wv[j] << 16) + q_s[g * 128 + d + 2 * j + 1] * __uint_as_float(wv[j] & 0xffff0000u); }
                    sc[i] = s * ATT_SCALE; } }
            mx = fmaxf(mx, sc[i]); }
        mx = wave_max(mx); float l = 0.f;
#pragma unroll
        for (int i = 0; i < 7; ++i) { const float p = __expf(sc[i] - mx); l += p; p_s[lane + 64 * i] = p; }
        l = wave_sum(l);
        asm volatile("s_waitcnt lgkmcnt(0)" ::: "memory");
        float a0 = 0.f, a1 = 0.f;
        for (int kk = 0; kk < 387; ++kk) { const int g = kk / 129, off = kk % 129, dil = (g == 0) ? 1 : (g == 1 ? 4 : 16), kpos = t - off * dil;
            if (kpos >= 0) { const float p = p_s[kk]; const unsigned v = *(const unsigned*)(proj + (size_t)(b * SEQ + kpos) * EP + E_VA + h * 128 + 2 * lane);
                a0 += p * __uint_as_float(v << 16); a1 += p * __uint_as_float(v & 0xffff0000u); } }
        const float il = 1.f / l; bf16_t* zp = proj + (size_t)tok * EP + E_Z + h * 128 + 2 * lane;
        const unsigned zz = *(const unsigned*)zp;
        *(unsigned*)zp = pk2(a0 * il * silu(__uint_as_float(zz << 16)), a1 * il * silu(__uint_as_float(zz & 0xffff0000u)));
        asm volatile("s_waitcnt lgkmcnt(0)" ::: "memory");
    }
}
__device__ __forceinline__ void attnM_naive(const Frame& F, bf16_t* proj, int ld, int qcol, int zcol, const bf16_t* __restrict__ mkv  ) {
    LAS float* q_s = (LAS float*)(F.lds) + F.wave * 128; LAS float* p_s = (LAS float*)(F.lds + 16384) + F.wave * 256;
    const int lane = F.lane, gw = F.vcu * NWAVES + F.wave, nw = F.G * NWAVES;
    for (int item = gw; item < NT * 4; item += nw) {
        const int tok = item >> 2, h = item & 3, b = tok / SEQ;
        for (int j = lane; j < 128; j += 64) q_s[j] = bf2f(proj[(size_t)tok * ld + qcol + h * 128 + j]);
        asm volatile("s_waitcnt lgkmcnt(0)" ::: "memory");
        float sc[4]; float mx = -INFINITY;
#pragma unroll
        for (int i = 0; i < 4; ++i) { const int kk = lane + 64 * i; const bf16_t* kr = mkv + (size_t)(b * NMEM + kk) * 4096 + h * 128; float s = 0.f;
            for (int d = 0; d < 128; d += 8) { const uint4 v = *(const uint4*)(kr + d); const unsigned wv[4] = {v.x, v.y, v.z, v.w};
#pragma unroll
                for (int j = 0; j < 4; ++j) s += q_s[d + 2 * j] * __uint_as_float(wv[j] << 16) + q_s[d + 2 * j + 1] * __uint_as_float(wv[j] & 0xffff0000u); }
            sc[i] = s * ATT_SCALE; mx = fmaxf(mx, sc[i]); }
        mx = wave_max(mx); float l = 0.f;
#pragma unroll
        for (int i = 0; i < 4; ++i) { const float p = __expf(sc[i] - mx); l += p; p_s[lane + 64 * i] = p; }
        l = wave_sum(l);
        asm volatile("s_waitcnt lgkmcnt(0)" ::: "memory");
        float a0 = 0.f, a1 = 0.f;
        for (int kk = 0; kk < 256; ++kk) { const float p = p_s[kk]; const unsigned v = *(const unsigned*)(mkv + (size_t)(b * NMEM + kk) * 4096 + 512 + h * 128 + 2 * lane);
            a0 += p * __uint_as_float(v << 16); a1 += p * __uint_as_float(v & 0xffff0000u); }
        const float il = 1.f / l; bf16_t* zp = proj + (size_t)tok * ld + zcol + h * 128 + 2 * lane;
        const unsigned zz = *(const unsigned*)zp;
        *(unsigned*)zp = pk2(a0 * il * silu(__uint_as_float(zz << 16)), a1 * il * silu(__uint_as_float(zz & 0xffff0000u)));
        asm volatile("s_waitcnt lgkmcnt(0)" ::: "memory");
    }
}
__device__ __forceinline__ void pool_naive(const Frame& F, bf16_t* proj, const float* __restrict__ wpool, const float* __restrict__ scale) {
    LAS float* pooled = (LAS float*)(F.lds);
    const int tid = F.tid, gi = tid >> 7, c = tid & 127;
    for (int tok = F.vcu; tok < NT; tok += F.G) {
        const int t = tok % SEQ, w = 2 << gi, cnt = (t + 1 < w) ? t + 1 : w;
        float s = 0.f;
        for (int j = 0; j < cnt; ++j) s += bf2f(proj[(size_t)(tok - j) * EP + E_XB + gi * 128 + c]);
        pooled[gi * 128 + c] = s / (float)cnt - bf2f(proj[(size_t)tok * EP + E_XB + gi * 128 + c]);
        __syncthreads();
        float y = 0.f;
        for (int cc = 0; cc < 128; ++cc) y += pooled[gi * 128 + cc] * wpool[(gi * 128 + cc) * 128 + c];
        bf16_t* zp = proj + (size_t)tok * EP + E_Z + 512 + gi * 128 + c;
        *zp = (bf16_t)f2bf(y * scale[gi * 128 + c] * silu(bf2f(*zp)));
        __syncthreads();
    }
}
__device__ __forceinline__ void cmix_naive(const Frame& F, bf16_t* proj, const float* __restrict__ ln_g, const float* __restrict__ ln_b,
                                           const float* __restrict__ w_s, const float* __restrict__ b_s) {
    LAS float* vn = (LAS float*)(F.lds); LAS float* mu = vn + 128 * 128; LAS float* rstd = mu + 128;
    const int tid = F.tid, lane = F.lane, wv = F.wave;
    for (int ch = F.vcu; ch < NT / 128; ch += F.G) {
        const size_t row0 = (size_t)ch * 128;
        for (int r = wv; r < 128; r += 8) { const bf16_t* vr = proj + (row0 + r) * OP + O_V; float s = 0.f, s2 = 0.f;
            for (int j = lane; j < 1024; j += 64) { const float v = bf2f(vr[j]); s += v; }
            s = wave_sum(s); const float m = s * (1.f / 1024.f);
            for (int j = lane; j < 1024; j += 64) { const float v = bf2f(vr[j]) - m; s2 += v * v; }
            s2 = wave_sum(s2);
            if (lane == 0) { mu[r] = m; rstd[r] = rsqrtf(s2 * (1.f / 1024.f) + EPS); } }
        __syncthreads();
        for (int g = 0; g < 8; ++g) {
            for (int i = tid; i < 128 * 128; i += NTHREADS) { const int s = i >> 7, c = i & 127;
                vn[i] = (bf2f(proj[(row0 + s) * OP + O_V + g * 128 + c]) - mu[s]) * rstd[s] * ln_g[g * 128 + c] + ln_b[g * 128 + c]; }
            __syncthreads();
            const int c = tid & 127, tq = tid >> 7;
            for (int t = tq * 32; t < tq * 32 + 32; ++t) { float acc = 0.f; const float* wr = w_s + ((size_t)g * 128 + t) * 128;
                for (int s = 0; s <= t; ++s) acc += wr[s] * vn[s * 128 + c];
                const float mixed = acc + b_s[g * 128 + t];
                const float u = bf2f(proj[(row0 + t) * OP + O_U + g * 128 + c]);
                bf16_t* zp = proj + (row0 + t) * OP + O_Z + g * 128 + c;
                *zp = (bf16_t)f2bf(u * mixed * silu(bf2f(*zp))); }
            __syncthreads();
        }
    }
}


__device__ __forceinline__ att::BlockRef att_item(int L, bool even, bf16_t* proj, const bf16_t* mkv, float* lse) {
    att::BlockRef r;
    if (even && L < 1536) {
        const int g = L >> 9, rem = L & 511, b = rem >> 6, h = (rem >> 4) & 3, x = rem & 15;
        const int dsh = 2 * g, dil = 1 << dsh, nqb = 16 >> dsh, rr = x >> (4 - dsh), qb = x & (nqb - 1);
        const size_t tok0 = (size_t)b * SEQ + rr;
        bf16_t* base = proj + tok0 * EP;
        r.Q = base + (size_t)qb * 256 * dil * EP + g * 1024 + h * 128; r.O = base + (size_t)qb * 256 * dil * EP + g * 1024 + h * 128;
        r.K = base + g * 1024 + 512 + h * 128; r.V = base + E_VA + h * 128;
        r.P0 = qb * 256; r.pq = dil * EP; r.pk = dil * EP; r.skv = SEQ >> dsh; r.W = 129; r.mode = 0;
        r.lse = lse + ((size_t)g * NT + tok0 + (size_t)qb * 256 * dil) * 4 + h; r.lsep = dil * 4;
    } else {
        const int m = even ? L - 1536 : L, b = m >> 6, h = (m >> 4) & 3, qb = m & 15;
        const int ld = even ? EP : OP, qcol = even ? E_QM : O_QM, zcol = (even ? E_Z : O_Z) + 1024;
        const size_t row0 = (size_t)b * SEQ + qb * 256;
        r.Q = proj + row0 * ld + qcol + h * 128; r.O = proj + row0 * ld + zcol + h * 128;
        r.K = mkv + (size_t)(b * NMEM) * 4096 + h * 128; r.V = r.K + 512;
        r.P0 = 256; r.pq = ld; r.pk = 4096; r.skv = 256; r.W = 1 << 20; r.mode = 1; r.lse = nullptr; r.lsep = 0;
    }
    return r;
}
__device__ __forceinline__ void attn_phase(char* lds, int vcu, int G, bool even, bf16_t* proj, const bf16_t* mkv, float* lse, int tid_in) {
    int tid = tid_in; asm volatile("" : "+v"(tid));
    const int total = even ? 2048 : 512;
    int L = vcu; if (L >= total) return;
    att::BlockRef cur = att_item(L, even, proj, mkv, lse);
    att::Seam S;
    att::swa_prime(cur, lds, S, tid);
    for (;;) {
        const int Ln = L + G; const bool last = Ln >= total;
        const att::BlockRef nxt = last ? cur : att_item(Ln, even, proj, mkv, lse);
        att::swa_block(cur, nxt, lds, S, tid);
        if (last) break;
        cur = nxt; L = Ln;
    }
}
__device__ __forceinline__ void combine_phase(const Frame& F, bf16_t* proj, const float* __restrict__ lse) {
    const int lane = F.lane, h = lane >> 4, dc = (lane & 15) * 8, NGW = F.G * NWAVES;
    for (int tok = F.vcu * NWAVES + F.wave; tok < NT; tok += NGW) {
        const float l0 = lse[((size_t)0 * NT + tok) * 4 + h], l1 = lse[((size_t)1 * NT + tok) * 4 + h], l2 = lse[((size_t)2 * NT + tok) * 4 + h];
        const float M = fmaxf(l0, fmaxf(l1, l2)); float w0 = __expf(l0 - M), w1 = __expf(l1 - M), w2 = __expf(l2 - M);
        const float inv = 1.f / (w0 + w1 + w2); w0 *= inv; w1 *= inv; w2 *= inv;
        bf16_t* row = proj + (size_t)tok * EP + h * 128 + dc;
        const u32x4 o0 = *(const u32x4*)(row), o1 = *(const u32x4*)(row + 1024), o2 = *(const u32x4*)(row + 2048), zz = *(const u32x4*)(row + E_Z);
        u32x4 y;
#pragma unroll
        for (int j = 0; j < 4; ++j) {
            const float a = w0 * __uint_as_float(o0[j] << 16) + w1 * __uint_as_float(o1[j] << 16) + w2 * __uint_as_float(o2[j] << 16);
            const float b = w0 * __uint_as_float(o0[j] & 0xffff0000u) + w1 * __uint_as_float(o1[j] & 0xffff0000u) + w2 * __uint_as_float(o2[j] & 0xffff0000u);
            y[j] = pk2(a * silu(__uint_as_float(zz[j] << 16)), b * silu(__uint_as_float(zz[j] & 0xffff0000u))); }
        *(u32x4*)(row + E_Z) = y;
    }
}

struct Args { const void* in[19]; float* out; unsigned char* ws; };
__global__ void __launch_bounds__(NTHREADS, 2) mega_fwd(Args args) {
    extern __shared__ __attribute__((aligned(16))) unsigned char lds_raw[];
    Frame F;
    F.lds = (LAS unsigned char*)lds_raw;
    const int wave_s = __builtin_amdgcn_readfirstlane((int)threadIdx.x >> 6);
#define TID() (wave_s * 64 + lane_id_opaque())
    F.tid = TID(); F.lane = F.tid & 63; F.wave = wave_s;
    F.G = gridDim.x; { const int bx = blockIdx.x; F.vcu = (F.G % 8 == 0) ? (bx % 8) * (F.G / 8) + bx / 8 : bx; }
    volatile LAS unsigned* MISC = (volatile LAS unsigned*)(F.lds + MISC_OFF);
    unsigned char* ws = args.ws;
    for (int u = F.tid; u < (LDS_BYTES - LDSCTL_OFF) / 4; u += NTHREADS) ((LAS unsigned*)(F.lds + LDSCTL_OFF))[u] = 0u;
    __syncthreads();
    XcdBarrier bar = xcd_barrier_post((unsigned*)(ws + OFF_CTL) + CW_BAR, MISC + 8, F.tid);
#define GRID_BAR() xcd_barrier(bar, TID())
#define REFRESH() do { int t_ = TID(); asm volatile("" : "+v"(t_)); F.tid = t_; F.lane = t_ & 63; F.wave = wave_s; } while (0)

    const float* x = (const float*)args.in[0]; const float* mem = (const float*)args.in[1]; const int* pos = (const int*)args.in[2]; const float* g_mem = (const float*)args.in[3];
    const float* e_ng = (const float*)args.in[4]; const float* e_win = (const float*)args.in[5]; const float* e_wpool = (const float*)args.in[6]; const float* e_pscale = (const float*)args.in[7];
    const float* e_wmkv = (const float*)args.in[8]; const float* e_wout = (const float*)args.in[9];
    const float* o_ng = (const float*)args.in[10]; const float* o_win = (const float*)args.in[11]; const float* o_lng = (const float*)args.in[12]; const float* o_lnb = (const float*)args.in[13];
    const float* o_ws = (const float*)args.in[14]; const float* o_bs = (const float*)args.in[15]; const float* o_wmkv = (const float*)args.in[16]; const float* o_wout = (const float*)args.in[17];
    const float* f_g = (const float*)args.in[18];
    float* out = args.out;
    bf16_t* proj = (bf16_t*)(ws + OFF_PROJ); bf16_t* xb = (bf16_t*)(ws + OFF_XB); bf16_t* win = (bf16_t*)(ws + OFF_WIN); bf16_t* wout = (bf16_t*)(ws + OFF_WOUT);
    bf16_t* memkv = (bf16_t*)(ws + OFF_MEMKV); float* rowss = (float*)(ws + OFF_ROWSS); float2* rope = (float2*)(ws + OFF_ROPE); float* lse = (float*)(ws + OFF_LSE);
    bf16_t* memn = (bf16_t*)((unsigned char*)args.out + DO_MEMN); bf16_t* wmkv = (bf16_t*)((unsigned char*)args.out + DO_WMKV);
    const int NGW = F.G * NWAVES;
    { const int gw = F.vcu * NWAVES + F.wave, lane = F.lane;

    convert_weight(F, e_win, DM, EP, win, 0, e_ng);
    convert_weight(F, e_wout, MIX, DM, wout, 0, nullptr);
    for (int l = 0; l < 4; ++l) convert_weight(F, ((l & 1) ? o_wmkv : e_wmkv) + (size_t)(l >> 1) * DM * 1024, DM, 1024, wmkv, l * 1024, nullptr);
    for (int r = gw; r < NT; r += NGW) {
        const float* xr = x + (size_t)r * DM; float s = 0.f;
#pragma unroll
        for (int j = 0; j < 4; ++j) { const f32x4 v = *(const f32x4*)(xr + 4 * lane + 256 * j); s += (v[0] * v[0] + v[1] * v[1]) + (v[2] * v[2] + v[3] * v[3]);
            u32x2 w; w.x = pk2(v[0], v[1]); w.y = pk2(v[2], v[3]); *(u32x2*)(xb + (size_t)r * DM + 4 * lane + 256 * j) = w; }
        s = wave_sum(s);
        if (lane < 16) rowss[(size_t)r * 16 + lane] = (lane == 0) ? s : 0.f;
    }
    for (int r = gw; r < NB * NMEM; r += NGW) {
        const float* xr = mem + (size_t)r * DM; f32x4 v[4]; float s = 0.f;
#pragma unroll
        for (int j = 0; j < 4; ++j) { v[j] = *(const f32x4*)(xr + 4 * lane + 256 * j); s += (v[j][0] * v[j][0] + v[j][1] * v[j][1]) + (v[j][2] * v[j][2] + v[j][3] * v[j][3]); }
        s = wave_sum(s); const float ri = rsqrtf(s * (1.f / DM) + EPS);
#pragma unroll
        for (int j = 0; j < 4; ++j) { const f32x4 gg = *(const f32x4*)(g_mem + 4 * lane + 256 * j);
            u32x2 w; w.x = pk2(v[j][0] * ri * gg[0], v[j][1] * ri * gg[1]); w.y = pk2(v[j][2] * ri * gg[2], v[j][3] * ri * gg[3]); *(u32x2*)(memn + (size_t)r * DM + 4 * lane + 256 * j) = w; }
    }
    for (int i = F.vcu * NTHREADS + F.tid; i < NT * 16; i += F.G * NTHREADS) {
        const int tok = i >> 4, f = i & 15; const float ang = (float)pos[tok] * c_inv_freq[f];
        const double rev = (double)ang * 0.15915494309189535; const float fr = (float)(rev - rint(rev));
        rope[i] = make_float2(__builtin_amdgcn_cosf(fr), __builtin_amdgcn_sinf(fr));
    }
    }
    GRID_BAR();

    { pg8::Gemm g{memn, wmkv, NB * NMEM, 4096, DM, DM}; pg8::StaticOrder S; S.init(NB * NMEM, 4096, F.G, (int)blockIdx.x);
      pg8::EpiIn E{memkv, 4096, nullptr, nullptr, 0};
      pg8::gemm_phase<pg8::EpiIn, pg8::StaticOrder, true, true>(F.lds, g, S, E, TID()); }

    for (int l = 0; l < 4; ++l) {
        const int i = l >> 1; const bool odd = l & 1; const int NP = odd ? OP : EP;
        { pg8::Gemm g{xb, win, NT, NP, DM, DM}; pg8::StaticOrder S; S.init(NT, NP, F.G, (int)blockIdx.x);
          pg8::EpiIn E{proj, NP, rowss, rope, odd ? 0 : 12};
          pg8::gemm_phase<pg8::EpiIn, pg8::StaticOrder, true, true>(F.lds, g, S, E, TID()); }
        GRID_BAR();
        REFRESH();
        if (l < 3) { const int l1 = l + 1, i1 = l1 >> 1;
            if (l1 & 1) { convert_weight(F, o_win + (size_t)i1 * DM * OP, DM, OP, win, 0, o_ng + i1 * DM); convert_weight(F, o_wout + (size_t)i1 * MIX * DM, MIX, DM, wout + (size_t)(l1 & 1) * DM * MIX, 0, nullptr); }
            else        { convert_weight(F, e_win + (size_t)i1 * DM * EP, DM, EP, win, 0, e_ng + i1 * DM); convert_weight(F, e_wout + (size_t)i1 * MIX * DM, MIX, DM, wout + (size_t)(l1 & 1) * DM * MIX, 0, nullptr); }
            __syncthreads(); }
        if (!odd) {
            REFRESH(); pool_naive(F, proj, e_wpool + (size_t)i * 4 * 128 * 128, e_pscale + i * 512); __syncthreads();
            attn_phase((char*)lds_raw, F.vcu, F.G, true, proj, memkv + l * 1024, lse, TID());
            GRID_BAR();
            REFRESH(); combine_phase(F, proj, lse);
        } else {
            REFRESH(); cmix_naive(F, proj, o_lng + i * 1024, o_lnb + i * 1024, o_ws + (size_t)i * 8 * 128 * 128, o_bs + i * 8 * 128); __syncthreads();
            attn_phase((char*)lds_raw, F.vcu, F.G, false, proj, memkv + l * 1024, lse, TID());
        }
        GRID_BAR();
        { pg8::Gemm g{proj + (odd ? O_Z : E_Z), wout + (size_t)(l & 1) * DM * MIX, NT, DM, MIX, NP}; pg8::StaticOrder S; S.init(NT, DM, F.G, (int)blockIdx.x);
          pg8::EpiOut E{l == 0 ? x : out, out, xb, rowss};
          pg8::gemm_phase<pg8::EpiOut, pg8::StaticOrder, true, true>(F.lds, g, S, E, TID()); }
        GRID_BAR();
    }
    REFRESH();
    for (int r = F.vcu * NWAVES + F.wave; r < NT; r += NGW) { const int lane = F.lane;
        float* xr = out + (size_t)r * DM; f32x4 v[4]; float s = 0.f;
#pragma unroll
        for (int j = 0; j < 4; ++j) { v[j] = *(const f32x4*)(xr + 4 * lane + 256 * j); s += (v[j][0] * v[j][0] + v[j][1] * v[j][1]) + (v[j][2] * v[j][2] + v[j][3] * v[j][3]); }
        s = wave_sum(s); const float ri = rsqrtf(s * (1.f / DM) + EPS);
#pragma unroll
        for (int j = 0; j < 4; ++j) { const f32x4 gg = *(const f32x4*)(f_g + 4 * lane + 256 * j); *(f32x4*)(xr + 4 * lane + 256 * j) = v[j] * ri * gg; }
    }
}

extern "C" void kernel_launch(void* const* d_in, const int* in_sizes, int n_in, void* d_out, int out_size, void* d_ws, size_t ws_size, hipStream_t stream) {
    static int grid = 0;
    if (grid == 0) {
        if (n_in != 19 || in_sizes[0] != NT * DM || out_size != NT * DM || ws_size < WS_END) {
            fprintf(stderr, "kernel_launch: unexpected shapes (n_in %d, in0 %d, out %d, ws %zu; need ws >= %zu)\n", n_in, n_in > 0 ? in_sizes[0] : -1, out_size, ws_size, (size_t)WS_END);
            grid = -1; return; }
        int dev = 0, cus = 0;
        if (hipGetDevice(&dev) != hipSuccess || hipDeviceGetAttribute(&cus, hipDeviceAttributeMultiprocessorCount, dev) != hipSuccess) { grid = -1; return; }
        if (hipFuncSetAttribute((const void*)mega_fwd, hipFuncAttributeMaxDynamicSharedMemorySize, LDS_BYTES) != hipSuccess) { fprintf(stderr, "kernel_launch: hipFuncSetAttribute failed\n"); grid = -1; return; }
        int per_cu = 0;
        if (hipOccupancyMaxActiveBlocksPerMultiprocessor(&per_cu, (const void*)mega_fwd, NTHREADS, LDS_BYTES) != hipSuccess || per_cu < 1)
            fprintf(stderr, "kernel_launch: note: occupancy query reports %d workgroups per CU\n", per_cu);
        (void)hipGetLastError();
        grid = cus;
    }
    if (grid < 0) return;
    if (hipMemsetAsync((char*)d_ws + OFF_CTL, 0, CTL_ZERO_BYTES, stream) != hipSuccess) return;
    Args a{};
    for (int i = 0; i < 19; ++i) a.in[i] = d_in[i];
    a.out = (float*)d_out; a.ws = (unsigned char*)d_ws;
    hipLaunchKernelGGL(mega_fwd, dim3(grid), dim3(NTHREADS), LDS_BYTES, stream, a);
}
```

```cpp
#include <hip/hip_runtime.h>
#include <cstdint>
#include <cstdio>

typedef unsigned short bf16_t;
#define LAS __attribute__((address_space(3)))
#define GAS __attribute__((address_space(1)))
typedef short bf16x8 __attribute__((ext_vector_type(8)));
typedef float f32x4 __attribute__((ext_vector_type(4)));
typedef unsigned u32x4 __attribute__((ext_vector_type(4)));
typedef unsigned u32x2 __attribute__((ext_vector_type(2)));

constexpr int NB = 8, SEQ = 4096, DM = 1024, NT = NB * SEQ;
constexpr int HD = 128, NMEM = 256;
constexpr int EP = 6144, OP = 4096, MIX = 1536;
constexpr int E_VA = 3072, E_XB = 3584, E_QM = 4096, E_Z = 4608;
constexpr int O_U = 0, O_V = 1024, O_QM = 2048, O_Z = 2560;
constexpr float EPS = 1e-6f;
constexpr float ATT_SCALE = 0.08838834764831845f;
constexpr int NWAVES = 8, NTHREADS = 512;

constexpr size_t MiB = 1u << 20;
constexpr size_t OFF_CTL = 0, CTL_ZERO_BYTES = 1 * MiB;
constexpr size_t OFF_PROJ = 1 * MiB;
constexpr size_t OFF_XB = 385 * MiB;
constexpr size_t OFF_WIN = 449 * MiB;
constexpr size_t OFF_WOUT = 461 * MiB;
constexpr size_t OFF_MEMKV = 467 * MiB;
constexpr size_t OFF_ROWSS = 483 * MiB;
constexpr size_t OFF_ROPE = 489 * MiB;
constexpr size_t OFF_LSE = 493 * MiB;
constexpr size_t OFF_WPT = 495 * MiB;
constexpr size_t OFF_WSM = OFF_WPT + 256 * 1024;
constexpr size_t WS_END = 496 * MiB;
constexpr size_t DO_MEMN = 0;
constexpr size_t DO_WMKV = 4 * MiB;
constexpr int CW_BAR = 4096;

constexpr int RING_BYTES = 131072, LDSCTL_OFF = RING_BYTES, MISC_OFF = LDSCTL_OFF + 320, LDS_BYTES = 147456;

__device__ __forceinline__ float bf2f(bf16_t h) { return __uint_as_float((unsigned)h << 16); }
__device__ __forceinline__ unsigned f2bf(float f) { unsigned u = __float_as_uint(f); return (u + 0x7fffu + ((u >> 16) & 1u)) >> 16; }
__device__ __forceinline__ unsigned pk2(float lo, float hi) { return f2bf(lo) | (f2bf(hi) << 16); }
__device__ __forceinline__ float wave_sum(float v) {
#pragma unroll
    for (int o = 1; o < 64; o <<= 1) v += __shfl_xor(v, o);
    return v;
}
__device__ __forceinline__ float wave_max(float v) {
#pragma unroll
    for (int o = 1; o < 64; o <<= 1) v = fmaxf(v, __shfl_xor(v, o));
    return v;
}
__device__ __forceinline__ float silu(float z) { return z / (1.f + __expf(-z)); }

__constant__ float c_inv_freq[16] = {1.0f, 0.44036659598350525f, 0.1939227432012558f, 0.08539710193872452f, 0.03760603070259094f, 0.01656043902039528f,
    0.007292664609849453f, 0.0032114458736032248f, 0.0014142135623842478f, 0.000622772378847003f, 0.00027424818836152554f, 0.00012076973507646471f,
    5.318296098266728e-05f, 2.34199997066753e-05f, 1.0313386155758053e-05f, 4.541670477919979e-06f};

namespace pg8 {
constexpr int BM = 256, BK = 64, HALF = 128, HTB = HALF * BK * 2, STAGE_BYTES = 8 * HTB, NXCD = 8, WGM = 8;
__host__ __device__ __forceinline__ int lds_byte(int r, int c) { const int st = (r >> 4) * 2 + (c >> 5), rr = r & 15, cc = c & 31, ob = rr * 64 + cc * 2; return st * 1024 + (ob ^ (((ob >> 9) & 1) << 5)); }
__host__ __device__ __forceinline__ void stage_rc(int b, int& R, int& C) { const int st = b / 1024, sb = b % 1024, swz = sb ^ (((sb >> 9) & 1) << 5); R = (st >> 1) * 16 + swz / 64; C = (st & 1) * 32 + (swz % 64) / 2; }
__host__ __device__ __forceinline__ int perm32(int rho) { const int n = rho >> 4, i = rho & 15; return 8 * (i >> 2) + 4 * n + (i & 3); }
struct Unit { int pm, pn; };
struct Gemm { const bf16_t* A; const bf16_t* Bt; int M, N, K, lda; };
struct StaticOrder {
    int nM, nN, nwg, G, c;
    __host__ __device__ void init(int M, int N, int G_, int c_) { nM = M / BM; nN = N / BM; nwg = nM * nN; G = G_; c = c_; }
    __host__ __device__ bool next(int i, Unit& u) const {
        const long L = (long)i * G + c; if (L >= nwg) return false;
        int wgid = (int)L; { const int q = nwg / NXCD, r = nwg % NXCD, xcd = wgid % NXCD, off = wgid / NXCD; wgid = (xcd < r ? xcd * (q + 1) : r * (q + 1) + (xcd - r) * q) + off; }
        const int nig = WGM * nN, gid = wgid / nig, fm = gid * WGM, gsz = (nM - fm) < WGM ? (nM - fm) : WGM;
        u.pm = fm + ((wgid % nig) % gsz); u.pn = (wgid % nig) / gsz; return true;
    }
    __device__ __forceinline__ void a_ready(const Unit&) const {}
    __device__ __forceinline__ void done(const Unit&) const {}
};
__device__ __forceinline__ unsigned cvt_pk_bf16(float lo, float hi) { unsigned r; asm volatile("v_cvt_pk_bf16_f32 %0, %1, %2" : "=v"(r) : "v"(lo), "v"(hi)); return r; }

struct EpiIn {
    static constexpr bool PERM = true, AFTER_DRAIN = false;
    bf16_t* O; int ldc; const float* rowss; const float2* rope; int nrope;
    __device__ __forceinline__ void operator()(const f32x4 (&acc)[2][2][4][2], const Unit& u, int wr, int wc, int fr, int fq) const {
        const int row0 = u.pm * BM + wr * 64 + fr, col0 = u.pn * BM + wc * 32 + 8 * fq;
        const bool rp = (u.pn < nrope) && (wc == 0);
#pragma unroll
        for (int ai = 0; ai < 2; ++ai)
#pragma unroll
            for (int m = 0; m < 4; ++m) { const int row = row0 + ai * HALF + m * 16; float r = 1.f;
                if (rowss) { const f32x4 p = *(const f32x4*)(rowss + (size_t)row * 16 + 4 * fq); float s = (p[0] + p[1]) + (p[2] + p[3]);
                    s += __shfl_xor(s, 16); s += __shfl_xor(s, 32); r = rsqrtf(s * (1.f / DM) + EPS); }
                bf16_t* rowp = O + (size_t)row * ldc + col0;
#pragma unroll
                for (int bj = 0; bj < 2; ++bj) { float v[8];
#pragma unroll
                    for (int j = 0; j < 4; ++j) { v[j] = acc[ai][bj][m][0][j] * r; v[4 + j] = acc[ai][bj][m][1][j] * r; }
                    if (rp) { const float2* cs = rope + (size_t)row * 16 + 8 * (fq & 1);
#pragma unroll
                        for (int j = 0; j < 8; ++j) { const float pv = __shfl_xor(v[j], 32); const float2 c = cs[j];
                            v[j] = (fq < 2) ? (v[j] * c.x - pv * c.y) : (v[j] * c.x + pv * c.y); } }
                    u32x4 w; w.x = cvt_pk_bf16(v[0], v[1]); w.y = cvt_pk_bf16(v[2], v[3]); w.z = cvt_pk_bf16(v[4], v[5]); w.w = cvt_pk_bf16(v[6], v[7]);
                    *(u32x4*)(rowp + bj * HALF) = w; } }
    }
};
struct EpiOut {
    static constexpr bool PERM = false, AFTER_DRAIN = false;
    const float* base; float* out; bf16_t* xb; float* rowss;
    __device__ __forceinline__ void operator()(const f32x4 (&acc)[2][2][4][2], const Unit& u, int wr, int wc, int fr, int fq) const {
        const int row0 = u.pm * BM + wr * 64 + fr, col0 = u.pn * BM + wc * 32 + 4 * fq;
#pragma unroll
        for (int ai = 0; ai < 2; ++ai)
#pragma unroll
            for (int m = 0; m < 4; ++m) { const int row = row0 + ai * HALF + m * 16; const size_t off = (size_t)row * DM + col0; float ss = 0.f;
#pragma unroll
                for (int bj = 0; bj < 2; ++bj)
#pragma unroll
                    for (int n = 0; n < 2; ++n) { const f32x4 o = *(const f32x4*)(base + off + bj * HALF + n * 16) + acc[ai][bj][m][n];
                        *(f32x4*)(out + off + bj * HALF + n * 16) = o; ss += (o[0] * o[0] + o[1] * o[1]) + (o[2] * o[2] + o[3] * o[3]);
                        u32x2 w; w.x = cvt_pk_bf16(o[0], o[1]); w.y = cvt_pk_bf16(o[2], o[3]); *(u32x2*)(xb + off + bj * HALF + n * 16) = w; }
                ss += __shfl_xor(ss, 16); ss += __shfl_xor(ss, 32);
                if (fq == 0) rowss[(size_t)row * 16 + u.pn * 4 + wc] = ss; }
    }
};

template <class Epi, class Sched, bool ALIGN_EPI = false, bool SP2 = false>
__device__ __forceinline__ void gemm_phase(LAS unsigned char* lds, const Gemm g, const Sched& S, const Epi& E, int tid_in) {
    int tid_ = tid_in; asm volatile("" : "+v"(tid_));
    const int tid = tid_, wid = __builtin_amdgcn_readfirstlane(tid >> 6), lane = tid & 63, wr = wid >> 2, wc = wid & 3, fr = lane & 15, fq = lane >> 4;
    const int K = g.K, nt = K / BK, lda = g.lda;
    unsigned voffA[2], voffB[2];
#pragma unroll
    for (int i = 0; i < 2; ++i) { int R, C; stage_rc(tid * 16 + i * 8192, R, C); const int Rb = Epi::PERM ? ((R & ~31) + perm32(R & 31)) : R;
        voffA[i] = (unsigned)(R * lda + C) * 2u; voffB[i] = (unsigned)(Rb * K + C) * 2u; }
    const size_t kstep = (size_t)(BK * 2);
    const size_t hstepA = (size_t)HALF * lda * 2, hstepB = (size_t)HALF * K * 2;
    const size_t tstepA = 2 * hstepA, tstepB = 2 * hstepB;
    const unsigned ldsw = (unsigned)wid * 1024u;
    const int aoff = lds_byte(wr * 64 + fr, fq * 8), boff = lds_byte(wc * 32 + fr, fq * 8);
#define PG8_SA(b, h) (((b) * 2 + (h)) * HTB)
#define PG8_SB(b, h) ((4 + (b) * 2 + (h)) * HTB)
#define PG8_STAGE(bufoff, gbase, voff) do { _Pragma("unroll") for (int _i = 0; _i < 2; ++_i) \
        __builtin_amdgcn_global_load_lds((const unsigned*)((const char*)(gbase) + (voff)[_i]), (LAS unsigned*)(lds + (bufoff) + ldsw + _i * 8192), 16, 0, 0); } while (0)
#define PG8_LDA(dst, b, h) do { _Pragma("unroll") for (int m = 0; m < 4; ++m) _Pragma("unroll") for (int k = 0; k < 2; ++k) dst[m][k] = *(const LAS bf16x8*)(lds + PG8_SA(b, h) + aoff + m * 2048 + k * 1024); } while (0)
#define PG8_LDB(dst, b, h) do { _Pragma("unroll") for (int n = 0; n < 2; ++n) _Pragma("unroll") for (int k = 0; k < 2; ++k) dst[n][k] = *(const LAS bf16x8*)(lds + PG8_SB(b, h) + boff + n * 2048 + k * 1024); } while (0)
#define PG8_MMA(ai, bj, At, Bt) do { __builtin_amdgcn_s_setprio(1); _Pragma("unroll") for (int m = 0; m < 4; ++m) _Pragma("unroll") for (int n = 0; n < 2; ++n) _Pragma("unroll") for (int k = 0; k < 2; ++k) \
        acc[ai][bj][m][n] = __builtin_amdgcn_mfma_f32_16x16x32_bf16(Bt[n][k], At[m][k], acc[ai][bj][m][n], 0, 0, 0); __builtin_amdgcn_s_setprio(0); } while (0)
#define PG8_WAIT_V(n) asm volatile("s_waitcnt vmcnt(" #n ")" ::: "memory")
#define PG8_WAIT_L(n) asm volatile("s_waitcnt lgkmcnt(" #n ")" ::: "memory")
#define PG8_BAR __builtin_amdgcn_s_barrier()
#define PG8_SCHED __builtin_amdgcn_sched_barrier(0)
    Unit cur, nxt; int ui = 0;
    if (!S.next(0, cur)) return;
    f32x4 acc[2][2][4][2];
#pragma unroll
    for (int a = 0; a < 2; ++a)
#pragma unroll
        for (int b = 0; b < 2; ++b)
#pragma unroll
            for (int m = 0; m < 4; ++m)
#pragma unroll
                for (int n = 0; n < 2; ++n) acc[a][b][m][n] = (f32x4){0.f, 0.f, 0.f, 0.f};
    bf16x8 At[4][2], B0[2][2], B1[2][2];
    const char* cA = (const char*)g.A + (size_t)cur.pm * tstepA; const char* cB = (const char*)g.Bt + (size_t)cur.pn * tstepB;
    S.a_ready(cur);
    if constexpr (SP2) {
        PG8_STAGE(PG8_SB(0, 0), cB, voffB); PG8_STAGE(PG8_SB(0, 1), cB + hstepB, voffB); PG8_STAGE(PG8_SA(0, 0), cA, voffA); PG8_STAGE(PG8_SA(0, 1), cA + hstepA, voffA);
        if (wr == 1) PG8_BAR;
        PG8_WAIT_V(2); PG8_BAR;
        PG8_STAGE(PG8_SB(1, 0), cB + kstep, voffB); PG8_STAGE(PG8_SA(1, 0), cA + kstep, voffA); PG8_STAGE(PG8_SB(1, 1), cB + hstepB + kstep, voffB);
        PG8_WAIT_V(6); PG8_BAR;
    } else {
        PG8_STAGE(PG8_SB(0, 0), cB, voffB); PG8_STAGE(PG8_SA(0, 0), cA, voffA); PG8_STAGE(PG8_SB(0, 1), cB + hstepB, voffB); PG8_STAGE(PG8_SA(0, 1), cA + hstepA, voffA);
        if (wr == 1) PG8_BAR;
        PG8_WAIT_V(4); PG8_BAR;
        PG8_STAGE(PG8_SB(1, 0), cB + kstep, voffB); PG8_STAGE(PG8_SA(1, 0), cA + kstep, voffA); PG8_STAGE(PG8_SB(1, 1), cB + hstepB + kstep, voffB);
        PG8_WAIT_V(6); PG8_BAR;
    }
    for (;;) {
        const bool has_next = S.next(ui + 1, nxt);
        const char* nA = has_next ? (const char*)g.A + (size_t)nxt.pm * tstepA : cA; const char* nB = has_next ? (const char*)g.Bt + (size_t)nxt.pn * tstepB : cB;
        for (int t = 0; t < nt; t += 2) {
            const bool last = (t == nt - 2);
            const char* a1 = cA + (size_t)(t + 1) * kstep;
            const char* a2 = last ? nA : cA + (size_t)(t + 2) * kstep; const char* b2 = last ? nB : cB + (size_t)(t + 2) * kstep;
            const char* a3 = a2 + kstep; const char* b3 = b2 + kstep;
            if (last && has_next) S.a_ready(nxt);
            if constexpr (SP2) {
            PG8_LDB(B0, 0, 0); PG8_LDB(B1, 0, 1); PG8_SCHED; PG8_LDA(At, 0, 0); PG8_STAGE(PG8_SA(1, 1), a1 + hstepA, voffA);
            PG8_WAIT_V(8); PG8_WAIT_L(0); PG8_BAR; PG8_MMA(0, 0, At, B0); PG8_MMA(0, 1, At, B1); PG8_BAR; PG8_SCHED;
            PG8_LDA(At, 0, 1); PG8_STAGE(PG8_SB(0, 0), b2, voffB); PG8_STAGE(PG8_SB(0, 1), b2 + hstepB, voffB); PG8_STAGE(PG8_SA(0, 0), a2, voffA);
            PG8_WAIT_V(8); PG8_WAIT_L(0); PG8_BAR; PG8_MMA(1, 0, At, B0); PG8_MMA(1, 1, At, B1); PG8_BAR; PG8_SCHED;
            PG8_LDB(B0, 1, 0); PG8_LDB(B1, 1, 1); PG8_SCHED; PG8_LDA(At, 1, 0); PG8_STAGE(PG8_SA(0, 1), a2 + hstepA, voffA);
            PG8_WAIT_V(8); PG8_WAIT_L(0); PG8_BAR; PG8_MMA(0, 0, At, B0); PG8_MMA(0, 1, At, B1); PG8_BAR; PG8_SCHED;
            PG8_LDA(At, 1, 1); PG8_STAGE(PG8_SB(1, 0), b3, voffB); PG8_STAGE(PG8_SB(1, 1), b3 + hstepB, voffB); PG8_STAGE(PG8_SA(1, 0), a3, voffA);
            PG8_WAIT_V(8); PG8_WAIT_L(0); PG8_BAR; PG8_MMA(1, 0, At, B0); PG8_MMA(1, 1, At, B1); PG8_BAR; PG8_SCHED;
            } else {
            PG8_LDB(B0, 0, 0); PG8_SCHED; PG8_LDA(At, 0, 0); PG8_STAGE(PG8_SA(1, 1), a1 + hstepA, voffA);
            PG8_WAIT_L(8); PG8_BAR; PG8_WAIT_L(0); PG8_MMA(0, 0, At, B0); PG8_BAR; PG8_SCHED;
            PG8_LDB(B1, 0, 1); PG8_STAGE(PG8_SB(0, 0), b2, voffB);
            PG8_BAR; PG8_WAIT_L(0); PG8_MMA(0, 1, At, B1); PG8_BAR;
            PG8_LDA(At, 0, 1); PG8_STAGE(PG8_SA(0, 0), a2, voffA);
            PG8_BAR; PG8_WAIT_L(0); PG8_MMA(1, 0, At, B0); PG8_BAR; PG8_SCHED;
            PG8_STAGE(PG8_SB(0, 1), b2 + hstepB, voffB);
            PG8_WAIT_V(6); PG8_BAR; PG8_MMA(1, 1, At, B1); PG8_BAR;
            PG8_LDB(B0, 1, 0); PG8_SCHED; PG8_LDA(At, 1, 0); PG8_STAGE(PG8_SA(0, 1), a2 + hstepA, voffA);
            PG8_WAIT_L(8); PG8_BAR; PG8_WAIT_L(0); PG8_MMA(0, 0, At, B0); PG8_BAR; PG8_SCHED;
            PG8_LDB(B1, 1, 1); PG8_STAGE(PG8_SB(1, 0), b3, voffB);
            PG8_BAR; PG8_WAIT_L(0); PG8_MMA(0, 1, At, B1); PG8_BAR;
            PG8_LDA(At, 1, 1); PG8_STAGE(PG8_SA(1, 0), a3, voffA);
            PG8_BAR; PG8_WAIT_L(0); PG8_MMA(1, 0, At, B0); PG8_BAR; PG8_SCHED;
            PG8_STAGE(PG8_SB(1, 1), b3 + hstepB, voffB);
            PG8_WAIT_V(6); PG8_BAR; PG8_MMA(1, 1, At, B1); PG8_BAR;
            }
        }
        if constexpr (ALIGN_EPI) { if (wr == 0) PG8_BAR; }
        if constexpr (!Epi::AFTER_DRAIN) { E(acc, cur, wr, wc, fr, fq); S.done(cur); }
        if (!has_next) break;
#pragma unroll
        for (int a = 0; a < 2; ++a)
#pragma unroll
            for (int b = 0; b < 2; ++b)
#pragma unroll
                for (int m = 0; m < 4; ++m)
#pragma unroll
                    for (int n = 0; n < 2; ++n) acc[a][b][m][n] = (f32x4){0.f, 0.f, 0.f, 0.f};
        cur = nxt; cA = nA; cB = nB; ++ui;
        if constexpr (ALIGN_EPI) { if (wr == 1) PG8_BAR; }
    }
    PG8_WAIT_V(0);
    if constexpr (!ALIGN_EPI) { if (wr == 0) PG8_BAR; }
    PG8_BAR;
#undef PG8_SA
#undef PG8_SB
#undef PG8_STAGE
#undef PG8_LDA
#undef PG8_LDB
#undef PG8_MMA
#undef PG8_WAIT_V
#undef PG8_WAIT_L
#undef PG8_BAR
#undef PG8_SCHED
}
}


namespace att {
typedef short s16x4 __attribute__((ext_vector_type(4)));
typedef float f32x16 __attribute__((ext_vector_type(16)));
constexpr int D = 128, NW = 8, QBLK = 32, KVBLK = 64, QB = NW * QBLK;
constexpr int SHM_V = KVBLK * D * 2, SHM_K = KVBLK * D * 2;
constexpr int ATT_LDS_BYTES = 2 * SHM_V + 2 * SHM_K + NW * 64 * 4;
constexpr float SCALE = 0.08838834764831845f, THR = 8.f;
#define KSWZ(row, colB) ((row) * 256 + ((colB) ^ (((row) & 7) << 4)))
#define SBAR() __builtin_amdgcn_sched_barrier(0)
__device__ __forceinline__ int v_st(int k, int c) { const int kk = (k & ~0xC) | ((k & 4) << 1) | ((k & 8) >> 1); return ((kk >> 3) * 4 + (c >> 5)) * 512 + ((kk & 7) * 32 + (c & 31)) * 2; }
__device__ __forceinline__ int v_rd_base(int lane) { return ((lane & 3) << 3) | (((lane >> 2) & 3) << 6) | (((lane >> 4) & 1) << 5) | (((lane >> 5) & 1) << 8); }
constexpr int v_rd_off(int d0, int ks, int half) { return d0 * 512 + ks * 4096 + half * 2048; }
__device__ __forceinline__ int crow(int r, int hi) { return (r & 3) + 8 * (r >> 2) + 4 * hi; }
__device__ __forceinline__ unsigned cvtpk(float lo, float hi) { unsigned r; asm volatile("v_cvt_pk_bf16_f32 %0, %1, %2" : "=v"(r) : "v"(lo), "v"(hi)); return r; }
__device__ __forceinline__ bf16x8 load8(const bf16_t* p) { return *reinterpret_cast<const bf16x8*>(p); }
__device__ __forceinline__ void mask_tile(f32x16& p0, f32x16& p1, int dq, unsigned W) {
    const float NEG = -__builtin_inff();
#pragma unroll
    for (int r = 0; r < 16; ++r) { const int c = (r & 3) + 8 * (r >> 2);
        if ((unsigned)(dq - c) >= W) p0[r] = NEG;
        if ((unsigned)(dq - c - 32) >= W) p1[r] = NEG; }
}
__device__ __forceinline__ void partialSM(f32x16& p0, f32x16& p1, float& m_reg, float& mn, float& alpha) {
    float pmax = p0[0]; for (int r = 1; r < 16; ++r) pmax = fmaxf(pmax, p0[r]); for (int r = 0; r < 16; ++r) pmax = fmaxf(pmax, p1[r]);
    { auto rr = __builtin_amdgcn_permlane32_swap(__float_as_uint(pmax), __float_as_uint(pmax), false, false);
      pmax = fmaxf(__uint_as_float(rr[0]), __uint_as_float(rr[1])); }
    constexpr float C2 = 1.4426950408889634f * SCALE;
    if (__builtin_expect(__all((pmax - m_reg) * SCALE <= THR), 1)) { mn = m_reg; alpha = 1.f; }
    else { mn = fmaxf(m_reg, pmax); alpha = __builtin_amdgcn_exp2f((m_reg - mn) * C2); m_reg = mn; }
    const float mnL = -mn * C2;
    for (int r = 0; r < 16; ++r) p0[r] = fmaf(p0[r], C2, mnL); for (int r = 0; r < 16; ++r) p1[r] = fmaf(p1[r], C2, mnL);
    for (int r = 0; r < 16; ++r) p0[r] = __builtin_amdgcn_exp2f(p0[r]);
}
__device__ __forceinline__ void finishSM(f32x16& p0, f32x16& p1, float alpha, float& l_reg, bf16x8& pa0, bf16x8& pa1, bf16x8& pa2, bf16x8& pa3) {
    for (int r = 0; r < 16; ++r) p1[r] = __builtin_amdgcn_exp2f(p1[r]);
    float ps = 0; for (int r = 0; r < 16; ++r) ps += p0[r]; for (int r = 0; r < 16; ++r) ps += p1[r];
    { auto rr = __builtin_amdgcn_permlane32_swap(__float_as_uint(ps), __float_as_uint(ps), false, false);
      ps = __uint_as_float(rr[0]) + __uint_as_float(rr[1]); }
    l_reg = l_reg * alpha + ps;
#define PK4(P, B_, OUT) do { unsigned a0 = cvtpk(P[B_+0], P[B_+1]), a1 = cvtpk(P[B_+2], P[B_+3]);                          \
        unsigned b0 = cvtpk(P[B_+4], P[B_+5]), b1 = cvtpk(P[B_+6], P[B_+7]);                                             \
        auto r0 = __builtin_amdgcn_permlane32_swap(a0, b0, false, false); auto r1 = __builtin_amdgcn_permlane32_swap(a1, b1, false, false); \
        u32x4 w = {r0[0], r1[0], r0[1], r1[1]}; OUT = *reinterpret_cast<bf16x8*>(&w); } while (0)
    PK4(p0, 0, pa0); PK4(p0, 8, pa1); PK4(p1, 0, pa2); PK4(p1, 8, pa3);
#undef PK4
}
template <int KB>
__device__ __forceinline__ void qkt(f32x16& p0, f32x16& p1, const char* K_lds, int r32, int hi, const bf16x8* qr, bool act) {
    if (!act) { const float NEG = -__builtin_inff();
#pragma unroll
        for (int r = 0; r < 16; ++r) { p0[r] = NEG; p1[r] = NEG; } return; }
    p0 = f32x16{}; p1 = f32x16{};
    const char* kb[4];
#pragma unroll
    for (int dd = 0; dd < 4; ++dd) kb[dd] = K_lds + KB * SHM_K + KSWZ(r32, (dd * 16 + hi * 8) * 2);
#pragma unroll
    for (int d0 = 0; d0 < 8; ++d0) { const char* a = kb[d0 & 3] + (d0 >> 2) * 128;
        bf16x8 b0 = *reinterpret_cast<const bf16x8*>(a);
        bf16x8 b1 = *reinterpret_cast<const bf16x8*>(a + 32 * 256);
        p0 = __builtin_amdgcn_mfma_f32_32x32x16_bf16(b0, qr[d0], p0, 0, 0, 0);
        p1 = __builtin_amdgcn_mfma_f32_32x32x16_bf16(b1, qr[d0], p1, 0, 0, 0); }
}
template <int VB>
__device__ __forceinline__ void pv_tile(f32x16* o, int vb0, bf16x8 pa0, bf16x8 pa1, bf16x8 pa2, bf16x8 pa3, bool act) {
    if (!act) return;
#define TRRD(dst, off) asm volatile("ds_read_b64_tr_b16 %0, %1 offset:%2" : "=&v"(dst) : "v"(vb0), "i"(off) : "memory")
#define PV_D0(d0) do { s16x4 l0, l1, l2, l3, h0, h1, h2, h3; constexpr int b_ = VB * SHM_V + v_rd_off(d0, 0, 0); \
        TRRD(l0, b_); TRRD(h0, b_ + 2048); TRRD(l1, b_ + 4096); TRRD(h1, b_ + 6144); TRRD(l2, b_ + 8192); TRRD(h2, b_ + 10240); TRRD(l3, b_ + 12288); TRRD(h3, b_ + 14336); \
        asm volatile("s_waitcnt lgkmcnt(0)" ::: "memory"); SBAR();   \
        o[d0] = __builtin_amdgcn_mfma_f32_32x32x16_bf16(pa0, (bf16x8){l0[0], l0[1], l0[2], l0[3], h0[0], h0[1], h0[2], h0[3]}, o[d0], 0, 0, 0);   \
        o[d0] = __builtin_amdgcn_mfma_f32_32x32x16_bf16(pa1, (bf16x8){l1[0], l1[1], l1[2], l1[3], h1[0], h1[1], h1[2], h1[3]}, o[d0], 0, 0, 0);   \
        o[d0] = __builtin_amdgcn_mfma_f32_32x32x16_bf16(pa2, (bf16x8){l2[0], l2[1], l2[2], l2[3], h2[0], h2[1], h2[2], h2[3]}, o[d0], 0, 0, 0);   \
        o[d0] = __builtin_amdgcn_mfma_f32_32x32x16_bf16(pa3, (bf16x8){l3[0], l3[1], l3[2], l3[3], h3[0], h3[1], h3[2], h3[3]}, o[d0], 0, 0, 0); } while (0)
    PV_D0(0); PV_D0(1); PV_D0(2); PV_D0(3);
#undef PV_D0
#undef TRRD
}
struct BlockRef { const bf16_t* Q; const bf16_t* K; const bf16_t* V; bf16_t* O; float* lse; int P0, pq, pk, skv, W, lsep, mode; };
struct Seam { bf16x8 qr[8]; bf16x8 st_v0, st_v1, st_k0, st_k1; };
__device__ __forceinline__ int swa_jlo(int P0, int W) { const int lowk = P0 - W + 1; return lowk > 0 ? lowk / KVBLK : 0; }
#define ROWK(p, k0, rr, pk_) ((const bf16_t*)((const char*)(p) + (size_t)(unsigned)((((unsigned)((k0) + (rr))) * (unsigned)(pk_) + (unsigned)sc) * 2u)))
#define VMW() asm volatile("s_waitcnt vmcnt(0)" ::: "memory")
#define VMWN(n) asm volatile("s_waitcnt vmcnt(%0)" :: "i"(n) : "memory")
#define SLOAD_H(Kp, Vp, k0, pk_) do { S.st_v0 = load8(ROWK(Vp, k0, sr, pk_)); S.st_v1 = load8(ROWK(Vp, k0, 32 + sr, pk_));              \
                         S.st_k0 = load8(ROWK(Kp, k0, sr, pk_)); S.st_k1 = load8(ROWK(Kp, k0, 32 + sr, pk_)); } while (0)
#define SWRITE_HK(bf) do { *(bf16x8*)(K_lds + (bf) * SHM_K + kws) = S.st_k0; *(bf16x8*)(K_lds + (bf) * SHM_K + kws + 32 * 256) = S.st_k1; } while (0)
#define SWRITE_HV(bf) do { *(bf16x8*)(V_lds + (bf) * SHM_V + vst0) = S.st_v0; *(bf16x8*)(V_lds + (bf) * SHM_V + vst1) = S.st_v1; } while (0)
#define SWRITE_H(bf) do { SWRITE_HV(bf); SWRITE_HK(bf); } while (0)
__device__ __forceinline__ void swa_prime(const BlockRef& cur, char* lds, Seam& S, int tid) {
    const int wid = __builtin_amdgcn_readfirstlane(tid >> 6), lane = tid & 63, r32 = lane & 31, hi = lane >> 5;
    const int sr = tid >> 4, sc = (tid & 15) * 8, kws = KSWZ(sr, sc * 2); char* K_lds = lds + 2 * SHM_V;
    const int kb0 = swa_jlo(cur.P0, cur.W) * KVBLK;
    { const unsigned qoff = ((unsigned)(wid * QBLK + r32) * (unsigned)cur.pq + (unsigned)hi * 8u) * 2u;
      for (int d0 = 0; d0 < 8; ++d0) S.qr[d0] = *(const bf16x8*)((const char*)cur.Q + (size_t)qoff + d0 * 32); }
    SLOAD_H(cur.K, cur.V, kb0, cur.pk); VMW(); SWRITE_HK(0);
    __syncthreads();
}
__device__ __forceinline__ void swa_block(const BlockRef& cur, const BlockRef& nxt, char* lds, Seam& S, int tid) {
    const int wid = __builtin_amdgcn_readfirstlane(tid >> 6), lane = tid & 63, r32 = lane & 31, hi = lane >> 5;
    const int W = cur.W, pk = cur.pk;
    const int j_lo = swa_jlo(cur.P0, W);
    int j_hi = (cur.P0 + QB - 1) / KVBLK + 1; if (j_hi > cur.skv / KVBLK) j_hi = cur.skv / KVBLK;
    const int NT = j_hi - j_lo;
    const int kbn = swa_jlo(nxt.P0, nxt.W) * KVBLK;
    const int qlo = cur.P0 + wid * QBLK, qm = qlo + r32 - 4 * hi;
    char* V_lds = lds; char* K_lds = lds + 2 * SHM_V;
    float* ws = (float*)(lds + 2 * SHM_V + 2 * SHM_K) + wid * 64; float* li_l = ws, * al_l = ws + 32;
    float m_reg = -1e30f, l_reg = 0; f32x16 o[4] = {};
    const int sr = tid >> 4, sc = (tid & 15) * 8, vst0 = v_st(sr, sc), vst1 = v_st(32 + sr, sc), kws = KSWZ(sr, sc * 2);
    const int vb0 = (int)(uintptr_t)V_lds + v_rd_base(lane);
    const bf16_t* Kh = cur.K; const bf16_t* Vh = cur.V;
#define RESC(a) do { if (__any((a) < 1.f)) { if (hi == 0) al_l[r32] = (a); asm volatile("s_waitcnt lgkmcnt(0)" ::: "memory");              \
                     for (int d_ = 0; d_ < 4; ++d_) for (int r = 0; r < 16; ++r) o[d_][r] *= al_l[crow(r, hi)]; } } while (0)
#define KBASE(t) ((j_lo + (t)) * KVBLK)
#define ACT(t) (KBASE(t) <= qlo + QBLK - 1 && KBASE(t) + KVBLK - 1 >= qlo - W + 1)
#define MASKT(P0_, P1_, t) do { const int kb_ = KBASE(t); if (ACT(t) && (kb_ + KVBLK - 1 > qlo || kb_ <= qlo + QBLK - 1 - W)) mask_tile(P0_, P1_, qm - kb_, (unsigned)W); } while (0)
    constexpr int NQL = 8;
#define SEAM_K0() do { VMWN(NQL); SWRITE_HK(0); SBAR(); } while (0)
    f32x16 pA0, pA1, pB0, pB1; float mnA, mnB, alA, alB; bf16x8 pa0, pa1, pa2, pa3;
    SWRITE_HV(0); SBAR();
    if (NT > 1) { SLOAD_H(Kh, Vh, KBASE(1), pk); }
    SBAR(); qkt<0>(pA0, pA1, K_lds, r32, hi, S.qr, ACT(0));
    MASKT(pA0, pA1, 0); partialSM(pA0, pA1, m_reg, mnA, alA);
    if (NT > 1) { VMW(); SWRITE_H(1); }
    __syncthreads();
#define HALF_STEP(PX0, PX1, mnX, alX, PY0, PY1, alY, t, KB, VB, SB) do {                                                      \
        SBAR(); qkt<KB>(PX0, PX1, K_lds, r32, hi, S.qr, ACT(t));                                             \
        finishSM(PY0, PY1, alY, l_reg, pa0, pa1, pa2, pa3); SBAR();                                                           \
        if ((t) + 1 < NT) { SLOAD_H(Kh, Vh, KBASE((t) + 1), pk); SBAR(); }                                               \
        pv_tile<VB>(o, vb0, pa0, pa1, pa2, pa3, ACT((t) - 1)); MASKT(PX0, PX1, (t)); partialSM(PX0, PX1, m_reg, mnX, alX);                                        \
        __syncthreads();                                                                                                      \
        if ((t) + 1 < NT) { VMW(); SWRITE_H(SB); }                                                                          \
        RESC(alX); __syncthreads(); } while (0)
    for (int t = 1; t + 1 < NT; t += 2) {
        HALF_STEP(pB0, pB1, mnB, alB, pA0, pA1, alA, t, 1, 0, 0);
        HALF_STEP(pA0, pA1, mnA, alA, pB0, pB1, alB, t + 1, 0, 1, 1);
    }
    const bool even = (NT & 1) == 0;
    if (even) { SBAR(); qkt<1>(pB0, pB1, K_lds, r32, hi, S.qr, ACT(NT - 1)); SBAR(); }
    { SLOAD_H(nxt.K, nxt.V, kbn, nxt.pk); SBAR();
        const unsigned qoff = ((unsigned)(wid * QBLK + r32) * (unsigned)nxt.pq + (unsigned)hi * 8u) * 2u;
#pragma unroll
        for (int d0 = 0; d0 < 8; ++d0) S.qr[d0] = *(const bf16x8*)((const char*)nxt.Q + (size_t)qoff + d0 * 32); }
    SBAR();
    finishSM(pA0, pA1, alA, l_reg, pa0, pa1, pa2, pa3); SBAR();
    pv_tile<0>(o, vb0, pa0, pa1, pa2, pa3, ACT(even ? NT - 2 : NT - 1));
    if (even) { MASKT(pB0, pB1, NT - 1); partialSM(pB0, pB1, m_reg, mnB, alB); __syncthreads(); RESC(alB);
        finishSM(pB0, pB1, alB, l_reg, pa0, pa1, pa2, pa3); SBAR(); pv_tile<1>(o, vb0, pa0, pa1, pa2, pa3, ACT(NT - 1)); }
    SBAR(); SEAM_K0();
    if (hi == 0) li_l[r32] = l_reg; asm volatile("s_waitcnt lgkmcnt(0)" ::: "memory");
    float rli[16];
#pragma unroll
    for (int r = 0; r < 16; ++r) rli[r] = __builtin_amdgcn_rcpf(li_l[crow(r, hi)]);
    int r32e = r32, hie = hi; asm volatile("" : "+v"(r32e), "+v"(hie));
    bf16_t* Ow = cur.O + (size_t)(wid * QBLK) * cur.pq;
    const unsigned pqu = (unsigned)cur.pq, lane_off = (unsigned)(4 * hie) * pqu + (unsigned)r32e;
    if (cur.mode == 0) {
        if (hie == 0) cur.lse[(size_t)(wid * QBLK + r32e) * cur.lsep] = m_reg * SCALE + __logf(l_reg);
#pragma unroll
        for (int r = 0; r < 16; ++r) { const unsigned roff = lane_off + (unsigned)((r & 3) + 8 * (r >> 2)) * pqu;
#pragma unroll
            for (int d0 = 0; d0 < 4; ++d0) { const float v = o[d0][r] * rli[r]; const float vn = __shfl_xor(v, 1);
                if ((r32e & 1) == 0) *(unsigned*)(Ow + (size_t)(roff + d0 * 32)) = cvtpk(v, vn); } }
    } else {
#pragma unroll
        for (int r = 0; r < 16; ++r) { const unsigned roff = lane_off + (unsigned)((r & 3) + 8 * (r >> 2)) * pqu;
#pragma unroll
            for (int d0 = 0; d0 < 4; ++d0) { const float v = o[d0][r] * rli[r]; const float vn = __shfl_xor(v, 1);
                if ((r32e & 1) == 0) { unsigned* zp = (unsigned*)(Ow + (size_t)(roff + d0 * 32)); const unsigned zz = *zp;
                    *zp = cvtpk(v * silu(__uint_as_float(zz << 16)), vn * silu(__uint_as_float(zz & 0xffff0000u))); } } }
    }
    __syncthreads();
#undef RESC
#undef KBASE
#undef ACT
#undef MASKT
#undef SEAM_K0
#undef HALF_STEP
}
#undef ROWK
#undef VMW
#undef VMWN
#undef SLOAD_H
#undef SWRITE_HK
#undef SWRITE_HV
#undef SWRITE_H
#undef KSWZ
#undef SBAR
}

typedef GAS unsigned gu32;
#define RLX_AGENT __ATOMIC_RELAXED, __HIP_MEMORY_SCOPE_AGENT
#define XB_TMO      128
#define XB_XCNT(j)  (256  + 64 * (j))
#define XB_XSUB(j)  (1280 + 64 * (j))
#define XB_XGEN(j)  (2304 + 64 * (j))
#define XB_TOP      3328
#define XB_TOPGEN   3392
#define XCD_BAR_WORDS 3456
#define XB_SPIN_CAP (1u << 18)
__device__ __forceinline__ unsigned xb_ld(unsigned* p)              { return __hip_atomic_load(p, __ATOMIC_RELAXED, __HIP_MEMORY_SCOPE_AGENT); }
__device__ __forceinline__ unsigned xb_add(unsigned* p, unsigned v) { return __hip_atomic_fetch_add(p, v, __ATOMIC_RELAXED, __HIP_MEMORY_SCOPE_AGENT); }
__device__ __forceinline__ unsigned xb_xcc_id() { return (unsigned)__builtin_amdgcn_s_getreg((3 << 11) | 20) & 0xFu; }
#define XB_SPIN(cond, bar) do { unsigned _sp = 0; while (cond) { __builtin_amdgcn_s_sleep(1); \
    if ((++_sp & 255u) == 0u) { if (xb_ld(&(bar)[XB_TMO])) break; if (_sp > XB_SPIN_CAP) { atomicAdd(&(bar)[XB_TMO], 1u); break; } } } } while (0)
struct XcdBarrier { unsigned* bar; unsigned x; volatile LAS unsigned* st; };
__device__ __forceinline__ XcdBarrier xcd_barrier_post(unsigned* bar, volatile LAS unsigned* st, int tid) {
    XcdBarrier b; b.bar = bar; b.x = xb_xcc_id(); b.st = st;
    if (tid == 0) (void)xb_add(&bar[XB_XCNT(b.x)], 1u);
    return b;
}
__device__ __forceinline__ void xcd_barrier_complete(unsigned* bar, unsigned x, unsigned& nloc, unsigned& nx) {
    const unsigned G = gridDim.x * gridDim.y * gridDim.z;
    unsigned sum, cnt, mine, sp = 0u;
    for (;;) {
        sum = 0u; cnt = 0u; mine = 0u;
#pragma unroll
        for (unsigned j = 0; j < 16; ++j) { const unsigned c = xb_ld(&bar[XB_XCNT(j)]); sum += c; cnt += (c > 0u) ? 1u : 0u; mine = (j == x) ? c : mine; }
        if (sum == G) break;
        __builtin_amdgcn_s_sleep(1);
        if ((++sp & 255u) == 0u) { if (xb_ld(&bar[XB_TMO])) break; if (sp > XB_SPIN_CAP) { atomicAdd(&bar[XB_TMO], 1u); break; } }
    }
    nloc = mine > 0u ? mine : 1u; nx = cnt > 0u ? cnt : 1u;
}
__device__ __forceinline__ void xcd_barrier(const XcdBarrier& b, int tid) {
    asm volatile("s_waitcnt vmcnt(0)" ::: "memory");
    __syncthreads();
    if (tid == 0) {
        unsigned* bar = b.bar;
        __builtin_amdgcn_s_waitcnt(0);
        unsigned nloc = b.st[0], nx = b.st[1];
        if (nloc == 0u) { xcd_barrier_complete(bar, b.x, nloc, nx); b.st[0] = nloc; b.st[1] = nx; }
        const unsigned old = xb_add(&bar[XB_XSUB(b.x)], 1u);
        const unsigned gen = old / nloc;
        if (old + 1u == (gen + 1u) * nloc) {
            __builtin_amdgcn_fence(__ATOMIC_RELEASE, "agent");
            asm volatile("s_waitcnt vmcnt(0)" ::: "memory");
            const unsigned og = xb_add(&bar[XB_TOP], 1u);
            const unsigned tg = og / nx;
            if (og + 1u == (tg + 1u) * nx) xb_add(&bar[XB_TOPGEN], 1u);
            else XB_SPIN(xb_ld(&bar[XB_TOPGEN]) == tg, bar);
            __builtin_amdgcn_fence(__ATOMIC_ACQUIRE, "agent");
            xb_add(&bar[XB_XGEN(b.x)], 1u);
            asm volatile("s_waitcnt vmcnt(0)" ::: "memory");
        } else {
            XB_SPIN(xb_ld(&bar[XB_XGEN(b.x)]) == gen, bar);
            __builtin_amdgcn_fence(__ATOMIC_ACQUIRE, "agent");
            asm volatile("s_waitcnt vmcnt(0)" ::: "memory");
        }
    }
    __syncthreads();
}

__device__ __forceinline__ int lane_id_opaque() { int l; asm volatile("v_mbcnt_lo_u32_b32 %0, -1, 0\n\tv_mbcnt_hi_u32_b32 %0, -1, %0" : "=v"(l)); return l; }
struct Frame {
    LAS unsigned char* lds;
    int tid, lane, wave, vcu, G;
};

__device__ __forceinline__ void transpose_item(const float* __restrict__ W, int K, int N, bf16_t* WT, int row_off, const float* __restrict__ g, LAS float* scr, int item, int lane) {
    const int nblk = N / 32, kb = item / nblk, nb = item % nblk, k0 = 64 * kb, n0 = 32 * nb;
#pragma unroll 8
    for (int i = 0; i < 32; ++i) { const int kk = 2 * i + (lane >> 5); float v = W[(size_t)(k0 + kk) * N + n0 + (lane & 31)]; if (g) v *= g[k0 + kk]; scr[kk * 33 + (lane & 31)] = v; }
    asm volatile("s_waitcnt lgkmcnt(0)" ::: "memory");
    const int c = lane & 7;
#pragma unroll
    for (int j = 0; j < 4; ++j) { const int n = (lane >> 3) + 8 * j; const LAS float* s = scr + (8 * c) * 33 + n;
        u32x4 o; o.x = pk2(s[0 * 33], s[1 * 33]); o.y = pk2(s[2 * 33], s[3 * 33]); o.z = pk2(s[4 * 33], s[5 * 33]); o.w = pk2(s[6 * 33], s[7 * 33]);
        *(u32x4*)(WT + (size_t)(row_off + n0 + n) * K + k0 + 8 * c) = o; }
    asm volatile("s_waitcnt lgkmcnt(0)" ::: "memory");
}
__device__ __forceinline__ void convert_weight(const Frame& F, const float* W, int K, int N, bf16_t* WT, int row_off, const float* g) {
    LAS float* scr = (LAS float*)(F.lds + F.wave * 16384);
    const int gw = F.vcu * NWAVES + F.wave, NGW = F.G * NWAVES, nitems = (K / 64) * (N / 32);
    for (int it = gw; it < nitems; it += NGW) transpose_item(W, K, N, WT, row_off, g, scr, it, F.lane);
}

__device__ __forceinline__ void attnA_naive(const Frame& F, bf16_t* proj) {
    LAS float* q_s = (LAS float*)(F.lds) + F.wave * 384; LAS float* p_s = (LAS float*)(F.lds + 16384) + F.wave * 448;
    const int lane = F.lane, gw = F.vcu * NWAVES + F.wave, nw = F.G * NWAVES;
    for (int item = gw; item < NT * 4; item += nw) {
        const int tok = item >> 2, h = item & 3, b = tok / SEQ, t = tok % SEQ;
        for (int j = lane; j < 384; j += 64) { const int g = j >> 7, d = j & 127; q_s[g * 128 + d] = bf2f(proj[(size_t)tok * EP + g * 1024 + h * 128 + d]); }
        asm volatile("s_waitcnt lgkmcnt(0)" ::: "memory");
        float sc[7]; float mx = -INFINITY;
#pragma unroll
        for (int i = 0; i < 7; ++i) { const int kk = lane + 64 * i; sc[i] = -INFINITY;
            if (kk < 387) { const int g = kk / 129, off = kk % 129, dil = (g == 0) ? 1 : (g == 1 ? 4 : 16), kpos = t - off * dil;
                if (kpos >= 0) { const bf16_t* kr = proj + (size_t)(b * SEQ + kpos) * EP + g * 1024 + 512 + h * 128; float s = 0.f;
                    for (int d = 0; d < 128; d += 8) { const uint4 v = *(const uint4*)(kr + d); const unsigned wv[4] = {v.x, v.y, v.z, v.w};
#pragma unroll
                        for (int j = 0; j < 4; ++j) s += q_s[g * 128 + d + 2 * j] * __uint_as_float(wv[j] << 16) + q_s[g * 128 + d + 2 * j + 1] * __uint_as_float(wv[j] & 0xffff0000u); }
                    sc[i] = s * ATT_SCALE; } }
            mx = fmaxf(mx, sc[i]); }
        mx = wave_max(mx); float l = 0.f;
#pragma unroll
        for (int i = 0; i < 7; ++i) { const float p = __expf(sc[i] - mx); l += p; p_s[lane + 64 * i] = p; }
        l = wave_sum(l);
        asm volatile("s_waitcnt lgkmcnt(0)" ::: "memory");
        float a0 = 0.f, a1 = 0.f;
        for (int kk = 0; kk < 387; ++kk) { const int g = kk / 129, off = kk % 129, dil = (g == 0) ? 1 : (g == 1 ? 4 : 16), kpos = t - off * dil;
            if (kpos >= 0) { const float p = p_s[kk]; const unsigned v = *(const unsigned*)(proj + (size_t)(b * SEQ + kpos) * EP + E_VA + h * 128 + 2 * lane);
                a0 += p * __uint_as_float(v << 16); a1 += p * __uint_as_float(v & 0xffff0000u); } }
        const float il = 1.f / l; bf16_t* zp = proj + (size_t)tok * EP + E_Z + h * 128 + 2 * lane;
        const unsigned zz = *(const unsigned*)zp;
        *(unsigned*)zp = pk2(a0 * il * silu(__uint_as_float(zz << 16)), a1 * il * silu(__uint_as_float(zz & 0xffff0000u)));
        asm volatile("s_waitcnt lgkmcnt(0)" ::: "memory");
    }
}
__device__ __forceinline__ void attnM_naive(const Frame& F, bf16_t* proj, int ld, int qcol, int zcol, const bf16_t* __restrict__ mkv  ) {
    LAS float* q_s = (LAS float*)(F.lds) + F.wave * 128; LAS float* p_s = (LAS float*)(F.lds + 16384) + F.wave * 256;
    const int lane = F.lane, gw = F.vcu * NWAVES + F.wave, nw = F.G * NWAVES;
    for (int item = gw; item < NT * 4; item += nw) {
        const int tok = item >> 2, h = item & 3, b = tok / SEQ;
        for (int j = lane; j < 128; j += 64) q_s[j] = bf2f(proj[(size_t)tok * ld + qcol + h * 128 + j]);
        asm volatile("s_waitcnt lgkmcnt(0)" ::: "memory");
        float sc[4]; float mx = -INFINITY;
#pragma unroll
        for (int i = 0; i < 4; ++i) { const int kk = lane + 64 * i; const bf16_t* kr = mkv + (size_t)(b * NMEM + kk) * 4096 + h * 128; float s = 0.f;
            for (int d = 0; d < 128; d += 8) { const uint4 v = *(const uint4*)(kr + d); const unsigned wv[4] = {v.x, v.y, v.z, v.w};
#pragma unroll
                for (int j = 0; j < 4; ++j) s += q_s[d + 2 * j] * __uint_as_float(wv[j] << 16) + q_s[d + 2 * j + 1] * __uint_as_float(wv[j] & 0xffff0000u); }
            sc[i] = s * ATT_SCALE; mx = fmaxf(mx, sc[i]); }
        mx = wave_max(mx); float l = 0.f;
#pragma unroll
        for (int i = 0; i < 4; ++i) { const float p = __expf(sc[i] - mx); l += p; p_s[lane + 64 * i] = p; }
        l = wave_sum(l);
        asm volatile("s_waitcnt lgkmcnt(0)" ::: "memory");
        float a0 = 0.f, a1 = 0.f;
        for (int kk = 0; kk < 256; ++kk) { const float p = p_s[kk]; const unsigned v = *(const unsigned*)(mkv + (size_t)(b * NMEM + kk) * 4096 + 512 + h * 128 + 2 * lane);
            a0 += p * __uint_as_float(v << 16); a1 += p * __uint_as_float(v & 0xffff0000u); }
        const float il = 1.f / l; bf16_t* zp = proj + (size_t)tok * ld + zcol + h * 128 + 2 * lane;
        const unsigned zz = *(const unsigned*)zp;
        *(unsigned*)zp = pk2(a0 * il * silu(__uint_as_float(zz << 16)), a1 * il * silu(__uint_as_float(zz & 0xffff0000u)));
        asm volatile("s_waitcnt lgkmcnt(0)" ::: "memory");
    }
}
__device__ __forceinline__ void pool_naive(const Frame& F, bf16_t* proj, const float* __restrict__ wpool, const float* __restrict__ scale) {
    LAS float* pooled = (LAS float*)(F.lds);
    const int tid = F.tid, gi = tid >> 7, c = tid & 127;
    for (int tok = F.vcu; tok < NT; tok += F.G) {
        const int t = tok % SEQ, w = 2 << gi, cnt = (t + 1 < w) ? t + 1 : w;
        float s = 0.f;
        for (int j = 0; j < cnt; ++j) s += bf2f(proj[(size_t)(tok - j) * EP + E_XB + gi * 128 + c]);
        pooled[gi * 128 + c] = s / (float)cnt - bf2f(proj[(size_t)tok * EP + E_XB + gi * 128 + c]);
        __syncthreads();
        float y = 0.f;
        for (int cc = 0; cc < 128; ++cc) y += pooled[gi * 128 + cc] * wpool[(gi * 128 + cc) * 128 + c];
        bf16_t* zp = proj + (size_t)tok * EP + E_Z + 512 + gi * 128 + c;
        *zp = (bf16_t)f2bf(y * scale[gi * 128 + c] * silu(bf2f(*zp)));
        __syncthreads();
    }
}
__device__ __forceinline__ void cmix_naive(const Frame& F, bf16_t* proj, const float* __restrict__ ln_g, const float* __restrict__ ln_b,
                                           const float* __restrict__ w_s, const float* __restrict__ b_s) {
    LAS float* vn = (LAS float*)(F.lds); LAS float* mu = vn + 128 * 128; LAS float* rstd = mu + 128;
    const int tid = F.tid, lane = F.lane, wv = F.wave;
    for (int ch = F.vcu; ch < NT / 128; ch += F.G) {
        const size_t row0 = (size_t)ch * 128;
        for (int r = wv; r < 128; r += 8) { const bf16_t* vr = proj + (row0 + r) * OP + O_V; float s = 0.f, s2 = 0.f;
            for (int j = lane; j < 1024; j += 64) { const float v = bf2f(vr[j]); s += v; }
            s = wave_sum(s); const float m = s * (1.f / 1024.f);
            for (int j = lane; j < 1024; j += 64) { const float v = bf2f(vr[j]) - m; s2 += v * v; }
            s2 = wave_sum(s2);
            if (lane == 0) { mu[r] = m; rstd[r] = rsqrtf(s2 * (1.f / 1024.f) + EPS); } }
        __syncthreads();
        for (int g = 0; g < 8; ++g) {
            for (int i = tid; i < 128 * 128; i += NTHREADS) { const int s = i >> 7, c = i & 127;
                vn[i] = (bf2f(proj[(row0 + s) * OP + O_V + g * 128 + c]) - mu[s]) * rstd[s] * ln_g[g * 128 + c] + ln_b[g * 128 + c]; }
            __syncthreads();
            const int c = tid & 127, tq = tid >> 7;
            for (int t = tq * 32; t < tq * 32 + 32; ++t) { float acc = 0.f; const float* wr = w_s + ((size_t)g * 128 + t) * 128;
                for (int s = 0; s <= t; ++s) acc += wr[s] * vn[s * 128 + c];
                const float mixed = acc + b_s[g * 128 + t];
                const float u = bf2f(proj[(row0 + t) * OP + O_U + g * 128 + c]);
                bf16_t* zp = proj + (row0 + t) * OP + O_Z + g * 128 + c;
                *zp = (bf16_t)f2bf(u * mixed * silu(bf2f(*zp))); }
            __syncthreads();
        }
    }
}


__device__ __forceinline__ att::BlockRef att_item(int L, bool even, bf16_t* proj, const bf16_t* mkv, float* lse) {
    att::BlockRef r;
    if (even && L < 1536) {
        const int g = L >> 9, rem = L & 511, b = rem >> 6, h = (rem >> 4) & 3, x = rem & 15;
        const int dsh = 2 * g, dil = 1 << dsh, nqb = 16 >> dsh, rr = x >> (4 - dsh), qb = x & (nqb - 1);
        const size_t tok0 = (size_t)b * SEQ + rr;
        bf16_t* base = proj + tok0 * EP;
        r.Q = base + (size_t)qb * 256 * dil * EP + g * 1024 + h * 128; r.O = base + (size_t)qb * 256 * dil * EP + g * 1024 + h * 128;
        r.K = base + g * 1024 + 512 + h * 128; r.V = base + E_VA + h * 128;
        r.P0 = qb * 256; r.pq = dil * EP; r.pk = dil * EP; r.skv = SEQ >> dsh; r.W = 129; r.mode = 0;
        r.lse = lse + ((size_t)g * NT + tok0 + (size_t)qb * 256 * dil) * 4 + h; r.lsep = dil * 4;
    } else {
        const int m = even ? L - 1536 : L, b = m >> 6, h = (m >> 4) & 3, qb = m & 15;
        const int ld = even ? EP : OP, qcol = even ? E_QM : O_QM, zcol = (even ? E_Z : O_Z) + 1024;
        const size_t row0 = (size_t)b * SEQ + qb * 256;
        r.Q = proj + row0 * ld + qcol + h * 128; r.O = proj + row0 * ld + zcol + h * 128;
        r.K = mkv + (size_t)(b * NMEM) * 4096 + h * 128; r.V = r.K + 512;
        r.P0 = 256; r.pq = ld; r.pk = 4096; r.skv = 256; r.W = 1 << 20; r.mode = 1; r.lse = nullptr; r.lsep = 0;
    }
    return r;
}
__device__ __forceinline__ void attn_phase(char* lds, int vcu, int G, bool even, bf16_t* proj, const bf16_t* mkv, float* lse, int tid_in) {
    int tid = tid_in; asm volatile("" : "+v"(tid));
    const int total = even ? 2048 : 512;
    int L = vcu; if (L >= total) return;
    att::BlockRef cur = att_item(L, even, proj, mkv, lse);
    att::Seam S;
    att::swa_prime(cur, lds, S, tid);
    for (;;) {
        const int Ln = L + G; const bool last = Ln >= total;
        const att::BlockRef nxt = last ? cur : att_item(Ln, even, proj, mkv, lse);
        att::swa_block(cur, nxt, lds, S, tid);
        if (last) break;
        cur = nxt; L = Ln;
    }
}
__device__ __forceinline__ void combine_phase(const Frame& F, bf16_t* proj, const float* __restrict__ lse) {
    const int lane = F.lane, h = lane >> 4, dc = (lane & 15) * 8, NGW = F.G * NWAVES;
    for (int tok = F.vcu * NWAVES + F.wave; tok < NT; tok += NGW) {
        const float l0 = lse[((size_t)0 * NT + tok) * 4 + h], l1 = lse[((size_t)1 * NT + tok) * 4 + h], l2 = lse[((size_t)2 * NT + tok) * 4 + h];
        const float M = fmaxf(l0, fmaxf(l1, l2)); float w0 = __expf(l0 - M), w1 = __expf(l1 - M), w2 = __expf(l2 - M);
        const float inv = 1.f / (w0 + w1 + w2); w0 *= inv; w1 *= inv; w2 *= inv;
        bf16_t* row = proj + (size_t)tok * EP + h * 128 + dc;
        const u32x4 o0 = *(const u32x4*)(row), o1 = *(const u32x4*)(row + 1024), o2 = *(const u32x4*)(row + 2048), zz = *(const u32x4*)(row + E_Z);
        u32x4 y;
#pragma unroll
        for (int j = 0; j < 4; ++j) {
            const float a = w0 * __uint_as_float(o0[j] << 16) + w1 * __uint_as_float(o1[j] << 16) + w2 * __uint_as_float(o2[j] << 16);
            const float b = w0 * __uint_as_float(o0[j] & 0xffff0000u) + w1 * __uint_as_float(o1[j] & 0xffff0000u) + w2 * __uint_as_float(o2[j] & 0xffff0000u);
            y[j] = pk2(a * silu(__uint_as_float(zz[j] << 16)), b * silu(__uint_as_float(zz[j] & 0xffff0000u))); }
        *(u32x4*)(row + E_Z) = y;
    }
}


__device__ __forceinline__ void pool_phase(const Frame& F, bf16_t* proj, const bf16_t* __restrict__ wpT, const float* __restrict__ scale) {
    const int tid = F.tid, lane = F.lane, wv = F.wave, fr = lane & 15, fq = lane >> 4;
    LAS unsigned char* A = F.lds;
    for (int item = F.vcu; item < NT / 64; item += F.G) {
        const int t0 = item * 64, p0 = t0 % SEQ;
        { const int gi = tid >> 7, c = tid & 127, w = 2 << gi; const bf16_t* xc = proj + (size_t)t0 * EP + E_XB + gi * 128 + c;
          float sum = 0.f;
          for (int j = 1; j <= w; ++j) if (p0 - j >= 0) sum += bf2f(xc[-(long)j * EP]);
          for (int i = 0; i < 64; ++i) { const int p = p0 + i; const float xv = bf2f(xc[(long)i * EP]); sum += xv;
              if (p >= w) sum -= bf2f(xc[(long)(i - w) * EP]);
              const int cnt = (p + 1 < w) ? p + 1 : w;
              *(LAS bf16_t*)(A + (gi * 64 + i) * 272 + c * 2) = (bf16_t)f2bf(sum / (float)cnt - xv); } }
        __syncthreads();
        { const int gi = wv >> 1, nh = wv & 1;
          f32x4 acc[4][4];
#pragma unroll
          for (int m = 0; m < 4; ++m)
#pragma unroll
              for (int n = 0; n < 4; ++n) acc[m][n] = (f32x4){0.f, 0.f, 0.f, 0.f};
#pragma unroll
          for (int ks = 0; ks < 4; ++ks) { bf16x8 a[4], b[4];
#pragma unroll
              for (int m = 0; m < 4; ++m) a[m] = *(const LAS bf16x8*)(A + (gi * 64 + m * 16 + fr) * 272 + (ks * 32 + 8 * fq) * 2);
#pragma unroll
              for (int n = 0; n < 4; ++n) b[n] = *(const bf16x8*)(wpT + (size_t)(gi * 128 + nh * 64 + n * 16 + fr) * 128 + ks * 32 + 8 * fq);
#pragma unroll
              for (int m = 0; m < 4; ++m)
#pragma unroll
                  for (int n = 0; n < 4; ++n) acc[m][n] = __builtin_amdgcn_mfma_f32_16x16x32_bf16(a[m], b[n], acc[m][n], 0, 0, 0); }
#pragma unroll
          for (int n = 0; n < 4; ++n) { const int d = gi * 128 + nh * 64 + n * 16 + fr; const float sc = scale[d];
#pragma unroll
              for (int m = 0; m < 4; ++m)
#pragma unroll
                  for (int r = 0; r < 4; ++r) { bf16_t* zp = proj + (size_t)(t0 + m * 16 + 4 * fq + r) * EP + E_Z + 512 + d;
                      *zp = (bf16_t)f2bf(acc[m][n][r] * sc * silu(bf2f(*zp))); } } }
        __syncthreads();
    }
}
__device__ __forceinline__ void cmix_phase(const Frame& F, bf16_t* proj, const float* __restrict__ ln_g, const float* __restrict__ ln_b,
                                           const bf16_t* __restrict__ wsm  , const float* __restrict__ b_s) {
    const int tid = F.tid, lane = F.lane, wv = F.wave, fr = lane & 15, fq = lane >> 4;
    LAS unsigned char* VT = F.lds; LAS float* mu = (LAS float*)(F.lds + 128 * 272); LAS float* rstd = mu + 128;
    for (int ch = F.vcu; ch < NT / 128; ch += F.G) {
        const size_t row0 = (size_t)ch * 128;
        for (int r = wv * 16; r < wv * 16 + 16; ++r) { const bf16_t* vr = proj + (row0 + r) * OP + O_V + lane * 16;
            const u32x4 q0 = *(const u32x4*)vr, q1 = *(const u32x4*)(vr + 8); float x[16]; float s = 0.f;
#pragma unroll
            for (int j = 0; j < 4; ++j) { x[2 * j] = __uint_as_float(q0[j] << 16); x[2 * j + 1] = __uint_as_float(q0[j] & 0xffff0000u); x[8 + 2 * j] = __uint_as_float(q1[j] << 16); x[8 + 2 * j + 1] = __uint_as_float(q1[j] & 0xffff0000u); }
#pragma unroll
            for (int j = 0; j < 16; ++j) s += x[j];
            const float m = wave_sum(s) * (1.f / 1024.f); float s2 = 0.f;
#pragma unroll
            for (int j = 0; j < 16; ++j) { const float d = x[j] - m; s2 += d * d; }
            s2 = wave_sum(s2);
            if (lane == 0) { mu[r] = m; rstd[r] = rsqrtf(s2 * (1.f / 1024.f) + EPS); } }
        __syncthreads();
        for (int g = 0; g < 8; ++g) {
            { const int sI = tid >> 2, cq = tid & 3; const bf16_t* vr = proj + (row0 + sI) * OP + O_V + g * 128 + cq * 32; const float m = mu[sI], rs = rstd[sI];
#pragma unroll
              for (int k = 0; k < 4; ++k) { const u32x4 q = *(const u32x4*)(vr + 8 * k); const int c0 = cq * 32 + 8 * k;
#pragma unroll
                  for (int j = 0; j < 4; ++j) { const int c = c0 + 2 * j;
                      const float v0 = (__uint_as_float(q[j] << 16) - m) * rs * ln_g[g * 128 + c] + ln_b[g * 128 + c];
                      const float v1 = (__uint_as_float(q[j] & 0xffff0000u) - m) * rs * ln_g[g * 128 + c + 1] + ln_b[g * 128 + c + 1];
                      *(LAS bf16_t*)(VT + c * 272 + sI * 2) = (bf16_t)f2bf(v0); *(LAS bf16_t*)(VT + (c + 1) * 272 + sI * 2) = (bf16_t)f2bf(v1); } } }
            __syncthreads();
            { f32x4 acc[8];
#pragma unroll
              for (int n = 0; n < 8; ++n) acc[n] = (f32x4){0.f, 0.f, 0.f, 0.f};
              const int ksmax = wv >> 1;
              for (int ks = 0; ks <= ksmax; ++ks) {
                  const bf16x8 a = *(const bf16x8*)(wsm + ((size_t)g * 128 + wv * 16 + fr) * 128 + ks * 32 + 8 * fq);
#pragma unroll
                  for (int n = 0; n < 8; ++n) { const bf16x8 b = *(const LAS bf16x8*)(VT + (n * 16 + fr) * 272 + (ks * 32 + 8 * fq) * 2);
                      acc[n] = __builtin_amdgcn_mfma_f32_16x16x32_bf16(a, b, acc[n], 0, 0, 0); } }
#pragma unroll
              for (int r = 0; r < 4; ++r) { const int t = wv * 16 + 4 * fq + r; const float bs = b_s[g * 128 + t]; bf16_t* rowp = proj + (row0 + t) * OP;
#pragma unroll
                  for (int n = 0; n < 8; ++n) { const int c = g * 128 + n * 16 + fr; const float u = bf2f(rowp[O_U + c]); bf16_t* zp = rowp + O_Z + c;
                      *zp = (bf16_t)f2bf(u * (acc[n][r] + bs) * silu(bf2f(*zp))); } } }
            __syncthreads();
        }
    }
}

struct Args { const void* in[19]; float* out; unsigned char* ws; };
__global__ void __launch_bounds__(NTHREADS, 2) mega_fwd(Args args) {
    extern __shared__ __attribute__((aligned(16))) unsigned char lds_raw[];
    Frame F;
    F.lds = (LAS unsigned char*)lds_raw;
    const int wave_s = __builtin_amdgcn_readfirstlane((int)threadIdx.x >> 6);
#define TID() (wave_s * 64 + lane_id_opaque())
    F.tid = TID(); F.lane = F.tid & 63; F.wave = wave_s;
    F.G = gridDim.x; { const int bx = blockIdx.x; F.vcu = (F.G % 8 == 0) ? (bx % 8) * (F.G / 8) + bx / 8 : bx; }
    volatile LAS unsigned* MISC = (volatile LAS unsigned*)(F.lds + MISC_OFF);
    unsigned char* ws = args.ws;
    for (int u = F.tid; u < (LDS_BYTES - LDSCTL_OFF) / 4; u += NTHREADS) ((LAS unsigned*)(F.lds + LDSCTL_OFF))[u] = 0u;
    __syncthreads();
    XcdBarrier bar = xcd_barrier_post((unsigned*)(ws + OFF_CTL) + CW_BAR, MISC + 8, F.tid);
#define GRID_BAR() xcd_barrier(bar, TID())
#define REFRESH() do { int t_ = TID(); asm volatile("" : "+v"(t_)); F.tid = t_; F.lane = t_ & 63; F.wave = wave_s; } while (0)

    const float* x = (const float*)args.in[0]; const float* mem = (const float*)args.in[1]; const int* pos = (const int*)args.in[2]; const float* g_mem = (const float*)args.in[3];
    const float* e_ng = (const float*)args.in[4]; const float* e_win = (const float*)args.in[5]; const float* e_wpool = (const float*)args.in[6]; const float* e_pscale = (const float*)args.in[7];
    const float* e_wmkv = (const float*)args.in[8]; const float* e_wout = (const float*)args.in[9];
    const float* o_ng = (const float*)args.in[10]; const float* o_win = (const float*)args.in[11]; const float* o_lng = (const float*)args.in[12]; const float* o_lnb = (const float*)args.in[13];
    const float* o_ws = (const float*)args.in[14]; const float* o_bs = (const float*)args.in[15]; const float* o_wmkv = (const float*)args.in[16]; const float* o_wout = (const float*)args.in[17];
    const float* f_g = (const float*)args.in[18];
    float* out = args.out;
    bf16_t* proj = (bf16_t*)(ws + OFF_PROJ); bf16_t* xb = (bf16_t*)(ws + OFF_XB); bf16_t* win = (bf16_t*)(ws + OFF_WIN); bf16_t* wout = (bf16_t*)(ws + OFF_WOUT);
    bf16_t* memkv = (bf16_t*)(ws + OFF_MEMKV); float* rowss = (float*)(ws + OFF_ROWSS); float2* rope = (float2*)(ws + OFF_ROPE); float* lse = (float*)(ws + OFF_LSE); bf16_t* wpT = (bf16_t*)(ws + OFF_WPT); bf16_t* wsm = (bf16_t*)(ws + OFF_WSM);
    bf16_t* memn = (bf16_t*)((unsigned char*)args.out + DO_MEMN); bf16_t* wmkv = (bf16_t*)((unsigned char*)args.out + DO_WMKV);
    const int NGW = F.G * NWAVES;
    { const int gw = F.vcu * NWAVES + F.wave, lane = F.lane;

    convert_weight(F, e_win, DM, EP, win, 0, e_ng);
    convert_weight(F, e_wout, MIX, DM, wout, 0, nullptr);
    for (int l = 0; l < 4; ++l) convert_weight(F, ((l & 1) ? o_wmkv : e_wmkv) + (size_t)(l >> 1) * DM * 1024, DM, 1024, wmkv, l * 1024, nullptr);
    for (int m = 0; m < 8; ++m) convert_weight(F, e_wpool + (size_t)m * 128 * 128, 128, 128, wpT + (size_t)m * 128 * 128, 0, nullptr);
    for (int i = F.vcu * NTHREADS + F.tid; i < 2 * 8 * 128 * 128; i += F.G * NTHREADS) { const int t = (i >> 7) & 127, sI = i & 127; wsm[i] = (sI <= t) ? (bf16_t)f2bf(o_ws[i]) : (bf16_t)0; }
    for (int r = gw; r < NT; r += NGW) {
        const float* xr = x + (size_t)r * DM; float s = 0.f;
#pragma unroll
        for (int j = 0; j < 4; ++j) { const f32x4 v = *(const f32x4*)(xr + 4 * lane + 256 * j); s += (v[0] * v[0] + v[1] * v[1]) + (v[2] * v[2] + v[3] * v[3]);
            u32x2 w; w.x = pk2(v[0], v[1]); w.y = pk2(v[2], v[3]); *(u32x2*)(xb + (size_t)r * DM + 4 * lane + 256 * j) = w; }
        s = wave_sum(s);
        if (lane < 16) rowss[(size_t)r * 16 + lane] = (lane == 0) ? s : 0.f;
    }
    for (int r = gw; r < NB * NMEM; r += NGW) {
        const float* xr = mem + (size_t)r * DM; f32x4 v[4]; float s = 0.f;
#pragma unroll
        for (int j = 0; j < 4; ++j) { v[j] = *(const f32x4*)(xr + 4 * lane + 256 * j); s += (v[j][0] * v[j][0] + v[j][1] * v[j][1]) + (v[j][2] * v[j][2] + v[j][3] * v[j][3]); }
        s = wave_sum(s); const float ri = rsqrtf(s * (1.f / DM) + EPS);
#pragma unroll
        for (int j = 0; j < 4; ++j) { const f32x4 gg = *(const f32x4*)(g_mem + 4 * lane + 256 * j);
            u32x2 w; w.x = pk2(v[j][0] * ri * gg[0], v[j][1] * ri * gg[1]); w.y = pk2(v[j][2] * ri * gg[2], v[j][3] * ri * gg[3]); *(u32x2*)(memn + (size_t)r * DM + 4 * lane + 256 * j) = w; }
    }
    for (int i = F.vcu * NTHREADS + F.tid; i < NT * 16; i += F.G * NTHREADS) {
        const int tok = i >> 4, f = i & 15; const float ang = (float)pos[tok] * c_inv_freq[f];
        const double rev = (double)ang * 0.15915494309189535; const float fr = (float)(rev - rint(rev));
        rope[i] = make_float2(__builtin_amdgcn_cosf(fr), __builtin_amdgcn_sinf(fr));
    }
    }
    GRID_BAR();

    { pg8::Gemm g{memn, wmkv, NB * NMEM, 4096, DM, DM}; pg8::StaticOrder S; S.init(NB * NMEM, 4096, F.G, (int)blockIdx.x);
      pg8::EpiIn E{memkv, 4096, nullptr, nullptr, 0};
      pg8::gemm_phase<pg8::EpiIn, pg8::StaticOrder, true, true>(F.lds, g, S, E, TID()); }

    for (int l = 0; l < 4; ++l) {
        const int i = l >> 1; const bool odd = l & 1; const int NP = odd ? OP : EP;
        { pg8::Gemm g{xb, win, NT, NP, DM, DM}; pg8::StaticOrder S; S.init(NT, NP, F.G, (int)blockIdx.x);
          pg8::EpiIn E{proj, NP, rowss, rope, odd ? 0 : 12};
          pg8::gemm_phase<pg8::EpiIn, pg8::StaticOrder, true, true>(F.lds, g, S, E, TID()); }
        GRID_BAR();
        REFRESH();
        if (l < 3) { const int l1 = l + 1, i1 = l1 >> 1;
            if (l1 & 1) { convert_weight(F, o_win + (size_t)i1 * DM * OP, DM, OP, win, 0, o_ng + i1 * DM); convert_weight(F, o_wout + (size_t)i1 * MIX * DM, MIX, DM, wout + (size_t)(l1 & 1) * DM * MIX, 0, nullptr); }
            else        { convert_weight(F, e_win + (size_t)i1 * DM * EP, DM, EP, win, 0, e_ng + i1 * DM); convert_weight(F, e_wout + (size_t)i1 * MIX * DM, MIX, DM, wout + (size_t)(l1 & 1) * DM * MIX, 0, nullptr); }
            __syncthreads(); }
        if (!odd) {
            REFRESH(); pool_phase(F, proj, wpT + (size_t)i * 4 * 128 * 128, e_pscale + i * 512);
            attn_phase((char*)lds_raw, F.vcu, F.G, true, proj, memkv + l * 1024, lse, TID());
            GRID_BAR();
            REFRESH(); combine_phase(F, proj, lse);
        } else {
            REFRESH(); cmix_phase(F, proj, o_lng + i * 1024, o_lnb + i * 1024, wsm + (size_t)i * 8 * 128 * 128, o_bs + i * 8 * 128);
            attn_phase((char*)lds_raw, F.vcu, F.G, false, proj, memkv + l * 1024, lse, TID());
        }
        GRID_BAR();
        { pg8::Gemm g{proj + (odd ? O_Z : E_Z), wout + (size_t)(l & 1) * DM * MIX, NT, DM, MIX, NP}; pg8::StaticOrder S; S.init(NT, DM, F.G, (int)blockIdx.x);
          pg8::EpiOut E{l == 0 ? x : out, out, xb, rowss};
          pg8::gemm_phase<pg8::EpiOut, pg8::StaticOrder, true, true>(F.lds, g, S, E, TID()); }
        GRID_BAR();
    }
    REFRESH();
    for (int r = F.vcu * NWAVES + F.wave; r < NT; r += NGW) { const int lane = F.lane;
        float* xr = out + (size_t)r * DM; f32x4 v[4]; float s = 0.f;
#pragma unroll
        for (int j = 0; j < 4; ++j) { v[j] = *(const f32x4*)(xr + 4 * lane + 256 * j); s += (v[j][0] * v[j][0] + v[j][1] * v[j][1]) + (v[j][2] * v[j][2] + v[j][3] * v[j][3]); }
        s = wave_sum(s); const float ri = rsqrtf(s * (1.f / DM) + EPS);
#pragma unroll
        for (int j = 0; j < 4; ++j) { const f32x4 gg = *(const f32x4*)(f_g + 4 * lane + 256 * j); *(f32x4*)(xr + 4 * lane + 256 * j) = v[j] * ri * gg; }
    }
}

extern "C" void kernel_launch(void* const* d_in, const int* in_sizes, int n_in, void* d_out, int out_size, void* d_ws, size_t ws_size, hipStream_t stream) {
    static int grid = 0;
    if (grid == 0) {
        if (n_in != 19 || in_sizes[0] != NT * DM || out_size != NT * DM || ws_size < WS_END) {
            fprintf(stderr, "kernel_launch: unexpected shapes (n_in %d, in0 %d, out %d, ws %zu; need ws >= %zu)\n", n_in, n_in > 0 ? in_sizes[0] : -1, out_size, ws_size, (size_t)WS_END);
            grid = -1; return; }
        int dev = 0, cus = 0;
        if (hipGetDevice(&dev) != hipSuccess || hipDeviceGetAttribute(&cus, hipDeviceAttributeMultiprocessorCount, dev) != hipSuccess) { grid = -1; return; }
        if (hipFuncSetAttribute((const void*)mega_fwd, hipFuncAttributeMaxDynamicSharedMemorySize, LDS_BYTES) != hipSuccess) { fprintf(stderr, "kernel_launch: hipFuncSetAttribute failed\n"); grid = -1; return; }
        int per_cu = 0;
        if (hipOccupancyMaxActiveBlocksPerMultiprocessor(&per_cu, (const void*)mega_fwd, NTHREADS, LDS_BYTES) != hipSuccess || per_cu < 1)
            fprintf(stderr, "kernel_launch: note: occupancy query reports %d workgroups per CU\n", per_cu);
        (void)hipGetLastError();
        grid = cus;
    }
    if (grid < 0) return;
    if (hipMemsetAsync((char*)d_ws + OFF_CTL, 0, CTL_ZERO_BYTES, stream) != hipSuccess) return;
    Args a{};
    for (int i = 0; i < 19; ++i) a.in[i] = d_in[i];
    a.out = (float*)d_out; a.ws = (unsigned char*)d_ws;
    hipLaunchKernelGGL(mega_fwd, dim3(grid), dim3(NTHREADS), LDS_BYTES, stream, a);
}
```

```cpp
#include <hip/hip_runtime.h>
#include <cstdint>
#include <cstdio>

typedef unsigned short bf16_t;
#define LAS __attribute__((address_space(3)))
#define GAS __attribute__((address_space(1)))
typedef short bf16x8 __attribute__((ext_vector_type(8)));
typedef float f32x4 __attribute__((ext_vector_type(4)));
typedef unsigned u32x4 __attribute__((ext_vector_type(4)));
typedef unsigned u32x2 __attribute__((ext_vector_type(2)));

constexpr int NB = 8, SEQ = 4096, DM = 1024, NT = NB * SEQ;
constexpr int HD = 128, NMEM = 256;
constexpr int EP = 6144, OP = 4096, MIX = 1536;
constexpr int E_VA = 3072, E_XB = 3584, E_QM = 4096, E_Z = 4608;
constexpr int O_U = 0, O_V = 1024, O_QM = 2048, O_Z = 2560;
constexpr float EPS = 1e-6f;
constexpr float ATT_SCALE = 0.08838834764831845f;
constexpr int NWAVES = 8, NTHREADS = 512;

constexpr size_t MiB = 1u << 20;
constexpr size_t OFF_CTL = 0, CTL_ZERO_BYTES = 1 * MiB;
constexpr size_t OFF_PROJ = 1 * MiB;
constexpr size_t OFF_XB = 385 * MiB;
constexpr size_t OFF_WIN = 449 * MiB;
constexpr size_t OFF_WOUT = 461 * MiB;
constexpr size_t OFF_MEMKV = 467 * MiB;
constexpr size_t OFF_ROWSS = 483 * MiB;
constexpr size_t OFF_ROPE = 489 * MiB;
constexpr size_t OFF_LSE = 493 * MiB;
constexpr size_t OFF_WPT = 495 * MiB;
constexpr size_t OFF_WSM = OFF_WPT + 256 * 1024;
constexpr size_t WS_END = 496 * MiB;
constexpr size_t DO_MEMN = 0;
constexpr size_t DO_WMKV = 4 * MiB;
constexpr int CW_BAR = 4096;

#ifndef PROBE_MODE
#define PROBE_MODE 0
#endif
#define PROBE_LO 0
#define PROBE_HI 1
#define PROBE_K 0
#ifndef PROBE_DUP
#define PROBE_DUP 0
#endif
constexpr int RING_BYTES = 131072, LDSCTL_OFF = RING_BYTES, MISC_OFF = LDSCTL_OFF + 320, LDS_BYTES = 147456;

__device__ __forceinline__ float bf2f(bf16_t h) { return __uint_as_float((unsigned)h << 16); }
__device__ __forceinline__ unsigned f2bf(float f) { unsigned u = __float_as_uint(f); return (u + 0x7fffu + ((u >> 16) & 1u)) >> 16; }
__device__ __forceinline__ unsigned pk2(float lo, float hi) { return f2bf(lo) | (f2bf(hi) << 16); }
__device__ __forceinline__ float wave_sum(float v) {
#pragma unroll
    for (int o = 1; o < 64; o <<= 1) v += __shfl_xor(v, o);
    return v;
}
__device__ __forceinline__ float wave_max(float v) {
#pragma unroll
    for (int o = 1; o < 64; o <<= 1) v = fmaxf(v, __shfl_xor(v, o));
    return v;
}
__device__ __forceinline__ float silu(float z) { return z / (1.f + __expf(-z)); }

__constant__ float c_inv_freq[16] = {1.0f, 0.44036659598350525f, 0.1939227432012558f, 0.08539710193872452f, 0.03760603070259094f, 0.01656043902039528f,
    0.007292664609849453f, 0.0032114458736032248f, 0.0014142135623842478f, 0.000622772378847003f, 0.00027424818836152554f, 0.00012076973507646471f,
    5.318296098266728e-05f, 2.34199997066753e-05f, 1.0313386155758053e-05f, 4.541670477919979e-06f};

namespace pg8 {
constexpr int BM = 256, BK = 64, HALF = 128, HTB = HALF * BK * 2, STAGE_BYTES = 8 * HTB, NXCD = 8, WGM = 8;
__host__ __device__ __forceinline__ int lds_byte(int r, int c) { const int st = (r >> 4) * 2 + (c >> 5), rr = r & 15, cc = c & 31, ob = rr * 64 + cc * 2; return st * 1024 + (ob ^ (((ob >> 9) & 1) << 5)); }
__host__ __device__ __forceinline__ void stage_rc(int b, int& R, int& C) { const int st = b / 1024, sb = b % 1024, swz = sb ^ (((sb >> 9) & 1) << 5); R = (st >> 1) * 16 + swz / 64; C = (st & 1) * 32 + (swz % 64) / 2; }
__host__ __device__ __forceinline__ int perm32(int rho) { const int n = rho >> 4, i = rho & 15; return 8 * (i >> 2) + 4 * n + (i & 3); }
struct Unit { int pm, pn; };
struct Gemm { const bf16_t* A; const bf16_t* Bt; int M, N, K, lda; };
struct StaticOrder {
    int nM, nN, nwg, G, c;
    __host__ __device__ void init(int M, int N, int G_, int c_) { nM = M / BM; nN = N / BM; nwg = nM * nN; G = G_; c = c_; }
    __host__ __device__ bool next(int i, Unit& u) const {
        const long L = (long)i * G + c; if (L >= nwg) return false;
        int wgid = (int)L; { const int q = nwg / NXCD, r = nwg % NXCD, xcd = wgid % NXCD, off = wgid / NXCD; wgid = (xcd < r ? xcd * (q + 1) : r * (q + 1) + (xcd - r) * q) + off; }
        const int nig = WGM * nN, gid = wgid / nig, fm = gid * WGM, gsz = (nM - fm) < WGM ? (nM - fm) : WGM;
        u.pm = fm + ((wgid % nig) % gsz); u.pn = (wgid % nig) / gsz; return true;
    }
    __device__ __forceinline__ void a_ready(const Unit&) const {}
    __device__ __forceinline__ void done(const Unit&) const {}
};
__device__ __forceinline__ unsigned cvt_pk_bf16(float lo, float hi) { unsigned r; asm volatile("v_cvt_pk_bf16_f32 %0, %1, %2" : "=v"(r) : "v"(lo), "v"(hi)); return r; }

struct EpiIn {
    static constexpr bool PERM = true, AFTER_DRAIN = false;
    bf16_t* O; int ldc; const float* rowss; const float2* rope; int nrope;
    __device__ __forceinline__ void operator()(const f32x4 (&acc)[2][2][4][2], const Unit& u, int wr, int wc, int fr, int fq) const {
        const int row0 = u.pm * BM + wr * 64 + fr, col0 = u.pn * BM + wc * 32 + 8 * fq;
        const bool rp = (u.pn < nrope) && (wc == 0);
#pragma unroll
        for (int ai = 0; ai < 2; ++ai)
#pragma unroll
            for (int m = 0; m < 4; ++m) { const int row = row0 + ai * HALF + m * 16; float r = 1.f;
                if (rowss) { const f32x4 p = *(const f32x4*)(rowss + (size_t)row * 16 + 4 * fq); float s = (p[0] + p[1]) + (p[2] + p[3]);
                    s += __shfl_xor(s, 16); s += __shfl_xor(s, 32); r = rsqrtf(s * (1.f / DM) + EPS); }
                bf16_t* rowp = O + (size_t)row * ldc + col0;
#pragma unroll
                for (int bj = 0; bj < 2; ++bj) { float v[8];
#pragma unroll
                    for (int j = 0; j < 4; ++j) { v[j] = acc[ai][bj][m][0][j] * r; v[4 + j] = acc[ai][bj][m][1][j] * r; }
                    if (rp) { const float2* cs = rope + (size_t)row * 16 + 8 * (fq & 1);
#pragma unroll
                        for (int j = 0; j < 8; ++j) { const float pv = __shfl_xor(v[j], 32); const float2 c = cs[j];
                            v[j] = (fq < 2) ? (v[j] * c.x - pv * c.y) : (v[j] * c.x + pv * c.y); } }
                    u32x4 w; w.x = cvt_pk_bf16(v[0], v[1]); w.y = cvt_pk_bf16(v[2], v[3]); w.z = cvt_pk_bf16(v[4], v[5]); w.w = cvt_pk_bf16(v[6], v[7]);
                    *(u32x4*)(rowp + bj * HALF) = w; } }
    }
};
struct EpiOut {
    static constexpr bool PERM = false, AFTER_DRAIN = false;
    const float* base; float* out; bf16_t* xb; float* rowss;
    __device__ __forceinline__ void operator()(const f32x4 (&acc)[2][2][4][2], const Unit& u, int wr, int wc, int fr, int fq) const {
        const int row0 = u.pm * BM + wr * 64 + fr, col0 = u.pn * BM + wc * 32 + 4 * fq;
#pragma unroll
        for (int ai = 0; ai < 2; ++ai)
#pragma unroll
            for (int m = 0; m < 4; ++m) { const int row = row0 + ai * HALF + m * 16; const size_t off = (size_t)row * DM + col0; float ss = 0.f;
#pragma unroll
                for (int bj = 0; bj < 2; ++bj)
#pragma unroll
                    for (int n = 0; n < 2; ++n) { const f32x4 o = *(const f32x4*)(base + off + bj * HALF + n * 16) + acc[ai][bj][m][n];
                        *(f32x4*)(out + off + bj * HALF + n * 16) = o; ss += (o[0] * o[0] + o[1] * o[1]) + (o[2] * o[2] + o[3] * o[3]);
                        u32x2 w; w.x = cvt_pk_bf16(o[0], o[1]); w.y = cvt_pk_bf16(o[2], o[3]); *(u32x2*)(xb + off + bj * HALF + n * 16) = w; }
                ss += __shfl_xor(ss, 16); ss += __shfl_xor(ss, 32);
                if (fq == 0) rowss[(size_t)row * 16 + u.pn * 4 + wc] = ss; }
    }
};

template <class Epi, class Sched, bool ALIGN_EPI = false, bool SP2 = false>
__device__ __forceinline__ void gemm_phase(LAS unsigned char* lds, const Gemm g, const Sched& S, const Epi& E, int tid_in) {
    int tid_ = tid_in; asm volatile("" : "+v"(tid_));
    const int tid = tid_, wid = __builtin_amdgcn_readfirstlane(tid >> 6), lane = tid & 63, wr = wid >> 2, wc = wid & 3, fr = lane & 15, fq = lane >> 4;
    const int K = g.K, nt = K / BK, lda = g.lda;
    unsigned voffA[2], voffB[2];
#pragma unroll
    for (int i = 0; i < 2; ++i) { int R, C; stage_rc(tid * 16 + i * 8192, R, C); const int Rb = Epi::PERM ? ((R & ~31) + perm32(R & 31)) : R;
        voffA[i] = (unsigned)(R * lda + C) * 2u; voffB[i] = (unsigned)(Rb * K + C) * 2u; }
    const size_t kstep = (size_t)(BK * 2);
    const size_t hstepA = (size_t)HALF * lda * 2, hstepB = (size_t)HALF * K * 2;
    const size_t tstepA = 2 * hstepA, tstepB = 2 * hstepB;
    const unsigned ldsw = (unsigned)wid * 1024u;
    const int aoff = lds_byte(wr * 64 + fr, fq * 8), boff = lds_byte(wc * 32 + fr, fq * 8);
#define PG8_SA(b, h) (((b) * 2 + (h)) * HTB)
#define PG8_SB(b, h) ((4 + (b) * 2 + (h)) * HTB)
#define PG8_STAGE(bufoff, gbase, voff) do { _Pragma("unroll") for (int _i = 0; _i < 2; ++_i) \
        __builtin_amdgcn_global_load_lds((const unsigned*)((const char*)(gbase) + (voff)[_i]), (LAS unsigned*)(lds + (bufoff) + ldsw + _i * 8192), 16, 0, 0); } while (0)
#define PG8_LDA(dst, b, h) do { _Pragma("unroll") for (int m = 0; m < 4; ++m) _Pragma("unroll") for (int k = 0; k < 2; ++k) dst[m][k] = *(const LAS bf16x8*)(lds + PG8_SA(b, h) + aoff + m * 2048 + k * 1024); } while (0)
#define PG8_LDB(dst, b, h) do { _Pragma("unroll") for (int n = 0; n < 2; ++n) _Pragma("unroll") for (int k = 0; k < 2; ++k) dst[n][k] = *(const LAS bf16x8*)(lds + PG8_SB(b, h) + boff + n * 2048 + k * 1024); } while (0)
#define PG8_MMA(ai, bj, At, Bt) do { __builtin_amdgcn_s_setprio(1); _Pragma("unroll") for (int m = 0; m < 4; ++m) _Pragma("unroll") for (int n = 0; n < 2; ++n) _Pragma("unroll") for (int k = 0; k < 2; ++k) \
        acc[ai][bj][m][n] = __builtin_amdgcn_mfma_f32_16x16x32_bf16(Bt[n][k], At[m][k], acc[ai][bj][m][n], 0, 0, 0); __builtin_amdgcn_s_setprio(0); } while (0)
#define PG8_WAIT_V(n) asm volatile("s_waitcnt vmcnt(" #n ")" ::: "memory")
#define PG8_WAIT_L(n) asm volatile("s_waitcnt lgkmcnt(" #n ")" ::: "memory")
#define PG8_BAR __builtin_amdgcn_s_barrier()
#define PG8_SCHED __builtin_amdgcn_sched_barrier(0)
    Unit cur, nxt; int ui = 0;
    if (!S.next(0, cur)) return;
    f32x4 acc[2][2][4][2];
#pragma unroll
    for (int a = 0; a < 2; ++a)
#pragma unroll
        for (int b = 0; b < 2; ++b)
#pragma unroll
            for (int m = 0; m < 4; ++m)
#pragma unroll
                for (int n = 0; n < 2; ++n) acc[a][b][m][n] = (f32x4){0.f, 0.f, 0.f, 0.f};
    bf16x8 At[4][2], B0[2][2], B1[2][2];
    const char* cA = (const char*)g.A + (size_t)cur.pm * tstepA; const char* cB = (const char*)g.Bt + (size_t)cur.pn * tstepB;
    S.a_ready(cur);
    if constexpr (SP2) {
        PG8_STAGE(PG8_SB(0, 0), cB, voffB); PG8_STAGE(PG8_SB(0, 1), cB + hstepB, voffB); PG8_STAGE(PG8_SA(0, 0), cA, voffA); PG8_STAGE(PG8_SA(0, 1), cA + hstepA, voffA);
        if (wr == 1) PG8_BAR;
        PG8_WAIT_V(2); PG8_BAR;
        PG8_STAGE(PG8_SB(1, 0), cB + kstep, voffB); PG8_STAGE(PG8_SA(1, 0), cA + kstep, voffA); PG8_STAGE(PG8_SB(1, 1), cB + hstepB + kstep, voffB);
        PG8_WAIT_V(6); PG8_BAR;
    } else {
        PG8_STAGE(PG8_SB(0, 0), cB, voffB); PG8_STAGE(PG8_SA(0, 0), cA, voffA); PG8_STAGE(PG8_SB(0, 1), cB + hstepB, voffB); PG8_STAGE(PG8_SA(0, 1), cA + hstepA, voffA);
        if (wr == 1) PG8_BAR;
        PG8_WAIT_V(4); PG8_BAR;
        PG8_STAGE(PG8_SB(1, 0), cB + kstep, voffB); PG8_STAGE(PG8_SA(1, 0), cA + kstep, voffA); PG8_STAGE(PG8_SB(1, 1), cB + hstepB + kstep, voffB);
        PG8_WAIT_V(6); PG8_BAR;
    }
    for (;;) {
        const bool has_next = S.next(ui + 1, nxt);
        const char* nA = has_next ? (const char*)g.A + (size_t)nxt.pm * tstepA : cA; const char* nB = has_next ? (const char*)g.Bt + (size_t)nxt.pn * tstepB : cB;
        for (int t = 0; t < nt; t += 2) {
            const bool last = (t == nt - 2);
            const char* a1 = cA + (size_t)(t + 1) * kstep;
            const char* a2 = last ? nA : cA + (size_t)(t + 2) * kstep; const char* b2 = last ? nB : cB + (size_t)(t + 2) * kstep;
            const char* a3 = a2 + kstep; const char* b3 = b2 + kstep;
            if (last && has_next) S.a_ready(nxt);
            if constexpr (SP2) {
            PG8_LDB(B0, 0, 0); PG8_LDB(B1, 0, 1); PG8_SCHED; PG8_LDA(At, 0, 0); PG8_STAGE(PG8_SA(1, 1), a1 + hstepA, voffA);
            PG8_WAIT_V(8); PG8_WAIT_L(0); PG8_BAR; PG8_MMA(0, 0, At, B0); PG8_MMA(0, 1, At, B1); PG8_BAR; PG8_SCHED;
            PG8_LDA(At, 0, 1); PG8_STAGE(PG8_SB(0, 0), b2, voffB); PG8_STAGE(PG8_SB(0, 1), b2 + hstepB, voffB); PG8_STAGE(PG8_SA(0, 0), a2, voffA);
            PG8_WAIT_V(8); PG8_WAIT_L(0); PG8_BAR; PG8_MMA(1, 0, At, B0); PG8_MMA(1, 1, At, B1); PG8_BAR; PG8_SCHED;
            PG8_LDB(B0, 1, 0); PG8_LDB(B1, 1, 1); PG8_SCHED; PG8_LDA(At, 1, 0); PG8_STAGE(PG8_SA(0, 1), a2 + hstepA, voffA);
            PG8_WAIT_V(8); PG8_WAIT_L(0); PG8_BAR; PG8_MMA(0, 0, At, B0); PG8_MMA(0, 1, At, B1); PG8_BAR; PG8_SCHED;
            PG8_LDA(At, 1, 1); PG8_STAGE(PG8_SB(1, 0), b3, voffB); PG8_STAGE(PG8_SB(1, 1), b3 + hstepB, voffB); PG8_STAGE(PG8_SA(1, 0), a3, voffA);
            PG8_WAIT_V(8); PG8_WAIT_L(0); PG8_BAR; PG8_MMA(1, 0, At, B0); PG8_MMA(1, 1, At, B1); PG8_BAR; PG8_SCHED;
            } else {
            PG8_LDB(B0, 0, 0); PG8_SCHED; PG8_LDA(At, 0, 0); PG8_STAGE(PG8_SA(1, 1), a1 + hstepA, voffA);
            PG8_WAIT_L(8); PG8_BAR; PG8_WAIT_L(0); PG8_MMA(0, 0, At, B0); PG8_BAR; PG8_SCHED;
            PG8_LDB(B1, 0, 1); PG8_STAGE(PG8_SB(0, 0), b2, voffB);
            PG8_BAR; PG8_WAIT_L(0); PG8_MMA(0, 1, At, B1); PG8_BAR;
            PG8_LDA(At, 0, 1); PG8_STAGE(PG8_SA(0, 0), a2, voffA);
            PG8_BAR; PG8_WAIT_L(0); PG8_MMA(1, 0, At, B0); PG8_BAR; PG8_SCHED;
            PG8_STAGE(PG8_SB(0, 1), b2 + hstepB, voffB);
            PG8_WAIT_V(6); PG8_BAR; PG8_MMA(1, 1, At, B1); PG8_BAR;
            PG8_LDB(B0, 1, 0); PG8_SCHED; PG8_LDA(At, 1, 0); PG8_STAGE(PG8_SA(0, 1), a2 + hstepA, voffA);
            PG8_WAIT_L(8); PG8_BAR; PG8_WAIT_L(0); PG8_MMA(0, 0, At, B0); PG8_BAR; PG8_SCHED;
            PG8_LDB(B1, 1, 1); PG8_STAGE(PG8_SB(1, 0), b3, voffB);
            PG8_BAR; PG8_WAIT_L(0); PG8_MMA(0, 1, At, B1); PG8_BAR;
            PG8_LDA(At, 1, 1); PG8_STAGE(PG8_SA(1, 0), a3, voffA);
            PG8_BAR; PG8_WAIT_L(0); PG8_MMA(1, 0, At, B0); PG8_BAR; PG8_SCHED;
            PG8_STAGE(PG8_SB(1, 1), b3 + hstepB, voffB);
            PG8_WAIT_V(6); PG8_BAR; PG8_MMA(1, 1, At, B1); PG8_BAR;
            }
        }
        if constexpr (ALIGN_EPI) { if (wr == 0) PG8_BAR; }
        if constexpr (!Epi::AFTER_DRAIN) { E(acc, cur, wr, wc, fr, fq); S.done(cur); }
        if (!has_next) break;
#pragma unroll
        for (int a = 0; a < 2; ++a)
#pragma unroll
            for (int b = 0; b < 2; ++b)
#pragma unroll
                for (int m = 0; m < 4; ++m)
#pragma unroll
                    for (int n = 0; n < 2; ++n) acc[a][b][m][n] = (f32x4){0.f, 0.f, 0.f, 0.f};
        cur = nxt; cA = nA; cB = nB; ++ui;
        if constexpr (ALIGN_EPI) { if (wr == 1) PG8_BAR; }
    }
    PG8_WAIT_V(0);
    if constexpr (!ALIGN_EPI) { if (wr == 0) PG8_BAR; }
    PG8_BAR;
#undef PG8_SA
#undef PG8_SB
#undef PG8_STAGE
#undef PG8_LDA
#undef PG8_LDB
#undef PG8_MMA
#undef PG8_WAIT_V
#undef PG8_WAIT_L
#undef PG8_BAR
#undef PG8_SCHED
}
}


namespace att {
typedef short s16x4 __attribute__((ext_vector_type(4)));
typedef float f32x16 __attribute__((ext_vector_type(16)));
constexpr int D = 128, NW = 8, QBLK = 32, KVBLK = 64, QB = NW * QBLK;
constexpr int SHM_V = KVBLK * D * 2, SHM_K = KVBLK * D * 2;
constexpr int ATT_LDS_BYTES = 2 * SHM_V + 2 * SHM_K + NW * 64 * 4;
constexpr float SCALE = 0.08838834764831845f, THR = 8.f;
#define KSWZ(row, colB) ((row) * 256 + ((colB) ^ (((row) & 7) << 4)))
#define SBAR() __builtin_amdgcn_sched_barrier(0)
__device__ __forceinline__ int v_st(int k, int c) { const int kk = (k & ~0xC) | ((k & 4) << 1) | ((k & 8) >> 1); return ((kk >> 3) * 4 + (c >> 5)) * 512 + ((kk & 7) * 32 + (c & 31)) * 2; }
__device__ __forceinline__ int v_rd_base(int lane) { return ((lane & 3) << 3) | (((lane >> 2) & 3) << 6) | (((lane >> 4) & 1) << 5) | (((lane >> 5) & 1) << 8); }
constexpr int v_rd_off(int d0, int ks, int half) { return d0 * 512 + ks * 4096 + half * 2048; }
__device__ __forceinline__ int crow(int r, int hi) { return (r & 3) + 8 * (r >> 2) + 4 * hi; }
__device__ __forceinline__ unsigned cvtpk(float lo, float hi) { unsigned r; asm volatile("v_cvt_pk_bf16_f32 %0, %1, %2" : "=v"(r) : "v"(lo), "v"(hi)); return r; }
__device__ __forceinline__ bf16x8 load8(const bf16_t* p) { return *reinterpret_cast<const bf16x8*>(p); }
__device__ __forceinline__ void mask_tile(f32x16& p0, f32x16& p1, int dq, unsigned W) {
    const float NEG = -__builtin_inff();
#pragma unroll
    for (int r = 0; r < 16; ++r) { const int c = (r & 3) + 8 * (r >> 2);
        if ((unsigned)(dq - c) >= W) p0[r] = NEG;
        if ((unsigned)(dq - c - 32) >= W) p1[r] = NEG; }
}
__device__ __forceinline__ void partialSM(f32x16& p0, f32x16& p1, float& m_reg, float& mn, float& alpha) {
    float pmax = p0[0]; for (int r = 1; r < 16; ++r) pmax = fmaxf(pmax, p0[r]); for (int r = 0; r < 16; ++r) pmax = fmaxf(pmax, p1[r]);
    { auto rr = __builtin_amdgcn_permlane32_swap(__float_as_uint(pmax), __float_as_uint(pmax), false, false);
      pmax = fmaxf(__uint_as_float(rr[0]), __uint_as_float(rr[1])); }
    constexpr float C2 = 1.4426950408889634f * SCALE;
    if (__builtin_expect(__all((pmax - m_reg) * SCALE <= THR), 1)) { mn = m_reg; alpha = 1.f; }
    else { mn = fmaxf(m_reg, pmax); alpha = __builtin_amdgcn_exp2f((m_reg - mn) * C2); m_reg = mn; }
    const float mnL = -mn * C2;
    for (int r = 0; r < 16; ++r) p0[r] = fmaf(p0[r], C2, mnL); for (int r = 0; r < 16; ++r) p1[r] = fmaf(p1[r], C2, mnL);
    for (int r = 0; r < 16; ++r) p0[r] = __builtin_amdgcn_exp2f(p0[r]);
}
__device__ __forceinline__ void finishSM(f32x16& p0, f32x16& p1, float alpha, float& l_reg, bf16x8& pa0, bf16x8& pa1, bf16x8& pa2, bf16x8& pa3) {
    for (int r = 0; r < 16; ++r) p1[r] = __builtin_amdgcn_exp2f(p1[r]);
    float ps = 0; for (int r = 0; r < 16; ++r) ps += p0[r]; for (int r = 0; r < 16; ++r) ps += p1[r];
    { auto rr = __builtin_amdgcn_permlane32_swap(__float_as_uint(ps), __float_as_uint(ps), false, false);
      ps = __uint_as_float(rr[0]) + __uint_as_float(rr[1]); }
    l_reg = l_reg * alpha + ps;
#define PK4(P, B_, OUT) do { unsigned a0 = cvtpk(P[B_+0], P[B_+1]), a1 = cvtpk(P[B_+2], P[B_+3]);                          \
        unsigned b0 = cvtpk(P[B_+4], P[B_+5]), b1 = cvtpk(P[B_+6], P[B_+7]);                                             \
        auto r0 = __builtin_amdgcn_permlane32_swap(a0, b0, false, false); auto r1 = __builtin_amdgcn_permlane32_swap(a1, b1, false, false); \
        u32x4 w = {r0[0], r1[0], r0[1], r1[1]}; OUT = *reinterpret_cast<bf16x8*>(&w); } while (0)
    PK4(p0, 0, pa0); PK4(p0, 8, pa1); PK4(p1, 0, pa2); PK4(p1, 8, pa3);
#undef PK4
}
template <int KB>
__device__ __forceinline__ void qkt(f32x16& p0, f32x16& p1, const char* K_lds, int r32, int hi, const bf16x8* qr, bool act) {
    if (!act) { const float NEG = -__builtin_inff();
#pragma unroll
        for (int r = 0; r < 16; ++r) { p0[r] = NEG; p1[r] = NEG; } return; }
    p0 = f32x16{}; p1 = f32x16{};
    const char* kb[4];
#pragma unroll
    for (int dd = 0; dd < 4; ++dd) kb[dd] = K_lds + KB * SHM_K + KSWZ(r32, (dd * 16 + hi * 8) * 2);
#pragma unroll
    for (int d0 = 0; d0 < 8; ++d0) { const char* a = kb[d0 & 3] + (d0 >> 2) * 128;
        bf16x8 b0 = *reinterpret_cast<const bf16x8*>(a);
        bf16x8 b1 = *reinterpret_cast<const bf16x8*>(a + 32 * 256);
        p0 = __builtin_amdgcn_mfma_f32_32x32x16_bf16(b0, qr[d0], p0, 0, 0, 0);
        p1 = __builtin_amdgcn_mfma_f32_32x32x16_bf16(b1, qr[d0], p1, 0, 0, 0); }
}
template <int VB>
__device__ __forceinline__ void pv_tile(f32x16* o, int vb0, bf16x8 pa0, bf16x8 pa1, bf16x8 pa2, bf16x8 pa3, bool act) {
    if (!act) return;
#define TRRD(dst, off) asm volatile("ds_read_b64_tr_b16 %0, %1 offset:%2" : "=&v"(dst) : "v"(vb0), "i"(off) : "memory")
#define PV_D0(d0) do { s16x4 l0, l1, l2, l3, h0, h1, h2, h3; constexpr int b_ = VB * SHM_V + v_rd_off(d0, 0, 0); \
        TRRD(l0, b_); TRRD(h0, b_ + 2048); TRRD(l1, b_ + 4096); TRRD(h1, b_ + 6144); TRRD(l2, b_ + 8192); TRRD(h2, b_ + 10240); TRRD(l3, b_ + 12288); TRRD(h3, b_ + 14336); \
        asm volatile("s_waitcnt lgkmcnt(0)" ::: "memory"); SBAR();   \
        o[d0] = __builtin_amdgcn_mfma_f32_32x32x16_bf16(pa0, (bf16x8){l0[0], l0[1], l0[2], l0[3], h0[0], h0[1], h0[2], h0[3]}, o[d0], 0, 0, 0);   \
        o[d0] = __builtin_amdgcn_mfma_f32_32x32x16_bf16(pa1, (bf16x8){l1[0], l1[1], l1[2], l1[3], h1[0], h1[1], h1[2], h1[3]}, o[d0], 0, 0, 0);   \
        o[d0] = __builtin_amdgcn_mfma_f32_32x32x16_bf16(pa2, (bf16x8){l2[0], l2[1], l2[2], l2[3], h2[0], h2[1], h2[2], h2[3]}, o[d0], 0, 0, 0);   \
        o[d0] = __builtin_amdgcn_mfma_f32_32x32x16_bf16(pa3, (bf16x8){l3[0], l3[1], l3[2], l3[3], h3[0], h3[1], h3[2], h3[3]}, o[d0], 0, 0, 0); } while (0)
    PV_D0(0); PV_D0(1); PV_D0(2); PV_D0(3);
#undef PV_D0
#undef TRRD
}
struct BlockRef { const bf16_t* Q; const bf16_t* K; const bf16_t* V; bf16_t* O; float* lse; int P0, pq, pk, skv, W, lsep, mode; };
struct Seam { bf16x8 qr[8]; bf16x8 st_v0, st_v1, st_k0, st_k1; };
__device__ __forceinline__ int swa_jlo(int P0, int W) { const int lowk = P0 - W + 1; return lowk > 0 ? lowk / KVBLK : 0; }
#define ROWK(p, k0, rr, pk_) ((const bf16_t*)((const char*)(p) + (size_t)(unsigned)((((unsigned)((k0) + (rr))) * (unsigned)(pk_) + (unsigned)sc) * 2u)))
#define VMW() asm volatile("s_waitcnt vmcnt(0)" ::: "memory")
#define VMWN(n) asm volatile("s_waitcnt vmcnt(%0)" :: "i"(n) : "memory")
#define SLOAD_H(Kp, Vp, k0, pk_) do { S.st_v0 = load8(ROWK(Vp, k0, sr, pk_)); S.st_v1 = load8(ROWK(Vp, k0, 32 + sr, pk_));              \
                         S.st_k0 = load8(ROWK(Kp, k0, sr, pk_)); S.st_k1 = load8(ROWK(Kp, k0, 32 + sr, pk_)); } while (0)
#define SWRITE_HK(bf) do { *(bf16x8*)(K_lds + (bf) * SHM_K + kws) = S.st_k0; *(bf16x8*)(K_lds + (bf) * SHM_K + kws + 32 * 256) = S.st_k1; } while (0)
#define SWRITE_HV(bf) do { *(bf16x8*)(V_lds + (bf) * SHM_V + vst0) = S.st_v0; *(bf16x8*)(V_lds + (bf) * SHM_V + vst1) = S.st_v1; } while (0)
#define SWRITE_H(bf) do { SWRITE_HV(bf); SWRITE_HK(bf); } while (0)
__device__ __forceinline__ void swa_prime(const BlockRef& cur, char* lds, Seam& S, int tid) {
    const int wid = __builtin_amdgcn_readfirstlane(tid >> 6), lane = tid & 63, r32 = lane & 31, hi = lane >> 5;
    const int sr = tid >> 4, sc = (tid & 15) * 8, kws = KSWZ(sr, sc * 2); char* K_lds = lds + 2 * SHM_V;
    const int kb0 = swa_jlo(cur.P0, cur.W) * KVBLK;
    { const unsigned qoff = ((unsigned)(wid * QBLK + r32) * (unsigned)cur.pq + (unsigned)hi * 8u) * 2u;
      for (int d0 = 0; d0 < 8; ++d0) S.qr[d0] = *(const bf16x8*)((const char*)cur.Q + (size_t)qoff + d0 * 32); }
    SLOAD_H(cur.K, cur.V, kb0, cur.pk); VMW(); SWRITE_HK(0);
    __syncthreads();
}
__device__ __forceinline__ void swa_block(const BlockRef& cur, const BlockRef& nxt, char* lds, Seam& S, int tid) {
    const int wid = __builtin_amdgcn_readfirstlane(tid >> 6), lane = tid & 63, r32 = lane & 31, hi = lane >> 5;
    const int W = cur.W, pk = cur.pk;
    const int j_lo = swa_jlo(cur.P0, W);
    int j_hi = (cur.P0 + QB - 1) / KVBLK + 1; if (j_hi > cur.skv / KVBLK) j_hi = cur.skv / KVBLK;
    const int NT = j_hi - j_lo;
    const int kbn = swa_jlo(nxt.P0, nxt.W) * KVBLK;
    const int qlo = cur.P0 + wid * QBLK, qm = qlo + r32 - 4 * hi;
    char* V_lds = lds; char* K_lds = lds + 2 * SHM_V;
    float* ws = (float*)(lds + 2 * SHM_V + 2 * SHM_K) + wid * 64; float* li_l = ws, * al_l = ws + 32;
    float m_reg = -1e30f, l_reg = 0; f32x16 o[4] = {};
    const int sr = tid >> 4, sc = (tid & 15) * 8, vst0 = v_st(sr, sc), vst1 = v_st(32 + sr, sc), kws = KSWZ(sr, sc * 2);
    const int vb0 = (int)(uintptr_t)V_lds + v_rd_base(lane);
    const bf16_t* Kh = cur.K; const bf16_t* Vh = cur.V;
#define RESC(a) do { if (__any((a) < 1.f)) { if (hi == 0) al_l[r32] = (a); asm volatile("s_waitcnt lgkmcnt(0)" ::: "memory");              \
                     for (int d_ = 0; d_ < 4; ++d_) for (int r = 0; r < 16; ++r) o[d_][r] *= al_l[crow(r, hi)]; } } while (0)
#define KBASE(t) ((j_lo + (t)) * KVBLK)
#define ACT(t) (KBASE(t) <= qlo + QBLK - 1 && KBASE(t) + KVBLK - 1 >= qlo - W + 1)
#define MASKT(P0_, P1_, t) do { const int kb_ = KBASE(t); if (ACT(t) && (kb_ + KVBLK - 1 > qlo || kb_ <= qlo + QBLK - 1 - W)) mask_tile(P0_, P1_, qm - kb_, (unsigned)W); } while (0)
    constexpr int NQL = 8;
#define SEAM_K0() do { VMWN(NQL); SWRITE_HK(0); SBAR(); } while (0)
    f32x16 pA0, pA1, pB0, pB1; float mnA, mnB, alA, alB; bf16x8 pa0, pa1, pa2, pa3;
    SWRITE_HV(0); SBAR();
    if (NT > 1) { SLOAD_H(Kh, Vh, KBASE(1), pk); }
    SBAR(); qkt<0>(pA0, pA1, K_lds, r32, hi, S.qr, ACT(0));
    MASKT(pA0, pA1, 0); partialSM(pA0, pA1, m_reg, mnA, alA);
    if (NT > 1) { VMW(); SWRITE_H(1); }
    __syncthreads();
#define HALF_STEP(PX0, PX1, mnX, alX, PY0, PY1, alY, t, KB, VB, SB) do {                                                      \
        SBAR(); qkt<KB>(PX0, PX1, K_lds, r32, hi, S.qr, ACT(t));                                             \
        finishSM(PY0, PY1, alY, l_reg, pa0, pa1, pa2, pa3); SBAR();                                                           \
        if ((t) + 1 < NT) { SLOAD_H(Kh, Vh, KBASE((t) + 1), pk); SBAR(); }                                               \
        pv_tile<VB>(o, vb0, pa0, pa1, pa2, pa3, ACT((t) - 1)); MASKT(PX0, PX1, (t)); partialSM(PX0, PX1, m_reg, mnX, alX);                                        \
        __syncthreads();                                                                                                      \
        if ((t) + 1 < NT) { VMW(); SWRITE_H(SB); }                                                                          \
        RESC(alX); __syncthreads(); } while (0)
    for (int t = 1; t + 1 < NT; t += 2) {
        HALF_STEP(pB0, pB1, mnB, alB, pA0, pA1, alA, t, 1, 0, 0);
        HALF_STEP(pA0, pA1, mnA, alA, pB0, pB1, alB, t + 1, 0, 1, 1);
    }
    const bool even = (NT & 1) == 0;
    if (even) { SBAR(); qkt<1>(pB0, pB1, K_lds, r32, hi, S.qr, ACT(NT - 1)); SBAR(); }
    { SLOAD_H(nxt.K, nxt.V, kbn, nxt.pk); SBAR();
        const unsigned qoff = ((unsigned)(wid * QBLK + r32) * (unsigned)nxt.pq + (unsigned)hi * 8u) * 2u;
#pragma unroll
        for (int d0 = 0; d0 < 8; ++d0) S.qr[d0] = *(const bf16x8*)((const char*)nxt.Q + (size_t)qoff + d0 * 32); }
    SBAR();
    finishSM(pA0, pA1, alA, l_reg, pa0, pa1, pa2, pa3); SBAR();
    pv_tile<0>(o, vb0, pa0, pa1, pa2, pa3, ACT(even ? NT - 2 : NT - 1));
    if (even) { MASKT(pB0, pB1, NT - 1); partialSM(pB0, pB1, m_reg, mnB, alB); __syncthreads(); RESC(alB);
        finishSM(pB0, pB1, alB, l_reg, pa0, pa1, pa2, pa3); SBAR(); pv_tile<1>(o, vb0, pa0, pa1, pa2, pa3, ACT(NT - 1)); }
    SBAR(); SEAM_K0();
    if (hi == 0) li_l[r32] = l_reg; asm volatile("s_waitcnt lgkmcnt(0)" ::: "memory");
    float rli[16];
#pragma unroll
    for (int r = 0; r < 16; ++r) rli[r] = __builtin_amdgcn_rcpf(li_l[crow(r, hi)]);
    int r32e = r32, hie = hi; asm volatile("" : "+v"(r32e), "+v"(hie));
    bf16_t* Ow = cur.O + (size_t)(wid * QBLK) * cur.pq;
    const unsigned pqu = (unsigned)cur.pq, lane_off = (unsigned)(4 * hie) * pqu + (unsigned)r32e;
    if (cur.mode == 2) {
        float sink = 0.f;
#pragma unroll
        for (int r = 0; r < 16; ++r)
#pragma unroll
            for (int d0 = 0; d0 < 4; ++d0) sink += o[d0][r] * rli[r];
        asm volatile("" :: "v"(sink), "v"(m_reg));
    } else if (cur.mode == 0) {
        if (hie == 0) cur.lse[(size_t)(wid * QBLK + r32e) * cur.lsep] = m_reg * SCALE + __logf(l_reg);
#pragma unroll
        for (int r = 0; r < 16; ++r) { const unsigned roff = lane_off + (unsigned)((r & 3) + 8 * (r >> 2)) * pqu;
#pragma unroll
            for (int d0 = 0; d0 < 4; ++d0) { const float v = o[d0][r] * rli[r]; const float vn = __shfl_xor(v, 1);
                if ((r32e & 1) == 0) *(unsigned*)(Ow + (size_t)(roff + d0 * 32)) = cvtpk(v, vn); } }
    } else {
#pragma unroll
        for (int rb = 0; rb < 16; rb += 4) { unsigned zz[4][4];
#pragma unroll
            for (int rr = 0; rr < 4; ++rr) { const unsigned roff = lane_off + (unsigned)(((rb + rr) & 3) + 8 * ((rb + rr) >> 2)) * pqu;
#pragma unroll
                for (int d0 = 0; d0 < 4; ++d0) zz[rr][d0] = ((r32e & 1) == 0) ? *(const unsigned*)(Ow + (size_t)(roff + d0 * 32)) : 0u; }
#pragma unroll
            for (int rr = 0; rr < 4; ++rr) { const int r = rb + rr; const unsigned roff = lane_off + (unsigned)((r & 3) + 8 * (r >> 2)) * pqu;
#pragma unroll
                for (int d0 = 0; d0 < 4; ++d0) { const float v = o[d0][r] * rli[r]; const float vn = __shfl_xor(v, 1);
                    if ((r32e & 1) == 0) *(unsigned*)(Ow + (size_t)(roff + d0 * 32)) = cvtpk(v * silu(__uint_as_float(zz[rr][d0] << 16)), vn * silu(__uint_as_float(zz[rr][d0] & 0xffff0000u))); } } }
    }
    __syncthreads();
#undef RESC
#undef KBASE
#undef ACT
#undef MASKT
#undef SEAM_K0
#undef HALF_STEP
}
#undef ROWK
#undef VMW
#undef VMWN
#undef SLOAD_H
#undef SWRITE_HK
#undef SWRITE_HV
#undef SWRITE_H
#undef KSWZ
#undef SBAR
}

typedef GAS unsigned gu32;
#define RLX_AGENT __ATOMIC_RELAXED, __HIP_MEMORY_SCOPE_AGENT
#define XB_TMO      128
#define XB_XCNT(j)  (256  + 64 * (j))
#define XB_XSUB(j)  (1280 + 64 * (j))
#define XB_XGEN(j)  (2304 + 64 * (j))
#define XB_TOP      3328
#define XB_TOPGEN   3392
#define XCD_BAR_WORDS 3456
#define XB_SPIN_CAP (1u << 18)
__device__ __forceinline__ unsigned xb_ld(unsigned* p)              { return __hip_atomic_load(p, __ATOMIC_RELAXED, __HIP_MEMORY_SCOPE_AGENT); }
__device__ __forceinline__ unsigned xb_add(unsigned* p, unsigned v) { return __hip_atomic_fetch_add(p, v, __ATOMIC_RELAXED, __HIP_MEMORY_SCOPE_AGENT); }
__device__ __forceinline__ unsigned xb_xcc_id() { return (unsigned)__builtin_amdgcn_s_getreg((3 << 11) | 20) & 0xFu; }
#define XB_SPIN(cond, bar) do { unsigned _sp = 0; while (cond) { __builtin_amdgcn_s_sleep(1); \
    if ((++_sp & 255u) == 0u) { if (xb_ld(&(bar)[XB_TMO])) break; if (_sp > XB_SPIN_CAP) { atomicAdd(&(bar)[XB_TMO], 1u); break; } } } } while (0)
struct XcdBarrier { unsigned* bar; unsigned x; volatile LAS unsigned* st; };
__device__ __forceinline__ XcdBarrier xcd_barrier_post(unsigned* bar, volatile LAS unsigned* st, int tid) {
    XcdBarrier b; b.bar = bar; b.x = xb_xcc_id(); b.st = st;
    if (tid == 0) (void)xb_add(&bar[XB_XCNT(b.x)], 1u);
    return b;
}
__device__ __forceinline__ void xcd_barrier_complete(unsigned* bar, unsigned x, unsigned& nloc, unsigned& nx) {
    const unsigned G = gridDim.x * gridDim.y * gridDim.z;
    unsigned sum, cnt, mine, sp = 0u;
    for (;;) {
        sum = 0u; cnt = 0u; mine = 0u;
#pragma unroll
        for (unsigned j = 0; j < 16; ++j) { const unsigned c = xb_ld(&bar[XB_XCNT(j)]); sum += c; cnt += (c > 0u) ? 1u : 0u; mine = (j == x) ? c : mine; }
        if (sum == G) break;
        __builtin_amdgcn_s_sleep(1);
        if ((++sp & 255u) == 0u) { if (xb_ld(&bar[XB_TMO])) break; if (sp > XB_SPIN_CAP) { atomicAdd(&bar[XB_TMO], 1u); break; } }
    }
    nloc = mine > 0u ? mine : 1u; nx = cnt > 0u ? cnt : 1u;
}
__device__ __forceinline__ void xcd_barrier(const XcdBarrier& b, int tid) {
    asm volatile("s_waitcnt vmcnt(0)" ::: "memory");
    __syncthreads();
    if (tid == 0) {
        unsigned* bar = b.bar;
        __builtin_amdgcn_s_waitcnt(0);
        unsigned nloc = b.st[0], nx = b.st[1];
        if (nloc == 0u) { xcd_barrier_complete(bar, b.x, nloc, nx); b.st[0] = nloc; b.st[1] = nx; }
        const unsigned old = xb_add(&bar[XB_XSUB(b.x)], 1u);
        const unsigned gen = old / nloc;
        if (old + 1u == (gen + 1u) * nloc) {
            __builtin_amdgcn_fence(__ATOMIC_RELEASE, "agent");
            asm volatile("s_waitcnt vmcnt(0)" ::: "memory");
            const unsigned og = xb_add(&bar[XB_TOP], 1u);
            const unsigned tg = og / nx;
            if (og + 1u == (tg + 1u) * nx) xb_add(&bar[XB_TOPGEN], 1u);
            else XB_SPIN(xb_ld(&bar[XB_TOPGEN]) == tg, bar);
            __builtin_amdgcn_fence(__ATOMIC_ACQUIRE, "agent");
            xb_add(&bar[XB_XGEN(b.x)], 1u);
            asm volatile("s_waitcnt vmcnt(0)" ::: "memory");
        } else {
            XB_SPIN(xb_ld(&bar[XB_XGEN(b.x)]) == gen, bar);
            __builtin_amdgcn_fence(__ATOMIC_ACQUIRE, "agent");
            asm volatile("s_waitcnt vmcnt(0)" ::: "memory");
        }
    }
    __syncthreads();
}

__device__ __forceinline__ int lane_id_opaque() { int l; asm volatile("v_mbcnt_lo_u32_b32 %0, -1, 0\n\tv_mbcnt_hi_u32_b32 %0, -1, %0" : "=v"(l)); return l; }
struct Frame {
    LAS unsigned char* lds;
    int tid, lane, wave, vcu, G;
};

__device__ __forceinline__ void transpose_item(const float* __restrict__ W, int K, int N, bf16_t* WT, int row_off, const float* __restrict__ g, LAS float* scr, int item, int lane, bool dry = false) {
    const int nblk = N / 32, kb = item / nblk, nb = item % nblk, k0 = 64 * kb, n0 = 32 * nb;
#pragma unroll 8
    for (int i = 0; i < 32; ++i) { const int kk = 2 * i + (lane >> 5); float v = W[(size_t)(k0 + kk) * N + n0 + (lane & 31)]; if (g) v *= g[k0 + kk]; scr[kk * 33 + (lane & 31)] = v; }
    asm volatile("s_waitcnt lgkmcnt(0)" ::: "memory");
    const int c = lane & 7;
#pragma unroll
    for (int j = 0; j < 4; ++j) { const int n = (lane >> 3) + 8 * j; const LAS float* s = scr + (8 * c) * 33 + n;
        u32x4 o; o.x = pk2(s[0 * 33], s[1 * 33]); o.y = pk2(s[2 * 33], s[3 * 33]); o.z = pk2(s[4 * 33], s[5 * 33]); o.w = pk2(s[6 * 33], s[7 * 33]);
        if (!dry) *(u32x4*)(WT + (size_t)(row_off + n0 + n) * K + k0 + 8 * c) = o; }
    asm volatile("s_waitcnt lgkmcnt(0)" ::: "memory");
}
__device__ __forceinline__ void convert_weight(const Frame& F, const float* W, int K, int N, bf16_t* WT, int row_off, const float* g, bool dry = false) {
    LAS float* scr = (LAS float*)(F.lds + F.wave * 16384);
    const int gw = F.vcu * NWAVES + F.wave, NGW = F.G * NWAVES, nitems = (K / 64) * (N / 32);
    for (int it = gw; it < nitems; it += NGW) transpose_item(W, K, N, WT, row_off, g, scr, it, F.lane, dry);
}

__device__ __forceinline__ void attnA_naive(const Frame& F, bf16_t* proj) {
    LAS float* q_s = (LAS float*)(F.lds) + F.wave * 384; LAS float* p_s = (LAS float*)(F.lds + 16384) + F.wave * 448;
    const int lane = F.lane, gw = F.vcu * NWAVES + F.wave, nw = F.G * NWAVES;
    for (int item = gw; item < NT * 4; item += nw) {
        const int tok = item >> 2, h = item & 3, b = tok / SEQ, t = tok % SEQ;
        for (int j = lane; j < 384; j += 64) { const int g = j >> 7, d = j & 127; q_s[g * 128 + d] = bf2f(proj[(size_t)tok * EP + g * 1024 + h * 128 + d]); }
        asm volatile("s_waitcnt lgkmcnt(0)" ::: "memory");
        float sc[7]; float mx = -INFINITY;
#pragma unroll
        for (int i = 0; i < 7; ++i) { const int kk = lane + 64 * i; sc[i] = -INFINITY;
            if (kk < 387) { const int g = kk / 129, off = kk % 129, dil = (g == 0) ? 1 : (g == 1 ? 4 : 16), kpos = t - off * dil;
                if (kpos >= 0) { const bf16_t* kr = proj + (size_t)(b * SEQ + kpos) * EP + g * 1024 + 512 + h * 128; float s = 0.f;
                    for (int d = 0; d < 128; d += 8) { const uint4 v = *(const uint4*)(kr + d); const unsigned wv[4] = {v.x, v.y, v.z, v.w};
#pragma unroll
                        for (int j = 0; j < 4; ++j) s += q_s[g * 128 + d + 2 * j] * __uint_as_float(wv[j] << 16) + q_s[g * 128 + d + 2 * j + 1] * __uint_as_float(wv[j] & 0xffff0000u); }
                    sc[i] = s * ATT_SCALE; } }
            mx = fmaxf(mx, sc[i]); }
        mx = wave_max(mx); float l = 0.f;
#pragma unroll
        for (int i = 0; i < 7; ++i) { const float p = __expf(sc[i] - mx); l += p; p_s[lane + 64 * i] = p; }
        l = wave_sum(l);
        asm volatile("s_waitcnt lgkmcnt(0)" ::: "memory");
        float a0 = 0.f, a1 = 0.f;
        for (int kk = 0; kk < 387; ++kk) { const int g = kk / 129, off = kk % 129, dil = (g == 0) ? 1 : (g == 1 ? 4 : 16), kpos = t - off * dil;
            if (kpos >= 0) { const float p = p_s[kk]; const unsigned v = *(const unsigned*)(proj + (size_t)(b * SEQ + kpos) * EP + E_VA + h * 128 + 2 * lane);
                a0 += p * __uint_as_float(v << 16); a1 += p * __uint_as_float(v & 0xffff0000u); } }
        const float il = 1.f / l; bf16_t* zp = proj + (size_t)tok * EP + E_Z + h * 128 + 2 * lane;
        const unsigned zz = *(const unsigned*)zp;
        *(unsigned*)zp = pk2(a0 * il * silu(__uint_as_float(zz << 16)), a1 * il * silu(__uint_as_float(zz & 0xffff0000u)));
        asm volatile("s_waitcnt lgkmcnt(0)" ::: "memory");
    }
}
__device__ __forceinline__ void attnM_naive(const Frame& F, bf16_t* proj, int ld, int qcol, int zcol, const bf16_t* __restrict__ mkv  ) {
    LAS float* q_s = (LAS float*)(F.lds) + F.wave * 128; LAS float* p_s = (LAS float*)(F.lds + 16384) + F.wave * 256;
    const int lane = F.lane, gw = F.vcu * NWAVES + F.wave, nw = F.G * NWAVES;
    for (int item = gw; item < NT * 4; item += nw) {
        const int tok = item >> 2, h = item & 3, b = tok / SEQ;
        for (int j = lane; j < 128; j += 64) q_s[j] = bf2f(proj[(size_t)tok * ld + qcol + h * 128 + j]);
        asm volatile("s_waitcnt lgkmcnt(0)" ::: "memory");
        float sc[4]; float mx = -INFINITY;
#pragma unroll
        for (int i = 0; i < 4; ++i) { const int kk = lane + 64 * i; const bf16_t* kr = mkv + (size_t)(b * NMEM + kk) * 4096 + h * 128; float s = 0.f;
            for (int d = 0; d < 128; d += 8) { const uint4 v = *(const uint4*)(kr + d); const unsigned wv[4] = {v.x, v.y, v.z, v.w};
#pragma unroll
                for (int j = 0; j < 4; ++j) s += q_s[d + 2 * j] * __uint_as_float(wv[j] << 16) + q_s[d + 2 * j + 1] * __uint_as_float(wv[j] & 0xffff0000u); }
            sc[i] = s * ATT_SCALE; mx = fmaxf(mx, sc[i]); }
        mx = wave_max(mx); float l = 0.f;
#pragma unroll
        for (int i = 0; i < 4; ++i) { const float p = __expf(sc[i] - mx); l += p; p_s[lane + 64 * i] = p; }
        l = wave_sum(l);
        asm volatile("s_waitcnt lgkmcnt(0)" ::: "memory");
        float a0 = 0.f, a1 = 0.f;
        for (int kk = 0; kk < 256; ++kk) { const float p = p_s[kk]; const unsigned v = *(const unsigned*)(mkv + (size_t)(b * NMEM + kk) * 4096 + 512 + h * 128 + 2 * lane);
            a0 += p * __uint_as_float(v << 16); a1 += p * __uint_as_float(v & 0xffff0000u); }
        const float il = 1.f / l; bf16_t* zp = proj + (size_t)tok * ld + zcol + h * 128 + 2 * lane;
        const unsigned zz = *(const unsigned*)zp;
        *(unsigned*)zp = pk2(a0 * il * silu(__uint_as_float(zz << 16)), a1 * il * silu(__uint_as_float(zz & 0xffff0000u)));
        asm volatile("s_waitcnt lgkmcnt(0)" ::: "memory");
    }
}
__device__ __forceinline__ void pool_naive(const Frame& F, bf16_t* proj, const float* __restrict__ wpool, const float* __restrict__ scale) {
    LAS float* pooled = (LAS float*)(F.lds);
    const int tid = F.tid, gi = tid >> 7, c = tid & 127;
    for (int tok = F.vcu; tok < NT; tok += F.G) {
        const int t = tok % SEQ, w = 2 << gi, cnt = (t + 1 < w) ? t + 1 : w;
        float s = 0.f;
        for (int j = 0; j < cnt; ++j) s += bf2f(proj[(size_t)(tok - j) * EP + E_XB + gi * 128 + c]);
        pooled[gi * 128 + c] = s / (float)cnt - bf2f(proj[(size_t)tok * EP + E_XB + gi * 128 + c]);
        __syncthreads();
        float y = 0.f;
        for (int cc = 0; cc < 128; ++cc) y += pooled[gi * 128 + cc] * wpool[(gi * 128 + cc) * 128 + c];
        bf16_t* zp = proj + (size_t)tok * EP + E_Z + 512 + gi * 128 + c;
        *zp = (bf16_t)f2bf(y * scale[gi * 128 + c] * silu(bf2f(*zp)));
        __syncthreads();
    }
}
__device__ __forceinline__ void cmix_naive(const Frame& F, bf16_t* proj, const float* __restrict__ ln_g, const float* __restrict__ ln_b,
                                           const float* __restrict__ w_s, const float* __restrict__ b_s) {
    LAS float* vn = (LAS float*)(F.lds); LAS float* mu = vn + 128 * 128; LAS float* rstd = mu + 128;
    const int tid = F.tid, lane = F.lane, wv = F.wave;
    for (int ch = F.vcu; ch < NT / 128; ch += F.G) {
        const size_t row0 = (size_t)ch * 128;
        for (int r = wv; r < 128; r += 8) { const bf16_t* vr = proj + (row0 + r) * OP + O_V; float s = 0.f, s2 = 0.f;
            for (int j = lane; j < 1024; j += 64) { const float v = bf2f(vr[j]); s += v; }
            s = wave_sum(s); const float m = s * (1.f / 1024.f);
            for (int j = lane; j < 1024; j += 64) { const float v = bf2f(vr[j]) - m; s2 += v * v; }
            s2 = wave_sum(s2);
            if (lane == 0) { mu[r] = m; rstd[r] = rsqrtf(s2 * (1.f / 1024.f) + EPS); } }
        __syncthreads();
        for (int g = 0; g < 8; ++g) {
            for (int i = tid; i < 128 * 128; i += NTHREADS) { const int s = i >> 7, c = i & 127;
                vn[i] = (bf2f(proj[(row0 + s) * OP + O_V + g * 128 + c]) - mu[s]) * rstd[s] * ln_g[g * 128 + c] + ln_b[g * 128 + c]; }
            __syncthreads();
            const int c = tid & 127, tq = tid >> 7;
            for (int t = tq * 32; t < tq * 32 + 32; ++t) { float acc = 0.f; const float* wr = w_s + ((size_t)g * 128 + t) * 128;
                for (int s = 0; s <= t; ++s) acc += wr[s] * vn[s * 128 + c];
                const float mixed = acc + b_s[g * 128 + t];
                const float u = bf2f(proj[(row0 + t) * OP + O_U + g * 128 + c]);
                bf16_t* zp = proj + (row0 + t) * OP + O_Z + g * 128 + c;
                *zp = (bf16_t)f2bf(u * mixed * silu(bf2f(*zp))); }
            __syncthreads();
        }
    }
}


__device__ __forceinline__ att::BlockRef att_item(int L, bool even, bf16_t* proj, const bf16_t* mkv, float* lse, bool dry) {
    att::BlockRef r;
    if (even && L < 1536) {
        const int g = L >> 9, rem = L & 511, b = rem >> 6, h = (rem >> 4) & 3, x = rem & 15;
        const int dsh = 2 * g, dil = 1 << dsh, nqb = 16 >> dsh, rr = x >> (4 - dsh), qb = x & (nqb - 1);
        const size_t tok0 = (size_t)b * SEQ + rr;
        bf16_t* base = proj + tok0 * EP;
        r.Q = base + (size_t)qb * 256 * dil * EP + g * 1024 + h * 128; r.O = base + (size_t)qb * 256 * dil * EP + g * 1024 + h * 128;
        r.K = base + g * 1024 + 512 + h * 128; r.V = base + E_VA + h * 128;
        r.P0 = qb * 256; r.pq = dil * EP; r.pk = dil * EP; r.skv = SEQ >> dsh; r.W = 129; r.mode = 0;
        r.lse = lse + ((size_t)g * NT + tok0 + (size_t)qb * 256 * dil) * 4 + h; r.lsep = dil * 4;
    } else {
        const int m = even ? L - 1536 : L, b = m >> 6, h = (m >> 4) & 3, qb = m & 15;
        const int ld = even ? EP : OP, qcol = even ? E_QM : O_QM, zcol = (even ? E_Z : O_Z) + 1024;
        const size_t row0 = (size_t)b * SEQ + qb * 256;
        r.Q = proj + row0 * ld + qcol + h * 128; r.O = proj + row0 * ld + zcol + h * 128;
        r.K = mkv + (size_t)(b * NMEM) * 4096 + h * 128; r.V = r.K + 512;
        r.P0 = 256; r.pq = ld; r.pk = 4096; r.skv = 256; r.W = 1 << 20; r.mode = 1; r.lse = nullptr; r.lsep = 0;
    }
    if (dry) r.mode = 2;
    return r;
}
__device__ __forceinline__ void attn_phase(char* lds, int vcu, int G, bool even, bf16_t* proj, const bf16_t* mkv, float* lse, int tid_in, bool dry = false, int lo = 0, int hi = 1 << 30) {
    int tid = tid_in; asm volatile("" : "+v"(tid));
    const int total = (even ? 2048 : 512) < hi ? (even ? 2048 : 512) : hi;
    int L = vcu + lo; if (L >= total) return;
    att::BlockRef cur = att_item(L, even, proj, mkv, lse, dry);
    att::Seam S;
    att::swa_prime(cur, lds, S, tid);
    for (;;) {
        const int Ln = L + G; const bool last = Ln >= total;
        const att::BlockRef nxt = last ? cur : att_item(Ln, even, proj, mkv, lse, dry);
        att::swa_block(cur, nxt, lds, S, tid);
        if (last) break;
        cur = nxt; L = Ln;
    }
}
__device__ __forceinline__ void combine_phase(const Frame& F, bf16_t* proj, const float* __restrict__ lse, bool dry = false) {
    const int lane = F.lane, h = lane >> 4, dc = (lane & 15) * 8, NGW = F.G * NWAVES;
    for (int tok0 = (F.vcu * NWAVES + F.wave) * 4; tok0 < NT; tok0 += NGW * 4) {
        u32x4 o0[4], o1[4], o2[4], zz[4]; float w0[4], w1[4], w2[4];
#pragma unroll
        for (int q = 0; q < 4; ++q) { const int tok = tok0 + q; const bf16_t* row = proj + (size_t)tok * EP + h * 128 + dc;
            w0[q] = lse[((size_t)0 * NT + tok) * 4 + h]; w1[q] = lse[((size_t)1 * NT + tok) * 4 + h]; w2[q] = lse[((size_t)2 * NT + tok) * 4 + h];
            o0[q] = *(const u32x4*)(row); o1[q] = *(const u32x4*)(row + 1024); o2[q] = *(const u32x4*)(row + 2048); zz[q] = *(const u32x4*)(row + E_Z); }
#pragma unroll
        for (int q = 0; q < 4; ++q) { const int tok = tok0 + q; bf16_t* row = proj + (size_t)tok * EP + h * 128 + dc;
            const float M = fmaxf(w0[q], fmaxf(w1[q], w2[q])); float a0 = __expf(w0[q] - M), a1 = __expf(w1[q] - M), a2 = __expf(w2[q] - M);
            const float inv = 1.f / (a0 + a1 + a2); a0 *= inv; a1 *= inv; a2 *= inv;
            u32x4 y;
#pragma unroll
            for (int j = 0; j < 4; ++j) {
                const float a = a0 * __uint_as_float(o0[q][j] << 16) + a1 * __uint_as_float(o1[q][j] << 16) + a2 * __uint_as_float(o2[q][j] << 16);
                const float b = a0 * __uint_as_float(o0[q][j] & 0xffff0000u) + a1 * __uint_as_float(o1[q][j] & 0xffff0000u) + a2 * __uint_as_float(o2[q][j] & 0xffff0000u);
                y[j] = pk2(a * silu(__uint_as_float(zz[q][j] << 16)), b * silu(__uint_as_float(zz[q][j] & 0xffff0000u))); }
            if (!dry) *(u32x4*)(row + E_Z) = y; }
    }
}
__device__ __forceinline__ void pool_phase(const Frame& F, bf16_t* proj, const bf16_t* __restrict__ wpT, const float* __restrict__ scale, bool dry = false) {
    const int tid = F.tid, lane = F.lane, wv = F.wave, fr = lane & 15, fq = lane >> 4;
    LAS unsigned char* A = F.lds;
    for (int item = F.vcu; item < NT / 64; item += F.G) {
        const int t0 = item * 64, p0 = t0 % SEQ;
        { const int gi = tid >> 7, c = tid & 127, w = 2 << gi; const bf16_t* xc = proj + (size_t)t0 * EP + E_XB + gi * 128 + c;
          float sum = 0.f;
          for (int j = 1; j <= w; ++j) if (p0 - j >= 0) sum += bf2f(xc[-(long)j * EP]);
          for (int i = 0; i < 64; ++i) { const int p = p0 + i; const float xv = bf2f(xc[(long)i * EP]); sum += xv;
              if (p >= w) sum -= bf2f(xc[(long)(i - w) * EP]);
              const int cnt = (p + 1 < w) ? p + 1 : w;
              *(LAS bf16_t*)(A + (gi * 64 + i) * 272 + c * 2) = (bf16_t)f2bf(sum / (float)cnt - xv); } }
        __syncthreads();
        { const int gi = wv >> 1, nh = wv & 1;
          f32x4 acc[4][4];
#pragma unroll
          for (int m = 0; m < 4; ++m)
#pragma unroll
              for (int n = 0; n < 4; ++n) acc[m][n] = (f32x4){0.f, 0.f, 0.f, 0.f};
#pragma unroll
          for (int ks = 0; ks < 4; ++ks) { bf16x8 a[4], b[4];
#pragma unroll
              for (int m = 0; m < 4; ++m) a[m] = *(const LAS bf16x8*)(A + (gi * 64 + m * 16 + fr) * 272 + (ks * 32 + 8 * fq) * 2);
#pragma unroll
              for (int n = 0; n < 4; ++n) b[n] = *(const bf16x8*)(wpT + (size_t)(gi * 128 + nh * 64 + n * 16 + fr) * 128 + ks * 32 + 8 * fq);
#pragma unroll
              for (int m = 0; m < 4; ++m)
#pragma unroll
                  for (int n = 0; n < 4; ++n) acc[m][n] = __builtin_amdgcn_mfma_f32_16x16x32_bf16(a[m], b[n], acc[m][n], 0, 0, 0); }
#pragma unroll
          for (int n = 0; n < 4; ++n) { const int d = gi * 128 + nh * 64 + n * 16 + fr; const float sc = scale[d]; bf16_t zv[4][4];
#pragma unroll
              for (int m = 0; m < 4; ++m)
#pragma unroll
                  for (int r = 0; r < 4; ++r) zv[m][r] = proj[(size_t)(t0 + m * 16 + 4 * fq + r) * EP + E_Z + 512 + d];
#pragma unroll
              for (int m = 0; m < 4; ++m)
#pragma unroll
                  for (int r = 0; r < 4; ++r) { const bf16_t yv = (bf16_t)f2bf(acc[m][n][r] * sc * silu(bf2f(zv[m][r]))); if (!dry) proj[(size_t)(t0 + m * 16 + 4 * fq + r) * EP + E_Z + 512 + d] = yv; } } }
        __syncthreads();
    }
}
__device__ __forceinline__ void cmix_phase(const Frame& F, bf16_t* proj, const float* __restrict__ ln_g, const float* __restrict__ ln_b,
                                           const bf16_t* __restrict__ wsm  , const float* __restrict__ b_s, bool dry = false) {
    const int tid = F.tid, lane = F.lane, wv = F.wave, fr = lane & 15, fq = lane >> 4;
    LAS unsigned char* VT = F.lds; LAS float* mu = (LAS float*)(F.lds + 128 * 272); LAS float* rstd = mu + 128;
    for (int ch = F.vcu; ch < NT / 128; ch += F.G) {
        const size_t row0 = (size_t)ch * 128;
        for (int r = wv * 16; r < wv * 16 + 16; ++r) { const bf16_t* vr = proj + (row0 + r) * OP + O_V + lane * 16;
            const u32x4 q0 = *(const u32x4*)vr, q1 = *(const u32x4*)(vr + 8); float x[16]; float s = 0.f;
#pragma unroll
            for (int j = 0; j < 4; ++j) { x[2 * j] = __uint_as_float(q0[j] << 16); x[2 * j + 1] = __uint_as_float(q0[j] & 0xffff0000u); x[8 + 2 * j] = __uint_as_float(q1[j] << 16); x[8 + 2 * j + 1] = __uint_as_float(q1[j] & 0xffff0000u); }
#pragma unroll
            for (int j = 0; j < 16; ++j) s += x[j];
            const float m = wave_sum(s) * (1.f / 1024.f); float s2 = 0.f;
#pragma unroll
            for (int j = 0; j < 16; ++j) { const float d = x[j] - m; s2 += d * d; }
            s2 = wave_sum(s2);
            if (lane == 0) { mu[r] = m; rstd[r] = rsqrtf(s2 * (1.f / 1024.f) + EPS); } }
        __syncthreads();
        for (int g = 0; g < 8; ++g) {
            { const int sI = tid >> 2, cq = tid & 3; const bf16_t* vr = proj + (row0 + sI) * OP + O_V + g * 128 + cq * 32; const float m = mu[sI], rs = rstd[sI];
#pragma unroll
              for (int k = 0; k < 4; ++k) { const u32x4 q = *(const u32x4*)(vr + 8 * k); const int c0 = cq * 32 + 8 * k;
#pragma unroll
                  for (int j = 0; j < 4; ++j) { const int c = c0 + 2 * j;
                      const float v0 = (__uint_as_float(q[j] << 16) - m) * rs * ln_g[g * 128 + c] + ln_b[g * 128 + c];
                      const float v1 = (__uint_as_float(q[j] & 0xffff0000u) - m) * rs * ln_g[g * 128 + c + 1] + ln_b[g * 128 + c + 1];
                      *(LAS bf16_t*)(VT + c * 272 + sI * 2) = (bf16_t)f2bf(v0); *(LAS bf16_t*)(VT + (c + 1) * 272 + sI * 2) = (bf16_t)f2bf(v1); } } }
            __syncthreads();
            { f32x4 acc[8];
#pragma unroll
              for (int n = 0; n < 8; ++n) acc[n] = (f32x4){0.f, 0.f, 0.f, 0.f};
              const int ksmax = wv >> 1;
              for (int ks = 0; ks <= ksmax; ++ks) {
                  const bf16x8 a = *(const bf16x8*)(wsm + ((size_t)g * 128 + wv * 16 + fr) * 128 + ks * 32 + 8 * fq);
#pragma unroll
                  for (int n = 0; n < 8; ++n) { const bf16x8 b = *(const LAS bf16x8*)(VT + (n * 16 + fr) * 272 + (ks * 32 + 8 * fq) * 2);
                      acc[n] = __builtin_amdgcn_mfma_f32_16x16x32_bf16(a, b, acc[n], 0, 0, 0); } }
              bf16_t uv[4][8], zv[4][8];
#pragma unroll
              for (int r = 0; r < 4; ++r) { const bf16_t* rowp = proj + (row0 + wv * 16 + 4 * fq + r) * OP;
#pragma unroll
                  for (int n = 0; n < 8; ++n) { const int c = g * 128 + n * 16 + fr; uv[r][n] = rowp[O_U + c]; zv[r][n] = rowp[O_Z + c]; } }
#pragma unroll
              for (int r = 0; r < 4; ++r) { const int t = wv * 16 + 4 * fq + r; const float bs = b_s[g * 128 + t]; bf16_t* rowp = proj + (row0 + t) * OP;
#pragma unroll
                  for (int n = 0; n < 8; ++n) { const int c = g * 128 + n * 16 + fr;
                      const bf16_t yv = (bf16_t)f2bf(bf2f(uv[r][n]) * (acc[n][r] + bs) * silu(bf2f(zv[r][n]))); if (!dry) rowp[O_Z + c] = yv; } } }
            __syncthreads();
        }
    }
}

struct Args { const void* in[19]; float* out; unsigned char* ws; };
__global__ void __launch_bounds__(NTHREADS, 2) mega_fwd(Args args) {
    extern __shared__ __attribute__((aligned(16))) unsigned char lds_raw[];
    Frame F;
    F.lds = (LAS unsigned char*)lds_raw;
    const int wave_s = __builtin_amdgcn_readfirstlane((int)threadIdx.x >> 6);
#define TID() (wave_s * 64 + lane_id_opaque())
    F.tid = TID(); F.lane = F.tid & 63; F.wave = wave_s;
    F.G = gridDim.x; { const int bx = blockIdx.x; F.vcu = (F.G % 8 == 0) ? (bx % 8) * (F.G / 8) + bx / 8 : bx; }
    volatile LAS unsigned* MISC = (volatile LAS unsigned*)(F.lds + MISC_OFF);
    unsigned char* ws = args.ws;
    for (int u = F.tid; u < (LDS_BYTES - LDSCTL_OFF) / 4; u += NTHREADS) ((LAS unsigned*)(F.lds + LDSCTL_OFF))[u] = 0u;
    __syncthreads();
    XcdBarrier bar = xcd_barrier_post((unsigned*)(ws + OFF_CTL) + CW_BAR, MISC + 8, F.tid);
#define GRID_BAR() xcd_barrier(bar, TID())
    const bool DRY = (args.ws != nullptr);
#if PROBE_MODE
    int sidx = 0;
#define STAMP() do { if (TID() == 0) { ((volatile LAS unsigned long long*)(F.lds + LDSCTL_OFF))[sidx] = __builtin_amdgcn_s_memrealtime(); } ++sidx; } while (0)
#else
#define STAMP() do {} while (0)
#endif
#define REFRESH() do { int t_ = TID(); asm volatile("" : "+v"(t_)); F.tid = t_; F.lane = t_ & 63; F.wave = wave_s; } while (0)

    const float* x = (const float*)args.in[0]; const float* mem = (const float*)args.in[1]; const int* pos = (const int*)args.in[2]; const float* g_mem = (const float*)args.in[3];
    const float* e_ng = (const float*)args.in[4]; const float* e_win = (const float*)args.in[5]; const float* e_wpool = (const float*)args.in[6]; const float* e_pscale = (const float*)args.in[7];
    const float* e_wmkv = (const float*)args.in[8]; const float* e_wout = (const float*)args.in[9];
    const float* o_ng = (const float*)args.in[10]; const float* o_win = (const float*)args.in[11]; const float* o_lng = (const float*)args.in[12]; const float* o_lnb = (const float*)args.in[13];
    const float* o_ws = (const float*)args.in[14]; const float* o_bs = (const float*)args.in[15]; const float* o_wmkv = (const float*)args.in[16]; const float* o_wout = (const float*)args.in[17];
    const float* f_g = (const float*)args.in[18];
    float* out = args.out;
    bf16_t* proj = (bf16_t*)(ws + OFF_PROJ); bf16_t* xb = (bf16_t*)(ws + OFF_XB); bf16_t* win = (bf16_t*)(ws + OFF_WIN); bf16_t* wout = (bf16_t*)(ws + OFF_WOUT);
    bf16_t* memkv = (bf16_t*)(ws + OFF_MEMKV); float* rowss = (float*)(ws + OFF_ROWSS); float2* rope = (float2*)(ws + OFF_ROPE); float* lse = (float*)(ws + OFF_LSE); bf16_t* wpT = (bf16_t*)(ws + OFF_WPT); bf16_t* wsm = (bf16_t*)(ws + OFF_WSM);
    bf16_t* memn = (bf16_t*)((unsigned char*)args.out + DO_MEMN); bf16_t* wmkv = (bf16_t*)((unsigned char*)args.out + DO_WMKV);
    const int NGW = F.G * NWAVES;
    { const int gw = F.vcu * NWAVES + F.wave, lane = F.lane;

    STAMP();
    convert_weight(F, e_win, DM, EP, win, 0, e_ng);
    convert_weight(F, e_wout, MIX, DM, wout, 0, nullptr);
    for (int l = 0; l < 4; ++l) convert_weight(F, ((l & 1) ? o_wmkv : e_wmkv) + (size_t)(l >> 1) * DM * 1024, DM, 1024, wmkv, l * 1024, nullptr);
    for (int m = 0; m < 8; ++m) convert_weight(F, e_wpool + (size_t)m * 128 * 128, 128, 128, wpT + (size_t)m * 128 * 128, 0, nullptr);
    for (int i = F.vcu * NTHREADS + F.tid; i < 2 * 8 * 128 * 128; i += F.G * NTHREADS) { const int t = (i >> 7) & 127, sI = i & 127; wsm[i] = (sI <= t) ? (bf16_t)f2bf(o_ws[i]) : (bf16_t)0; }
    for (int r = gw; r < NT; r += NGW) {
        const float* xr = x + (size_t)r * DM; float s = 0.f;
#pragma unroll
        for (int j = 0; j < 4; ++j) { const f32x4 v = *(const f32x4*)(xr + 4 * lane + 256 * j); s += (v[0] * v[0] + v[1] * v[1]) + (v[2] * v[2] + v[3] * v[3]);
            u32x2 w; w.x = pk2(v[0], v[1]); w.y = pk2(v[2], v[3]); *(u32x2*)(xb + (size_t)r * DM + 4 * lane + 256 * j) = w; }
        s = wave_sum(s);
        if (lane < 16) rowss[(size_t)r * 16 + lane] = (lane == 0) ? s : 0.f;
    }
    for (int r = gw; r < NB * NMEM; r += NGW) {
        const float* xr = mem + (size_t)r * DM; f32x4 v[4]; float s = 0.f;
#pragma unroll
        for (int j = 0; j < 4; ++j) { v[j] = *(const f32x4*)(xr + 4 * lane + 256 * j); s += (v[j][0] * v[j][0] + v[j][1] * v[j][1]) + (v[j][2] * v[j][2] + v[j][3] * v[j][3]); }
        s = wave_sum(s); const float ri = rsqrtf(s * (1.f / DM) + EPS);
#pragma unroll
        for (int j = 0; j < 4; ++j) { const f32x4 gg = *(const f32x4*)(g_mem + 4 * lane + 256 * j);
            u32x2 w; w.x = pk2(v[j][0] * ri * gg[0], v[j][1] * ri * gg[1]); w.y = pk2(v[j][2] * ri * gg[2], v[j][3] * ri * gg[3]); *(u32x2*)(memn + (size_t)r * DM + 4 * lane + 256 * j) = w; }
    }
    for (int i = F.vcu * NTHREADS + F.tid; i < NT * 16; i += F.G * NTHREADS) {
        const int tok = i >> 4, f = i & 15; const float ang = (float)pos[tok] * c_inv_freq[f];
        const double rev = (double)ang * 0.15915494309189535; const float fr = (float)(rev - rint(rev));
        rope[i] = make_float2(__builtin_amdgcn_cosf(fr), __builtin_amdgcn_sinf(fr));
    }
    }
    GRID_BAR();
    STAMP();

    { pg8::Gemm g{memn, wmkv, NB * NMEM, 4096, DM, DM}; pg8::StaticOrder S; S.init(NB * NMEM, 4096, F.G, (int)blockIdx.x);
      pg8::EpiIn E{memkv, 4096, nullptr, nullptr, 0};
      pg8::gemm_phase<pg8::EpiIn, pg8::StaticOrder, true, true>(F.lds, g, S, E, TID()); }
    STAMP();

    for (int l = 0; l < 4; ++l) {
        const int i = l >> 1; const bool odd = l & 1; const int NP = odd ? OP : EP;
        { pg8::Gemm g{xb, win, NT, NP, DM, DM}; pg8::StaticOrder S; S.init(NT, NP, F.G, (int)blockIdx.x);
          pg8::EpiIn E{proj, NP, rowss, rope, odd ? 0 : 12};
#if PROBE_DUP == 6
          pg8::gemm_phase<pg8::EpiIn, pg8::StaticOrder, true, true>(F.lds, g, S, E, TID());
#endif
          pg8::gemm_phase<pg8::EpiIn, pg8::StaticOrder, true, true>(F.lds, g, S, E, TID()); }
        GRID_BAR();
    STAMP();
        REFRESH();
#if PROBE_DUP == 7
        if (l < 3) { const int l1 = l + 1, i1 = l1 >> 1;
            if (l1 & 1) { convert_weight(F, o_win + (size_t)i1 * DM * OP, DM, OP, win, 0, o_ng + i1 * DM, DRY); convert_weight(F, o_wout + (size_t)i1 * MIX * DM, MIX, DM, wout + (size_t)(l1 & 1) * DM * MIX, 0, nullptr, DRY); }
            else        { convert_weight(F, e_win + (size_t)i1 * DM * EP, DM, EP, win, 0, e_ng + i1 * DM, DRY); convert_weight(F, e_wout + (size_t)i1 * MIX * DM, MIX, DM, wout + (size_t)(l1 & 1) * DM * MIX, 0, nullptr, DRY); }
            __syncthreads(); }
#endif
        if (l < 3) { const int l1 = l + 1, i1 = l1 >> 1;
            if (l1 & 1) { convert_weight(F, o_win + (size_t)i1 * DM * OP, DM, OP, win, 0, o_ng + i1 * DM); convert_weight(F, o_wout + (size_t)i1 * MIX * DM, MIX, DM, wout + (size_t)(l1 & 1) * DM * MIX, 0, nullptr); }
            else        { convert_weight(F, e_win + (size_t)i1 * DM * EP, DM, EP, win, 0, e_ng + i1 * DM); convert_weight(F, e_wout + (size_t)i1 * MIX * DM, MIX, DM, wout + (size_t)(l1 & 1) * DM * MIX, 0, nullptr); }
            __syncthreads(); }
        STAMP();
        if (!odd) {
#if PROBE_DUP == 1
            REFRESH(); pool_phase(F, proj, wpT + (size_t)i * 4 * 128 * 128, e_pscale + i * 512, DRY);
#endif
            REFRESH(); pool_phase(F, proj, wpT + (size_t)i * 4 * 128 * 128, e_pscale + i * 512);
            STAMP();
#if PROBE_DUP == 2
            attn_phase((char*)lds_raw, F.vcu, F.G, true, proj, memkv + l * 1024, lse, TID(), DRY, 0, 1536);
#endif
#if PROBE_DUP == 3
            attn_phase((char*)lds_raw, F.vcu, F.G, true, proj, memkv + l * 1024, lse, TID(), DRY, 1536, 2048);
#endif
            attn_phase((char*)lds_raw, F.vcu, F.G, true, proj, memkv + l * 1024, lse, TID());
            GRID_BAR();
    STAMP();
#if PROBE_DUP == 4
            REFRESH(); combine_phase(F, proj, lse, DRY);
#endif
            REFRESH(); combine_phase(F, proj, lse);
        } else {
#if PROBE_DUP == 5
            REFRESH(); cmix_phase(F, proj, o_lng + i * 1024, o_lnb + i * 1024, wsm + (size_t)i * 8 * 128 * 128, o_bs + i * 8 * 128, DRY);
#endif
            REFRESH(); cmix_phase(F, proj, o_lng + i * 1024, o_lnb + i * 1024, wsm + (size_t)i * 8 * 128 * 128, o_bs + i * 8 * 128);
            STAMP();
            attn_phase((char*)lds_raw, F.vcu, F.G, false, proj, memkv + l * 1024, lse, TID());
        }
        GRID_BAR();
    STAMP();
#if PROBE_DUP == 8
        GRID_BAR(); GRID_BAR(); GRID_BAR(); GRID_BAR();
#endif
        { pg8::Gemm g{proj + (odd ? O_Z : E_Z), wout + (size_t)(l & 1) * DM * MIX, NT, DM, MIX, NP}; pg8::StaticOrder S; S.init(NT, DM, F.G, (int)blockIdx.x);
          pg8::EpiOut E{l == 0 ? x : out, out, xb, rowss};
#if PROBE_DUP == 9
          if (l == 0) pg8::gemm_phase<pg8::EpiOut, pg8::StaticOrder, true, true>(F.lds, g, S, E, TID());
#endif
          pg8::gemm_phase<pg8::EpiOut, pg8::StaticOrder, true, true>(F.lds, g, S, E, TID()); }
        GRID_BAR();
    STAMP();
    }
    REFRESH();
    for (int r = F.vcu * NWAVES + F.wave; r < NT; r += NGW) { const int lane = F.lane;
        float* xr = out + (size_t)r * DM; f32x4 v[4]; float s = 0.f;
#pragma unroll
        for (int j = 0; j < 4; ++j) { v[j] = *(const f32x4*)(xr + 4 * lane + 256 * j); s += (v[j][0] * v[j][0] + v[j][1] * v[j][1]) + (v[j][2] * v[j][2] + v[j][3] * v[j][3]); }
        s = wave_sum(s); const float ri = rsqrtf(s * (1.f / DM) + EPS);
#pragma unroll
        for (int j = 0; j < 4; ++j) { const f32x4 gg = *(const f32x4*)(f_g + 4 * lane + 256 * j); *(f32x4*)(xr + 4 * lane + 256 * j) = v[j] * ri * gg; }
    }
#if PROBE_MODE
    GRID_BAR(); STAMP();
    if (blockIdx.x == 0 && TID() == 0) {
        volatile LAS unsigned long long* st = (volatile LAS unsigned long long*)(F.lds + LDSCTL_OFF);
        const unsigned long long wait = (unsigned long long)PROBE_K * (st[PROBE_HI] - st[PROBE_LO]), t0 = __builtin_amdgcn_s_memrealtime();
        while (__builtin_amdgcn_s_memrealtime() - t0 < wait) __builtin_amdgcn_s_sleep(8);
    }
#endif
}

extern "C" void kernel_launch(void* const* d_in, const int* in_sizes, int n_in, void* d_out, int out_size, void* d_ws, size_t ws_size, hipStream_t stream) {
    static int grid = 0;
    if (grid == 0) {
        if (n_in != 19 || in_sizes[0] != NT * DM || out_size != NT * DM || ws_size < WS_END) {
            fprintf(stderr, "kernel_launch: unexpected shapes (n_in %d, in0 %d, out %d, ws %zu; need ws >= %zu)\n", n_in, n_in > 0 ? in_sizes[0] : -1, out_size, ws_size, (size_t)WS_END);
            grid = -1; return; }
        int dev = 0, cus = 0;
        if (hipGetDevice(&dev) != hipSuccess || hipDeviceGetAttribute(&cus, hipDeviceAttributeMultiprocessorCount, dev) != hipSuccess) { grid = -1; return; }
        if (hipFuncSetAttribute((const void*)mega_fwd, hipFuncAttributeMaxDynamicSharedMemorySize, LDS_BYTES) != hipSuccess) { fprintf(stderr, "kernel_launch: hipFuncSetAttribute failed\n"); grid = -1; return; }
        int per_cu = 0;
        if (hipOccupancyMaxActiveBlocksPerMultiprocessor(&per_cu, (const void*)mega_fwd, NTHREADS, LDS_BYTES) != hipSuccess || per_cu < 1)
            fprintf(stderr, "kernel_launch: note: occupancy query reports %d workgroups per CU\n", per_cu);
        (void)hipGetLastError();
        grid = cus;
    }
    if (grid < 0) return;
    if (hipMemsetAsync((char*)d_ws + OFF_CTL, 0, CTL_ZERO_BYTES, stream) != hipSuccess) return;
    Args a{};
    for (int i = 0; i < 19; ++i) a.in[i] = d_in[i];
    a.out = (float*)d_out; a.ws = (unsigned char*)d_ws;
    hipLaunchKernelGGL(mega_fwd, dim3(grid), dim3(NTHREADS), LDS_BYTES, stream, a);
}
```

```cpp
#include <hip/hip_runtime.h>
#include <cstdint>
#include <cstdio>

typedef unsigned short bf16_t;
#define LAS __attribute__((address_space(3)))
#define GAS __attribute__((address_space(1)))
typedef short bf16x8 __attribute__((ext_vector_type(8)));
typedef float f32x4 __attribute__((ext_vector_type(4)));
typedef unsigned u32x4 __attribute__((ext_vector_type(4)));
typedef unsigned u32x2 __attribute__((ext_vector_type(2)));

constexpr int NB = 8, SEQ = 4096, DM = 1024, NT = NB * SEQ;
constexpr int HD = 128, NMEM = 256;
constexpr int EP = 6144, OP = 4096, MIX = 1536;
constexpr int E_VA = 3072, E_XB = 3584, E_QM = 4096, E_Z = 4608;
constexpr int O_U = 0, O_V = 1024, O_QM = 2048, O_Z = 2560;
constexpr float EPS = 1e-6f;
constexpr float ATT_SCALE = 0.08838834764831845f;
constexpr int NWAVES = 8, NTHREADS = 512;

constexpr size_t MiB = 1u << 20;
constexpr size_t OFF_CTL = 0, CTL_ZERO_BYTES = 1 * MiB;
constexpr size_t OFF_PROJ = 1 * MiB;
constexpr size_t OFF_XB = 385 * MiB;
constexpr size_t OFF_WIN = 449 * MiB;
constexpr size_t OFF_WOUT = 461 * MiB;
constexpr size_t OFF_MEMKV = 467 * MiB;
constexpr size_t OFF_ROWSS = 483 * MiB;
constexpr size_t OFF_ROPE = 489 * MiB;
constexpr size_t OFF_LSE = 493 * MiB;
constexpr size_t OFF_WPT = 495 * MiB;
constexpr size_t OFF_WSM = OFF_WPT + 256 * 1024;
constexpr size_t WS_END = 496 * MiB;
constexpr size_t DO_MEMN = 0;
constexpr size_t DO_WMKV = 4 * MiB;
constexpr int CW_BAR = 4096;

#ifndef PROBE_MODE
#define PROBE_MODE 0
#endif
#define PROBE_LO 0
#define PROBE_HI 1
#define PROBE_K 0
#ifndef PROBE_DUP
#define PROBE_DUP 0
#endif
constexpr int RING_BYTES = 131072, LDSCTL_OFF = RING_BYTES, MISC_OFF = LDSCTL_OFF + 320, LDS_BYTES = 147456;

__device__ __forceinline__ float bf2f(bf16_t h) { return __uint_as_float((unsigned)h << 16); }
__device__ __forceinline__ unsigned f2bf(float f) { unsigned u = __float_as_uint(f); return (u + 0x7fffu + ((u >> 16) & 1u)) >> 16; }
__device__ __forceinline__ unsigned pk2(float lo, float hi) { return f2bf(lo) | (f2bf(hi) << 16); }
__device__ __forceinline__ float wave_sum(float v) {
#pragma unroll
    for (int o = 1; o < 64; o <<= 1) v += __shfl_xor(v, o);
    return v;
}
__device__ __forceinline__ float wave_max(float v) {
#pragma unroll
    for (int o = 1; o < 64; o <<= 1) v = fmaxf(v, __shfl_xor(v, o));
    return v;
}
__device__ __forceinline__ float silu(float z) { return z / (1.f + __expf(-z)); }

__constant__ float c_inv_freq[16] = {1.0f, 0.44036659598350525f, 0.1939227432012558f, 0.08539710193872452f, 0.03760603070259094f, 0.01656043902039528f,
    0.007292664609849453f, 0.0032114458736032248f, 0.0014142135623842478f, 0.000622772378847003f, 0.00027424818836152554f, 0.00012076973507646471f,
    5.318296098266728e-05f, 2.34199997066753e-05f, 1.0313386155758053e-05f, 4.541670477919979e-06f};

namespace pg8 {
constexpr int BM = 256, BK = 64, HALF = 128, HTB = HALF * BK * 2, STAGE_BYTES = 8 * HTB, NXCD = 8, WGM = 8;
__host__ __device__ __forceinline__ int lds_byte(int r, int c) { const int st = (r >> 4) * 2 + (c >> 5), rr = r & 15, cc = c & 31, ob = rr * 64 + cc * 2; return st * 1024 + (ob ^ (((ob >> 9) & 1) << 5)); }
__host__ __device__ __forceinline__ void stage_rc(int b, int& R, int& C) { const int st = b / 1024, sb = b % 1024, swz = sb ^ (((sb >> 9) & 1) << 5); R = (st >> 1) * 16 + swz / 64; C = (st & 1) * 32 + (swz % 64) / 2; }
__host__ __device__ __forceinline__ int perm32(int rho) { const int n = rho >> 4, i = rho & 15; return 8 * (i >> 2) + 4 * n + (i & 3); }
struct Unit { int pm, pn; };
struct Gemm { const bf16_t* A; const bf16_t* Bt; int M, N, K, lda; };
struct StaticOrder {
    int nM, nN, nwg, G, c;
    __host__ __device__ void init(int M, int N, int G_, int c_) { nM = M / BM; nN = N / BM; nwg = nM * nN; G = G_; c = c_; }
    __host__ __device__ bool next(int i, Unit& u) const {
        const long L = (long)i * G + c; if (L >= nwg) return false;
        int wgid = (int)L; { const int q = nwg / NXCD, r = nwg % NXCD, xcd = wgid % NXCD, off = wgid / NXCD; wgid = (xcd < r ? xcd * (q + 1) : r * (q + 1) + (xcd - r) * q) + off; }
        const int nig = WGM * nN, gid = wgid / nig, fm = gid * WGM, gsz = (nM - fm) < WGM ? (nM - fm) : WGM;
        u.pm = fm + ((wgid % nig) % gsz); u.pn = (wgid % nig) / gsz; return true;
    }
    __device__ __forceinline__ void a_ready(const Unit&) const {}
    __device__ __forceinline__ void done(const Unit&) const {}
};
__device__ __forceinline__ unsigned cvt_pk_bf16(float lo, float hi) { unsigned r; asm volatile("v_cvt_pk_bf16_f32 %0, %1, %2" : "=v"(r) : "v"(lo), "v"(hi)); return r; }

struct EpiIn {
    static constexpr bool PERM = true, AFTER_DRAIN = false;
    bf16_t* O; int ldc; const float* rowss; const float2* rope; int nrope;
    __device__ __forceinline__ void operator()(const f32x4 (&acc)[2][2][4][2], const Unit& u, int wr, int wc, int fr, int fq) const {
        const int row0 = u.pm * BM + wr * 64 + fr, col0 = u.pn * BM + wc * 32 + 8 * fq;
        const bool rp = (u.pn < nrope) && (wc == 0);
#pragma unroll
        for (int ai = 0; ai < 2; ++ai)
#pragma unroll
            for (int m = 0; m < 4; ++m) { const int row = row0 + ai * HALF + m * 16; float r = 1.f;
                if (rowss) { const f32x4 p = *(const f32x4*)(rowss + (size_t)row * 16 + 4 * fq); float s = (p[0] + p[1]) + (p[2] + p[3]);
                    s += __shfl_xor(s, 16); s += __shfl_xor(s, 32); r = rsqrtf(s * (1.f / DM) + EPS); }
                bf16_t* rowp = O + (size_t)row * ldc + col0;
#pragma unroll
                for (int bj = 0; bj < 2; ++bj) { float v[8];
#pragma unroll
                    for (int j = 0; j < 4; ++j) { v[j] = acc[ai][bj][m][0][j] * r; v[4 + j] = acc[ai][bj][m][1][j] * r; }
                    if (rp) { const float2* cs = rope + (size_t)row * 16 + 8 * (fq & 1);
#pragma unroll
                        for (int j = 0; j < 8; ++j) { const float pv = __shfl_xor(v[j], 32); const float2 c = cs[j];
                            v[j] = (fq < 2) ? (v[j] * c.x - pv * c.y) : (v[j] * c.x + pv * c.y); } }
                    u32x4 w; w.x = cvt_pk_bf16(v[0], v[1]); w.y = cvt_pk_bf16(v[2], v[3]); w.z = cvt_pk_bf16(v[4], v[5]); w.w = cvt_pk_bf16(v[6], v[7]);
                    *(u32x4*)(rowp + bj * HALF) = w; } }
    }
};
struct EpiOut {
    static constexpr bool PERM = false, AFTER_DRAIN = false;
    const float* base; float* out; bf16_t* xb; float* rowss;
    __device__ __forceinline__ void operator()(const f32x4 (&acc)[2][2][4][2], const Unit& u, int wr, int wc, int fr, int fq) const {
        const int row0 = u.pm * BM + wr * 64 + fr, col0 = u.pn * BM + wc * 32 + 4 * fq;
#pragma unroll
        for (int ai = 0; ai < 2; ++ai)
#pragma unroll
            for (int m = 0; m < 4; ++m) { const int row = row0 + ai * HALF + m * 16; const size_t off = (size_t)row * DM + col0; float ss = 0.f;
#pragma unroll
                for (int bj = 0; bj < 2; ++bj)
#pragma unroll
                    for (int n = 0; n < 2; ++n) { const f32x4 o = *(const f32x4*)(base + off + bj * HALF + n * 16) + acc[ai][bj][m][n];
                        *(f32x4*)(out + off + bj * HALF + n * 16) = o; ss += (o[0] * o[0] + o[1] * o[1]) + (o[2] * o[2] + o[3] * o[3]);
                        u32x2 w; w.x = cvt_pk_bf16(o[0], o[1]); w.y = cvt_pk_bf16(o[2], o[3]); *(u32x2*)(xb + off + bj * HALF + n * 16) = w; }
                ss += __shfl_xor(ss, 16); ss += __shfl_xor(ss, 32);
                if (fq == 0) rowss[(size_t)row * 16 + u.pn * 4 + wc] = ss; }
    }
};

template <class Epi, class Sched, bool ALIGN_EPI = false, bool SP2 = false>
__device__ __forceinline__ void gemm_phase(LAS unsigned char* lds, const Gemm g, const Sched& S, const Epi& E, int tid_in) {
    int tid_ = tid_in; asm volatile("" : "+v"(tid_));
    const int tid = tid_, wid = __builtin_amdgcn_readfirstlane(tid >> 6), lane = tid & 63, wr = wid >> 2, wc = wid & 3, fr = lane & 15, fq = lane >> 4;
    const int K = g.K, nt = K / BK, lda = g.lda;
    unsigned voffA[2], voffB[2];
#pragma unroll
    for (int i = 0; i < 2; ++i) { int R, C; stage_rc(tid * 16 + i * 8192, R, C); const int Rb = Epi::PERM ? ((R & ~31) + perm32(R & 31)) : R;
        voffA[i] = (unsigned)(R * lda + C) * 2u; voffB[i] = (unsigned)(Rb * K + C) * 2u; }
    const size_t kstep = (size_t)(BK * 2);
    const size_t hstepA = (size_t)HALF * lda * 2, hstepB = (size_t)HALF * K * 2;
    const size_t tstepA = 2 * hstepA, tstepB = 2 * hstepB;
    const unsigned ldsw = (unsigned)wid * 1024u;
    const int aoff = lds_byte(wr * 64 + fr, fq * 8), boff = lds_byte(wc * 32 + fr, fq * 8);
#define PG8_SA(b, h) (((b) * 2 + (h)) * HTB)
#define PG8_SB(b, h) ((4 + (b) * 2 + (h)) * HTB)
#define PG8_STAGE(bufoff, gbase, voff) do { _Pragma("unroll") for (int _i = 0; _i < 2; ++_i) \
        __builtin_amdgcn_global_load_lds((const unsigned*)((const char*)(gbase) + (voff)[_i]), (LAS unsigned*)(lds + (bufoff) + ldsw + _i * 8192), 16, 0, 0); } while (0)
#define PG8_LDA(dst, b, h) do { _Pragma("unroll") for (int m = 0; m < 4; ++m) _Pragma("unroll") for (int k = 0; k < 2; ++k) dst[m][k] = *(const LAS bf16x8*)(lds + PG8_SA(b, h) + aoff + m * 2048 + k * 1024); } while (0)
#define PG8_LDB(dst, b, h) do { _Pragma("unroll") for (int n = 0; n < 2; ++n) _Pragma("unroll") for (int k = 0; k < 2; ++k) dst[n][k] = *(const LAS bf16x8*)(lds + PG8_SB(b, h) + boff + n * 2048 + k * 1024); } while (0)
#define PG8_MMA(ai, bj, At, Bt) do { __builtin_amdgcn_s_setprio(1); _Pragma("unroll") for (int m = 0; m < 4; ++m) _Pragma("unroll") for (int n = 0; n < 2; ++n) _Pragma("unroll") for (int k = 0; k < 2; ++k) \
        acc[ai][bj][m][n] = __builtin_amdgcn_mfma_f32_16x16x32_bf16(Bt[n][k], At[m][k], acc[ai][bj][m][n], 0, 0, 0); __builtin_amdgcn_s_setprio(0); } while (0)
#define PG8_WAIT_V(n) asm volatile("s_waitcnt vmcnt(" #n ")" ::: "memory")
#define PG8_WAIT_L(n) asm volatile("s_waitcnt lgkmcnt(" #n ")" ::: "memory")
#define PG8_BAR __builtin_amdgcn_s_barrier()
#define PG8_SCHED __builtin_amdgcn_sched_barrier(0)
    Unit cur, nxt; int ui = 0;
    if (!S.next(0, cur)) return;
    f32x4 acc[2][2][4][2];
#pragma unroll
    for (int a = 0; a < 2; ++a)
#pragma unroll
        for (int b = 0; b < 2; ++b)
#pragma unroll
            for (int m = 0; m < 4; ++m)
#pragma unroll
                for (int n = 0; n < 2; ++n) acc[a][b][m][n] = (f32x4){0.f, 0.f, 0.f, 0.f};
    bf16x8 At[4][2], B0[2][2], B1[2][2];
    const char* cA = (const char*)g.A + (size_t)cur.pm * tstepA; const char* cB = (const char*)g.Bt + (size_t)cur.pn * tstepB;
    S.a_ready(cur);
    if constexpr (SP2) {
        PG8_STAGE(PG8_SB(0, 0), cB, voffB); PG8_STAGE(PG8_SB(0, 1), cB + hstepB, voffB); PG8_STAGE(PG8_SA(0, 0), cA, voffA); PG8_STAGE(PG8_SA(0, 1), cA + hstepA, voffA);
        if (wr == 1) PG8_BAR;
        PG8_WAIT_V(2); PG8_BAR;
        PG8_STAGE(PG8_SB(1, 0), cB + kstep, voffB); PG8_STAGE(PG8_SA(1, 0), cA + kstep, voffA); PG8_STAGE(PG8_SB(1, 1), cB + hstepB + kstep, voffB);
        PG8_WAIT_V(6); PG8_BAR;
    } else {
        PG8_STAGE(PG8_SB(0, 0), cB, voffB); PG8_STAGE(PG8_SA(0, 0), cA, voffA); PG8_STAGE(PG8_SB(0, 1), cB + hstepB, voffB); PG8_STAGE(PG8_SA(0, 1), cA + hstepA, voffA);
        if (wr == 1) PG8_BAR;
        PG8_WAIT_V(4); PG8_BAR;
        PG8_STAGE(PG8_SB(1, 0), cB + kstep, voffB); PG8_STAGE(PG8_SA(1, 0), cA + kstep, voffA); PG8_STAGE(PG8_SB(1, 1), cB + hstepB + kstep, voffB);
        PG8_WAIT_V(6); PG8_BAR;
    }
    for (;;) {
        const bool has_next = S.next(ui + 1, nxt);
        const char* nA = has_next ? (const char*)g.A + (size_t)nxt.pm * tstepA : cA; const char* nB = has_next ? (const char*)g.Bt + (size_t)nxt.pn * tstepB : cB;
        for (int t = 0; t < nt; t += 2) {
            const bool last = (t == nt - 2);
            const char* a1 = cA + (size_t)(t + 1) * kstep;
            const char* a2 = last ? nA : cA + (size_t)(t + 2) * kstep; const char* b2 = last ? nB : cB + (size_t)(t + 2) * kstep;
            const char* a3 = a2 + kstep; const char* b3 = b2 + kstep;
            if (last && has_next) S.a_ready(nxt);
            if constexpr (SP2) {
            PG8_LDB(B0, 0, 0); PG8_LDB(B1, 0, 1); PG8_SCHED; PG8_LDA(At, 0, 0); PG8_STAGE(PG8_SA(1, 1), a1 + hstepA, voffA);
            PG8_WAIT_V(8); PG8_WAIT_L(0); PG8_BAR; PG8_MMA(0, 0, At, B0); PG8_MMA(0, 1, At, B1); PG8_BAR; PG8_SCHED;
            PG8_LDA(At, 0, 1); PG8_STAGE(PG8_SB(0, 0), b2, voffB); PG8_STAGE(PG8_SB(0, 1), b2 + hstepB, voffB); PG8_STAGE(PG8_SA(0, 0), a2, voffA);
            PG8_WAIT_V(8); PG8_WAIT_L(0); PG8_BAR; PG8_MMA(1, 0, At, B0); PG8_MMA(1, 1, At, B1); PG8_BAR; PG8_SCHED;
            PG8_LDB(B0, 1, 0); PG8_LDB(B1, 1, 1); PG8_SCHED; PG8_LDA(At, 1, 0); PG8_STAGE(PG8_SA(0, 1), a2 + hstepA, voffA);
            PG8_WAIT_V(8); PG8_WAIT_L(0); PG8_BAR; PG8_MMA(0, 0, At, B0); PG8_MMA(0, 1, At, B1); PG8_BAR; PG8_SCHED;
            PG8_LDA(At, 1, 1); PG8_STAGE(PG8_SB(1, 0), b3, voffB); PG8_STAGE(PG8_SB(1, 1), b3 + hstepB, voffB); PG8_STAGE(PG8_SA(1, 0), a3, voffA);
            PG8_WAIT_V(8); PG8_WAIT_L(0); PG8_BAR; PG8_MMA(1, 0, At, B0); PG8_MMA(1, 1, At, B1); PG8_BAR; PG8_SCHED;
            } else {
            PG8_LDB(B0, 0, 0); PG8_SCHED; PG8_LDA(At, 0, 0); PG8_STAGE(PG8_SA(1, 1), a1 + hstepA, voffA);
            PG8_WAIT_L(8); PG8_BAR; PG8_WAIT_L(0); PG8_MMA(0, 0, At, B0); PG8_BAR; PG8_SCHED;
            PG8_LDB(B1, 0, 1); PG8_STAGE(PG8_SB(0, 0), b2, voffB);
            PG8_BAR; PG8_WAIT_L(0); PG8_MMA(0, 1, At, B1); PG8_BAR;
            PG8_LDA(At, 0, 1); PG8_STAGE(PG8_SA(0, 0), a2, voffA);
            PG8_BAR; PG8_WAIT_L(0); PG8_MMA(1, 0, At, B0); PG8_BAR; PG8_SCHED;
            PG8_STAGE(PG8_SB(0, 1), b2 + hstepB, voffB);
            PG8_WAIT_V(6); PG8_BAR; PG8_MMA(1, 1, At, B1); PG8_BAR;
            PG8_LDB(B0, 1, 0); PG8_SCHED; PG8_LDA(At, 1, 0); PG8_STAGE(PG8_SA(0, 1), a2 + hstepA, voffA);
            PG8_WAIT_L(8); PG8_BAR; PG8_WAIT_L(0); PG8_MMA(0, 0, At, B0); PG8_BAR; PG8_SCHED;
            PG8_LDB(B1, 1, 1); PG8_STAGE(PG8_SB(1, 0), b3, voffB);
            PG8_BAR; PG8_WAIT_L(0); PG8_MMA(0, 1, At, B1); PG8_BAR;
            PG8_LDA(At, 1, 1); PG8_STAGE(PG8_SA(1, 0), a3, voffA);
            PG8_BAR; PG8_WAIT_L(0); PG8_MMA(1, 0, At, B0); PG8_BAR; PG8_SCHED;
            PG8_STAGE(PG8_SB(1, 1), b3 + hstepB, voffB);
            PG8_WAIT_V(6); PG8_BAR; PG8_MMA(1, 1, At, B1); PG8_BAR;
            }
        }
        if constexpr (ALIGN_EPI) { if (wr == 0) PG8_BAR; }
        if constexpr (!Epi::AFTER_DRAIN) { E(acc, cur, wr, wc, fr, fq); S.done(cur); }
        if (!has_next) break;
#pragma unroll
        for (int a = 0; a < 2; ++a)
#pragma unroll
            for (int b = 0; b < 2; ++b)
#pragma unroll
                for (int m = 0; m < 4; ++m)
#pragma unroll
                    for (int n = 0; n < 2; ++n) acc[a][b][m][n] = (f32x4){0.f, 0.f, 0.f, 0.f};
        cur = nxt; cA = nA; cB = nB; ++ui;
        if constexpr (ALIGN_EPI) { if (wr == 1) PG8_BAR; }
    }
    PG8_WAIT_V(0);
    if constexpr (!ALIGN_EPI) { if (wr == 0) PG8_BAR; }
    PG8_BAR;
#undef PG8_SA
#undef PG8_SB
#undef PG8_STAGE
#undef PG8_LDA
#undef PG8_LDB
#undef PG8_MMA
#undef PG8_WAIT_V
#undef PG8_WAIT_L
#undef PG8_BAR
#undef PG8_SCHED
}
}


namespace att {
typedef short s16x4 __attribute__((ext_vector_type(4)));
typedef float f32x16 __attribute__((ext_vector_type(16)));
constexpr int D = 128, NW = 8, QBLK = 32, KVBLK = 64, QB = NW * QBLK;
constexpr int SHM_V = KVBLK * D * 2, SHM_K = KVBLK * D * 2;
constexpr int ATT_LDS_BYTES = 2 * SHM_V + 2 * SHM_K + NW * 64 * 4;
constexpr float SCALE = 0.08838834764831845f, THR = 8.f;
#define KSWZ(row, colB) ((row) * 256 + ((colB) ^ (((row) & 7) << 4)))
#define SBAR() __builtin_amdgcn_sched_barrier(0)
__device__ __forceinline__ int v_st(int k, int c) { const int kk = (k & ~0xC) | ((k & 4) << 1) | ((k & 8) >> 1); return ((kk >> 3) * 4 + (c >> 5)) * 512 + ((kk & 7) * 32 + (c & 31)) * 2; }
__device__ __forceinline__ int v_rd_base(int lane) { return ((lane & 3) << 3) | (((lane >> 2) & 3) << 6) | (((lane >> 4) & 1) << 5) | (((lane >> 5) & 1) << 8); }
constexpr int v_rd_off(int d0, int ks, int half) { return d0 * 512 + ks * 4096 + half * 2048; }
__device__ __forceinline__ int crow(int r, int hi) { return (r & 3) + 8 * (r >> 2) + 4 * hi; }
__device__ __forceinline__ unsigned cvtpk(float lo, float hi) { unsigned r; asm volatile("v_cvt_pk_bf16_f32 %0, %1, %2" : "=v"(r) : "v"(lo), "v"(hi)); return r; }
__device__ __forceinline__ bf16x8 load8(const bf16_t* p) { return *reinterpret_cast<const bf16x8*>(p); }
__device__ __forceinline__ void mask_tile(f32x16& p0, f32x16& p1, int dq, unsigned W) {
    const float NEG = -__builtin_inff();
#pragma unroll
    for (int r = 0; r < 16; ++r) { const int c = (r & 3) + 8 * (r >> 2);
        if ((unsigned)(dq - c) >= W) p0[r] = NEG;
        if ((unsigned)(dq - c - 32) >= W) p1[r] = NEG; }
}
__device__ __forceinline__ void partialSM(f32x16& p0, f32x16& p1, float& m_reg, float& mn, float& alpha) {
    float pmax = p0[0]; for (int r = 1; r < 16; ++r) pmax = fmaxf(pmax, p0[r]); for (int r = 0; r < 16; ++r) pmax = fmaxf(pmax, p1[r]);
    { auto rr = __builtin_amdgcn_permlane32_swap(__float_as_uint(pmax), __float_as_uint(pmax), false, false);
      pmax = fmaxf(__uint_as_float(rr[0]), __uint_as_float(rr[1])); }
    constexpr float C2 = 1.4426950408889634f * SCALE;
    if (__builtin_expect(__all((pmax - m_reg) * SCALE <= THR), 1)) { mn = m_reg; alpha = 1.f; }
    else { mn = fmaxf(m_reg, pmax); alpha = __builtin_amdgcn_exp2f((m_reg - mn) * C2); m_reg = mn; }
    const float mnL = -mn * C2;
    for (int r = 0; r < 16; ++r) p0[r] = fmaf(p0[r], C2, mnL); for (int r = 0; r < 16; ++r) p1[r] = fmaf(p1[r], C2, mnL);
    for (int r = 0; r < 16; ++r) p0[r] = __builtin_amdgcn_exp2f(p0[r]);
}
__device__ __forceinline__ void finishSM(f32x16& p0, f32x16& p1, float alpha, float& l_reg, bf16x8& pa0, bf16x8& pa1, bf16x8& pa2, bf16x8& pa3) {
    for (int r = 0; r < 16; ++r) p1[r] = __builtin_amdgcn_exp2f(p1[r]);
    float ps = 0; for (int r = 0; r < 16; ++r) ps += p0[r]; for (int r = 0; r < 16; ++r) ps += p1[r];
    { auto rr = __builtin_amdgcn_permlane32_swap(__float_as_uint(ps), __float_as_uint(ps), false, false);
      ps = __uint_as_float(rr[0]) + __uint_as_float(rr[1]); }
    l_reg = l_reg * alpha + ps;
#define PK4(P, B_, OUT) do { unsigned a0 = cvtpk(P[B_+0], P[B_+1]), a1 = cvtpk(P[B_+2], P[B_+3]);                          \
        unsigned b0 = cvtpk(P[B_+4], P[B_+5]), b1 = cvtpk(P[B_+6], P[B_+7]);                                             \
        auto r0 = __builtin_amdgcn_permlane32_swap(a0, b0, false, false); auto r1 = __builtin_amdgcn_permlane32_swap(a1, b1, false, false); \
        u32x4 w = {r0[0], r1[0], r0[1], r1[1]}; OUT = *reinterpret_cast<bf16x8*>(&w); } while (0)
    PK4(p0, 0, pa0); PK4(p0, 8, pa1); PK4(p1, 0, pa2); PK4(p1, 8, pa3);
#undef PK4
}
template <int KB>
__device__ __forceinline__ void qkt(f32x16& p0, f32x16& p1, const char* K_lds, int r32, int hi, const bf16x8* qr, bool act) {
    if (!act) { const float NEG = -__builtin_inff();
#pragma unroll
        for (int r = 0; r < 16; ++r) { p0[r] = NEG; p1[r] = NEG; } return; }
    p0 = f32x16{}; p1 = f32x16{};
    const char* kb[4];
#pragma unroll
    for (int dd = 0; dd < 4; ++dd) kb[dd] = K_lds + KB * SHM_K + KSWZ(r32, (dd * 16 + hi * 8) * 2);
#pragma unroll
    for (int d0 = 0; d0 < 8; ++d0) { const char* a = kb[d0 & 3] + (d0 >> 2) * 128;
        bf16x8 b0 = *reinterpret_cast<const bf16x8*>(a);
        bf16x8 b1 = *reinterpret_cast<const bf16x8*>(a + 32 * 256);
        p0 = __builtin_amdgcn_mfma_f32_32x32x16_bf16(b0, qr[d0], p0, 0, 0, 0);
        p1 = __builtin_amdgcn_mfma_f32_32x32x16_bf16(b1, qr[d0], p1, 0, 0, 0); }
}
template <int VB>
__device__ __forceinline__ void pv_tile(f32x16* o, int vb0, bf16x8 pa0, bf16x8 pa1, bf16x8 pa2, bf16x8 pa3, bool act) {
    if (!act) return;
#define TRRD(dst, off) asm volatile("ds_read_b64_tr_b16 %0, %1 offset:%2" : "=&v"(dst) : "v"(vb0), "i"(off) : "memory")
#define PV_D0(d0) do { s16x4 l0, l1, l2, l3, h0, h1, h2, h3; constexpr int b_ = VB * SHM_V + v_rd_off(d0, 0, 0); \
        TRRD(l0, b_); TRRD(h0, b_ + 2048); TRRD(l1, b_ + 4096); TRRD(h1, b_ + 6144); TRRD(l2, b_ + 8192); TRRD(h2, b_ + 10240); TRRD(l3, b_ + 12288); TRRD(h3, b_ + 14336); \
        asm volatile("s_waitcnt lgkmcnt(0)" ::: "memory"); SBAR();   \
        o[d0] = __builtin_amdgcn_mfma_f32_32x32x16_bf16(pa0, (bf16x8){l0[0], l0[1], l0[2], l0[3], h0[0], h0[1], h0[2], h0[3]}, o[d0], 0, 0, 0);   \
        o[d0] = __builtin_amdgcn_mfma_f32_32x32x16_bf16(pa1, (bf16x8){l1[0], l1[1], l1[2], l1[3], h1[0], h1[1], h1[2], h1[3]}, o[d0], 0, 0, 0);   \
        o[d0] = __builtin_amdgcn_mfma_f32_32x32x16_bf16(pa2, (bf16x8){l2[0], l2[1], l2[2], l2[3], h2[0], h2[1], h2[2], h2[3]}, o[d0], 0, 0, 0);   \
        o[d0] = __builtin_amdgcn_mfma_f32_32x32x16_bf16(pa3, (bf16x8){l3[0], l3[1], l3[2], l3[3], h3[0], h3[1], h3[2], h3[3]}, o[d0], 0, 0, 0); } while (0)
    PV_D0(0); PV_D0(1); PV_D0(2); PV_D0(3);
#undef PV_D0
#undef TRRD
}
struct BlockRef { const bf16_t* Q; const bf16_t* K; const bf16_t* V; bf16_t* O; float* lse; int P0, pq, pk, skv, W, lsep, mode; };
struct Seam { bf16x8 qr[8]; bf16x8 st_v0, st_v1, st_k0, st_k1; };
__device__ __forceinline__ int swa_jlo(int P0, int W) { const int lowk = P0 - W + 1; return lowk > 0 ? lowk / KVBLK : 0; }
#define ROWK(p, k0, rr, pk_) ((const bf16_t*)((const char*)(p) + (size_t)(unsigned)((((unsigned)((k0) + (rr))) * (unsigned)(pk_) + (unsigned)sc) * 2u)))
#define VMW() asm volatile("s_waitcnt vmcnt(0)" ::: "memory")
#define VMWN(n) asm volatile("s_waitcnt vmcnt(%0)" :: "i"(n) : "memory")
#define SLOAD_H(Kp, Vp, k0, pk_) do { S.st_v0 = load8(ROWK(Vp, k0, sr, pk_)); S.st_v1 = load8(ROWK(Vp, k0, 32 + sr, pk_));              \
                         S.st_k0 = load8(ROWK(Kp, k0, sr, pk_)); S.st_k1 = load8(ROWK(Kp, k0, 32 + sr, pk_)); } while (0)
#define SWRITE_HK(bf) do { *(bf16x8*)(K_lds + (bf) * SHM_K + kws) = S.st_k0; *(bf16x8*)(K_lds + (bf) * SHM_K + kws + 32 * 256) = S.st_k1; } while (0)
#define SWRITE_HV(bf) do { *(bf16x8*)(V_lds + (bf) * SHM_V + vst0) = S.st_v0; *(bf16x8*)(V_lds + (bf) * SHM_V + vst1) = S.st_v1; } while (0)
#define SWRITE_H(bf) do { SWRITE_HV(bf); SWRITE_HK(bf); } while (0)
__device__ __forceinline__ void swa_prime(const BlockRef& cur, char* lds, Seam& S, int tid) {
    const int wid = __builtin_amdgcn_readfirstlane(tid >> 6), lane = tid & 63, r32 = lane & 31, hi = lane >> 5;
    const int sr = tid >> 4, sc = (tid & 15) * 8, kws = KSWZ(sr, sc * 2); char* K_lds = lds + 2 * SHM_V;
    const int kb0 = swa_jlo(cur.P0, cur.W) * KVBLK;
    { const unsigned qoff = ((unsigned)(wid * QBLK + r32) * (unsigned)cur.pq + (unsigned)hi * 8u) * 2u;
      for (int d0 = 0; d0 < 8; ++d0) S.qr[d0] = *(const bf16x8*)((const char*)cur.Q + (size_t)qoff + d0 * 32); }
    SLOAD_H(cur.K, cur.V, kb0, cur.pk); VMW(); SWRITE_HK(0);
    __syncthreads();
}
__device__ __forceinline__ void swa_block(const BlockRef& cur, const BlockRef& nxt, char* lds, Seam& S, int tid) {
    const int wid = __builtin_amdgcn_readfirstlane(tid >> 6), lane = tid & 63, r32 = lane & 31, hi = lane >> 5;
    const int W = cur.W, pk = cur.pk;
    const int j_lo = swa_jlo(cur.P0, W);
    int j_hi = (cur.P0 + QB - 1) / KVBLK + 1; if (j_hi > cur.skv / KVBLK) j_hi = cur.skv / KVBLK;
    const int NT = j_hi - j_lo;
    const int kbn = swa_jlo(nxt.P0, nxt.W) * KVBLK;
    const int qlo = cur.P0 + wid * QBLK, qm = qlo + r32 - 4 * hi;
    char* V_lds = lds; char* K_lds = lds + 2 * SHM_V;
    float* ws = (float*)(lds + 2 * SHM_V + 2 * SHM_K) + wid * 64; float* li_l = ws, * al_l = ws + 32;
    float m_reg = -1e30f, l_reg = 0; f32x16 o[4] = {};
    const int sr = tid >> 4, sc = (tid & 15) * 8, vst0 = v_st(sr, sc), vst1 = v_st(32 + sr, sc), kws = KSWZ(sr, sc * 2);
    const int vb0 = (int)(uintptr_t)V_lds + v_rd_base(lane);
    const bf16_t* Kh = cur.K; const bf16_t* Vh = cur.V;
#define RESC(a) do { if (__any((a) < 1.f)) { if (hi == 0) al_l[r32] = (a); asm volatile("s_waitcnt lgkmcnt(0)" ::: "memory");              \
                     for (int d_ = 0; d_ < 4; ++d_) for (int r = 0; r < 16; ++r) o[d_][r] *= al_l[crow(r, hi)]; } } while (0)
#define KBASE(t) ((j_lo + (t)) * KVBLK)
#define ACT(t) (KBASE(t) <= qlo + QBLK - 1 && KBASE(t) + KVBLK - 1 >= qlo - W + 1)
#define MASKT(P0_, P1_, t) do { const int kb_ = KBASE(t); if (ACT(t) && (kb_ + KVBLK - 1 > qlo || kb_ <= qlo + QBLK - 1 - W)) mask_tile(P0_, P1_, qm - kb_, (unsigned)W); } while (0)
    constexpr int NQL = 8;
#define SEAM_K0() do { VMWN(NQL); SWRITE_HK(0); SBAR(); } while (0)
    f32x16 pA0, pA1, pB0, pB1; float mnA, mnB, alA, alB; bf16x8 pa0, pa1, pa2, pa3;
    SWRITE_HV(0); SBAR();
    if (NT > 1) { SLOAD_H(Kh, Vh, KBASE(1), pk); }
    SBAR(); qkt<0>(pA0, pA1, K_lds, r32, hi, S.qr, ACT(0));
    MASKT(pA0, pA1, 0); partialSM(pA0, pA1, m_reg, mnA, alA);
    if (NT > 1) { VMW(); SWRITE_H(1); }
    __syncthreads();
#define HALF_STEP(PX0, PX1, mnX, alX, PY0, PY1, alY, t, KB, VB, SB) do {                                                      \
        SBAR(); qkt<KB>(PX0, PX1, K_lds, r32, hi, S.qr, ACT(t));                                             \
        finishSM(PY0, PY1, alY, l_reg, pa0, pa1, pa2, pa3); SBAR();                                                           \
        if ((t) + 1 < NT) { SLOAD_H(Kh, Vh, KBASE((t) + 1), pk); SBAR(); }                                               \
        pv_tile<VB>(o, vb0, pa0, pa1, pa2, pa3, ACT((t) - 1)); MASKT(PX0, PX1, (t)); partialSM(PX0, PX1, m_reg, mnX, alX);                                        \
        __syncthreads();                                                                                                      \
        if ((t) + 1 < NT) { VMW(); SWRITE_H(SB); }                                                                          \
        RESC(alX); __syncthreads(); } while (0)
    for (int t = 1; t + 1 < NT; t += 2) {
        HALF_STEP(pB0, pB1, mnB, alB, pA0, pA1, alA, t, 1, 0, 0);
        HALF_STEP(pA0, pA1, mnA, alA, pB0, pB1, alB, t + 1, 0, 1, 1);
    }
    const bool even = (NT & 1) == 0;
    if (even) { SBAR(); qkt<1>(pB0, pB1, K_lds, r32, hi, S.qr, ACT(NT - 1)); SBAR(); }
    { SLOAD_H(nxt.K, nxt.V, kbn, nxt.pk); SBAR();
        const unsigned qoff = ((unsigned)(wid * QBLK + r32) * (unsigned)nxt.pq + (unsigned)hi * 8u) * 2u;
#pragma unroll
        for (int d0 = 0; d0 < 8; ++d0) S.qr[d0] = *(const bf16x8*)((const char*)nxt.Q + (size_t)qoff + d0 * 32); }
    SBAR();
    finishSM(pA0, pA1, alA, l_reg, pa0, pa1, pa2, pa3); SBAR();
    pv_tile<0>(o, vb0, pa0, pa1, pa2, pa3, ACT(even ? NT - 2 : NT - 1));
    if (even) { MASKT(pB0, pB1, NT - 1); partialSM(pB0, pB1, m_reg, mnB, alB); __syncthreads(); RESC(alB);
        finishSM(pB0, pB1, alB, l_reg, pa0, pa1, pa2, pa3); SBAR(); pv_tile<1>(o, vb0, pa0, pa1, pa2, pa3, ACT(NT - 1)); }
    SBAR(); SEAM_K0();
    if (hi == 0) li_l[r32] = l_reg; asm volatile("s_waitcnt lgkmcnt(0)" ::: "memory");
    float rli[16];
#pragma unroll
    for (int r = 0; r < 16; ++r) rli[r] = __builtin_amdgcn_rcpf(li_l[crow(r, hi)]);
    int r32e = r32, hie = hi; asm volatile("" : "+v"(r32e), "+v"(hie));
    bf16_t* Ow = cur.O + (size_t)(wid * QBLK) * cur.pq;
    const unsigned pqu = (unsigned)cur.pq, lane_off = (unsigned)(4 * hie) * pqu + (unsigned)r32e;
    if (cur.mode == 2) {
        float sink = 0.f;
#pragma unroll
        for (int r = 0; r < 16; ++r)
#pragma unroll
            for (int d0 = 0; d0 < 4; ++d0) sink += o[d0][r] * rli[r];
        asm volatile("" :: "v"(sink), "v"(m_reg));
    } else if (cur.mode == 0) {
        if (hie == 0) cur.lse[(size_t)(wid * QBLK + r32e) * cur.lsep] = m_reg * SCALE + __logf(l_reg);
#pragma unroll
        for (int r = 0; r < 16; ++r) { const unsigned roff = lane_off + (unsigned)((r & 3) + 8 * (r >> 2)) * pqu;
#pragma unroll
            for (int d0 = 0; d0 < 4; ++d0) { const float v = o[d0][r] * rli[r]; const float vn = __shfl_xor(v, 1);
                if ((r32e & 1) == 0) *(unsigned*)(Ow + (size_t)(roff + d0 * 32)) = cvtpk(v, vn); } }
    } else {
#pragma unroll
        for (int rb = 0; rb < 16; rb += 4) { unsigned zz[4][4];
#pragma unroll
            for (int rr = 0; rr < 4; ++rr) { const unsigned roff = lane_off + (unsigned)(((rb + rr) & 3) + 8 * ((rb + rr) >> 2)) * pqu;
#pragma unroll
                for (int d0 = 0; d0 < 4; ++d0) zz[rr][d0] = ((r32e & 1) == 0) ? *(const unsigned*)(Ow + (size_t)(roff + d0 * 32)) : 0u; }
#pragma unroll
            for (int rr = 0; rr < 4; ++rr) { const int r = rb + rr; const unsigned roff = lane_off + (unsigned)((r & 3) + 8 * (r >> 2)) * pqu;
#pragma unroll
                for (int d0 = 0; d0 < 4; ++d0) { const float v = o[d0][r] * rli[r]; const float vn = __shfl_xor(v, 1);
                    if ((r32e & 1) == 0) *(unsigned*)(Ow + (size_t)(roff + d0 * 32)) = cvtpk(v * silu(__uint_as_float(zz[rr][d0] << 16)), vn * silu(__uint_as_float(zz[rr][d0] & 0xffff0000u))); } } }
    }
    __syncthreads();
#undef RESC
#undef KBASE
#undef ACT
#undef MASKT
#undef SEAM_K0
#undef HALF_STEP
}
#undef ROWK
#undef VMW
#undef VMWN
#undef SLOAD_H
#undef SWRITE_HK
#undef SWRITE_HV
#undef SWRITE_H
#undef KSWZ
#undef SBAR
}

typedef GAS unsigned gu32;
#define RLX_AGENT __ATOMIC_RELAXED, __HIP_MEMORY_SCOPE_AGENT
#define XB_TMO      128
#define XB_XCNT(j)  (256  + 64 * (j))
#define XB_XSUB(j)  (1280 + 64 * (j))
#define XB_XGEN(j)  (2304 + 64 * (j))
#define XB_TOP      3328
#define XB_TOPGEN   3392
#define XCD_BAR_WORDS 3456
#define XB_SPIN_CAP (1u << 18)
__device__ __forceinline__ unsigned xb_ld(unsigned* p)              { return __hip_atomic_load(p, __ATOMIC_RELAXED, __HIP_MEMORY_SCOPE_AGENT); }
__device__ __forceinline__ unsigned xb_add(unsigned* p, unsigned v) { return __hip_atomic_fetch_add(p, v, __ATOMIC_RELAXED, __HIP_MEMORY_SCOPE_AGENT); }
__device__ __forceinline__ unsigned xb_xcc_id() { return (unsigned)__builtin_amdgcn_s_getreg((3 << 11) | 20) & 0xFu; }
#define XB_SPIN(cond, bar) do { unsigned _sp = 0; while (cond) { __builtin_amdgcn_s_sleep(1); \
    if ((++_sp & 255u) == 0u) { if (xb_ld(&(bar)[XB_TMO])) break; if (_sp > XB_SPIN_CAP) { atomicAdd(&(bar)[XB_TMO], 1u); break; } } } } while (0)
struct XcdBarrier { unsigned* bar; unsigned x; volatile LAS unsigned* st; };
__device__ __forceinline__ XcdBarrier xcd_barrier_post(unsigned* bar, volatile LAS unsigned* st, int tid) {
    XcdBarrier b; b.bar = bar; b.x = xb_xcc_id(); b.st = st;
    if (tid == 0) (void)xb_add(&bar[XB_XCNT(b.x)], 1u);
    return b;
}
__device__ __forceinline__ void xcd_barrier_complete(unsigned* bar, unsigned x, unsigned& nloc, unsigned& nx) {
    const unsigned G = gridDim.x * gridDim.y * gridDim.z;
    unsigned sum, cnt, mine, sp = 0u;
    for (;;) {
        sum = 0u; cnt = 0u; mine = 0u;
#pragma unroll
        for (unsigned j = 0; j < 16; ++j) { const unsigned c = xb_ld(&bar[XB_XCNT(j)]); sum += c; cnt += (c > 0u) ? 1u : 0u; mine = (j == x) ? c : mine; }
        if (sum == G) break;
        __builtin_amdgcn_s_sleep(1);
        if ((++sp & 255u) == 0u) { if (xb_ld(&bar[XB_TMO])) break; if (sp > XB_SPIN_CAP) { atomicAdd(&bar[XB_TMO], 1u); break; } }
    }
    nloc = mine > 0u ? mine : 1u; nx = cnt > 0u ? cnt : 1u;
}
__device__ __forceinline__ void xcd_barrier(const XcdBarrier& b, int tid) {
    asm volatile("s_waitcnt vmcnt(0)" ::: "memory");
    __syncthreads();
    if (tid == 0) {
        unsigned* bar = b.bar;
        __builtin_amdgcn_s_waitcnt(0);
        unsigned nloc = b.st[0], nx = b.st[1];
        if (nloc == 0u) { xcd_barrier_complete(bar, b.x, nloc, nx); b.st[0] = nloc; b.st[1] = nx; }
        const unsigned old = xb_add(&bar[XB_XSUB(b.x)], 1u);
        const unsigned gen = old / nloc;
        if (old + 1u == (gen + 1u) * nloc) {
            __builtin_amdgcn_fence(__ATOMIC_RELEASE, "agent");
            asm volatile("s_waitcnt vmcnt(0)" ::: "memory");
            const unsigned og = xb_add(&bar[XB_TOP], 1u);
            const unsigned tg = og / nx;
            if (og + 1u == (tg + 1u) * nx) xb_add(&bar[XB_TOPGEN], 1u);
            else XB_SPIN(xb_ld(&bar[XB_TOPGEN]) == tg, bar);
            __builtin_amdgcn_fence(__ATOMIC_ACQUIRE, "agent");
            xb_add(&bar[XB_XGEN(b.x)], 1u);
            asm volatile("s_waitcnt vmcnt(0)" ::: "memory");
        } else {
            XB_SPIN(xb_ld(&bar[XB_XGEN(b.x)]) == gen, bar);
            __builtin_amdgcn_fence(__ATOMIC_ACQUIRE, "agent");
            asm volatile("s_waitcnt vmcnt(0)" ::: "memory");
        }
    }
    __syncthreads();
}

__device__ __forceinline__ int lane_id_opaque() { int l; asm volatile("v_mbcnt_lo_u32_b32 %0, -1, 0\n\tv_mbcnt_hi_u32_b32 %0, -1, %0" : "=v"(l)); return l; }
struct Frame {
    LAS unsigned char* lds;
    int tid, lane, wave, vcu, G;
};

__device__ __forceinline__ void transpose_item(const float* __restrict__ W, int K, int N, bf16_t* WT, int row_off, const float* __restrict__ g, LAS float* scr, int item, int lane, bool dry = false,
                                               const float* __restrict__ wpool = nullptr, const float* __restrict__ pscale = nullptr) {
    const int nblk = N / 32, kb = item / nblk, nb = item % nblk, k0 = 64 * kb, n0 = 32 * nb;
    if (wpool && n0 >= E_XB && n0 < E_XB + 512) return;
#pragma unroll 8
    for (int i = 0; i < 32; ++i) { const int kk = 2 * i + (lane >> 5); float v = W[(size_t)(k0 + kk) * N + n0 + (lane & 31)]; if (g) v *= g[k0 + kk]; scr[kk * 33 + (lane & 31)] = v; }
    asm volatile("s_waitcnt lgkmcnt(0)" ::: "memory");
    const int c = lane & 7;
#pragma unroll
    for (int j = 0; j < 4; ++j) { const int n = (lane >> 3) + 8 * j; const LAS float* s = scr + (8 * c) * 33 + n;
        u32x4 o; o.x = pk2(s[0 * 33], s[1 * 33]); o.y = pk2(s[2 * 33], s[3 * 33]); o.z = pk2(s[4 * 33], s[5 * 33]); o.w = pk2(s[6 * 33], s[7 * 33]);
        if (!dry) *(u32x4*)(WT + (size_t)(row_off + n0 + n) * K + k0 + 8 * c) = o; }
    asm volatile("s_waitcnt lgkmcnt(0)" ::: "memory");
}
__device__ __forceinline__ void fold_item(const float* __restrict__ W, bf16_t* WT, const float* __restrict__ g, const float* __restrict__ wpool, const float* __restrict__ pscale, LAS float* scr, int item, int lane, bool dry) {
    const int kb = item >> 4, nb = item & 15, k0 = 8 * kb, nn0 = 32 * nb, gi = nn0 >> 7, d = (nn0 & 127) + (lane & 31), kh = lane >> 5;
    const float* wp = wpool + (size_t)gi * 128 * 128 + d; const float* wr = W + (size_t)(k0 + kh) * EP + E_XB + gi * 128;
    float acc[4] = {0.f, 0.f, 0.f, 0.f};
#pragma unroll 2
    for (int c = 0; c < 128; c += 4) { float pv[4];
#pragma unroll
        for (int j = 0; j < 4; ++j) pv[j] = wp[(c + j) * 128];
#pragma unroll
        for (int i = 0; i < 4; ++i) { const f32x4 w4 = *(const f32x4*)(wr + (size_t)(2 * i) * EP + c); acc[i] += (w4[0] * pv[0] + w4[1] * pv[1]) + (w4[2] * pv[2] + w4[3] * pv[3]); } }
    const float ps = pscale[gi * 128 + d];
#pragma unroll
    for (int i = 0; i < 4; ++i) { const int kk = 2 * i + kh; scr[kk * 33 + (lane & 31)] = acc[i] * ps * g[k0 + kk]; }
    asm volatile("s_waitcnt lgkmcnt(0)" ::: "memory");
    if (lane < 32) { const LAS float* sp = scr + lane; u32x4 o; o.x = pk2(sp[0 * 33], sp[1 * 33]); o.y = pk2(sp[2 * 33], sp[3 * 33]); o.z = pk2(sp[4 * 33], sp[5 * 33]); o.w = pk2(sp[6 * 33], sp[7 * 33]);
        if (!dry) *(u32x4*)(WT + (size_t)(E_XB + nn0 + lane) * DM + k0) = o; }
    asm volatile("s_waitcnt lgkmcnt(0)" ::: "memory");
}
__device__ __forceinline__ void convert_weight(const Frame& F, const float* W, int K, int N, bf16_t* WT, int row_off, const float* g, bool dry = false, const float* wpool = nullptr, const float* pscale = nullptr) {
    LAS float* scr = (LAS float*)(F.lds + F.wave * 16384);
    const int gw = F.vcu * NWAVES + F.wave, NGW = F.G * NWAVES, nitems = (K / 64) * (N / 32);
    for (int it = gw; it < nitems; it += NGW) transpose_item(W, K, N, WT, row_off, g, scr, it, F.lane, dry, wpool, pscale);
    if (wpool) for (int it = gw; it < (DM / 8) * 16; it += NGW) fold_item(W, WT, g, wpool, pscale, scr, it, F.lane, dry);
}

__device__ __forceinline__ void attnA_naive(const Frame& F, bf16_t* proj) {
    LAS float* q_s = (LAS float*)(F.lds) + F.wave * 384; LAS float* p_s = (LAS float*)(F.lds + 16384) + F.wave * 448;
    const int lane = F.lane, gw = F.vcu * NWAVES + F.wave, nw = F.G * NWAVES;
    for (int item = gw; item < NT * 4; item += nw) {
        const int tok = item >> 2, h = item & 3, b = tok / SEQ, t = tok % SEQ;
        for (int j = lane; j < 384; j += 64) { const int g = j >> 7, d = j & 127; q_s[g * 128 + d] = bf2f(proj[(size_t)tok * EP + g * 1024 + h * 128 + d]); }
        asm volatile("s_waitcnt lgkmcnt(0)" ::: "memory");
        float sc[7]; float mx = -INFINITY;
#pragma unroll
        for (int i = 0; i < 7; ++i) { const int kk = lane + 64 * i; sc[i] = -INFINITY;
            if (kk < 387) { const int g = kk / 129, off = kk % 129, dil = (g == 0) ? 1 : (g == 1 ? 4 : 16), kpos = t - off * dil;
                if (kpos >= 0) { const bf16_t* kr = proj + (size_t)(b * SEQ + kpos) * EP + g * 1024 + 512 + h * 128; float s = 0.f;
                    for (int d = 0; d < 128; d += 8) { const uint4 v = *(const uint4*)(kr + d); const unsigned wv[4] = {v.x, v.y, v.z, v.w};
#pragma unroll
                        for (int j = 0; j < 4; ++j) s += q_s[g * 128 + d + 2 * j] * __uint_as_float(wv[j] << 16) + q_s[g * 128 + d + 2 * j + 1] * __uint_as_float(wv[j] & 0xffff0000u); }
                    sc[i] = s * ATT_SCALE; } }
            mx = fmaxf(mx, sc[i]); }
        mx = wave_max(mx); float l = 0.f;
#pragma unroll
        for (int i = 0; i < 7; ++i) { const float p = __expf(sc[i] - mx); l += p; p_s[lane + 64 * i] = p; }
        l = wave_sum(l);
        asm volatile("s_waitcnt lgkmcnt(0)" ::: "memory");
        float a0 = 0.f, a1 = 0.f;
        for (int kk = 0; kk < 387; ++kk) { const int g = kk / 129, off = kk % 129, dil = (g == 0) ? 1 : (g == 1 ? 4 : 16), kpos = t - off * dil;
            if (kpos >= 0) { const float p = p_s[kk]; const unsigned v = *(const unsigned*)(proj + (size_t)(b * SEQ + kpos) * EP + E_VA + h * 128 + 2 * lane);
                a0 += p * __uint_as_float(v << 16); a1 += p * __uint_as_float(v & 0xffff0000u); } }
        const float il = 1.f / l; bf16_t* zp = proj + (size_t)tok * EP + E_Z + h * 128 + 2 * lane;
        const unsigned zz = *(const unsigned*)zp;
        *(unsigned*)zp = pk2(a0 * il * silu(__uint_as_float(zz << 16)), a1 * il * silu(__uint_as_float(zz & 0xffff0000u)));
        asm volatile("s_waitcnt lgkmcnt(0)" ::: "memory");
    }
}
__device__ __forceinline__ void attnM_naive(const Frame& F, bf16_t* proj, int ld, int qcol, int zcol, const bf16_t* __restrict__ mkv  ) {
    LAS float* q_s = (LAS float*)(F.lds) + F.wave * 128; LAS float* p_s = (LAS float*)(F.lds + 16384) + F.wave * 256;
    const int lane = F.lane, gw = F.vcu * NWAVES + F.wave, nw = F.G * NWAVES;
    for (int item = gw; item < NT * 4; item += nw) {
        const int tok = item >> 2, h = item & 3, b = tok / SEQ;
        for (int j = lane; j < 128; j += 64) q_s[j] = bf2f(proj[(size_t)tok * ld + qcol + h * 128 + j]);
        asm volatile("s_waitcnt lgkmcnt(0)" ::: "memory");
        float sc[4]; float mx = -INFINITY;
#pragma unroll
        for (int i = 0; i < 4; ++i) { const int kk = lane + 64 * i; const bf16_t* kr = mkv + (size_t)(b * NMEM + kk) * 4096 + h * 128; float s = 0.f;
            for (int d = 0; d < 128; d += 8) { const uint4 v = *(const uint4*)(kr + d); const unsigned wv[4] = {v.x, v.y, v.z, v.w};
#pragma unroll
                for (int j = 0; j < 4; ++j) s += q_s[d + 2 * j] * __uint_as_float(wv[j] << 16) + q_s[d + 2 * j + 1] * __uint_as_float(wv[j] & 0xffff0000u); }
            sc[i] = s * ATT_SCALE; mx = fmaxf(mx, sc[i]); }
        mx = wave_max(mx); float l = 0.f;
#pragma unroll
        for (int i = 0; i < 4; ++i) { const float p = __expf(sc[i] - mx); l += p; p_s[lane + 64 * i] = p; }
        l = wave_sum(l);
        asm volatile("s_waitcnt lgkmcnt(0)" ::: "memory");
        float a0 = 0.f, a1 = 0.f;
        for (int kk = 0; kk < 256; ++kk) { const float p = p_s[kk]; const unsigned v = *(const unsigned*)(mkv + (size_t)(b * NMEM + kk) * 4096 + 512 + h * 128 + 2 * lane);
            a0 += p * __uint_as_float(v << 16); a1 += p * __uint_as_float(v & 0xffff0000u); }
        const float il = 1.f / l; bf16_t* zp = proj + (size_t)tok * ld + zcol + h * 128 + 2 * lane;
        const unsigned zz = *(const unsigned*)zp;
        *(unsigned*)zp = pk2(a0 * il * silu(__uint_as_float(zz << 16)), a1 * il * silu(__uint_as_float(zz & 0xffff0000u)));
        asm volatile("s_waitcnt lgkmcnt(0)" ::: "memory");
    }
}
__device__ __forceinline__ void pool_naive(const Frame& F, bf16_t* proj, const float* __restrict__ wpool, const float* __restrict__ scale) {
    LAS float* pooled = (LAS float*)(F.lds);
    const int tid = F.tid, gi = tid >> 7, c = tid & 127;
    for (int tok = F.vcu; tok < NT; tok += F.G) {
        const int t = tok % SEQ, w = 2 << gi, cnt = (t + 1 < w) ? t + 1 : w;
        float s = 0.f;
        for (int j = 0; j < cnt; ++j) s += bf2f(proj[(size_t)(tok - j) * EP + E_XB + gi * 128 + c]);
        pooled[gi * 128 + c] = s / (float)cnt - bf2f(proj[(size_t)tok * EP + E_XB + gi * 128 + c]);
        __syncthreads();
        float y = 0.f;
        for (int cc = 0; cc < 128; ++cc) y += pooled[gi * 128 + cc] * wpool[(gi * 128 + cc) * 128 + c];
        bf16_t* zp = proj + (size_t)tok * EP + E_Z + 512 + gi * 128 + c;
        *zp = (bf16_t)f2bf(y * scale[gi * 128 + c] * silu(bf2f(*zp)));
        __syncthreads();
    }
}
__device__ __forceinline__ void cmix_naive(const Frame& F, bf16_t* proj, const float* __restrict__ ln_g, const float* __restrict__ ln_b,
                                           const float* __restrict__ w_s, const float* __restrict__ b_s) {
    LAS float* vn = (LAS float*)(F.lds); LAS float* mu = vn + 128 * 128; LAS float* rstd = mu + 128;
    const int tid = F.tid, lane = F.lane, wv = F.wave;
    for (int ch = F.vcu; ch < NT / 128; ch += F.G) {
        const size_t row0 = (size_t)ch * 128;
        for (int r = wv; r < 128; r += 8) { const bf16_t* vr = proj + (row0 + r) * OP + O_V; float s = 0.f, s2 = 0.f;
            for (int j = lane; j < 1024; j += 64) { const float v = bf2f(vr[j]); s += v; }
            s = wave_sum(s); const float m = s * (1.f / 1024.f);
            for (int j = lane; j < 1024; j += 64) { const float v = bf2f(vr[j]) - m; s2 += v * v; }
            s2 = wave_sum(s2);
            if (lane == 0) { mu[r] = m; rstd[r] = rsqrtf(s2 * (1.f / 1024.f) + EPS); } }
        __syncthreads();
        for (int g = 0; g < 8; ++g) {
            for (int i = tid; i < 128 * 128; i += NTHREADS) { const int s = i >> 7, c = i & 127;
                vn[i] = (bf2f(proj[(row0 + s) * OP + O_V + g * 128 + c]) - mu[s]) * rstd[s] * ln_g[g * 128 + c] + ln_b[g * 128 + c]; }
            __syncthreads();
            const int c = tid & 127, tq = tid >> 7;
            for (int t = tq * 32; t < tq * 32 + 32; ++t) { float acc = 0.f; const float* wr = w_s + ((size_t)g * 128 + t) * 128;
                for (int s = 0; s <= t; ++s) acc += wr[s] * vn[s * 128 + c];
                const float mixed = acc + b_s[g * 128 + t];
                const float u = bf2f(proj[(row0 + t) * OP + O_U + g * 128 + c]);
                bf16_t* zp = proj + (row0 + t) * OP + O_Z + g * 128 + c;
                *zp = (bf16_t)f2bf(u * mixed * silu(bf2f(*zp))); }
            __syncthreads();
        }
    }
}


__device__ __forceinline__ att::BlockRef att_item(int L, bool even, bf16_t* proj, const bf16_t* mkv, float* lse, bool dry) {
    att::BlockRef r;
    if (even && L < 1536) {
        const int g = L >> 9, rem = L & 511, b = rem >> 6, h = (rem >> 4) & 3, x = rem & 15;
        const int dsh = 2 * g, dil = 1 << dsh, nqb = 16 >> dsh, rr = x >> (4 - dsh), qb = x & (nqb - 1);
        const size_t tok0 = (size_t)b * SEQ + rr;
        bf16_t* base = proj + tok0 * EP;
        r.Q = base + (size_t)qb * 256 * dil * EP + g * 1024 + h * 128; r.O = base + (size_t)qb * 256 * dil * EP + g * 1024 + h * 128;
        r.K = base + g * 1024 + 512 + h * 128; r.V = base + E_VA + h * 128;
        r.P0 = qb * 256; r.pq = dil * EP; r.pk = dil * EP; r.skv = SEQ >> dsh; r.W = 129; r.mode = 0;
        r.lse = lse + ((size_t)g * NT + tok0 + (size_t)qb * 256 * dil) * 4 + h; r.lsep = dil * 4;
    } else {
        const int m = even ? L - 1536 : L, b = m >> 6, h = (m >> 4) & 3, qb = m & 15;
        const int ld = even ? EP : OP, qcol = even ? E_QM : O_QM, zcol = (even ? E_Z : O_Z) + 1024;
        const size_t row0 = (size_t)b * SEQ + qb * 256;
        r.Q = proj + row0 * ld + qcol + h * 128; r.O = proj + row0 * ld + zcol + h * 128;
        r.K = mkv + (size_t)(b * NMEM) * 4096 + h * 128; r.V = r.K + 512;
        r.P0 = 256; r.pq = ld; r.pk = 4096; r.skv = 256; r.W = 1 << 20; r.mode = 1; r.lse = nullptr; r.lsep = 0;
    }
    if (dry) r.mode = 2;
    return r;
}
__device__ __forceinline__ void attn_phase(char* lds, int vcu, int G, bool even, bf16_t* proj, const bf16_t* mkv, float* lse, int tid_in, bool dry = false, int lo = 0, int hi = 1 << 30) {
    int tid = tid_in; asm volatile("" : "+v"(tid));
    const int total = (even ? 2048 : 512) < hi ? (even ? 2048 : 512) : hi;
    int L = vcu + lo; if (L >= total) return;
    att::BlockRef cur = att_item(L, even, proj, mkv, lse, dry);
    att::Seam S;
    att::swa_prime(cur, lds, S, tid);
    for (;;) {
        const int Ln = L + G; const bool last = Ln >= total;
        const att::BlockRef nxt = last ? cur : att_item(Ln, even, proj, mkv, lse, dry);
        att::swa_block(cur, nxt, lds, S, tid);
        if (last) break;
        cur = nxt; L = Ln;
    }
}
__device__ __forceinline__ void combine_phase(const Frame& F, bf16_t* proj, const float* __restrict__ lse, bool dry = false) {
    const int lane = F.lane, h = lane >> 4, dc = (lane & 15) * 8, NGW = F.G * NWAVES;
    for (int tok0 = (F.vcu * NWAVES + F.wave) * 4; tok0 < NT; tok0 += NGW * 4) {
        u32x4 o0[4], o1[4], o2[4], zz[4]; float w0[4], w1[4], w2[4];
#pragma unroll
        for (int q = 0; q < 4; ++q) { const int tok = tok0 + q; const bf16_t* row = proj + (size_t)tok * EP + h * 128 + dc;
            w0[q] = lse[((size_t)0 * NT + tok) * 4 + h]; w1[q] = lse[((size_t)1 * NT + tok) * 4 + h]; w2[q] = lse[((size_t)2 * NT + tok) * 4 + h];
            o0[q] = *(const u32x4*)(row); o1[q] = *(const u32x4*)(row + 1024); o2[q] = *(const u32x4*)(row + 2048); zz[q] = *(const u32x4*)(row + E_Z); }
#pragma unroll
        for (int q = 0; q < 4; ++q) { const int tok = tok0 + q; bf16_t* row = proj + (size_t)tok * EP + h * 128 + dc;
            const float M = fmaxf(w0[q], fmaxf(w1[q], w2[q])); float a0 = __expf(w0[q] - M), a1 = __expf(w1[q] - M), a2 = __expf(w2[q] - M);
            const float inv = 1.f / (a0 + a1 + a2); a0 *= inv; a1 *= inv; a2 *= inv;
            u32x4 y;
#pragma unroll
            for (int j = 0; j < 4; ++j) {
                const float a = a0 * __uint_as_float(o0[q][j] << 16) + a1 * __uint_as_float(o1[q][j] << 16) + a2 * __uint_as_float(o2[q][j] << 16);
                const float b = a0 * __uint_as_float(o0[q][j] & 0xffff0000u) + a1 * __uint_as_float(o1[q][j] & 0xffff0000u) + a2 * __uint_as_float(o2[q][j] & 0xffff0000u);
                y[j] = pk2(a * silu(__uint_as_float(zz[q][j] << 16)), b * silu(__uint_as_float(zz[q][j] & 0xffff0000u))); }
            if (!dry) *(u32x4*)(row + E_Z) = y; }
    }
}
__device__ __forceinline__ void pool_phase(const Frame& F, bf16_t* proj, bool dry = false) {
    const int lane = F.lane, gi = lane >> 4, w = 2 << gi, NGW = F.G * NWAVES;
    for (int run = F.vcu * NWAVES + F.wave; run < NT / 16; run += NGW) {
        const int t0 = run * 16, p0 = t0 % SEQ;
        const bf16_t* xc = proj + (size_t)t0 * EP + E_XB + lane * 8; bf16_t* zc = proj + (size_t)t0 * EP + E_Z + 512 + lane * 8;
        float sum[8];
#pragma unroll
        for (int e = 0; e < 8; ++e) sum[e] = 0.f;
        { u32x4 h[16];
#pragma unroll
          for (int j = 1; j <= 16; ++j) h[j - 1] = (j <= w && p0 - j >= 0) ? *(const u32x4*)(xc - (long)j * EP) : (u32x4){0u, 0u, 0u, 0u};
#pragma unroll
          for (int j = 0; j < 16; ++j)
#pragma unroll
              for (int e = 0; e < 4; ++e) { sum[2 * e] += __uint_as_float(h[j][e] << 16); sum[2 * e + 1] += __uint_as_float(h[j][e] & 0xffff0000u); } }
#pragma unroll
        for (int bt = 0; bt < 16; bt += 8) { u32x4 xa[8], xs[8], zz[8];
#pragma unroll
            for (int i = 0; i < 8; ++i) { const int p = p0 + bt + i;
                xa[i] = *(const u32x4*)(xc + (long)(bt + i) * EP); zz[i] = *(const u32x4*)(zc + (long)(bt + i) * EP);
                xs[i] = (p >= w) ? *(const u32x4*)(xc + (long)(bt + i - w) * EP) : (u32x4){0u, 0u, 0u, 0u}; }
#pragma unroll
            for (int i = 0; i < 8; ++i) { const int p = p0 + bt + i; const float ic = 1.f / (float)((p + 1 < w) ? p + 1 : w); u32x4 y;
#pragma unroll
                for (int e = 0; e < 4; ++e) { const float x0 = __uint_as_float(xa[i][e] << 16), x1 = __uint_as_float(xa[i][e] & 0xffff0000u);
                    sum[2 * e] += x0 - __uint_as_float(xs[i][e] << 16); sum[2 * e + 1] += x1 - __uint_as_float(xs[i][e] & 0xffff0000u);
                    y[e] = pk2((sum[2 * e] * ic - x0) * silu(__uint_as_float(zz[i][e] << 16)), (sum[2 * e + 1] * ic - x1) * silu(__uint_as_float(zz[i][e] & 0xffff0000u))); }
                if (!dry) *(u32x4*)(zc + (long)(bt + i) * EP) = y; } }
    }
}
__device__ __forceinline__ void cmix_phase(const Frame& F, bf16_t* proj, const float* __restrict__ ln_g, const float* __restrict__ ln_b,
                                           const bf16_t* __restrict__ wsm  , const float* __restrict__ b_s, bool dry = false) {
    const int tid = F.tid, lane = F.lane, wv = F.wave, fr = lane & 15, fq = lane >> 4;
    LAS unsigned char* VT = F.lds; LAS float* mu = (LAS float*)(F.lds + 128 * 272); LAS float* rstd = mu + 128;
    for (int ch = F.vcu; ch < NT / 128; ch += F.G) {
        const size_t row0 = (size_t)ch * 128;
        for (int r = wv * 16; r < wv * 16 + 16; ++r) { const bf16_t* vr = proj + (row0 + r) * OP + O_V + lane * 16;
            const u32x4 q0 = *(const u32x4*)vr, q1 = *(const u32x4*)(vr + 8); float x[16]; float s = 0.f;
#pragma unroll
            for (int j = 0; j < 4; ++j) { x[2 * j] = __uint_as_float(q0[j] << 16); x[2 * j + 1] = __uint_as_float(q0[j] & 0xffff0000u); x[8 + 2 * j] = __uint_as_float(q1[j] << 16); x[8 + 2 * j + 1] = __uint_as_float(q1[j] & 0xffff0000u); }
#pragma unroll
            for (int j = 0; j < 16; ++j) s += x[j];
            const float m = wave_sum(s) * (1.f / 1024.f); float s2 = 0.f;
#pragma unroll
            for (int j = 0; j < 16; ++j) { const float d = x[j] - m; s2 += d * d; }
            s2 = wave_sum(s2);
            if (lane == 0) { mu[r] = m; rstd[r] = rsqrtf(s2 * (1.f / 1024.f) + EPS); } }
        __syncthreads();
        for (int g = 0; g < 8; ++g) {
            { const int sI = tid >> 2, cq = tid & 3; const bf16_t* vr = proj + (row0 + sI) * OP + O_V + g * 128 + cq * 32; const float m = mu[sI], rs = rstd[sI];
#pragma unroll
              for (int k = 0; k < 4; ++k) { const u32x4 q = *(const u32x4*)(vr + 8 * k); const int c0 = cq * 32 + 8 * k;
#pragma unroll
                  for (int j = 0; j < 4; ++j) { const int c = c0 + 2 * j;
                      const float v0 = (__uint_as_float(q[j] << 16) - m) * rs * ln_g[g * 128 + c] + ln_b[g * 128 + c];
                      const float v1 = (__uint_as_float(q[j] & 0xffff0000u) - m) * rs * ln_g[g * 128 + c + 1] + ln_b[g * 128 + c + 1];
                      *(LAS bf16_t*)(VT + c * 272 + sI * 2) = (bf16_t)f2bf(v0); *(LAS bf16_t*)(VT + (c + 1) * 272 + sI * 2) = (bf16_t)f2bf(v1); } } }
            __syncthreads();
            { f32x4 acc[8];
#pragma unroll
              for (int n = 0; n < 8; ++n) acc[n] = (f32x4){0.f, 0.f, 0.f, 0.f};
              const int ksmax = wv >> 1;
              for (int ks = 0; ks <= ksmax; ++ks) {
                  const bf16x8 a = *(const bf16x8*)(wsm + ((size_t)g * 128 + wv * 16 + fr) * 128 + ks * 32 + 8 * fq);
#pragma unroll
                  for (int n = 0; n < 8; ++n) { const bf16x8 b = *(const LAS bf16x8*)(VT + (n * 16 + fr) * 272 + (ks * 32 + 8 * fq) * 2);
                      acc[n] = __builtin_amdgcn_mfma_f32_16x16x32_bf16(a, b, acc[n], 0, 0, 0); } }
              bf16_t uv[4][8], zv[4][8];
#pragma unroll
              for (int r = 0; r < 4; ++r) { const bf16_t* rowp = proj + (row0 + wv * 16 + 4 * fq + r) * OP;
#pragma unroll
                  for (int n = 0; n < 8; ++n) { const int c = g * 128 + n * 16 + fr; uv[r][n] = rowp[O_U + c]; zv[r][n] = rowp[O_Z + c]; } }
#pragma unroll
              for (int r = 0; r < 4; ++r) { const int t = wv * 16 + 4 * fq + r; const float bs = b_s[g * 128 + t]; bf16_t* rowp = proj + (row0 + t) * OP;
#pragma unroll
                  for (int n = 0; n < 8; ++n) { const int c = g * 128 + n * 16 + fr;
                      const bf16_t yv = (bf16_t)f2bf(bf2f(uv[r][n]) * (acc[n][r] + bs) * silu(bf2f(zv[r][n]))); if (!dry) rowp[O_Z + c] = yv; } } }
            __syncthreads();
        }
    }
}

struct Args { const void* in[19]; float* out; unsigned char* ws; };
__global__ void __launch_bounds__(NTHREADS, 2) mega_fwd(Args args) {
    extern __shared__ __attribute__((aligned(16))) unsigned char lds_raw[];
    Frame F;
    F.lds = (LAS unsigned char*)lds_raw;
    const int wave_s = __builtin_amdgcn_readfirstlane((int)threadIdx.x >> 6);
#define TID() (wave_s * 64 + lane_id_opaque())
    F.tid = TID(); F.lane = F.tid & 63; F.wave = wave_s;
    F.G = gridDim.x; { const int bx = blockIdx.x; F.vcu = (F.G % 8 == 0) ? (bx % 8) * (F.G / 8) + bx / 8 : bx; }
    volatile LAS unsigned* MISC = (volatile LAS unsigned*)(F.lds + MISC_OFF);
    unsigned char* ws = args.ws;
    for (int u = F.tid; u < (LDS_BYTES - LDSCTL_OFF) / 4; u += NTHREADS) ((LAS unsigned*)(F.lds + LDSCTL_OFF))[u] = 0u;
    __syncthreads();
    XcdBarrier bar = xcd_barrier_post((unsigned*)(ws + OFF_CTL) + CW_BAR, MISC + 8, F.tid);
#define GRID_BAR() xcd_barrier(bar, TID())
    const bool DRY = (args.ws != nullptr);
#if PROBE_MODE
    int sidx = 0;
#define STAMP() do { if (TID() == 0) { ((volatile LAS unsigned long long*)(F.lds + LDSCTL_OFF))[sidx] = __builtin_amdgcn_s_memrealtime(); } ++sidx; } while (0)
#else
#define STAMP() do {} while (0)
#endif
#define REFRESH() do { int t_ = TID(); asm volatile("" : "+v"(t_)); F.tid = t_; F.lane = t_ & 63; F.wave = wave_s; } while (0)

    const float* x = (const float*)args.in[0]; const float* mem = (const float*)args.in[1]; const int* pos = (const int*)args.in[2]; const float* g_mem = (const float*)args.in[3];
    const float* e_ng = (const float*)args.in[4]; const float* e_win = (const float*)args.in[5]; const float* e_wpool = (const float*)args.in[6]; const float* e_pscale = (const float*)args.in[7];
    const float* e_wmkv = (const float*)args.in[8]; const float* e_wout = (const float*)args.in[9];
    const float* o_ng = (const float*)args.in[10]; const float* o_win = (const float*)args.in[11]; const float* o_lng = (const float*)args.in[12]; const float* o_lnb = (const float*)args.in[13];
    const float* o_ws = (const float*)args.in[14]; const float* o_bs = (const float*)args.in[15]; const float* o_wmkv = (const float*)args.in[16]; const float* o_wout = (const float*)args.in[17];
    const float* f_g = (const float*)args.in[18];
    float* out = args.out;
    bf16_t* proj = (bf16_t*)(ws + OFF_PROJ); bf16_t* xb = (bf16_t*)(ws + OFF_XB); bf16_t* win = (bf16_t*)(ws + OFF_WIN); bf16_t* wout = (bf16_t*)(ws + OFF_WOUT);
    bf16_t* memkv = (bf16_t*)(ws + OFF_MEMKV); float* rowss = (float*)(ws + OFF_ROWSS); float2* rope = (float2*)(ws + OFF_ROPE); float* lse = (float*)(ws + OFF_LSE); bf16_t* wpT = (bf16_t*)(ws + OFF_WPT); bf16_t* wsm = (bf16_t*)(ws + OFF_WSM);
    bf16_t* memn = (bf16_t*)((unsigned char*)args.out + DO_MEMN); bf16_t* wmkv = (bf16_t*)((unsigned char*)args.out + DO_WMKV);
    const int NGW = F.G * NWAVES;
    { const int gw = F.vcu * NWAVES + F.wave, lane = F.lane;

    STAMP();
    convert_weight(F, e_win, DM, EP, win, 0, e_ng, false, e_wpool, e_pscale);
    convert_weight(F, e_wout, MIX, DM, wout, 0, nullptr);
    for (int l = 0; l < 4; ++l) convert_weight(F, ((l & 1) ? o_wmkv : e_wmkv) + (size_t)(l >> 1) * DM * 1024, DM, 1024, wmkv, l * 1024, nullptr);
    for (int i = F.vcu * NTHREADS + F.tid; i < 2 * 8 * 128 * 128; i += F.G * NTHREADS) { const int t = (i >> 7) & 127, sI = i & 127; wsm[i] = (sI <= t) ? (bf16_t)f2bf(o_ws[i]) : (bf16_t)0; }
    for (int r = gw; r < NT; r += NGW) {
        const float* xr = x + (size_t)r * DM; float s = 0.f;
#pragma unroll
        for (int j = 0; j < 4; ++j) { const f32x4 v = *(const f32x4*)(xr + 4 * lane + 256 * j); s += (v[0] * v[0] + v[1] * v[1]) + (v[2] * v[2] + v[3] * v[3]);
            u32x2 w; w.x = pk2(v[0], v[1]); w.y = pk2(v[2], v[3]); *(u32x2*)(xb + (size_t)r * DM + 4 * lane + 256 * j) = w; }
        s = wave_sum(s);
        if (lane < 16) rowss[(size_t)r * 16 + lane] = (lane == 0) ? s : 0.f;
    }
    for (int r = gw; r < NB * NMEM; r += NGW) {
        const float* xr = mem + (size_t)r * DM; f32x4 v[4]; float s = 0.f;
#pragma unroll
        for (int j = 0; j < 4; ++j) { v[j] = *(const f32x4*)(xr + 4 * lane + 256 * j); s += (v[j][0] * v[j][0] + v[j][1] * v[j][1]) + (v[j][2] * v[j][2] + v[j][3] * v[j][3]); }
        s = wave_sum(s); const float ri = rsqrtf(s * (1.f / DM) + EPS);
#pragma unroll
        for (int j = 0; j < 4; ++j) { const f32x4 gg = *(const f32x4*)(g_mem + 4 * lane + 256 * j);
            u32x2 w; w.x = pk2(v[j][0] * ri * gg[0], v[j][1] * ri * gg[1]); w.y = pk2(v[j][2] * ri * gg[2], v[j][3] * ri * gg[3]); *(u32x2*)(memn + (size_t)r * DM + 4 * lane + 256 * j) = w; }
    }
    for (int i = F.vcu * NTHREADS + F.tid; i < NT * 16; i += F.G * NTHREADS) {
        const int tok = i >> 4, f = i & 15; const float ang = (float)pos[tok] * c_inv_freq[f];
        const double rev = (double)ang * 0.15915494309189535; const float fr = (float)(rev - rint(rev));
        rope[i] = make_float2(__builtin_amdgcn_cosf(fr), __builtin_amdgcn_sinf(fr));
    }
    }
    GRID_BAR();
    STAMP();

    { pg8::Gemm g{memn, wmkv, NB * NMEM, 4096, DM, DM}; pg8::StaticOrder S; S.init(NB * NMEM, 4096, F.G, (int)blockIdx.x);
      pg8::EpiIn E{memkv, 4096, nullptr, nullptr, 0};
      pg8::gemm_phase<pg8::EpiIn, pg8::StaticOrder, true, true>(F.lds, g, S, E, TID()); }
    STAMP();

    for (int l = 0; l < 4; ++l) {
        const int i = l >> 1; const bool odd = l & 1; const int NP = odd ? OP : EP;
        { pg8::Gemm g{xb, win, NT, NP, DM, DM}; pg8::StaticOrder S; S.init(NT, NP, F.G, (int)blockIdx.x);
          pg8::EpiIn E{proj, NP, rowss, rope, odd ? 0 : 12};
#if PROBE_DUP == 6
          pg8::gemm_phase<pg8::EpiIn, pg8::StaticOrder, true, true>(F.lds, g, S, E, TID());
#endif
          pg8::gemm_phase<pg8::EpiIn, pg8::StaticOrder, true, true>(F.lds, g, S, E, TID()); }
        GRID_BAR();
    STAMP();
        REFRESH();
#if PROBE_DUP == 7
        if (l < 3) { const int l1 = l + 1, i1 = l1 >> 1;
            if (l1 & 1) { convert_weight(F, o_win + (size_t)i1 * DM * OP, DM, OP, win, 0, o_ng + i1 * DM, DRY); convert_weight(F, o_wout + (size_t)i1 * MIX * DM, MIX, DM, wout + (size_t)(l1 & 1) * DM * MIX, 0, nullptr, DRY); }
            else        { convert_weight(F, e_win + (size_t)i1 * DM * EP, DM, EP, win, 0, e_ng + i1 * DM, DRY, e_wpool + (size_t)i1 * 4 * 128 * 128, e_pscale + i1 * 512); convert_weight(F, e_wout + (size_t)i1 * MIX * DM, MIX, DM, wout + (size_t)(l1 & 1) * DM * MIX, 0, nullptr, DRY); }
            __syncthreads(); }
#endif
        if (l < 3) { const int l1 = l + 1, i1 = l1 >> 1;
            if (l1 & 1) { convert_weight(F, o_win + (size_t)i1 * DM * OP, DM, OP, win, 0, o_ng + i1 * DM); convert_weight(F, o_wout + (size_t)i1 * MIX * DM, MIX, DM, wout + (size_t)(l1 & 1) * DM * MIX, 0, nullptr); }
            else        { convert_weight(F, e_win + (size_t)i1 * DM * EP, DM, EP, win, 0, e_ng + i1 * DM, false, e_wpool + (size_t)i1 * 4 * 128 * 128, e_pscale + i1 * 512); convert_weight(F, e_wout + (size_t)i1 * MIX * DM, MIX, DM, wout + (size_t)(l1 & 1) * DM * MIX, 0, nullptr); }
            __syncthreads(); }
        STAMP();
        if (!odd) {
#if PROBE_DUP == 1
            REFRESH(); pool_phase(F, proj, DRY);
#endif
            REFRESH(); pool_phase(F, proj);
            STAMP();
#if PROBE_DUP == 2
            attn_phase((char*)lds_raw, F.vcu, F.G, true, proj, memkv + l * 1024, lse, TID(), DRY, 0, 1536);
#endif
#if PROBE_DUP == 3
            attn_phase((char*)lds_raw, F.vcu, F.G, true, proj, memkv + l * 1024, lse, TID(), DRY, 1536, 2048);
#endif
            attn_phase((char*)lds_raw, F.vcu, F.G, true, proj, memkv + l * 1024, lse, TID());
            GRID_BAR();
    STAMP();
#if PROBE_DUP == 4
            REFRESH(); combine_phase(F, proj, lse, DRY);
#endif
            REFRESH(); combine_phase(F, proj, lse);
        } else {
#if PROBE_DUP == 5
            REFRESH(); cmix_phase(F, proj, o_lng + i * 1024, o_lnb + i * 1024, wsm + (size_t)i * 8 * 128 * 128, o_bs + i * 8 * 128, DRY);
#endif
            REFRESH(); cmix_phase(F, proj, o_lng + i * 1024, o_lnb + i * 1024, wsm + (size_t)i * 8 * 128 * 128, o_bs + i * 8 * 128);
            STAMP();
            attn_phase((char*)lds_raw, F.vcu, F.G, false, proj, memkv + l * 1024, lse, TID());
        }
        GRID_BAR();
    STAMP();
#if PROBE_DUP == 8
        GRID_BAR(); GRID_BAR(); GRID_BAR(); GRID_BAR();
#endif
        { pg8::Gemm g{proj + (odd ? O_Z : E_Z), wout + (size_t)(l & 1) * DM * MIX, NT, DM, MIX, NP}; pg8::StaticOrder S; S.init(NT, DM, F.G, (int)blockIdx.x);
          pg8::EpiOut E{l == 0 ? x : out, out, xb, rowss};
#if PROBE_DUP == 9
          if (l == 0) pg8::gemm_phase<pg8::EpiOut, pg8::StaticOrder, true, true>(F.lds, g, S, E, TID());
#endif
          pg8::gemm_phase<pg8::EpiOut, pg8::StaticOrder, true, true>(F.lds, g, S, E, TID()); }
        GRID_BAR();
    STAMP();
    }
    REFRESH();
    for (int r = F.vcu * NWAVES + F.wave; r < NT; r += NGW) { const int lane = F.lane;
        float* xr = out + (size_t)r * DM; f32x4 v[4]; float s = 0.f;
#pragma unroll
        for (int j = 0; j < 4; ++j) { v[j] = *(const f32x4*)(xr + 4 * lane + 256 * j); s += (v[j][0] * v[j][0] + v[j][1] * v[j][1]) + (v[j][2] * v[j][2] + v[j][3] * v[j][3]); }
        s = wave_sum(s); const float ri = rsqrtf(s * (1.f / DM) + EPS);
#pragma unroll
        for (int j = 0; j < 4; ++j) { const f32x4 gg = *(const f32x4*)(f_g + 4 * lane + 256 * j); *(f32x4*)(xr + 4 * lane + 256 * j) = v[j] * ri * gg; }
    }
#if PROBE_MODE
    GRID_BAR(); STAMP();
    if (blockIdx.x == 0 && TID() == 0) {
        volatile LAS unsigned long long* st = (volatile LAS unsigned long long*)(F.lds + LDSCTL_OFF);
        const unsigned long long wait = (unsigned long long)PROBE_K * (st[PROBE_HI] - st[PROBE_LO]), t0 = __builtin_amdgcn_s_memrealtime();
        while (__builtin_amdgcn_s_memrealtime() - t0 < wait) __builtin_amdgcn_s_sleep(8);
    }
#endif
}

extern "C" void kernel_launch(void* const* d_in, const int* in_sizes, int n_in, void* d_out, int out_size, void* d_ws, size_t ws_size, hipStream_t stream) {
    static int grid = 0;
    if (grid == 0) {
        if (n_in != 19 || in_sizes[0] != NT * DM || out_size != NT * DM || ws_size < WS_END) {
            fprintf(stderr, "kernel_launch: unexpected shapes (n_in %d, in0 %d, out %d, ws %zu; need ws >= %zu)\n", n_in, n_in > 0 ? in_sizes[0] : -1, out_size, ws_size, (size_t)WS_END);
            grid = -1; return; }
        int dev = 0, cus = 0;
        if (hipGetDevice(&dev) != hipSuccess || hipDeviceGetAttribute(&cus, hipDeviceAttributeMultiprocessorCount, dev) != hipSuccess) { grid = -1; return; }
        if (hipFuncSetAttribute((const void*)mega_fwd, hipFuncAttributeMaxDynamicSharedMemorySize, LDS_BYTES) != hipSuccess) { fprintf(stderr, "kernel_launch: hipFuncSetAttribute failed\n"); grid = -1; return; }
        int per_cu = 0;
        if (hipOccupancyMaxActiveBlocksPerMultiprocessor(&per_cu, (const void*)mega_fwd, NTHREADS, LDS_BYTES) != hipSuccess || per_cu < 1)
            fprintf(stderr, "kernel_launch: note: occupancy query reports %d workgroups per CU\n", per_cu);
        (void)hipGetLastError();
        grid = cus;
    }
    if (grid < 0) return;
    if (hipMemsetAsync((char*)d_ws + OFF_CTL, 0, CTL_ZERO_BYTES, stream) != hipSuccess) return;
    Args a{};
    for (int i = 0; i < 19; ++i) a.in[i] = d_in[i];
    a.out = (float*)d_out; a.ws = (unsigned char*)d_ws;
    hipLaunchKernelGGL(mega_fwd, dim3(grid), dim3(NTHREADS), LDS_BYTES, stream, a);
}
```

```cpp
#include <hip/hip_runtime.h>
#include <cstdint>
#include <cstdio>

typedef unsigned short bf16_t;
#define LAS __attribute__((address_space(3)))
#define GAS __attribute__((address_space(1)))
typedef short bf16x8 __attribute__((ext_vector_type(8)));
typedef float f32x4 __attribute__((ext_vector_type(4)));
typedef unsigned u32x4 __attribute__((ext_vector_type(4)));
typedef unsigned u32x2 __attribute__((ext_vector_type(2)));

constexpr int NB = 8, SEQ = 4096, DM = 1024, NT = NB * SEQ;
constexpr int HD = 128, NMEM = 256;
constexpr int EP = 6144, OP = 4096, MIX = 1536;
constexpr int E_VA = 3072, E_XB = 3584, E_QM = 4096, E_Z = 4608;
constexpr int O_U = 0, O_V = 1024, O_QM = 2048, O_Z = 2560;
constexpr float EPS = 1e-6f;
constexpr float ATT_SCALE = 0.08838834764831845f;
constexpr int NWAVES = 8, NTHREADS = 512;

constexpr size_t MiB = 1u << 20;
constexpr size_t OFF_CTL = 0, CTL_ZERO_BYTES = 1 * MiB;
constexpr size_t OFF_PROJ = 1 * MiB;
constexpr size_t OFF_XB = 385 * MiB;
constexpr size_t OFF_WIN = 449 * MiB;
constexpr size_t OFF_WOUT = 461 * MiB;
constexpr size_t OFF_MEMKV = 467 * MiB;
constexpr size_t OFF_ROWSS = 483 * MiB;
constexpr size_t OFF_ROPE = 489 * MiB;
constexpr size_t OFF_LSE = 493 * MiB;
constexpr size_t OFF_WPT = 495 * MiB;
constexpr size_t OFF_WSM = OFF_WPT + 256 * 1024;
constexpr size_t WS_END = 496 * MiB;
constexpr size_t DO_MEMN = 0;
constexpr size_t DO_WMKV = 4 * MiB;
constexpr int CW_BAR = 4096;

#ifndef PROBE_MODE
#define PROBE_MODE 0
#endif
#define PROBE_LO 0
#define PROBE_HI 1
#define PROBE_K 0
#ifndef PROBE_DUP
#define PROBE_DUP 0
#endif
constexpr int RING_BYTES = 131072, LDSCTL_OFF = RING_BYTES, MISC_OFF = LDSCTL_OFF + 320, LDS_BYTES = 147456;

__device__ __forceinline__ float bf2f(bf16_t h) { return __uint_as_float((unsigned)h << 16); }
__device__ __forceinline__ unsigned f2bf(float f) { unsigned u = __float_as_uint(f); return (u + 0x7fffu + ((u >> 16) & 1u)) >> 16; }
__device__ __forceinline__ unsigned pk2(float lo, float hi) { return f2bf(lo) | (f2bf(hi) << 16); }
__device__ __forceinline__ float wave_sum(float v) {
#pragma unroll
    for (int o = 1; o < 64; o <<= 1) v += __shfl_xor(v, o);
    return v;
}
__device__ __forceinline__ float wave_max(float v) {
#pragma unroll
    for (int o = 1; o < 64; o <<= 1) v = fmaxf(v, __shfl_xor(v, o));
    return v;
}
__device__ __forceinline__ float silu(float z) { return z / (1.f + __expf(-z)); }

__constant__ float c_inv_freq[16] = {1.0f, 0.44036659598350525f, 0.1939227432012558f, 0.08539710193872452f, 0.03760603070259094f, 0.01656043902039528f,
    0.007292664609849453f, 0.0032114458736032248f, 0.0014142135623842478f, 0.000622772378847003f, 0.00027424818836152554f, 0.00012076973507646471f,
    5.318296098266728e-05f, 2.34199997066753e-05f, 1.0313386155758053e-05f, 4.541670477919979e-06f};

namespace pg8 {
constexpr int BM = 256, BK = 64, HALF = 128, HTB = HALF * BK * 2, STAGE_BYTES = 8 * HTB, NXCD = 8, WGM = 8;
__host__ __device__ __forceinline__ int lds_byte(int r, int c) { const int st = (r >> 4) * 2 + (c >> 5), rr = r & 15, cc = c & 31, ob = rr * 64 + cc * 2; return st * 1024 + (ob ^ (((ob >> 9) & 1) << 5)); }
__host__ __device__ __forceinline__ void stage_rc(int b, int& R, int& C) { const int st = b / 1024, sb = b % 1024, swz = sb ^ (((sb >> 9) & 1) << 5); R = (st >> 1) * 16 + swz / 64; C = (st & 1) * 32 + (swz % 64) / 2; }
__host__ __device__ __forceinline__ int perm32(int rho) { const int n = rho >> 4, i = rho & 15; return 8 * (i >> 2) + 4 * n + (i & 3); }
struct Unit { int pm, pn; };
struct Gemm { const bf16_t* A; const bf16_t* Bt; int M, N, K, lda; };
struct StaticOrder {
    int nM, nN, nwg, G, c;
    __host__ __device__ void init(int M, int N, int G_, int c_) { nM = M / BM; nN = N / BM; nwg = nM * nN; G = G_; c = c_; }
    __host__ __device__ bool next(int i, Unit& u) const {
        const long L = (long)i * G + c; if (L >= nwg) return false;
        int wgid = (int)L; { const int q = nwg / NXCD, r = nwg % NXCD, xcd = wgid % NXCD, off = wgid / NXCD; wgid = (xcd < r ? xcd * (q + 1) : r * (q + 1) + (xcd - r) * q) + off; }
        const int nig = WGM * nN, gid = wgid / nig, fm = gid * WGM, gsz = (nM - fm) < WGM ? (nM - fm) : WGM;
        u.pm = fm + ((wgid % nig) % gsz); u.pn = (wgid % nig) / gsz; return true;
    }
    __device__ __forceinline__ void a_ready(const Unit&) const {}
    __device__ __forceinline__ void done(const Unit&) const {}
};
__device__ __forceinline__ unsigned cvt_pk_bf16(float lo, float hi) { unsigned r; asm volatile("v_cvt_pk_bf16_f32 %0, %1, %2" : "=v"(r) : "v"(lo), "v"(hi)); return r; }

struct EpiIn {
    static constexpr bool PERM = true, AFTER_DRAIN = false;
    bf16_t* O; int ldc; const float* rowss; const float2* rope; int nrope;
    __device__ __forceinline__ void operator()(const f32x4 (&acc)[2][2][4][2], const Unit& u, int wr, int wc, int fr, int fq) const {
        const int row0 = u.pm * BM + wr * 64 + fr, col0 = u.pn * BM + wc * 32 + 8 * fq;
        const bool rp = (u.pn < nrope) && (wc == 0);
#pragma unroll
        for (int ai = 0; ai < 2; ++ai)
#pragma unroll
            for (int m = 0; m < 4; ++m) { const int row = row0 + ai * HALF + m * 16; float r = 1.f;
                if (rowss) { const f32x4 p = *(const f32x4*)(rowss + (size_t)row * 16 + 4 * fq); float s = (p[0] + p[1]) + (p[2] + p[3]);
                    s += __shfl_xor(s, 16); s += __shfl_xor(s, 32); r = rsqrtf(s * (1.f / DM) + EPS); }
                bf16_t* rowp = O + (size_t)row * ldc + col0;
#pragma unroll
                for (int bj = 0; bj < 2; ++bj) { float v[8];
#pragma unroll
                    for (int j = 0; j < 4; ++j) { v[j] = acc[ai][bj][m][0][j] * r; v[4 + j] = acc[ai][bj][m][1][j] * r; }
                    if (rp) { const float2* cs = rope + (size_t)row * 16 + 8 * (fq & 1);
#pragma unroll
                        for (int j = 0; j < 8; ++j) { const float pv = __shfl_xor(v[j], 32); const float2 c = cs[j];
                            v[j] = (fq < 2) ? (v[j] * c.x - pv * c.y) : (v[j] * c.x + pv * c.y); } }
                    u32x4 w; w.x = cvt_pk_bf16(v[0], v[1]); w.y = cvt_pk_bf16(v[2], v[3]); w.z = cvt_pk_bf16(v[4], v[5]); w.w = cvt_pk_bf16(v[6], v[7]);
                    *(u32x4*)(rowp + bj * HALF) = w; } }
    }
};
struct EpiOut {
    static constexpr bool PERM = false, AFTER_DRAIN = false;
    const float* base32; bf16_t* xb; float* rowss;
    __device__ __forceinline__ void operator()(const f32x4 (&acc)[2][2][4][2], const Unit& u, int wr, int wc, int fr, int fq) const {
        const int row0 = u.pm * BM + wr * 64 + fr, col0 = u.pn * BM + wc * 32 + 4 * fq;
#pragma unroll
        for (int ai = 0; ai < 2; ++ai)
#pragma unroll
            for (int m = 0; m < 4; ++m) { const int row = row0 + ai * HALF + m * 16; const size_t off = (size_t)row * DM + col0; float ss = 0.f; f32x4 o[2][2];
                if (base32) {
#pragma unroll
                    for (int bj = 0; bj < 2; ++bj)
#pragma unroll
                        for (int n = 0; n < 2; ++n) o[bj][n] = *(const f32x4*)(base32 + off + bj * HALF + n * 16);
                } else {
#pragma unroll
                    for (int bj = 0; bj < 2; ++bj)
#pragma unroll
                        for (int n = 0; n < 2; ++n) { const u32x2 w = *(const u32x2*)(xb + off + bj * HALF + n * 16);
                            o[bj][n] = (f32x4){__uint_as_float(w.x << 16), __uint_as_float(w.x & 0xffff0000u), __uint_as_float(w.y << 16), __uint_as_float(w.y & 0xffff0000u)}; }
                }
#pragma unroll
                for (int bj = 0; bj < 2; ++bj)
#pragma unroll
                    for (int n = 0; n < 2; ++n) { const f32x4 v = o[bj][n] + acc[ai][bj][m][n]; ss += (v[0] * v[0] + v[1] * v[1]) + (v[2] * v[2] + v[3] * v[3]);
                        u32x2 w; w.x = cvt_pk_bf16(v[0], v[1]); w.y = cvt_pk_bf16(v[2], v[3]); *(u32x2*)(xb + off + bj * HALF + n * 16) = w; }
                ss += __shfl_xor(ss, 16); ss += __shfl_xor(ss, 32);
                if (fq == 0) rowss[(size_t)row * 16 + u.pn * 4 + wc] = ss; }
    }
};

template <class Epi, class Sched, bool ALIGN_EPI = false, bool SP2 = false>
__device__ __forceinline__ void gemm_phase(LAS unsigned char* lds, const Gemm g, const Sched& S, const Epi& E, int tid_in) {
    int tid_ = tid_in; asm volatile("" : "+v"(tid_));
    const int tid = tid_, wid = __builtin_amdgcn_readfirstlane(tid >> 6), lane = tid & 63, wr = wid >> 2, wc = wid & 3, fr = lane & 15, fq = lane >> 4;
    const int K = g.K, nt = K / BK, lda = g.lda;
    unsigned voffA[2], voffB[2];
#pragma unroll
    for (int i = 0; i < 2; ++i) { int R, C; stage_rc(tid * 16 + i * 8192, R, C); const int Rb = Epi::PERM ? ((R & ~31) + perm32(R & 31)) : R;
        voffA[i] = (unsigned)(R * lda + C) * 2u; voffB[i] = (unsigned)(Rb * K + C) * 2u; }
    const size_t kstep = (size_t)(BK * 2);
    const size_t hstepA = (size_t)HALF * lda * 2, hstepB = (size_t)HALF * K * 2;
    const size_t tstepA = 2 * hstepA, tstepB = 2 * hstepB;
    const unsigned ldsw = (unsigned)wid * 1024u;
    const int aoff = lds_byte(wr * 64 + fr, fq * 8), boff = lds_byte(wc * 32 + fr, fq * 8);
#define PG8_SA(b, h) (((b) * 2 + (h)) * HTB)
#define PG8_SB(b, h) ((4 + (b) * 2 + (h)) * HTB)
#define PG8_STAGE(bufoff, gbase, voff) do { _Pragma("unroll") for (int _i = 0; _i < 2; ++_i) \
        __builtin_amdgcn_global_load_lds((const unsigned*)((const char*)(gbase) + (voff)[_i]), (LAS unsigned*)(lds + (bufoff) + ldsw + _i * 8192), 16, 0, 0); } while (0)
#define PG8_LDA(dst, b, h) do { _Pragma("unroll") for (int m = 0; m < 4; ++m) _Pragma("unroll") for (int k = 0; k < 2; ++k) dst[m][k] = *(const LAS bf16x8*)(lds + PG8_SA(b, h) + aoff + m * 2048 + k * 1024); } while (0)
#define PG8_LDB(dst, b, h) do { _Pragma("unroll") for (int n = 0; n < 2; ++n) _Pragma("unroll") for (int k = 0; k < 2; ++k) dst[n][k] = *(const LAS bf16x8*)(lds + PG8_SB(b, h) + boff + n * 2048 + k * 1024); } while (0)
#define PG8_MMA(ai, bj, At, Bt) do { __builtin_amdgcn_s_setprio(1); _Pragma("unroll") for (int m = 0; m < 4; ++m) _Pragma("unroll") for (int n = 0; n < 2; ++n) _Pragma("unroll") for (int k = 0; k < 2; ++k) \
        acc[ai][bj][m][n] = __builtin_amdgcn_mfma_f32_16x16x32_bf16(Bt[n][k], At[m][k], acc[ai][bj][m][n], 0, 0, 0); __builtin_amdgcn_s_setprio(0); } while (0)
#define PG8_WAIT_V(n) asm volatile("s_waitcnt vmcnt(" #n ")" ::: "memory")
#define PG8_WAIT_L(n) asm volatile("s_waitcnt lgkmcnt(" #n ")" ::: "memory")
#define PG8_BAR __builtin_amdgcn_s_barrier()
#define PG8_SCHED __builtin_amdgcn_sched_barrier(0)
    Unit cur, nxt; int ui = 0;
    if (!S.next(0, cur)) return;
    f32x4 acc[2][2][4][2];
#pragma unroll
    for (int a = 0; a < 2; ++a)
#pragma unroll
        for (int b = 0; b < 2; ++b)
#pragma unroll
            for (int m = 0; m < 4; ++m)
#pragma unroll
                for (int n = 0; n < 2; ++n) acc[a][b][m][n] = (f32x4){0.f, 0.f, 0.f, 0.f};
    bf16x8 At[4][2], B0[2][2], B1[2][2];
    const char* cA = (const char*)g.A + (size_t)cur.pm * tstepA; const char* cB = (const char*)g.Bt + (size_t)cur.pn * tstepB;
    S.a_ready(cur);
    if constexpr (SP2) {
        PG8_STAGE(PG8_SB(0, 0), cB, voffB); PG8_STAGE(PG8_SB(0, 1), cB + hstepB, voffB); PG8_STAGE(PG8_SA(0, 0), cA, voffA); PG8_STAGE(PG8_SA(0, 1), cA + hstepA, voffA);
        if (wr == 1) PG8_BAR;
        PG8_WAIT_V(2); PG8_BAR;
        PG8_STAGE(PG8_SB(1, 0), cB + kstep, voffB); PG8_STAGE(PG8_SA(1, 0), cA + kstep, voffA); PG8_STAGE(PG8_SB(1, 1), cB + hstepB + kstep, voffB);
        PG8_WAIT_V(6); PG8_BAR;
    } else {
        PG8_STAGE(PG8_SB(0, 0), cB, voffB); PG8_STAGE(PG8_SA(0, 0), cA, voffA); PG8_STAGE(PG8_SB(0, 1), cB + hstepB, voffB); PG8_STAGE(PG8_SA(0, 1), cA + hstepA, voffA);
        if (wr == 1) PG8_BAR;
        PG8_WAIT_V(4); PG8_BAR;
        PG8_STAGE(PG8_SB(1, 0), cB + kstep, voffB); PG8_STAGE(PG8_SA(1, 0), cA + kstep, voffA); PG8_STAGE(PG8_SB(1, 1), cB + hstepB + kstep, voffB);
        PG8_WAIT_V(6); PG8_BAR;
    }
    for (;;) {
        const bool has_next = S.next(ui + 1, nxt);
        const char* nA = has_next ? (const char*)g.A + (size_t)nxt.pm * tstepA : cA; const char* nB = has_next ? (const char*)g.Bt + (size_t)nxt.pn * tstepB : cB;
        for (int t = 0; t < nt; t += 2) {
            const bool last = (t == nt - 2);
            const char* a1 = cA + (size_t)(t + 1) * kstep;
            const char* a2 = last ? nA : cA + (size_t)(t + 2) * kstep; const char* b2 = last ? nB : cB + (size_t)(t + 2) * kstep;
            const char* a3 = a2 + kstep; const char* b3 = b2 + kstep;
            if (last && has_next) S.a_ready(nxt);
            if constexpr (SP2) {
            PG8_LDB(B0, 0, 0); PG8_LDB(B1, 0, 1); PG8_SCHED; PG8_LDA(At, 0, 0); PG8_STAGE(PG8_SA(1, 1), a1 + hstepA, voffA);
            PG8_WAIT_V(8); PG8_WAIT_L(0); PG8_BAR; PG8_MMA(0, 0, At, B0); PG8_MMA(0, 1, At, B1); PG8_BAR; PG8_SCHED;
            PG8_LDA(At, 0, 1); PG8_STAGE(PG8_SB(0, 0), b2, voffB); PG8_STAGE(PG8_SB(0, 1), b2 + hstepB, voffB); PG8_STAGE(PG8_SA(0, 0), a2, voffA);
            PG8_WAIT_V(8); PG8_WAIT_L(0); PG8_BAR; PG8_MMA(1, 0, At, B0); PG8_MMA(1, 1, At, B1); PG8_BAR; PG8_SCHED;
            PG8_LDB(B0, 1, 0); PG8_LDB(B1, 1, 1); PG8_SCHED; PG8_LDA(At, 1, 0); PG8_STAGE(PG8_SA(0, 1), a2 + hstepA, voffA);
            PG8_WAIT_V(8); PG8_WAIT_L(0); PG8_BAR; PG8_MMA(0, 0, At, B0); PG8_MMA(0, 1, At, B1); PG8_BAR; PG8_SCHED;
            PG8_LDA(At, 1, 1); PG8_STAGE(PG8_SB(1, 0), b3, voffB); PG8_STAGE(PG8_SB(1, 1), b3 + hstepB, voffB); PG8_STAGE(PG8_SA(1, 0), a3, voffA);
            PG8_WAIT_V(8); PG8_WAIT_L(0); PG8_BAR; PG8_MMA(1, 0, At, B0); PG8_MMA(1, 1, At, B1); PG8_BAR; PG8_SCHED;
            } else {
            PG8_LDB(B0, 0, 0); PG8_SCHED; PG8_LDA(At, 0, 0); PG8_STAGE(PG8_SA(1, 1), a1 + hstepA, voffA);
            PG8_WAIT_L(8); PG8_BAR; PG8_WAIT_L(0); PG8_MMA(0, 0, At, B0); PG8_BAR; PG8_SCHED;
            PG8_LDB(B1, 0, 1); PG8_STAGE(PG8_SB(0, 0), b2, voffB);
            PG8_BAR; PG8_WAIT_L(0); PG8_MMA(0, 1, At, B1); PG8_BAR;
            PG8_LDA(At, 0, 1); PG8_STAGE(PG8_SA(0, 0), a2, voffA);
            PG8_BAR; PG8_WAIT_L(0); PG8_MMA(1, 0, At, B0); PG8_BAR; PG8_SCHED;
            PG8_STAGE(PG8_SB(0, 1), b2 + hstepB, voffB);
            PG8_WAIT_V(6); PG8_BAR; PG8_MMA(1, 1, At, B1); PG8_BAR;
            PG8_LDB(B0, 1, 0); PG8_SCHED; PG8_LDA(At, 1, 0); PG8_STAGE(PG8_SA(0, 1), a2 + hstepA, voffA);
            PG8_WAIT_L(8); PG8_BAR; PG8_WAIT_L(0); PG8_MMA(0, 0, At, B0); PG8_BAR; PG8_SCHED;
            PG8_LDB(B1, 1, 1); PG8_STAGE(PG8_SB(1, 0), b3, voffB);
            PG8_BAR; PG8_WAIT_L(0); PG8_MMA(0, 1, At, B1); PG8_BAR;
            PG8_LDA(At, 1, 1); PG8_STAGE(PG8_SA(1, 0), a3, voffA);
            PG8_BAR; PG8_WAIT_L(0); PG8_MMA(1, 0, At, B0); PG8_BAR; PG8_SCHED;
            PG8_STAGE(PG8_SB(1, 1), b3 + hstepB, voffB);
            PG8_WAIT_V(6); PG8_BAR; PG8_MMA(1, 1, At, B1); PG8_BAR;
            }
        }
        if constexpr (ALIGN_EPI) { if (wr == 0) PG8_BAR; }
        if constexpr (!Epi::AFTER_DRAIN) { E(acc, cur, wr, wc, fr, fq); S.done(cur); }
        if (!has_next) break;
#pragma unroll
        for (int a = 0; a < 2; ++a)
#pragma unroll
            for (int b = 0; b < 2; ++b)
#pragma unroll
                for (int m = 0; m < 4; ++m)
#pragma unroll
                    for (int n = 0; n < 2; ++n) acc[a][b][m][n] = (f32x4){0.f, 0.f, 0.f, 0.f};
        cur = nxt; cA = nA; cB = nB; ++ui;
        if constexpr (ALIGN_EPI) { if (wr == 1) PG8_BAR; }
    }
    PG8_WAIT_V(0);
    if constexpr (!ALIGN_EPI) { if (wr == 0) PG8_BAR; }
    PG8_BAR;
#undef PG8_SA
#undef PG8_SB
#undef PG8_STAGE
#undef PG8_LDA
#undef PG8_LDB
#undef PG8_MMA
#undef PG8_WAIT_V
#undef PG8_WAIT_L
#undef PG8_BAR
#undef PG8_SCHED
}
}


namespace att {
typedef short s16x4 __attribute__((ext_vector_type(4)));
typedef float f32x16 __attribute__((ext_vector_type(16)));
constexpr int D = 128, NW = 8, QBLK = 32, KVBLK = 64, QB = NW * QBLK;
constexpr int SHM_V = KVBLK * D * 2, SHM_K = KVBLK * D * 2;
constexpr int ATT_LDS_BYTES = 2 * SHM_V + 2 * SHM_K + NW * 64 * 4;
constexpr float SCALE = 0.08838834764831845f, THR = 8.f;
#define KSWZ(row, colB) ((row) * 256 + ((colB) ^ (((row) & 7) << 4)))
#define SBAR() __builtin_amdgcn_sched_barrier(0)
__device__ __forceinline__ int v_st(int k, int c) { const int kk = (k & ~0xC) | ((k & 4) << 1) | ((k & 8) >> 1); return ((kk >> 3) * 4 + (c >> 5)) * 512 + ((kk & 7) * 32 + (c & 31)) * 2; }
__device__ __forceinline__ int v_rd_base(int lane) { return ((lane & 3) << 3) | (((lane >> 2) & 3) << 6) | (((lane >> 4) & 1) << 5) | (((lane >> 5) & 1) << 8); }
constexpr int v_rd_off(int d0, int ks, int half) { return d0 * 512 + ks * 4096 + half * 2048; }
__device__ __forceinline__ int crow(int r, int hi) { return (r & 3) + 8 * (r >> 2) + 4 * hi; }
__device__ __forceinline__ unsigned cvtpk(float lo, float hi) { unsigned r; asm volatile("v_cvt_pk_bf16_f32 %0, %1, %2" : "=v"(r) : "v"(lo), "v"(hi)); return r; }
__device__ __forceinline__ bf16x8 load8(const bf16_t* p) { return *reinterpret_cast<const bf16x8*>(p); }
__device__ __forceinline__ void mask_tile(f32x16& p0, f32x16& p1, int dq, unsigned W) {
    const float NEG = -__builtin_inff();
#pragma unroll
    for (int r = 0; r < 16; ++r) { const int c = (r & 3) + 8 * (r >> 2);
        if ((unsigned)(dq - c) >= W) p0[r] = NEG;
        if ((unsigned)(dq - c - 32) >= W) p1[r] = NEG; }
}
__device__ __forceinline__ void partialSM(f32x16& p0, f32x16& p1, float& m_reg, float& mn, float& alpha) {
    float pmax = p0[0]; for (int r = 1; r < 16; ++r) pmax = fmaxf(pmax, p0[r]); for (int r = 0; r < 16; ++r) pmax = fmaxf(pmax, p1[r]);
    { auto rr = __builtin_amdgcn_permlane32_swap(__float_as_uint(pmax), __float_as_uint(pmax), false, false);
      pmax = fmaxf(__uint_as_float(rr[0]), __uint_as_float(rr[1])); }
    constexpr float C2 = 1.4426950408889634f * SCALE;
    if (__builtin_expect(__all((pmax - m_reg) * SCALE <= THR), 1)) { mn = m_reg; alpha = 1.f; }
    else { mn = fmaxf(m_reg, pmax); alpha = __builtin_amdgcn_exp2f((m_reg - mn) * C2); m_reg = mn; }
    const float mnL = -mn * C2;
    for (int r = 0; r < 16; ++r) p0[r] = fmaf(p0[r], C2, mnL); for (int r = 0; r < 16; ++r) p1[r] = fmaf(p1[r], C2, mnL);
    for (int r = 0; r < 16; ++r) p0[r] = __builtin_amdgcn_exp2f(p0[r]);
}
__device__ __forceinline__ void finishSM(f32x16& p0, f32x16& p1, float alpha, float& l_reg, bf16x8& pa0, bf16x8& pa1, bf16x8& pa2, bf16x8& pa3) {
    for (int r = 0; r < 16; ++r) p1[r] = __builtin_amdgcn_exp2f(p1[r]);
    float ps = 0; for (int r = 0; r < 16; ++r) ps += p0[r]; for (int r = 0; r < 16; ++r) ps += p1[r];
    { auto rr = __builtin_amdgcn_permlane32_swap(__float_as_uint(ps), __float_as_uint(ps), false, false);
      ps = __uint_as_float(rr[0]) + __uint_as_float(rr[1]); }
    l_reg = l_reg * alpha + ps;
#define PK4(P, B_, OUT) do { unsigned a0 = cvtpk(P[B_+0], P[B_+1]), a1 = cvtpk(P[B_+2], P[B_+3]);                          \
        unsigned b0 = cvtpk(P[B_+4], P[B_+5]), b1 = cvtpk(P[B_+6], P[B_+7]);                                             \
        auto r0 = __builtin_amdgcn_permlane32_swap(a0, b0, false, false); auto r1 = __builtin_amdgcn_permlane32_swap(a1, b1, false, false); \
        u32x4 w = {r0[0], r1[0], r0[1], r1[1]}; OUT = *reinterpret_cast<bf16x8*>(&w); } while (0)
    PK4(p0, 0, pa0); PK4(p0, 8, pa1); PK4(p1, 0, pa2); PK4(p1, 8, pa3);
#undef PK4
}
template <int KB>
__device__ __forceinline__ void qkt(f32x16& p0, f32x16& p1, const char* K_lds, int r32, int hi, const bf16x8* qr, bool act) {
    if (!act) { const float NEG = -__builtin_inff();
#pragma unroll
        for (int r = 0; r < 16; ++r) { p0[r] = NEG; p1[r] = NEG; } return; }
    p0 = f32x16{}; p1 = f32x16{};
    const char* kb[4];
#pragma unroll
    for (int dd = 0; dd < 4; ++dd) kb[dd] = K_lds + KB * SHM_K + KSWZ(r32, (dd * 16 + hi * 8) * 2);
#pragma unroll
    for (int d0 = 0; d0 < 8; ++d0) { const char* a = kb[d0 & 3] + (d0 >> 2) * 128;
        bf16x8 b0 = *reinterpret_cast<const bf16x8*>(a);
        bf16x8 b1 = *reinterpret_cast<const bf16x8*>(a + 32 * 256);
        p0 = __builtin_amdgcn_mfma_f32_32x32x16_bf16(b0, qr[d0], p0, 0, 0, 0);
        p1 = __builtin_amdgcn_mfma_f32_32x32x16_bf16(b1, qr[d0], p1, 0, 0, 0); }
}
template <int VB>
__device__ __forceinline__ void pv_tile(f32x16* o, int vb0, bf16x8 pa0, bf16x8 pa1, bf16x8 pa2, bf16x8 pa3, bool act) {
    if (!act) return;
#define TRRD(dst, off) asm volatile("ds_read_b64_tr_b16 %0, %1 offset:%2" : "=&v"(dst) : "v"(vb0), "i"(off) : "memory")
#define PV_D0(d0) do { s16x4 l0, l1, l2, l3, h0, h1, h2, h3; constexpr int b_ = VB * SHM_V + v_rd_off(d0, 0, 0); \
        TRRD(l0, b_); TRRD(h0, b_ + 2048); TRRD(l1, b_ + 4096); TRRD(h1, b_ + 6144); TRRD(l2, b_ + 8192); TRRD(h2, b_ + 10240); TRRD(l3, b_ + 12288); TRRD(h3, b_ + 14336); \
        asm volatile("s_waitcnt lgkmcnt(0)" ::: "memory"); SBAR();   \
        o[d0] = __builtin_amdgcn_mfma_f32_32x32x16_bf16(pa0, (bf16x8){l0[0], l0[1], l0[2], l0[3], h0[0], h0[1], h0[2], h0[3]}, o[d0], 0, 0, 0);   \
        o[d0] = __builtin_amdgcn_mfma_f32_32x32x16_bf16(pa1, (bf16x8){l1[0], l1[1], l1[2], l1[3], h1[0], h1[1], h1[2], h1[3]}, o[d0], 0, 0, 0);   \
        o[d0] = __builtin_amdgcn_mfma_f32_32x32x16_bf16(pa2, (bf16x8){l2[0], l2[1], l2[2], l2[3], h2[0], h2[1], h2[2], h2[3]}, o[d0], 0, 0, 0);   \
        o[d0] = __builtin_amdgcn_mfma_f32_32x32x16_bf16(pa3, (bf16x8){l3[0], l3[1], l3[2], l3[3], h3[0], h3[1], h3[2], h3[3]}, o[d0], 0, 0, 0); } while (0)
    PV_D0(0); PV_D0(1); PV_D0(2); PV_D0(3);
#undef PV_D0
#undef TRRD
}
struct BlockRef { const bf16_t* Q; const bf16_t* K; const bf16_t* V; bf16_t* O; float* lse; int P0, pq, pk, skv, W, lsep, mode; };
struct Seam { bf16x8 qr[8]; bf16x8 st_v0, st_v1, st_k0, st_k1; };
__device__ __forceinline__ int swa_jlo(int P0, int W) { const int lowk = P0 - W + 1; return lowk > 0 ? lowk / KVBLK : 0; }
#define ROWK(p, k0, rr, pk_) ((const bf16_t*)((const char*)(p) + (size_t)(unsigned)((((unsigned)((k0) + (rr))) * (unsigned)(pk_) + (unsigned)sc) * 2u)))
#define VMW() asm volatile("s_waitcnt vmcnt(0)" ::: "memory")
#define VMWN(n) asm volatile("s_waitcnt vmcnt(%0)" :: "i"(n) : "memory")
#define SLOAD_H(Kp, Vp, k0, pk_) do { S.st_v0 = load8(ROWK(Vp, k0, sr, pk_)); S.st_v1 = load8(ROWK(Vp, k0, 32 + sr, pk_));              \
                         S.st_k0 = load8(ROWK(Kp, k0, sr, pk_)); S.st_k1 = load8(ROWK(Kp, k0, 32 + sr, pk_)); } while (0)
#define SWRITE_HK(bf) do { *(bf16x8*)(K_lds + (bf) * SHM_K + kws) = S.st_k0; *(bf16x8*)(K_lds + (bf) * SHM_K + kws + 32 * 256) = S.st_k1; } while (0)
#define SWRITE_HV(bf) do { *(bf16x8*)(V_lds + (bf) * SHM_V + vst0) = S.st_v0; *(bf16x8*)(V_lds + (bf) * SHM_V + vst1) = S.st_v1; } while (0)
#define SWRITE_H(bf) do { SWRITE_HV(bf); SWRITE_HK(bf); } while (0)
__device__ __forceinline__ void swa_prime(const BlockRef& cur, char* lds, Seam& S, int tid) {
    const int wid = __builtin_amdgcn_readfirstlane(tid >> 6), lane = tid & 63, r32 = lane & 31, hi = lane >> 5;
    const int sr = tid >> 4, sc = (tid & 15) * 8, kws = KSWZ(sr, sc * 2); char* K_lds = lds + 2 * SHM_V;
    const int kb0 = swa_jlo(cur.P0, cur.W) * KVBLK;
    { const unsigned qoff = ((unsigned)(wid * QBLK + r32) * (unsigned)cur.pq + (unsigned)hi * 8u) * 2u;
      for (int d0 = 0; d0 < 8; ++d0) S.qr[d0] = *(const bf16x8*)((const char*)cur.Q + (size_t)qoff + d0 * 32); }
    SLOAD_H(cur.K, cur.V, kb0, cur.pk); VMW(); SWRITE_HK(0);
    __syncthreads();
}
__device__ __forceinline__ void swa_block(const BlockRef& cur, const BlockRef& nxt, char* lds, Seam& S, int tid) {
    const int wid = __builtin_amdgcn_readfirstlane(tid >> 6), lane = tid & 63, r32 = lane & 31, hi = lane >> 5;
    const int W = cur.W, pk = cur.pk;
    const int j_lo = swa_jlo(cur.P0, W);
    int j_hi = (cur.P0 + QB - 1) / KVBLK + 1; if (j_hi > cur.skv / KVBLK) j_hi = cur.skv / KVBLK;
    const int NT = j_hi - j_lo;
    const int kbn = swa_jlo(nxt.P0, nxt.W) * KVBLK;
    const int qlo = cur.P0 + wid * QBLK, qm = qlo + r32 - 4 * hi;
    char* V_lds = lds; char* K_lds = lds + 2 * SHM_V;
    float* ws = (float*)(lds + 2 * SHM_V + 2 * SHM_K) + wid * 64; float* li_l = ws, * al_l = ws + 32;
    float m_reg = -1e30f, l_reg = 0; f32x16 o[4] = {};
    const int sr = tid >> 4, sc = (tid & 15) * 8, vst0 = v_st(sr, sc), vst1 = v_st(32 + sr, sc), kws = KSWZ(sr, sc * 2);
    const int vb0 = (int)(uintptr_t)V_lds + v_rd_base(lane);
    const bf16_t* Kh = cur.K; const bf16_t* Vh = cur.V;
#define RESC(a) do { if (__any((a) < 1.f)) { if (hi == 0) al_l[r32] = (a); asm volatile("s_waitcnt lgkmcnt(0)" ::: "memory");              \
                     for (int d_ = 0; d_ < 4; ++d_) for (int r = 0; r < 16; ++r) o[d_][r] *= al_l[crow(r, hi)]; } } while (0)
#define KBASE(t) ((j_lo + (t)) * KVBLK)
#define ACT(t) (KBASE(t) <= qlo + QBLK - 1 && KBASE(t) + KVBLK - 1 >= qlo - W + 1)
#define MASKT(P0_, P1_, t) do { const int kb_ = KBASE(t); if (ACT(t) && (kb_ + KVBLK - 1 > qlo || kb_ <= qlo + QBLK - 1 - W)) mask_tile(P0_, P1_, qm - kb_, (unsigned)W); } while (0)
    constexpr int NQL = 8;
#define SEAM_K0() do { VMWN(NQL); SWRITE_HK(0); SBAR(); } while (0)
    f32x16 pA0, pA1, pB0, pB1; float mnA, mnB, alA, alB; bf16x8 pa0, pa1, pa2, pa3;
    SWRITE_HV(0); SBAR();
    if (NT > 1) { SLOAD_H(Kh, Vh, KBASE(1), pk); }
    SBAR(); qkt<0>(pA0, pA1, K_lds, r32, hi, S.qr, ACT(0));
    MASKT(pA0, pA1, 0); partialSM(pA0, pA1, m_reg, mnA, alA);
    if (NT > 1) { VMW(); SWRITE_H(1); }
    __syncthreads();
#define HALF_STEP(PX0, PX1, mnX, alX, PY0, PY1, alY, t, KB, VB, SB) do {                                                      \
        SBAR(); qkt<KB>(PX0, PX1, K_lds, r32, hi, S.qr, ACT(t));                                             \
        finishSM(PY0, PY1, alY, l_reg, pa0, pa1, pa2, pa3); SBAR();                                                           \
        if ((t) + 1 < NT) { SLOAD_H(Kh, Vh, KBASE((t) + 1), pk); SBAR(); }                                               \
        pv_tile<VB>(o, vb0, pa0, pa1, pa2, pa3, ACT((t) - 1)); MASKT(PX0, PX1, (t)); partialSM(PX0, PX1, m_reg, mnX, alX);                                        \
        __syncthreads();                                                                                                      \
        if ((t) + 1 < NT) { VMW(); SWRITE_H(SB); }                                                                          \
        RESC(alX); __syncthreads(); } while (0)
    for (int t = 1; t + 1 < NT; t += 2) {
        HALF_STEP(pB0, pB1, mnB, alB, pA0, pA1, alA, t, 1, 0, 0);
        HALF_STEP(pA0, pA1, mnA, alA, pB0, pB1, alB, t + 1, 0, 1, 1);
    }
    const bool even = (NT & 1) == 0;
    if (even) { SBAR(); qkt<1>(pB0, pB1, K_lds, r32, hi, S.qr, ACT(NT - 1)); SBAR(); }
    { SLOAD_H(nxt.K, nxt.V, kbn, nxt.pk); SBAR();
        const unsigned qoff = ((unsigned)(wid * QBLK + r32) * (unsigned)nxt.pq + (unsigned)hi * 8u) * 2u;
#pragma unroll
        for (int d0 = 0; d0 < 8; ++d0) S.qr[d0] = *(const bf16x8*)((const char*)nxt.Q + (size_t)qoff + d0 * 32); }
    SBAR();
    finishSM(pA0, pA1, alA, l_reg, pa0, pa1, pa2, pa3); SBAR();
    pv_tile<0>(o, vb0, pa0, pa1, pa2, pa3, ACT(even ? NT - 2 : NT - 1));
    if (even) { MASKT(pB0, pB1, NT - 1); partialSM(pB0, pB1, m_reg, mnB, alB); __syncthreads(); RESC(alB);
        finishSM(pB0, pB1, alB, l_reg, pa0, pa1, pa2, pa3); SBAR(); pv_tile<1>(o, vb0, pa0, pa1, pa2, pa3, ACT(NT - 1)); }
    SBAR(); SEAM_K0();
    if (hi == 0) li_l[r32] = l_reg; asm volatile("s_waitcnt lgkmcnt(0)" ::: "memory");
    float rli[16];
#pragma unroll
    for (int r = 0; r < 16; ++r) rli[r] = __builtin_amdgcn_rcpf(li_l[crow(r, hi)]);
    int r32e = r32, hie = hi; asm volatile("" : "+v"(r32e), "+v"(hie));
    bf16_t* Ow = cur.O + (size_t)(wid * QBLK) * cur.pq;
    const unsigned pqu = (unsigned)cur.pq, lane_off = (unsigned)(4 * hie) * pqu + (unsigned)r32e;
    if (cur.mode == 2) {
        float sink = 0.f;
#pragma unroll
        for (int r = 0; r < 16; ++r)
#pragma unroll
            for (int d0 = 0; d0 < 4; ++d0) sink += o[d0][r] * rli[r];
        asm volatile("" :: "v"(sink), "v"(m_reg));
    } else if (cur.mode == 0) {
        if (hie == 0) cur.lse[(size_t)(wid * QBLK + r32e) * cur.lsep] = m_reg * SCALE + __logf(l_reg);
#pragma unroll
        for (int r = 0; r < 16; ++r) { const unsigned roff = lane_off + (unsigned)((r & 3) + 8 * (r >> 2)) * pqu;
#pragma unroll
            for (int d0 = 0; d0 < 4; ++d0) { const float v = o[d0][r] * rli[r]; const float vn = __shfl_xor(v, 1);
                if ((r32e & 1) == 0) *(unsigned*)(Ow + (size_t)(roff + d0 * 32)) = cvtpk(v, vn); } }
    } else {
#pragma unroll
        for (int rb = 0; rb < 16; rb += 4) { unsigned zz[4][4];
#pragma unroll
            for (int rr = 0; rr < 4; ++rr) { const unsigned roff = lane_off + (unsigned)(((rb + rr) & 3) + 8 * ((rb + rr) >> 2)) * pqu;
#pragma unroll
                for (int d0 = 0; d0 < 4; ++d0) zz[rr][d0] = ((r32e & 1) == 0) ? *(const unsigned*)(Ow + (size_t)(roff + d0 * 32)) : 0u; }
#pragma unroll
            for (int rr = 0; rr < 4; ++rr) { const int r = rb + rr; const unsigned roff = lane_off + (unsigned)((r & 3) + 8 * (r >> 2)) * pqu;
#pragma unroll
                for (int d0 = 0; d0 < 4; ++d0) { const float v = o[d0][r] * rli[r]; const float vn = __shfl_xor(v, 1);
                    if ((r32e & 1) == 0) *(unsigned*)(Ow + (size_t)(roff + d0 * 32)) = cvtpk(v * silu(__uint_as_float(zz[rr][d0] << 16)), vn * silu(__uint_as_float(zz[rr][d0] & 0xffff0000u))); } } }
    }
    __syncthreads();
#undef RESC
#undef KBASE
#undef ACT
#undef MASKT
#undef SEAM_K0
#undef HALF_STEP
}
#undef ROWK
#undef VMW
#undef VMWN
#undef SLOAD_H
#undef SWRITE_HK
#undef SWRITE_HV
#undef SWRITE_H
#undef KSWZ
#undef SBAR
}

typedef GAS unsigned gu32;
#define RLX_AGENT __ATOMIC_RELAXED, __HIP_MEMORY_SCOPE_AGENT
#define XB_TMO      128
#define XB_XCNT(j)  (256  + 64 * (j))
#define XB_XSUB(j)  (1280 + 64 * (j))
#define XB_XGEN(j)  (2304 + 64 * (j))
#define XB_TOP      3328
#define XB_TOPGEN   3392
#define XCD_BAR_WORDS 3456
#define XB_SPIN_CAP (1u << 18)
__device__ __forceinline__ unsigned xb_ld(unsigned* p)              { return __hip_atomic_load(p, __ATOMIC_RELAXED, __HIP_MEMORY_SCOPE_AGENT); }
__device__ __forceinline__ unsigned xb_add(unsigned* p, unsigned v) { return __hip_atomic_fetch_add(p, v, __ATOMIC_RELAXED, __HIP_MEMORY_SCOPE_AGENT); }
__device__ __forceinline__ unsigned xb_xcc_id() { return (unsigned)__builtin_amdgcn_s_getreg((3 << 11) | 20) & 0xFu; }
#define XB_SPIN(cond, bar) do { unsigned _sp = 0; while (cond) { __builtin_amdgcn_s_sleep(1); \
    if ((++_sp & 255u) == 0u) { if (xb_ld(&(bar)[XB_TMO])) break; if (_sp > XB_SPIN_CAP) { atomicAdd(&(bar)[XB_TMO], 1u); break; } } } } while (0)
struct XcdBarrier { unsigned* bar; unsigned x; volatile LAS unsigned* st; };
__device__ __forceinline__ XcdBarrier xcd_barrier_post(unsigned* bar, volatile LAS unsigned* st, int tid) {
    XcdBarrier b; b.bar = bar; b.x = xb_xcc_id(); b.st = st;
    if (tid == 0) (void)xb_add(&bar[XB_XCNT(b.x)], 1u);
    return b;
}
__device__ __forceinline__ void xcd_barrier_complete(unsigned* bar, unsigned x, unsigned& nloc, unsigned& nx) {
    const unsigned G = gridDim.x * gridDim.y * gridDim.z;
    unsigned sum, cnt, mine, sp = 0u;
    for (;;) {
        sum = 0u; cnt = 0u; mine = 0u;
#pragma unroll
        for (unsigned j = 0; j < 16; ++j) { const unsigned c = xb_ld(&bar[XB_XCNT(j)]); sum += c; cnt += (c > 0u) ? 1u : 0u; mine = (j == x) ? c : mine; }
        if (sum == G) break;
        __builtin_amdgcn_s_sleep(1);
        if ((++sp & 255u) == 0u) { if (xb_ld(&bar[XB_TMO])) break; if (sp > XB_SPIN_CAP) { atomicAdd(&bar[XB_TMO], 1u); break; } }
    }
    nloc = mine > 0u ? mine : 1u; nx = cnt > 0u ? cnt : 1u;
}
__device__ __forceinline__ void xcd_barrier(const XcdBarrier& b, int tid) {
    asm volatile("s_waitcnt vmcnt(0)" ::: "memory");
    __syncthreads();
    if (tid == 0) {
        unsigned* bar = b.bar;
        __builtin_amdgcn_s_waitcnt(0);
        unsigned nloc = b.st[0], nx = b.st[1];
        if (nloc == 0u) { xcd_barrier_complete(bar, b.x, nloc, nx); b.st[0] = nloc; b.st[1] = nx; }
        const unsigned old = xb_add(&bar[XB_XSUB(b.x)], 1u);
        const unsigned gen = old / nloc;
        if (old + 1u == (gen + 1u) * nloc) {
            __builtin_amdgcn_fence(__ATOMIC_RELEASE, "agent");
            asm volatile("s_waitcnt vmcnt(0)" ::: "memory");
            const unsigned og = xb_add(&bar[XB_TOP], 1u);
            const unsigned tg = og / nx;
            if (og + 1u == (tg + 1u) * nx) xb_add(&bar[XB_TOPGEN], 1u);
            else XB_SPIN(xb_ld(&bar[XB_TOPGEN]) == tg, bar);
            __builtin_amdgcn_fence(__ATOMIC_ACQUIRE, "agent");
            xb_add(&bar[XB_XGEN(b.x)], 1u);
            asm volatile("s_waitcnt vmcnt(0)" ::: "memory");
        } else {
            XB_SPIN(xb_ld(&bar[XB_XGEN(b.x)]) == gen, bar);
            __builtin_amdgcn_fence(__ATOMIC_ACQUIRE, "agent");
            asm volatile("s_waitcnt vmcnt(0)" ::: "memory");
        }
    }
    __syncthreads();
}

__device__ __forceinline__ int lane_id_opaque() { int l; asm volatile("v_mbcnt_lo_u32_b32 %0, -1, 0\n\tv_mbcnt_hi_u32_b32 %0, -1, %0" : "=v"(l)); return l; }
struct Frame {
    LAS unsigned char* lds;
    int tid, lane, wave, vcu, G;
};

__device__ __forceinline__ void transpose_item(const float* __restrict__ W, int K, int N, bf16_t* WT, int row_off, const float* __restrict__ g, LAS float* scr, int item, int lane, bool dry = false,
                                               const float* __restrict__ wpool = nullptr, const float* __restrict__ pscale = nullptr) {
    const int nblk = N / 32, kb = item / nblk, nb = item % nblk, k0 = 64 * kb, n0 = 32 * nb;
    if (wpool && n0 >= E_XB && n0 < E_XB + 512) return;
#pragma unroll 8
    for (int i = 0; i < 32; ++i) { const int kk = 2 * i + (lane >> 5); float v = W[(size_t)(k0 + kk) * N + n0 + (lane & 31)]; if (g) v *= g[k0 + kk]; scr[kk * 33 + (lane & 31)] = v; }
    asm volatile("s_waitcnt lgkmcnt(0)" ::: "memory");
    const int c = lane & 7;
#pragma unroll
    for (int j = 0; j < 4; ++j) { const int n = (lane >> 3) + 8 * j; const LAS float* s = scr + (8 * c) * 33 + n;
        u32x4 o; o.x = pk2(s[0 * 33], s[1 * 33]); o.y = pk2(s[2 * 33], s[3 * 33]); o.z = pk2(s[4 * 33], s[5 * 33]); o.w = pk2(s[6 * 33], s[7 * 33]);
        if (!dry) *(u32x4*)(WT + (size_t)(row_off + n0 + n) * K + k0 + 8 * c) = o; }
    asm volatile("s_waitcnt lgkmcnt(0)" ::: "memory");
}
__device__ __forceinline__ void fold_item(const float* __restrict__ W, bf16_t* WT, const float* __restrict__ g, const float* __restrict__ wpool, const float* __restrict__ pscale, LAS float* scr, int item, int lane, bool dry) {
    const int kb = item >> 4, nb = item & 15, k0 = 8 * kb, nn0 = 32 * nb, gi = nn0 >> 7, d = (nn0 & 127) + (lane & 31), kh = lane >> 5;
    const float* wp = wpool + (size_t)gi * 128 * 128 + d; const float* wr = W + (size_t)(k0 + kh) * EP + E_XB + gi * 128;
    float acc[4] = {0.f, 0.f, 0.f, 0.f};
#pragma unroll 2
    for (int c = 0; c < 128; c += 4) { float pv[4];
#pragma unroll
        for (int j = 0; j < 4; ++j) pv[j] = wp[(c + j) * 128];
#pragma unroll
        for (int i = 0; i < 4; ++i) { const f32x4 w4 = *(const f32x4*)(wr + (size_t)(2 * i) * EP + c); acc[i] += (w4[0] * pv[0] + w4[1] * pv[1]) + (w4[2] * pv[2] + w4[3] * pv[3]); } }
    const float ps = pscale[gi * 128 + d];
#pragma unroll
    for (int i = 0; i < 4; ++i) { const int kk = 2 * i + kh; scr[kk * 33 + (lane & 31)] = acc[i] * ps * g[k0 + kk]; }
    asm volatile("s_waitcnt lgkmcnt(0)" ::: "memory");
    if (lane < 32) { const LAS float* sp = scr + lane; u32x4 o; o.x = pk2(sp[0 * 33], sp[1 * 33]); o.y = pk2(sp[2 * 33], sp[3 * 33]); o.z = pk2(sp[4 * 33], sp[5 * 33]); o.w = pk2(sp[6 * 33], sp[7 * 33]);
        if (!dry) *(u32x4*)(WT + (size_t)(E_XB + nn0 + lane) * DM + k0) = o; }
    asm volatile("s_waitcnt lgkmcnt(0)" ::: "memory");
}
__device__ __forceinline__ void convert_weight(const Frame& F, const float* W, int K, int N, bf16_t* WT, int row_off, const float* g, bool dry = false, const float* wpool = nullptr, const float* pscale = nullptr) {
    LAS float* scr = (LAS float*)(F.lds + F.wave * 16384);
    const int gw = F.vcu * NWAVES + F.wave, NGW = F.G * NWAVES, nitems = (K / 64) * (N / 32);
    for (int it = gw; it < nitems; it += NGW) transpose_item(W, K, N, WT, row_off, g, scr, it, F.lane, dry, wpool, pscale);
    if (wpool) for (int it = gw; it < (DM / 8) * 16; it += NGW) fold_item(W, WT, g, wpool, pscale, scr, it, F.lane, dry);
}

__device__ __forceinline__ void attnA_naive(const Frame& F, bf16_t* proj) {
    LAS float* q_s = (LAS float*)(F.lds) + F.wave * 384; LAS float* p_s = (LAS float*)(F.lds + 16384) + F.wave * 448;
    const int lane = F.lane, gw = F.vcu * NWAVES + F.wave, nw = F.G * NWAVES;
    for (int item = gw; item < NT * 4; item += nw) {
        const int tok = item >> 2, h = item & 3, b = tok / SEQ, t = tok % SEQ;
        for (int j = lane; j < 384; j += 64) { const int g = j >> 7, d = j & 127; q_s[g * 128 + d] = bf2f(proj[(size_t)tok * EP + g * 1024 + h * 128 + d]); }
        asm volatile("s_waitcnt lgkmcnt(0)" ::: "memory");
        float sc[7]; float mx = -INFINITY;
#pragma unroll
        for (int i = 0; i < 7; ++i) { const int kk = lane + 64 * i; sc[i] = -INFINITY;
            if (kk < 387) { const int g = kk / 129, off = kk % 129, dil = (g == 0) ? 1 : (g == 1 ? 4 : 16), kpos = t - off * dil;
                if (kpos >= 0) { const bf16_t* kr = proj + (size_t)(b * SEQ + kpos) * EP + g * 1024 + 512 + h * 128; float s = 0.f;
                    for (int d = 0; d < 128; d += 8) { const uint4 v = *(const uint4*)(kr + d); const unsigned wv[4] = {v.x, v.y, v.z, v.w};
#pragma unroll
                        for (int j = 0; j < 4; ++j) s += q_s[g * 128 + d + 2 * j] * __uint_as_float(wv[j] << 16) + q_s[g * 128 + d + 2 * j + 1] * __uint_as_float(wv[j] & 0xffff0000u); }
                    sc[i] = s * ATT_SCALE; } }
            mx = fmaxf(mx, sc[i]); }
        mx = wave_max(mx); float l = 0.f;
#pragma unroll
        for (int i = 0; i < 7; ++i) { const float p = __expf(sc[i] - mx); l += p; p_s[lane + 64 * i] = p; }
        l = wave_sum(l);
        asm volatile("s_waitcnt lgkmcnt(0)" ::: "memory");
        float a0 = 0.f, a1 = 0.f;
        for (int kk = 0; kk < 387; ++kk) { const int g = kk / 129, off = kk % 129, dil = (g == 0) ? 1 : (g == 1 ? 4 : 16), kpos = t - off * dil;
            if (kpos >= 0) { const float p = p_s[kk]; const unsigned v = *(const unsigned*)(proj + (size_t)(b * SEQ + kpos) * EP + E_VA + h * 128 + 2 * lane);
                a0 += p * __uint_as_float(v << 16); a1 += p * __uint_as_float(v & 0xffff0000u); } }
        const float il = 1.f / l; bf16_t* zp = proj + (size_t)tok * EP + E_Z + h * 128 + 2 * lane;
        const unsigned zz = *(const unsigned*)zp;
        *(unsigned*)zp = pk2(a0 * il * silu(__uint_as_float(zz << 16)), a1 * il * silu(__uint_as_float(zz & 0xffff0000u)));
        asm volatile("s_waitcnt lgkmcnt(0)" ::: "memory");
    }
}
__device__ __forceinline__ void attnM_naive(const Frame& F, bf16_t* proj, int ld, int qcol, int zcol, const bf16_t* __restrict__ mkv  ) {
    LAS float* q_s = (LAS float*)(F.lds) + F.wave * 128; LAS float* p_s = (LAS float*)(F.lds + 16384) + F.wave * 256;
    const int lane = F.lane, gw = F.vcu * NWAVES + F.wave, nw = F.G * NWAVES;
    for (int item = gw; item < NT * 4; item += nw) {
        const int tok = item >> 2, h = item & 3, b = tok / SEQ;
        for (int j = lane; j < 128; j += 64) q_s[j] = bf2f(proj[(size_t)tok * ld + qcol + h * 128 + j]);
        asm volatile("s_waitcnt lgkmcnt(0)" ::: "memory");
        float sc[4]; float mx = -INFINITY;
#pragma unroll
        for (int i = 0; i < 4; ++i) { const int kk = lane + 64 * i; const bf16_t* kr = mkv + (size_t)(b * NMEM + kk) * 4096 + h * 128; float s = 0.f;
            for (int d = 0; d < 128; d += 8) { const uint4 v = *(const uint4*)(kr + d); const unsigned wv[4] = {v.x, v.y, v.z, v.w};
#pragma unroll
                for (int j = 0; j < 4; ++j) s += q_s[d + 2 * j] * __uint_as_float(wv[j] << 16) + q_s[d + 2 * j + 1] * __uint_as_float(wv[j] & 0xffff0000u); }
            sc[i] = s * ATT_SCALE; mx = fmaxf(mx, sc[i]); }
        mx = wave_max(mx); float l = 0.f;
#pragma unroll
        for (int i = 0; i < 4; ++i) { const float p = __expf(sc[i] - mx); l += p; p_s[lane + 64 * i] = p; }
        l = wave_sum(l);
        asm volatile("s_waitcnt lgkmcnt(0)" ::: "memory");
        float a0 = 0.f, a1 = 0.f;
        for (int kk = 0; kk < 256; ++kk) { const float p = p_s[kk]; const unsigned v = *(const unsigned*)(mkv + (size_t)(b * NMEM + kk) * 4096 + 512 + h * 128 + 2 * lane);
            a0 += p * __uint_as_float(v << 16); a1 += p * __uint_as_float(v & 0xffff0000u); }
        const float il = 1.f / l; bf16_t* zp = proj + (size_t)tok * ld + zcol + h * 128 + 2 * lane;
        const unsigned zz = *(const unsigned*)zp;
        *(unsigned*)zp = pk2(a0 * il * silu(__uint_as_float(zz << 16)), a1 * il * silu(__uint_as_float(zz & 0xffff0000u)));
        asm volatile("s_waitcnt lgkmcnt(0)" ::: "memory");
    }
}
__device__ __forceinline__ void pool_naive(const Frame& F, bf16_t* proj, const float* __restrict__ wpool, const float* __restrict__ scale) {
    LAS float* pooled = (LAS float*)(F.lds);
    const int tid = F.tid, gi = tid >> 7, c = tid & 127;
    for (int tok = F.vcu; tok < NT; tok += F.G) {
        const int t = tok % SEQ, w = 2 << gi, cnt = (t + 1 < w) ? t + 1 : w;
        float s = 0.f;
        for (int j = 0; j < cnt; ++j) s += bf2f(proj[(size_t)(tok - j) * EP + E_XB + gi * 128 + c]);
        pooled[gi * 128 + c] = s / (float)cnt - bf2f(proj[(size_t)tok * EP + E_XB + gi * 128 + c]);
        __syncthreads();
        float y = 0.f;
        for (int cc = 0; cc < 128; ++cc) y += pooled[gi * 128 + cc] * wpool[(gi * 128 + cc) * 128 + c];
        bf16_t* zp = proj + (size_t)tok * EP + E_Z + 512 + gi * 128 + c;
        *zp = (bf16_t)f2bf(y * scale[gi * 128 + c] * silu(bf2f(*zp)));
        __syncthreads();
    }
}
__device__ __forceinline__ void cmix_naive(const Frame& F, bf16_t* proj, const float* __restrict__ ln_g, const float* __restrict__ ln_b,
                                           const float* __restrict__ w_s, const float* __restrict__ b_s) {
    LAS float* vn = (LAS float*)(F.lds); LAS float* mu = vn + 128 * 128; LAS float* rstd = mu + 128;
    const int tid = F.tid, lane = F.lane, wv = F.wave;
    for (int ch = F.vcu; ch < NT / 128; ch += F.G) {
        const size_t row0 = (size_t)ch * 128;
        for (int r = wv; r < 128; r += 8) { const bf16_t* vr = proj + (row0 + r) * OP + O_V; float s = 0.f, s2 = 0.f;
            for (int j = lane; j < 1024; j += 64) { const float v = bf2f(vr[j]); s += v; }
            s = wave_sum(s); const float m = s * (1.f / 1024.f);
            for (int j = lane; j < 1024; j += 64) { const float v = bf2f(vr[j]) - m; s2 += v * v; }
            s2 = wave_sum(s2);
            if (lane == 0) { mu[r] = m; rstd[r] = rsqrtf(s2 * (1.f / 1024.f) + EPS); } }
        __syncthreads();
        for (int g = 0; g < 8; ++g) {
            for (int i = tid; i < 128 * 128; i += NTHREADS) { const int s = i >> 7, c = i & 127;
                vn[i] = (bf2f(proj[(row0 + s) * OP + O_V + g * 128 + c]) - mu[s]) * rstd[s] * ln_g[g * 128 + c] + ln_b[g * 128 + c]; }
            __syncthreads();
            const int c = tid & 127, tq = tid >> 7;
            for (int t = tq * 32; t < tq * 32 + 32; ++t) { float acc = 0.f; const float* wr = w_s + ((size_t)g * 128 + t) * 128;
                for (int s = 0; s <= t; ++s) acc += wr[s] * vn[s * 128 + c];
                const float mixed = acc + b_s[g * 128 + t];
                const float u = bf2f(proj[(row0 + t) * OP + O_U + g * 128 + c]);
                bf16_t* zp = proj + (row0 + t) * OP + O_Z + g * 128 + c;
                *zp = (bf16_t)f2bf(u * mixed * silu(bf2f(*zp))); }
            __syncthreads();
        }
    }
}


__device__ __forceinline__ att::BlockRef att_item(int L, bool even, bf16_t* proj, const bf16_t* mkv, float* lse, bool dry) {
    att::BlockRef r;
    if (even && L < 1536) {
        const int g = L >> 9, rem = L & 511, b = rem >> 6, h = (rem >> 4) & 3, x = rem & 15;
        const int dsh = 2 * g, dil = 1 << dsh, nqb = 16 >> dsh, rr = x >> (4 - dsh), qb = x & (nqb - 1);
        const size_t tok0 = (size_t)b * SEQ + rr;
        bf16_t* base = proj + tok0 * EP;
        r.Q = base + (size_t)qb * 256 * dil * EP + g * 1024 + h * 128; r.O = base + (size_t)qb * 256 * dil * EP + g * 1024 + h * 128;
        r.K = base + g * 1024 + 512 + h * 128; r.V = base + E_VA + h * 128;
        r.P0 = qb * 256; r.pq = dil * EP; r.pk = dil * EP; r.skv = SEQ >> dsh; r.W = 129; r.mode = 0;
        r.lse = lse + ((size_t)g * NT + tok0 + (size_t)qb * 256 * dil) * 4 + h; r.lsep = dil * 4;
    } else {
        const int m = even ? L - 1536 : L, b = m >> 6, h = (m >> 4) & 3, qb = m & 15;
        const int ld = even ? EP : OP, qcol = even ? E_QM : O_QM, zcol = (even ? E_Z : O_Z) + 1024;
        const size_t row0 = (size_t)b * SEQ + qb * 256;
        r.Q = proj + row0 * ld + qcol + h * 128; r.O = proj + row0 * ld + zcol + h * 128;
        r.K = mkv + (size_t)(b * NMEM) * 4096 + h * 128; r.V = r.K + 512;
        r.P0 = 256; r.pq = ld; r.pk = 4096; r.skv = 256; r.W = 1 << 20; r.mode = 1; r.lse = nullptr; r.lsep = 0;
    }
    if (dry) r.mode = 2;
    return r;
}
__device__ __forceinline__ void attn_phase(char* lds, int vcu, int G, bool even, bf16_t* proj, const bf16_t* mkv, float* lse, int tid_in, bool dry = false, int lo = 0, int hi = 1 << 30) {
    int tid = tid_in; asm volatile("" : "+v"(tid));
    const int total = (even ? 2048 : 512) < hi ? (even ? 2048 : 512) : hi;
    int L = vcu + lo; if (L >= total) return;
    att::BlockRef cur = att_item(L, even, proj, mkv, lse, dry);
    att::Seam S;
    att::swa_prime(cur, lds, S, tid);
    for (;;) {
        const int Ln = L + G; const bool last = Ln >= total;
        const att::BlockRef nxt = last ? cur : att_item(Ln, even, proj, mkv, lse, dry);
        att::swa_block(cur, nxt, lds, S, tid);
        if (last) break;
        cur = nxt; L = Ln;
    }
}
__device__ __forceinline__ void combine_phase(const Frame& F, bf16_t* proj, const float* __restrict__ lse, bool dry = false) {
    const int lane = F.lane, h = lane >> 4, dc = (lane & 15) * 8, NGW = F.G * NWAVES;
    for (int tok0 = (F.vcu * NWAVES + F.wave) * 4; tok0 < NT; tok0 += NGW * 4) {
        u32x4 o0[4], o1[4], o2[4], zz[4]; float w0[4], w1[4], w2[4];
#pragma unroll
        for (int q = 0; q < 4; ++q) { const int tok = tok0 + q; const bf16_t* row = proj + (size_t)tok * EP + h * 128 + dc;
            w0[q] = lse[((size_t)0 * NT + tok) * 4 + h]; w1[q] = lse[((size_t)1 * NT + tok) * 4 + h]; w2[q] = lse[((size_t)2 * NT + tok) * 4 + h];
            o0[q] = *(const u32x4*)(row); o1[q] = *(const u32x4*)(row + 1024); o2[q] = *(const u32x4*)(row + 2048); zz[q] = *(const u32x4*)(row + E_Z); }
#pragma unroll
        for (int q = 0; q < 4; ++q) { const int tok = tok0 + q; bf16_t* row = proj + (size_t)tok * EP + h * 128 + dc;
            const float M = fmaxf(w0[q], fmaxf(w1[q], w2[q])); float a0 = __expf(w0[q] - M), a1 = __expf(w1[q] - M), a2 = __expf(w2[q] - M);
            const float inv = 1.f / (a0 + a1 + a2); a0 *= inv; a1 *= inv; a2 *= inv;
            u32x4 y;
#pragma unroll
            for (int j = 0; j < 4; ++j) {
                const float a = a0 * __uint_as_float(o0[q][j] << 16) + a1 * __uint_as_float(o1[q][j] << 16) + a2 * __uint_as_float(o2[q][j] << 16);
                const float b = a0 * __uint_as_float(o0[q][j] & 0xffff0000u) + a1 * __uint_as_float(o1[q][j] & 0xffff0000u) + a2 * __uint_as_float(o2[q][j] & 0xffff0000u);
                y[j] = pk2(a * silu(__uint_as_float(zz[q][j] << 16)), b * silu(__uint_as_float(zz[q][j] & 0xffff0000u))); }
            if (!dry) *(u32x4*)(row + E_Z) = y; }
    }
}
__device__ __forceinline__ void pool_phase(const Frame& F, bf16_t* proj, bool dry = false) {
    const int lane = F.lane, gi = lane >> 4, w = 2 << gi, NGW = F.G * NWAVES;
    for (int run = F.vcu * NWAVES + F.wave; run < NT / 16; run += NGW) {
        const int t0 = run * 16, p0 = t0 % SEQ;
        const bf16_t* xc = proj + (size_t)t0 * EP + E_XB + lane * 8; bf16_t* zc = proj + (size_t)t0 * EP + E_Z + 512 + lane * 8;
        float sum[8];
#pragma unroll
        for (int e = 0; e < 8; ++e) sum[e] = 0.f;
        { u32x4 h[16];
#pragma unroll
          for (int j = 1; j <= 16; ++j) h[j - 1] = (j <= w && p0 - j >= 0) ? *(const u32x4*)(xc - (long)j * EP) : (u32x4){0u, 0u, 0u, 0u};
#pragma unroll
          for (int j = 0; j < 16; ++j)
#pragma unroll
              for (int e = 0; e < 4; ++e) { sum[2 * e] += __uint_as_float(h[j][e] << 16); sum[2 * e + 1] += __uint_as_float(h[j][e] & 0xffff0000u); } }
#pragma unroll
        for (int bt = 0; bt < 16; bt += 8) { u32x4 xa[8], xs[8], zz[8];
#pragma unroll
            for (int i = 0; i < 8; ++i) { const int p = p0 + bt + i;
                xa[i] = *(const u32x4*)(xc + (long)(bt + i) * EP); zz[i] = *(const u32x4*)(zc + (long)(bt + i) * EP);
                xs[i] = (p >= w) ? *(const u32x4*)(xc + (long)(bt + i - w) * EP) : (u32x4){0u, 0u, 0u, 0u}; }
#pragma unroll
            for (int i = 0; i < 8; ++i) { const int p = p0 + bt + i; const float ic = 1.f / (float)((p + 1 < w) ? p + 1 : w); u32x4 y;
#pragma unroll
                for (int e = 0; e < 4; ++e) { const float x0 = __uint_as_float(xa[i][e] << 16), x1 = __uint_as_float(xa[i][e] & 0xffff0000u);
                    sum[2 * e] += x0 - __uint_as_float(xs[i][e] << 16); sum[2 * e + 1] += x1 - __uint_as_float(xs[i][e] & 0xffff0000u);
                    y[e] = pk2((sum[2 * e] * ic - x0) * silu(__uint_as_float(zz[i][e] << 16)), (sum[2 * e + 1] * ic - x1) * silu(__uint_as_float(zz[i][e] & 0xffff0000u))); }
                if (!dry) *(u32x4*)(zc + (long)(bt + i) * EP) = y; } }
    }
}
__device__ __forceinline__ void cmix_phase(const Frame& F, bf16_t* proj, const float* __restrict__ ln_g, const float* __restrict__ ln_b,
                                           const bf16_t* __restrict__ wsm  , const float* __restrict__ b_s, bool dry = false) {
    const int tid = F.tid, lane = F.lane, wv = F.wave, fr = lane & 15, fq = lane >> 4;
    LAS unsigned char* VT = F.lds; LAS float* mu = (LAS float*)(F.lds + 128 * 272); LAS float* rstd = mu + 128;
    for (int ch = F.vcu; ch < NT / 128; ch += F.G) {
        const size_t row0 = (size_t)ch * 128;
#pragma unroll
        for (int rb = 0; rb < 16; rb += 4) { u32x4 q[4][2];
#pragma unroll
            for (int rr = 0; rr < 4; ++rr) { const bf16_t* vr = proj + (row0 + wv * 16 + rb + rr) * OP + O_V + lane * 16; q[rr][0] = *(const u32x4*)vr; q[rr][1] = *(const u32x4*)(vr + 8); }
#pragma unroll
            for (int rr = 0; rr < 4; ++rr) { float x[16]; float s1 = 0.f;
#pragma unroll
                for (int j = 0; j < 4; ++j) { x[2 * j] = __uint_as_float(q[rr][0][j] << 16); x[2 * j + 1] = __uint_as_float(q[rr][0][j] & 0xffff0000u); x[8 + 2 * j] = __uint_as_float(q[rr][1][j] << 16); x[8 + 2 * j + 1] = __uint_as_float(q[rr][1][j] & 0xffff0000u); }
#pragma unroll
                for (int j = 0; j < 16; ++j) s1 += x[j];
                const float m = wave_sum(s1) * (1.f / 1024.f); float s2 = 0.f;
#pragma unroll
                for (int j = 0; j < 16; ++j) { const float d = x[j] - m; s2 += d * d; }
                s2 = wave_sum(s2);
                if (lane == 0) { mu[wv * 16 + rb + rr] = m; rstd[wv * 16 + rb + rr] = rsqrtf(s2 * (1.f / 1024.f) + EPS); } } }
        const int sI = tid >> 2, cq = tid & 3;
        const bf16_t* vrow = proj + (row0 + sI) * OP + O_V + cq * 8;
        bf16_t* trow = proj + (row0 + wv * 16 + fr) * OP;
        u32x4 vq[4];
#pragma unroll
        for (int k = 0; k < 4; ++k) vq[k] = *(const u32x4*)(vrow + k * 32);
        __syncthreads();
        const float m_s = mu[sI], r_s = rstd[sI];
        for (int g = 0; g < 8; ++g) {
            u32x2 uq[8], zq[8];
#pragma unroll
            for (int mt = 0; mt < 8; ++mt) { uq[mt] = *(const u32x2*)(trow + O_U + g * 128 + mt * 16 + 4 * fq); zq[mt] = *(const u32x2*)(trow + O_Z + g * 128 + mt * 16 + 4 * fq); }
            const float bs = b_s[g * 128 + wv * 16 + fr];
#pragma unroll
            for (int k = 0; k < 4; ++k) { const int c0 = k * 32 + cq * 8; const f32x4 g0 = *(const f32x4*)(ln_g + g * 128 + c0), g1 = *(const f32x4*)(ln_g + g * 128 + c0 + 4), b0 = *(const f32x4*)(ln_b + g * 128 + c0), b1 = *(const f32x4*)(ln_b + g * 128 + c0 + 4);
#pragma unroll
                for (int j = 0; j < 4; ++j) { const float gg0 = (j < 2) ? g0[2 * j] : g1[2 * j - 4], gg1 = (j < 2) ? g0[2 * j + 1] : g1[2 * j - 3], bb0 = (j < 2) ? b0[2 * j] : b1[2 * j - 4], bb1 = (j < 2) ? b0[2 * j + 1] : b1[2 * j - 3];
                    const float v0 = (__uint_as_float(vq[k][j] << 16) - m_s) * r_s * gg0 + bb0, v1 = (__uint_as_float(vq[k][j] & 0xffff0000u) - m_s) * r_s * gg1 + bb1;
                    *(LAS bf16_t*)(VT + (c0 + 2 * j) * 272 + sI * 2) = (bf16_t)f2bf(v0); *(LAS bf16_t*)(VT + (c0 + 2 * j + 1) * 272 + sI * 2) = (bf16_t)f2bf(v1); } }
            __syncthreads();
            if (g < 7) {
#pragma unroll
                for (int k = 0; k < 4; ++k) vq[k] = *(const u32x4*)(vrow + (g + 1) * 128 + k * 32); }
            f32x4 acc[8];
#pragma unroll
            for (int n = 0; n < 8; ++n) acc[n] = (f32x4){0.f, 0.f, 0.f, 0.f};
            const int ksmax = wv >> 1;
            for (int ks = 0; ks <= ksmax; ++ks) {
                const bf16x8 b = *(const bf16x8*)(wsm + ((size_t)g * 128 + wv * 16 + fr) * 128 + ks * 32 + 8 * fq);
#pragma unroll
                for (int mt = 0; mt < 8; ++mt) { const bf16x8 a = *(const LAS bf16x8*)(VT + (mt * 16 + fr) * 272 + (ks * 32 + 8 * fq) * 2);
                    acc[mt] = __builtin_amdgcn_mfma_f32_16x16x32_bf16(a, b, acc[mt], 0, 0, 0); } }
#pragma unroll
            for (int mt = 0; mt < 8; ++mt) { u32x2 y;
                y.x = pk2(__uint_as_float(uq[mt].x << 16) * (acc[mt][0] + bs) * silu(__uint_as_float(zq[mt].x << 16)), __uint_as_float(uq[mt].x & 0xffff0000u) * (acc[mt][1] + bs) * silu(__uint_as_float(zq[mt].x & 0xffff0000u)));
                y.y = pk2(__uint_as_float(uq[mt].y << 16) * (acc[mt][2] + bs) * silu(__uint_as_float(zq[mt].y << 16)), __uint_as_float(uq[mt].y & 0xffff0000u) * (acc[mt][3] + bs) * silu(__uint_as_float(zq[mt].y & 0xffff0000u)));
                if (!dry) *(u32x2*)(trow + O_Z + g * 128 + mt * 16 + 4 * fq) = y; }
            __syncthreads();
        }
    }
}

struct Args { const void* in[19]; float* out; unsigned char* ws; };
__global__ void __launch_bounds__(NTHREADS, 2) mega_fwd(Args args) {
    extern __shared__ __attribute__((aligned(16))) unsigned char lds_raw[];
    Frame F;
    F.lds = (LAS unsigned char*)lds_raw;
    const int wave_s = __builtin_amdgcn_readfirstlane((int)threadIdx.x >> 6);
#define TID() (wave_s * 64 + lane_id_opaque())
    F.tid = TID(); F.lane = F.tid & 63; F.wave = wave_s;
    F.G = gridDim.x; { const int bx = blockIdx.x; F.vcu = (F.G % 8 == 0) ? (bx % 8) * (F.G / 8) + bx / 8 : bx; }
    volatile LAS unsigned* MISC = (volatile LAS unsigned*)(F.lds + MISC_OFF);
    unsigned char* ws = args.ws;
    for (int u = F.tid; u < (LDS_BYTES - LDSCTL_OFF) / 4; u += NTHREADS) ((LAS unsigned*)(F.lds + LDSCTL_OFF))[u] = 0u;
    __syncthreads();
    XcdBarrier bar = xcd_barrier_post((unsigned*)(ws + OFF_CTL) + CW_BAR, MISC + 8, F.tid);
#define GRID_BAR() xcd_barrier(bar, TID())
    const bool DRY = (args.ws != nullptr);
#if PROBE_MODE
    int sidx = 0;
#define STAMP() do { if (TID() == 0) { ((volatile LAS unsigned long long*)(F.lds + LDSCTL_OFF))[sidx] = __builtin_amdgcn_s_memrealtime(); } ++sidx; } while (0)
#else
#define STAMP() do {} while (0)
#endif
#define REFRESH() do { int t_ = TID(); asm volatile("" : "+v"(t_)); F.tid = t_; F.lane = t_ & 63; F.wave = wave_s; } while (0)

    const float* x = (const float*)args.in[0]; const float* mem = (const float*)args.in[1]; const int* pos = (const int*)args.in[2]; const float* g_mem = (const float*)args.in[3];
    const float* e_ng = (const float*)args.in[4]; const float* e_win = (const float*)args.in[5]; const float* e_wpool = (const float*)args.in[6]; const float* e_pscale = (const float*)args.in[7];
    const float* e_wmkv = (const float*)args.in[8]; const float* e_wout = (const float*)args.in[9];
    const float* o_ng = (const float*)args.in[10]; const float* o_win = (const float*)args.in[11]; const float* o_lng = (const float*)args.in[12]; const float* o_lnb = (const float*)args.in[13];
    const float* o_ws = (const float*)args.in[14]; const float* o_bs = (const float*)args.in[15]; const float* o_wmkv = (const float*)args.in[16]; const float* o_wout = (const float*)args.in[17];
    const float* f_g = (const float*)args.in[18];
    float* out = args.out;
    bf16_t* proj = (bf16_t*)(ws + OFF_PROJ); bf16_t* xb = (bf16_t*)(ws + OFF_XB); bf16_t* win = (bf16_t*)(ws + OFF_WIN); bf16_t* wout = (bf16_t*)(ws + OFF_WOUT);
    bf16_t* memkv = (bf16_t*)(ws + OFF_MEMKV); float* rowss = (float*)(ws + OFF_ROWSS); float2* rope = (float2*)(ws + OFF_ROPE); float* lse = (float*)(ws + OFF_LSE); bf16_t* wpT = (bf16_t*)(ws + OFF_WPT); bf16_t* wsm = (bf16_t*)(ws + OFF_WSM);
    bf16_t* memn = (bf16_t*)((unsigned char*)args.out + DO_MEMN); bf16_t* wmkv = (bf16_t*)((unsigned char*)args.out + DO_WMKV);
    const int NGW = F.G * NWAVES;
    { const int gw = F.vcu * NWAVES + F.wave, lane = F.lane;

    STAMP();
    convert_weight(F, e_win, DM, EP, win, 0, e_ng, false, e_wpool, e_pscale);
    convert_weight(F, e_wout, MIX, DM, wout, 0, nullptr);
    for (int l = 0; l < 4; ++l) convert_weight(F, ((l & 1) ? o_wmkv : e_wmkv) + (size_t)(l >> 1) * DM * 1024, DM, 1024, wmkv, l * 1024, nullptr);
    for (int i = F.vcu * NTHREADS + F.tid; i < 2 * 8 * 128 * 128; i += F.G * NTHREADS) { const int t = (i >> 7) & 127, sI = i & 127; wsm[i] = (sI <= t) ? (bf16_t)f2bf(o_ws[i]) : (bf16_t)0; }
    for (int r = gw; r < NT; r += NGW) {
        const float* xr = x + (size_t)r * DM; float s = 0.f;
#pragma unroll
        for (int j = 0; j < 4; ++j) { const f32x4 v = *(const f32x4*)(xr + 4 * lane + 256 * j); s += (v[0] * v[0] + v[1] * v[1]) + (v[2] * v[2] + v[3] * v[3]);
            u32x2 w; w.x = pk2(v[0], v[1]); w.y = pk2(v[2], v[3]); *(u32x2*)(xb + (size_t)r * DM + 4 * lane + 256 * j) = w; }
        s = wave_sum(s);
        if (lane < 16) rowss[(size_t)r * 16 + lane] = (lane == 0) ? s : 0.f;
    }
    for (int r = gw; r < NB * NMEM; r += NGW) {
        const float* xr = mem + (size_t)r * DM; f32x4 v[4]; float s = 0.f;
#pragma unroll
        for (int j = 0; j < 4; ++j) { v[j] = *(const f32x4*)(xr + 4 * lane + 256 * j); s += (v[j][0] * v[j][0] + v[j][1] * v[j][1]) + (v[j][2] * v[j][2] + v[j][3] * v[j][3]); }
        s = wave_sum(s); const float ri = rsqrtf(s * (1.f / DM) + EPS);
#pragma unroll
        for (int j = 0; j < 4; ++j) { const f32x4 gg = *(const f32x4*)(g_mem + 4 * lane + 256 * j);
            u32x2 w; w.x = pk2(v[j][0] * ri * gg[0], v[j][1] * ri * gg[1]); w.y = pk2(v[j][2] * ri * gg[2], v[j][3] * ri * gg[3]); *(u32x2*)(memn + (size_t)r * DM + 4 * lane + 256 * j) = w; }
    }
    for (int i = F.vcu * NTHREADS + F.tid; i < NT * 16; i += F.G * NTHREADS) {
        const int tok = i >> 4, f = i & 15; const float ang = (float)pos[tok] * c_inv_freq[f];
        const double rev = (double)ang * 0.15915494309189535; const float fr = (float)(rev - rint(rev));
        rope[i] = make_float2(__builtin_amdgcn_cosf(fr), __builtin_amdgcn_sinf(fr));
    }
    }
    GRID_BAR();
    STAMP();

    { pg8::Gemm g{memn, wmkv, NB * NMEM, 4096, DM, DM}; pg8::StaticOrder S; S.init(NB * NMEM, 4096, F.G, (int)blockIdx.x);
      pg8::EpiIn E{memkv, 4096, nullptr, nullptr, 0};
      pg8::gemm_phase<pg8::EpiIn, pg8::StaticOrder, true, true>(F.lds, g, S, E, TID()); }
    STAMP();

    for (int l = 0; l < 4; ++l) {
        const int i = l >> 1; const bool odd = l & 1; const int NP = odd ? OP : EP;
        { pg8::Gemm g{xb, win, NT, NP, DM, DM}; pg8::StaticOrder S; S.init(NT, NP, F.G, (int)blockIdx.x);
          pg8::EpiIn E{proj, NP, rowss, rope, odd ? 0 : 12};
#if PROBE_DUP == 6
          pg8::gemm_phase<pg8::EpiIn, pg8::StaticOrder, true, true>(F.lds, g, S, E, TID());
#endif
          pg8::gemm_phase<pg8::EpiIn, pg8::StaticOrder, true, true>(F.lds, g, S, E, TID()); }
        GRID_BAR();
    STAMP();
        REFRESH();
#if PROBE_DUP == 7
        if (l < 3) { const int l1 = l + 1, i1 = l1 >> 1;
            if (l1 & 1) { convert_weight(F, o_win + (size_t)i1 * DM * OP, DM, OP, win, 0, o_ng + i1 * DM, DRY); convert_weight(F, o_wout + (size_t)i1 * MIX * DM, MIX, DM, wout + (size_t)(l1 & 1) * DM * MIX, 0, nullptr, DRY); }
            else        { convert_weight(F, e_win + (size_t)i1 * DM * EP, DM, EP, win, 0, e_ng + i1 * DM, DRY, e_wpool + (size_t)i1 * 4 * 128 * 128, e_pscale + i1 * 512); convert_weight(F, e_wout + (size_t)i1 * MIX * DM, MIX, DM, wout + (size_t)(l1 & 1) * DM * MIX, 0, nullptr, DRY); }
            __syncthreads(); }
#endif
        if (l < 3) { const int l1 = l + 1, i1 = l1 >> 1;
            if (l1 & 1) { convert_weight(F, o_win + (size_t)i1 * DM * OP, DM, OP, win, 0, o_ng + i1 * DM); convert_weight(F, o_wout + (size_t)i1 * MIX * DM, MIX, DM, wout + (size_t)(l1 & 1) * DM * MIX, 0, nullptr); }
            else        { convert_weight(F, e_win + (size_t)i1 * DM * EP, DM, EP, win, 0, e_ng + i1 * DM, false, e_wpool + (size_t)i1 * 4 * 128 * 128, e_pscale + i1 * 512); convert_weight(F, e_wout + (size_t)i1 * MIX * DM, MIX, DM, wout + (size_t)(l1 & 1) * DM * MIX, 0, nullptr); }
            __syncthreads(); }
        STAMP();
        if (!odd) {
#if PROBE_DUP == 1
            REFRESH(); pool_phase(F, proj, DRY);
#endif
            REFRESH(); pool_phase(F, proj);
            STAMP();
#if PROBE_DUP == 2
            attn_phase((char*)lds_raw, F.vcu, F.G, true, proj, memkv + l * 1024, lse, TID(), DRY, 0, 1536);
#endif
#if PROBE_DUP == 3
            attn_phase((char*)lds_raw, F.vcu, F.G, true, proj, memkv + l * 1024, lse, TID(), DRY, 1536, 2048);
#endif
            attn_phase((char*)lds_raw, F.vcu, F.G, true, proj, memkv + l * 1024, lse, TID());
            GRID_BAR();
    STAMP();
#if PROBE_DUP == 4
            REFRESH(); combine_phase(F, proj, lse, DRY);
#endif
            REFRESH(); combine_phase(F, proj, lse);
        } else {
#if PROBE_DUP == 5
            REFRESH(); cmix_phase(F, proj, o_lng + i * 1024, o_lnb + i * 1024, wsm + (size_t)i * 8 * 128 * 128, o_bs + i * 8 * 128, DRY);
#endif
            REFRESH(); cmix_phase(F, proj, o_lng + i * 1024, o_lnb + i * 1024, wsm + (size_t)i * 8 * 128 * 128, o_bs + i * 8 * 128);
            STAMP();
            attn_phase((char*)lds_raw, F.vcu, F.G, false, proj, memkv + l * 1024, lse, TID());
        }
        GRID_BAR();
    STAMP();
#if PROBE_DUP == 8
        GRID_BAR(); GRID_BAR(); GRID_BAR(); GRID_BAR();
#endif
        { pg8::Gemm g{proj + (odd ? O_Z : E_Z), wout + (size_t)(l & 1) * DM * MIX, NT, DM, MIX, NP}; pg8::StaticOrder S; S.init(NT, DM, F.G, (int)blockIdx.x);
          pg8::EpiOut E{l == 0 ? x : nullptr, xb, rowss};
#if PROBE_DUP == 9
          if (l == 0) pg8::gemm_phase<pg8::EpiOut, pg8::StaticOrder, true, true>(F.lds, g, S, E, TID());
#endif
          pg8::gemm_phase<pg8::EpiOut, pg8::StaticOrder, true, true>(F.lds, g, S, E, TID()); }
        GRID_BAR();
    STAMP();
    }
    REFRESH();
    for (int r = F.vcu * NWAVES + F.wave; r < NT; r += NGW) { const int lane = F.lane;
        float s = (lane < 16) ? rowss[(size_t)r * 16 + lane] : 0.f; s = wave_sum(s); const float ri = rsqrtf(s * (1.f / DM) + EPS);
        const bf16_t* xr = xb + (size_t)r * DM; float* orow = out + (size_t)r * DM;
#pragma unroll
        for (int j = 0; j < 2; ++j) { const u32x4 q = *(const u32x4*)(xr + 8 * lane + 512 * j); const f32x4 g0 = *(const f32x4*)(f_g + 8 * lane + 512 * j), g1 = *(const f32x4*)(f_g + 8 * lane + 512 * j + 4);
            const f32x4 a = {__uint_as_float(q[0] << 16) * ri * g0[0], __uint_as_float(q[0] & 0xffff0000u) * ri * g0[1], __uint_as_float(q[1] << 16) * ri * g0[2], __uint_as_float(q[1] & 0xffff0000u) * ri * g0[3]};
            const f32x4 b = {__uint_as_float(q[2] << 16) * ri * g1[0], __uint_as_float(q[2] & 0xffff0000u) * ri * g1[1], __uint_as_float(q[3] << 16) * ri * g1[2], __uint_as_float(q[3] & 0xffff0000u) * ri * g1[3]};
            *(f32x4*)(orow + 8 * lane + 512 * j) = a; *(f32x4*)(orow + 8 * lane + 512 * j + 4) = b; }
    }
#if PROBE_MODE
    GRID_BAR(); STAMP();
    if (blockIdx.x == 0 && TID() == 0) {
        volatile LAS unsigned long long* st = (volatile LAS unsigned long long*)(F.lds + LDSCTL_OFF);
        const unsigned long long wait = (unsigned long long)PROBE_K * (st[PROBE_HI] - st[PROBE_LO]), t0 = __builtin_amdgcn_s_memrealtime();
        while (__builtin_amdgcn_s_memrealtime() - t0 < wait) __builtin_amdgcn_s_sleep(8);
    }
#endif
}

extern "C" void kernel_launch(void* const* d_in, const int* in_sizes, int n_in, void* d_out, int out_size, void* d_ws, size_t ws_size, hipStream_t stream) {
    static int grid = 0;
    if (grid == 0) {
        if (n_in != 19 || in_sizes[0] != NT * DM || out_size != NT * DM || ws_size < WS_END) {
            fprintf(stderr, "kernel_launch: unexpected shapes (n_in %d, in0 %d, out %d, ws %zu; need ws >= %zu)\n", n_in, n_in > 0 ? in_sizes[0] : -1, out_size, ws_size, (size_t)WS_END);
            grid = -1; return; }
        int dev = 0, cus = 0;
        if (hipGetDevice(&dev) != hipSuccess || hipDeviceGetAttribute(&cus, hipDeviceAttributeMultiprocessorCount, dev) != hipSuccess) { grid = -1; return; }
        if (hipFuncSetAttribute((const void*)mega_fwd, hipFuncAttributeMaxDynamicSharedMemorySize, LDS_BYTES) != hipSuccess) { fprintf(stderr, "kernel_launch: hipFuncSetAttribute failed\n"); grid = -1; return; }
        int per_cu = 0;
        if (hipOccupancyMaxActiveBlocksPerMultiprocessor(&per_cu, (const void*)mega_fwd, NTHREADS, LDS_BYTES) != hipSuccess || per_cu < 1)
            fprintf(stderr, "kernel_launch: note: occupancy query reports %d workgroups per CU\n", per_cu);
        (void)hipGetLastError();
        grid = cus;
    }
    if (grid < 0) return;
    if (hipMemsetAsync((char*)d_ws + OFF_CTL, 0, CTL_ZERO_BYTES, stream) != hipSuccess) return;
    Args a{};
    for (int i = 0; i < 19; ++i) a.in[i] = d_in[i];
    a.out = (float*)d_out; a.ws = (unsigned char*)d_ws;
    hipLaunchKernelGGL(mega_fwd, dim3(grid), dim3(NTHREADS), LDS_BYTES, stream, a);
}
```

```cpp
#include <hip/hip_runtime.h>
#include <cstdint>
#include <cstdio>

typedef unsigned short bf16_t;
#define LAS __attribute__((address_space(3)))
#define GAS __attribute__((address_space(1)))
typedef short bf16x8 __attribute__((ext_vector_type(8)));
typedef float f32x4 __attribute__((ext_vector_type(4)));
typedef unsigned u32x4 __attribute__((ext_vector_type(4)));
typedef unsigned u32x2 __attribute__((ext_vector_type(2)));

constexpr int NB = 8, SEQ = 4096, DM = 1024, NT = NB * SEQ;
constexpr int HD = 128, NMEM = 256;
constexpr int EP = 6144, OP = 4096, MIX = 1536;
constexpr int E_VA = 3072, E_XB = 3584, E_QM = 4096, E_Z = 4608;
constexpr int O_U = 0, O_V = 1024, O_QM = 2048, O_Z = 2560;
constexpr size_t PS = (size_t)NT * 256;
constexpr int PR = 256;
constexpr float EPS = 1e-6f;
constexpr float ATT_SCALE = 0.08838834764831845f;
constexpr int NWAVES = 8, NTHREADS = 512;

constexpr size_t MiB = 1u << 20;
constexpr size_t OFF_CTL = 0, CTL_ZERO_BYTES = 64 * 1024;
constexpr size_t OFF_PROJ = 1 * MiB;
constexpr size_t OFF_XB = 385 * MiB;
constexpr size_t OFF_WIN = 449 * MiB;
constexpr size_t OFF_WOUT = 461 * MiB;
constexpr size_t OFF_MEMKV = 467 * MiB;
constexpr size_t OFF_ROWSS = 483 * MiB;
constexpr size_t OFF_ROPE = 489 * MiB;
constexpr size_t OFF_LSE = 493 * MiB;
constexpr size_t OFF_WPT = 495 * MiB;
constexpr size_t OFF_WSM = OFF_WPT + 256 * 1024;
constexpr size_t OFF_LNP = 496 * MiB;
constexpr size_t WS_END = 500 * MiB;
constexpr size_t DO_MEMN = 0;
constexpr size_t DO_WMKV = 4 * MiB;
constexpr size_t DO_WIN = 12 * MiB;
constexpr size_t DO_WOUT = 52 * MiB;
constexpr int CW_BAR = 4096;

constexpr int RING_BYTES = 131072, LDSCTL_OFF = RING_BYTES, MISC_OFF = LDSCTL_OFF + 320, LDS_BYTES = 147456;

__device__ __forceinline__ bf16_t* pcol(bf16_t* proj, int col) { return proj + (size_t)(col >> 8) * PS + (col & 255); }
__device__ __forceinline__ float bf2f(bf16_t h) { return __uint_as_float((unsigned)h << 16); }
__device__ __forceinline__ unsigned f2bf(float f) { unsigned u = __float_as_uint(f); return (u + 0x7fffu + ((u >> 16) & 1u)) >> 16; }
__device__ __forceinline__ unsigned pk2(float lo, float hi) { return f2bf(lo) | (f2bf(hi) << 16); }
__device__ __forceinline__ float wave_sum(float v) {
#pragma unroll
    for (int o = 1; o < 64; o <<= 1) v += __shfl_xor(v, o);
    return v;
}
__device__ __forceinline__ float wave_max(float v) {
#pragma unroll
    for (int o = 1; o < 64; o <<= 1) v = fmaxf(v, __shfl_xor(v, o));
    return v;
}
__device__ __forceinline__ float silu(float z) { return z / (1.f + __expf(-z)); }

__constant__ float c_inv_freq[16] = {1.0f, 0.44036659598350525f, 0.1939227432012558f, 0.08539710193872452f, 0.03760603070259094f, 0.01656043902039528f,
    0.007292664609849453f, 0.0032114458736032248f, 0.0014142135623842478f, 0.000622772378847003f, 0.00027424818836152554f, 0.00012076973507646471f,
    5.318296098266728e-05f, 2.34199997066753e-05f, 1.0313386155758053e-05f, 4.541670477919979e-06f};

namespace pg8 {
constexpr int BM = 256, BK = 64, HALF = 128, HTB = HALF * BK * 2, STAGE_BYTES = 8 * HTB, NXCD = 8, WGM = 8;
__host__ __device__ __forceinline__ int lds_byte(int r, int c) { const int st = (r >> 4) * 2 + (c >> 5), rr = r & 15, cc = c & 31, ob = rr * 64 + cc * 2; return st * 1024 + (ob ^ (((ob >> 9) & 1) << 5)); }
__host__ __device__ __forceinline__ void stage_rc(int b, int& R, int& C) { const int st = b / 1024, sb = b % 1024, swz = sb ^ (((sb >> 9) & 1) << 5); R = (st >> 1) * 16 + swz / 64; C = (st & 1) * 32 + (swz % 64) / 2; }
__host__ __device__ __forceinline__ int perm32(int rho) { const int n = rho >> 4, i = rho & 15; return 8 * (i >> 2) + 4 * n + (i & 3); }
struct Unit { int pm, pn; };
struct Gemm { const bf16_t* A; const bf16_t* Bt; int M, N, K, lda; size_t kpA = 512; };
struct StaticOrder {
    int nM, nN, nwg, G, c;
    __host__ __device__ void init(int M, int N, int G_, int c_) { nM = M / BM; nN = N / BM; nwg = nM * nN; G = G_; c = c_; }
    __host__ __device__ bool next(int i, Unit& u) const {
        const long L = (long)i * G + c; if (L >= nwg) return false;
        int wgid = (int)L; { const int q = nwg / NXCD, r = nwg % NXCD, xcd = wgid % NXCD, off = wgid / NXCD; wgid = (xcd < r ? xcd * (q + 1) : r * (q + 1) + (xcd - r) * q) + off; }
        const int nig = WGM * nN, gid = wgid / nig, fm = gid * WGM, gsz = (nM - fm) < WGM ? (nM - fm) : WGM;
        u.pm = fm + ((wgid % nig) % gsz); u.pn = (wgid % nig) / gsz; return true;
    }
    __device__ __forceinline__ void a_ready(const Unit&) const {}
    __device__ __forceinline__ void done(const Unit&) const {}
};
__device__ __forceinline__ unsigned cvt_pk_bf16(float lo, float hi) { unsigned r; asm volatile("v_cvt_pk_bf16_f32 %0, %1, %2" : "=v"(r) : "v"(lo), "v"(hi)); return r; }

struct EpiIn {
    static constexpr bool PERM = true, AFTER_DRAIN = false;
    bf16_t* O; int ldc; const float* rowss; const float2* rope; int nrope; float2* lnp = nullptr; int ln_pn0 = 0; size_t pstride = 0;
    __device__ __forceinline__ void operator()(const f32x4 (&acc)[2][2][4][2], const Unit& u, int wr, int wc, int fr, int fq) const {
        const int row0 = u.pm * BM + wr * 64 + fr, col0 = u.pn * BM + wc * 32 + 8 * fq;
        const bool rp = (u.pn < nrope) && (wc == 0);
        const bool lnst = lnp && u.pn >= ln_pn0 && u.pn < ln_pn0 + 4;
        float rs[2][4];
#pragma unroll
        for (int ai = 0; ai < 2; ++ai)
#pragma unroll
            for (int m = 0; m < 4; ++m) { rs[ai][m] = 1.f;
                if (rowss) { const f32x4 p = *(const f32x4*)(rowss + (size_t)(row0 + ai * HALF + m * 16) * 16 + 4 * fq); rs[ai][m] = (p[0] + p[1]) + (p[2] + p[3]); } }
        if (rowss) {
#pragma unroll
            for (int ai = 0; ai < 2; ++ai)
#pragma unroll
                for (int m = 0; m < 4; ++m) { float s = rs[ai][m]; s += __shfl_xor(s, 16); s += __shfl_xor(s, 32); rs[ai][m] = rsqrtf(s * (1.f / DM) + EPS); } }
        if (rp) {
#pragma unroll
            for (int ai = 0; ai < 2; ++ai) { f32x4 cs[4][4];
#pragma unroll
                for (int m = 0; m < 4; ++m) { const f32x4* cp = (const f32x4*)(rope + (size_t)(row0 + ai * HALF + m * 16) * 16 + 8 * (fq & 1));
#pragma unroll
                    for (int q = 0; q < 4; ++q) cs[m][q] = cp[q]; }
#pragma unroll
                for (int m = 0; m < 4; ++m) { const int row = row0 + ai * HALF + m * 16; const float r = rs[ai][m];
                    bf16_t* rowp = pstride ? O + (size_t)u.pn * pstride + (size_t)row * PR + wc * 32 + 8 * fq : O + (size_t)row * ldc + col0;
#pragma unroll
                    for (int bj = 0; bj < 2; ++bj) { float v[8];
#pragma unroll
                        for (int j = 0; j < 4; ++j) { v[j] = acc[ai][bj][m][0][j] * r; v[4 + j] = acc[ai][bj][m][1][j] * r; }
#pragma unroll
                        for (int j = 0; j < 8; ++j) { const auto sw = __builtin_amdgcn_permlane32_swap(__float_as_uint(v[j]), __float_as_uint(v[j]), false, false);
                            const float pv = __uint_as_float(fq < 2 ? sw[1] : sw[0]); const float c = cs[m][j >> 1][(j & 1) * 2], sn = cs[m][j >> 1][(j & 1) * 2 + 1];
                            v[j] = (fq < 2) ? (v[j] * c - pv * sn) : (v[j] * c + pv * sn); }
                        u32x4 w; w.x = cvt_pk_bf16(v[0], v[1]); w.y = cvt_pk_bf16(v[2], v[3]); w.z = cvt_pk_bf16(v[4], v[5]); w.w = cvt_pk_bf16(v[6], v[7]);
                        *(u32x4*)(rowp + bj * HALF) = w; } } }
        } else {
#pragma unroll
            for (int ai = 0; ai < 2; ++ai)
#pragma unroll
                for (int m = 0; m < 4; ++m) { const int row = row0 + ai * HALF + m * 16; const float r = rs[ai][m];
                    bf16_t* rowp = pstride ? O + (size_t)u.pn * pstride + (size_t)row * PR + wc * 32 + 8 * fq : O + (size_t)row * ldc + col0;
                    float s1 = 0.f, s2 = 0.f;
#pragma unroll
                    for (int bj = 0; bj < 2; ++bj) { const f32x4 a = acc[ai][bj][m][0] * r, b = acc[ai][bj][m][1] * r;
                        s1 += ((a[0] + a[1]) + (a[2] + a[3])) + ((b[0] + b[1]) + (b[2] + b[3]));
                        s2 += ((a[0] * a[0] + a[1] * a[1]) + (a[2] * a[2] + a[3] * a[3])) + ((b[0] * b[0] + b[1] * b[1]) + (b[2] * b[2] + b[3] * b[3]));
                        u32x4 w; w.x = cvt_pk_bf16(a[0], a[1]); w.y = cvt_pk_bf16(a[2], a[3]); w.z = cvt_pk_bf16(b[0], b[1]); w.w = cvt_pk_bf16(b[2], b[3]);
                        *(u32x4*)(rowp + bj * HALF) = w; }
                    if (lnst) { s1 += __shfl_xor(s1, 16); s1 += __shfl_xor(s1, 32); s2 += __shfl_xor(s2, 16); s2 += __shfl_xor(s2, 32);
                        if (fq == 0) lnp[(size_t)row * 16 + (u.pn - ln_pn0) * 4 + wc] = make_float2(s1, s2); } }
        }
    }
};
struct EpiOut {
    static constexpr bool PERM = true, AFTER_DRAIN = false;
    const float* base32; bf16_t* xb; float* rowss;
    __device__ __forceinline__ void operator()(const f32x4 (&acc)[2][2][4][2], const Unit& u, int wr, int wc, int fr, int fq) const {
        const int row0 = u.pm * BM + wr * 64 + fr, col0 = u.pn * BM + wc * 32 + 8 * fq;
#pragma unroll
        for (int ai = 0; ai < 2; ++ai) { f32x4 o[4][2][2];
            if (base32) {
#pragma unroll
                for (int m = 0; m < 4; ++m) { const size_t off = (size_t)(row0 + ai * HALF + m * 16) * DM + col0;
#pragma unroll
                    for (int bj = 0; bj < 2; ++bj)
#pragma unroll
                        for (int n = 0; n < 2; ++n) o[m][bj][n] = *(const f32x4*)(base32 + off + bj * HALF + n * 4); }
            } else {
                u32x4 w[4][2];
#pragma unroll
                for (int m = 0; m < 4; ++m) { const size_t off = (size_t)(row0 + ai * HALF + m * 16) * DM + col0;
#pragma unroll
                    for (int bj = 0; bj < 2; ++bj) w[m][bj] = *(const u32x4*)(xb + off + bj * HALF); }
#pragma unroll
                for (int m = 0; m < 4; ++m)
#pragma unroll
                    for (int bj = 0; bj < 2; ++bj) {
                        o[m][bj][0] = (f32x4){__uint_as_float(w[m][bj].x << 16), __uint_as_float(w[m][bj].x & 0xffff0000u), __uint_as_float(w[m][bj].y << 16), __uint_as_float(w[m][bj].y & 0xffff0000u)};
                        o[m][bj][1] = (f32x4){__uint_as_float(w[m][bj].z << 16), __uint_as_float(w[m][bj].z & 0xffff0000u), __uint_as_float(w[m][bj].w << 16), __uint_as_float(w[m][bj].w & 0xffff0000u)}; }
            }
#pragma unroll
            for (int m = 0; m < 4; ++m) { const int row = row0 + ai * HALF + m * 16; const size_t off = (size_t)row * DM + col0; float ss = 0.f;
#pragma unroll
                for (int bj = 0; bj < 2; ++bj) { const f32x4 v0 = o[m][bj][0] + acc[ai][bj][m][0], v1 = o[m][bj][1] + acc[ai][bj][m][1];
                    ss += ((v0[0] * v0[0] + v0[1] * v0[1]) + (v0[2] * v0[2] + v0[3] * v0[3])) + ((v1[0] * v1[0] + v1[1] * v1[1]) + (v1[2] * v1[2] + v1[3] * v1[3]));
                    u32x4 wv; wv.x = cvt_pk_bf16(v0[0], v0[1]); wv.y = cvt_pk_bf16(v0[2], v0[3]); wv.z = cvt_pk_bf16(v1[0], v1[1]); wv.w = cvt_pk_bf16(v1[2], v1[3]);
                    *(u32x4*)(xb + off + bj * HALF) = wv; }
                ss += __shfl_xor(ss, 16); ss += __shfl_xor(ss, 32);
                if (fq == 0) rowss[(size_t)row * 16 + u.pn * 4 + wc] = ss; } }
    }
};

template <class Epi, class Sched, bool ALIGN_EPI = false, bool SP2 = false>
__device__ __forceinline__ void gemm_phase(LAS unsigned char* lds, const Gemm g, const Sched& S, const Epi& E, int tid_in) {
    int tid_ = tid_in; asm volatile("" : "+v"(tid_));
    const int tid = tid_, wid = __builtin_amdgcn_readfirstlane(tid >> 6), lane = tid & 63, wr = wid >> 2, wc = wid & 3, fr = lane & 15, fq = lane >> 4;
    const int K = g.K, nt = K / BK, lda = g.lda;
    unsigned voffA[2], voffB[2];
#pragma unroll
    for (int i = 0; i < 2; ++i) { int R, C; stage_rc(tid * 16 + i * 8192, R, C); const int Rb = Epi::PERM ? ((R & ~31) + perm32(R & 31)) : R;
        voffA[i] = (unsigned)(R * lda + C) * 2u; voffB[i] = (unsigned)(Rb * K + C) * 2u; }
    const size_t kstep = (size_t)(BK * 2);
    const size_t kpA = g.kpA;
#define PG8_KA(t_) ((size_t)((t_) >> 2) * kpA + (size_t)((t_) & 3) * kstep)
    const size_t hstepA = (size_t)HALF * lda * 2, hstepB = (size_t)HALF * K * 2;
    const size_t tstepA = 2 * hstepA, tstepB = 2 * hstepB;
    const unsigned ldsw = (unsigned)wid * 1024u;
    const int aoff = lds_byte(wr * 64 + fr, fq * 8), boff = lds_byte(wc * 32 + fr, fq * 8);
#define PG8_SA(b, h) (((b) * 2 + (h)) * HTB)
#define PG8_SB(b, h) ((4 + (b) * 2 + (h)) * HTB)
#define PG8_STAGE(bufoff, gbase, voff) do { _Pragma("unroll") for (int _i = 0; _i < 2; ++_i) \
        __builtin_amdgcn_global_load_lds((const unsigned*)((const char*)(gbase) + (voff)[_i]), (LAS unsigned*)(lds + (bufoff) + ldsw + _i * 8192), 16, 0, 0); } while (0)
#define PG8_LDA(dst, b, h) do { _Pragma("unroll") for (int m = 0; m < 4; ++m) _Pragma("unroll") for (int k = 0; k < 2; ++k) dst[m][k] = *(const LAS bf16x8*)(lds + PG8_SA(b, h) + aoff + m * 2048 + k * 1024); } while (0)
#define PG8_LDB(dst, b, h) do { _Pragma("unroll") for (int n = 0; n < 2; ++n) _Pragma("unroll") for (int k = 0; k < 2; ++k) dst[n][k] = *(const LAS bf16x8*)(lds + PG8_SB(b, h) + boff + n * 2048 + k * 1024); } while (0)
#define PG8_MMA(ai, bj, At, Bt) do { __builtin_amdgcn_s_setprio(1); _Pragma("unroll") for (int m = 0; m < 4; ++m) _Pragma("unroll") for (int n = 0; n < 2; ++n) _Pragma("unroll") for (int k = 0; k < 2; ++k) \
        acc[ai][bj][m][n] = __builtin_amdgcn_mfma_f32_16x16x32_bf16(Bt[n][k], At[m][k], acc[ai][bj][m][n], 0, 0, 0); __builtin_amdgcn_s_setprio(0); } while (0)
#define PG8_WAIT_V(n) asm volatile("s_waitcnt vmcnt(" #n ")" ::: "memory")
#define PG8_WAIT_L(n) asm volatile("s_waitcnt lgkmcnt(" #n ")" ::: "memory")
#define PG8_BAR __builtin_amdgcn_s_barrier()
#define PG8_SCHED __builtin_amdgcn_sched_barrier(0)
    Unit cur, nxt; int ui = 0;
    if (!S.next(0, cur)) return;
    f32x4 acc[2][2][4][2];
#pragma unroll
    for (int a = 0; a < 2; ++a)
#pragma unroll
        for (int b = 0; b < 2; ++b)
#pragma unroll
            for (int m = 0; m < 4; ++m)
#pragma unroll
                for (int n = 0; n < 2; ++n) acc[a][b][m][n] = (f32x4){0.f, 0.f, 0.f, 0.f};
    bf16x8 At[4][2], B0[2][2], B1[2][2];
    const char* cA = (const char*)g.A + (size_t)cur.pm * tstepA; const char* cB = (const char*)g.Bt + (size_t)cur.pn * tstepB;
    S.a_ready(cur);
    if constexpr (SP2) {
        PG8_STAGE(PG8_SB(0, 0), cB, voffB); PG8_STAGE(PG8_SB(0, 1), cB + hstepB, voffB); PG8_STAGE(PG8_SA(0, 0), cA, voffA); PG8_STAGE(PG8_SA(0, 1), cA + hstepA, voffA);
        if (wr == 1) PG8_BAR;
        PG8_WAIT_V(2); PG8_BAR;
        PG8_STAGE(PG8_SB(1, 0), cB + kstep, voffB); PG8_STAGE(PG8_SA(1, 0), cA + PG8_KA(1), voffA); PG8_STAGE(PG8_SB(1, 1), cB + hstepB + kstep, voffB);
        PG8_WAIT_V(6); PG8_BAR;
    } else {
        PG8_STAGE(PG8_SB(0, 0), cB, voffB); PG8_STAGE(PG8_SA(0, 0), cA, voffA); PG8_STAGE(PG8_SB(0, 1), cB + hstepB, voffB); PG8_STAGE(PG8_SA(0, 1), cA + hstepA, voffA);
        if (wr == 1) PG8_BAR;
        PG8_WAIT_V(4); PG8_BAR;
        PG8_STAGE(PG8_SB(1, 0), cB + kstep, voffB); PG8_STAGE(PG8_SA(1, 0), cA + PG8_KA(1), voffA); PG8_STAGE(PG8_SB(1, 1), cB + hstepB + kstep, voffB);
        PG8_WAIT_V(6); PG8_BAR;
    }
    for (;;) {
        const bool has_next = S.next(ui + 1, nxt);
        const char* nA = has_next ? (const char*)g.A + (size_t)nxt.pm * tstepA : cA; const char* nB = has_next ? (const char*)g.Bt + (size_t)nxt.pn * tstepB : cB;
        for (int t = 0; t < nt; t += 2) {
            const bool last = (t == nt - 2);
            const char* a1 = cA + PG8_KA(t + 1);
            const char* a2 = last ? nA : cA + PG8_KA(t + 2); const char* b2 = last ? nB : cB + (size_t)(t + 2) * kstep;
            const char* a3 = last ? nA + PG8_KA(1) : cA + PG8_KA(t + 3); const char* b3 = b2 + kstep;
            if (last && has_next) S.a_ready(nxt);
            if constexpr (SP2) {
            PG8_LDB(B0, 0, 0); PG8_LDB(B1, 0, 1); PG8_SCHED; PG8_LDA(At, 0, 0); PG8_STAGE(PG8_SA(1, 1), a1 + hstepA, voffA);
            PG8_WAIT_V(8); PG8_WAIT_L(0); PG8_BAR; PG8_MMA(0, 0, At, B0); PG8_MMA(0, 1, At, B1); PG8_BAR; PG8_SCHED;
            PG8_LDA(At, 0, 1); PG8_STAGE(PG8_SB(0, 0), b2, voffB); PG8_STAGE(PG8_SB(0, 1), b2 + hstepB, voffB); PG8_STAGE(PG8_SA(0, 0), a2, voffA);
            PG8_WAIT_V(8); PG8_WAIT_L(0); PG8_BAR; PG8_MMA(1, 0, At, B0); PG8_MMA(1, 1, At, B1); PG8_BAR; PG8_SCHED;
            PG8_LDB(B0, 1, 0); PG8_LDB(B1, 1, 1); PG8_SCHED; PG8_LDA(At, 1, 0); PG8_STAGE(PG8_SA(0, 1), a2 + hstepA, voffA);
            PG8_WAIT_V(8); PG8_WAIT_L(0); PG8_BAR; PG8_MMA(0, 0, At, B0); PG8_MMA(0, 1, At, B1); PG8_BAR; PG8_SCHED;
            PG8_LDA(At, 1, 1); PG8_STAGE(PG8_SB(1, 0), b3, voffB); PG8_STAGE(PG8_SB(1, 1), b3 + hstepB, voffB); PG8_STAGE(PG8_SA(1, 0), a3, voffA);
            PG8_WAIT_V(8); PG8_WAIT_L(0); PG8_BAR; PG8_MMA(1, 0, At, B0); PG8_MMA(1, 1, At, B1); PG8_BAR; PG8_SCHED;
            } else {
            PG8_LDB(B0, 0, 0); PG8_SCHED; PG8_LDA(At, 0, 0); PG8_STAGE(PG8_SA(1, 1), a1 + hstepA, voffA);
            PG8_WAIT_L(8); PG8_BAR; PG8_WAIT_L(0); PG8_MMA(0, 0, At, B0); PG8_BAR; PG8_SCHED;
            PG8_LDB(B1, 0, 1); PG8_STAGE(PG8_SB(0, 0), b2, voffB);
            PG8_BAR; PG8_WAIT_L(0); PG8_MMA(0, 1, At, B1); PG8_BAR;
            PG8_LDA(At, 0, 1); PG8_STAGE(PG8_SA(0, 0), a2, voffA);
            PG8_BAR; PG8_WAIT_L(0); PG8_MMA(1, 0, At, B0); PG8_BAR; PG8_SCHED;
            PG8_STAGE(PG8_SB(0, 1), b2 + hstepB, voffB);
            PG8_WAIT_V(6); PG8_BAR; PG8_MMA(1, 1, At, B1); PG8_BAR;
            PG8_LDB(B0, 1, 0); PG8_SCHED; PG8_LDA(At, 1, 0); PG8_STAGE(PG8_SA(0, 1), a2 + hstepA, voffA);
            PG8_WAIT_L(8); PG8_BAR; PG8_WAIT_L(0); PG8_MMA(0, 0, At, B0); PG8_BAR; PG8_SCHED;
            PG8_LDB(B1, 1, 1); PG8_STAGE(PG8_SB(1, 0), b3, voffB);
            PG8_BAR; PG8_WAIT_L(0); PG8_MMA(0, 1, At, B1); PG8_BAR;
            PG8_LDA(At, 1, 1); PG8_STAGE(PG8_SA(1, 0), a3, voffA);
            PG8_BAR; PG8_WAIT_L(0); PG8_MMA(1, 0, At, B0); PG8_BAR; PG8_SCHED;
            PG8_STAGE(PG8_SB(1, 1), b3 + hstepB, voffB);
            PG8_WAIT_V(6); PG8_BAR; PG8_MMA(1, 1, At, B1); PG8_BAR;
            }
        }
        if constexpr (ALIGN_EPI) { if (wr == 0) PG8_BAR; }
        if constexpr (!Epi::AFTER_DRAIN) { E(acc, cur, wr, wc, fr, fq); S.done(cur); }
        if (!has_next) break;
#pragma unroll
        for (int a = 0; a < 2; ++a)
#pragma unroll
            for (int b = 0; b < 2; ++b)
#pragma unroll
                for (int m = 0; m < 4; ++m)
#pragma unroll
                    for (int n = 0; n < 2; ++n) acc[a][b][m][n] = (f32x4){0.f, 0.f, 0.f, 0.f};
        cur = nxt; cA = nA; cB = nB; ++ui;
        if constexpr (ALIGN_EPI) { if (wr == 1) PG8_BAR; }
    }
    PG8_WAIT_V(0);
    if constexpr (!ALIGN_EPI) { if (wr == 0) PG8_BAR; }
    PG8_BAR;
#undef PG8_KA
#undef PG8_SA
#undef PG8_SB
#undef PG8_STAGE
#undef PG8_LDA
#undef PG8_LDB
#undef PG8_MMA
#undef PG8_WAIT_V
#undef PG8_WAIT_L
#undef PG8_BAR
#undef PG8_SCHED
}
}


namespace att {
typedef short s16x4 __attribute__((ext_vector_type(4)));
typedef float f32x16 __attribute__((ext_vector_type(16)));
constexpr int D = 128, NW = 8, QBLK = 32, KVBLK = 64, QB = NW * QBLK;
constexpr int SHM_V = KVBLK * D * 2, SHM_K = KVBLK * D * 2;
constexpr int ATT_LDS_BYTES = 2 * SHM_V + 2 * SHM_K + NW * 64 * 4;
constexpr float SCALE = 0.08838834764831845f, THR = 8.f;
#define KSWZ(row, colB) ((row) * 256 + ((colB) ^ (((row) & 7) << 4)))
#define SBAR() __builtin_amdgcn_sched_barrier(0)
__device__ __forceinline__ int v_st(int k, int c) { const int kk = (k & ~0xC) | ((k & 4) << 1) | ((k & 8) >> 1); return ((kk >> 3) * 4 + (c >> 5)) * 512 + ((kk & 7) * 32 + (c & 31)) * 2; }
__device__ __forceinline__ int v_rd_base(int lane) { return ((lane & 3) << 3) | (((lane >> 2) & 3) << 6) | (((lane >> 4) & 1) << 5) | (((lane >> 5) & 1) << 8); }
constexpr int v_rd_off(int d0, int ks, int half) { return d0 * 512 + ks * 4096 + half * 2048; }
__device__ __forceinline__ int crow(int r, int hi) { return (r & 3) + 8 * (r >> 2) + 4 * hi; }
__device__ __forceinline__ unsigned cvtpk(float lo, float hi) { unsigned r; asm volatile("v_cvt_pk_bf16_f32 %0, %1, %2" : "=v"(r) : "v"(lo), "v"(hi)); return r; }
__device__ __forceinline__ bf16x8 load8(const bf16_t* p) { return *reinterpret_cast<const bf16x8*>(p); }
__device__ __forceinline__ void mask_tile(f32x16& p0, f32x16& p1, int dq, unsigned W) {
    const float NEG = -__builtin_inff();
#pragma unroll
    for (int r = 0; r < 16; ++r) { const int c = (r & 3) + 8 * (r >> 2);
        if ((unsigned)(dq - c) >= W) p0[r] = NEG;
        if ((unsigned)(dq - c - 32) >= W) p1[r] = NEG; }
}
__device__ __forceinline__ void partialSM(f32x16& p0, f32x16& p1, float& m_reg, float& mn, float& alpha) {
    float pmax = p0[0]; for (int r = 1; r < 16; ++r) pmax = fmaxf(pmax, p0[r]); for (int r = 0; r < 16; ++r) pmax = fmaxf(pmax, p1[r]);
    { auto rr = __builtin_amdgcn_permlane32_swap(__float_as_uint(pmax), __float_as_uint(pmax), false, false);
      pmax = fmaxf(__uint_as_float(rr[0]), __uint_as_float(rr[1])); }
    constexpr float C2 = 1.4426950408889634f * SCALE;
    if (__builtin_expect(__all((pmax - m_reg) * SCALE <= THR), 1)) { mn = m_reg; alpha = 1.f; }
    else { mn = fmaxf(m_reg, pmax); alpha = __builtin_amdgcn_exp2f((m_reg - mn) * C2); m_reg = mn; }
    const float mnL = -mn * C2;
    for (int r = 0; r < 16; ++r) p0[r] = fmaf(p0[r], C2, mnL); for (int r = 0; r < 16; ++r) p1[r] = fmaf(p1[r], C2, mnL);
    for (int r = 0; r < 16; ++r) p0[r] = __builtin_amdgcn_exp2f(p0[r]);
}
__device__ __forceinline__ void finishSM(f32x16& p0, f32x16& p1, float alpha, float& l_reg, bf16x8& pa0, bf16x8& pa1, bf16x8& pa2, bf16x8& pa3) {
    for (int r = 0; r < 16; ++r) p1[r] = __builtin_amdgcn_exp2f(p1[r]);
    float ps = 0; for (int r = 0; r < 16; ++r) ps += p0[r]; for (int r = 0; r < 16; ++r) ps += p1[r];
    { auto rr = __builtin_amdgcn_permlane32_swap(__float_as_uint(ps), __float_as_uint(ps), false, false);
      ps = __uint_as_float(rr[0]) + __uint_as_float(rr[1]); }
    l_reg = l_reg * alpha + ps;
#define PK4(P, B_, OUT) do { unsigned a0 = cvtpk(P[B_+0], P[B_+1]), a1 = cvtpk(P[B_+2], P[B_+3]);                          \
        unsigned b0 = cvtpk(P[B_+4], P[B_+5]), b1 = cvtpk(P[B_+6], P[B_+7]);                                             \
        auto r0 = __builtin_amdgcn_permlane32_swap(a0, b0, false, false); auto r1 = __builtin_amdgcn_permlane32_swap(a1, b1, false, false); \
        u32x4 w = {r0[0], r1[0], r0[1], r1[1]}; OUT = *reinterpret_cast<bf16x8*>(&w); } while (0)
    PK4(p0, 0, pa0); PK4(p0, 8, pa1); PK4(p1, 0, pa2); PK4(p1, 8, pa3);
#undef PK4
}
template <int KB>
__device__ __forceinline__ void qkt(f32x16& p0, f32x16& p1, const char* K_lds, int r32, int hi, const bf16x8* qr, bool act) {
    if (!act) { const float NEG = -__builtin_inff();
#pragma unroll
        for (int r = 0; r < 16; ++r) { p0[r] = NEG; p1[r] = NEG; } return; }
    p0 = f32x16{}; p1 = f32x16{};
    const char* kb[4];
#pragma unroll
    for (int dd = 0; dd < 4; ++dd) kb[dd] = K_lds + KB * SHM_K + KSWZ(r32, (dd * 16 + hi * 8) * 2);
#pragma unroll
    for (int d0 = 0; d0 < 8; ++d0) { const char* a = kb[d0 & 3] + (d0 >> 2) * 128;
        bf16x8 b0 = *reinterpret_cast<const bf16x8*>(a);
        bf16x8 b1 = *reinterpret_cast<const bf16x8*>(a + 32 * 256);
        p0 = __builtin_amdgcn_mfma_f32_32x32x16_bf16(b0, qr[d0], p0, 0, 0, 0);
        p1 = __builtin_amdgcn_mfma_f32_32x32x16_bf16(b1, qr[d0], p1, 0, 0, 0); }
}
template <int VB>
__device__ __forceinline__ void pv_tile(f32x16* o, int vb0, bf16x8 pa0, bf16x8 pa1, bf16x8 pa2, bf16x8 pa3, bool act) {
    if (!act) return;
#define TRRD(dst, off) asm volatile("ds_read_b64_tr_b16 %0, %1 offset:%2" : "=&v"(dst) : "v"(vb0), "i"(off) : "memory")
#define PV_D0(d0) do { s16x4 l0, l1, l2, l3, h0, h1, h2, h3; constexpr int b_ = VB * SHM_V + v_rd_off(d0, 0, 0); \
        TRRD(l0, b_); TRRD(h0, b_ + 2048); TRRD(l1, b_ + 4096); TRRD(h1, b_ + 6144); TRRD(l2, b_ + 8192); TRRD(h2, b_ + 10240); TRRD(l3, b_ + 12288); TRRD(h3, b_ + 14336); \
        asm volatile("s_waitcnt lgkmcnt(0)" ::: "memory"); SBAR();   \
        o[d0] = __builtin_amdgcn_mfma_f32_32x32x16_bf16(pa0, (bf16x8){l0[0], l0[1], l0[2], l0[3], h0[0], h0[1], h0[2], h0[3]}, o[d0], 0, 0, 0);   \
        o[d0] = __builtin_amdgcn_mfma_f32_32x32x16_bf16(pa1, (bf16x8){l1[0], l1[1], l1[2], l1[3], h1[0], h1[1], h1[2], h1[3]}, o[d0], 0, 0, 0);   \
        o[d0] = __builtin_amdgcn_mfma_f32_32x32x16_bf16(pa2, (bf16x8){l2[0], l2[1], l2[2], l2[3], h2[0], h2[1], h2[2], h2[3]}, o[d0], 0, 0, 0);   \
        o[d0] = __builtin_amdgcn_mfma_f32_32x32x16_bf16(pa3, (bf16x8){l3[0], l3[1], l3[2], l3[3], h3[0], h3[1], h3[2], h3[3]}, o[d0], 0, 0, 0); } while (0)
    PV_D0(0); PV_D0(1); PV_D0(2); PV_D0(3);
#undef PV_D0
#undef TRRD
}
struct BlockRef { const bf16_t* Q; const bf16_t* K; const bf16_t* V; bf16_t* O; float* lse; int P0, pq, pk, skv, W, lsep, mode; };
struct Seam { bf16x8 qr[8]; bf16x8 st_v0, st_v1, st_k0, st_k1; };
__device__ __forceinline__ int swa_jlo(int P0, int W) { const int lowk = P0 - W + 1; return lowk > 0 ? lowk / KVBLK : 0; }
#define ROWK(p, k0, rr, pk_) ((const bf16_t*)((const char*)(p) + (size_t)(unsigned)((((unsigned)((k0) + (rr))) * (unsigned)(pk_) + (unsigned)sc) * 2u)))
#define VMW() asm volatile("s_waitcnt vmcnt(0)" ::: "memory")
#define VMWN(n) asm volatile("s_waitcnt vmcnt(%0)" :: "i"(n) : "memory")
#define SLOAD_H(Kp, Vp, k0, pk_) do { S.st_v0 = load8(ROWK(Vp, k0, sr, pk_)); S.st_v1 = load8(ROWK(Vp, k0, 32 + sr, pk_));              \
                         S.st_k0 = load8(ROWK(Kp, k0, sr, pk_)); S.st_k1 = load8(ROWK(Kp, k0, 32 + sr, pk_)); } while (0)
#define SWRITE_HK(bf) do { *(bf16x8*)(K_lds + (bf) * SHM_K + kws) = S.st_k0; *(bf16x8*)(K_lds + (bf) * SHM_K + kws + 32 * 256) = S.st_k1; } while (0)
#define SWRITE_HV(bf) do { *(bf16x8*)(V_lds + (bf) * SHM_V + vst0) = S.st_v0; *(bf16x8*)(V_lds + (bf) * SHM_V + vst1) = S.st_v1; } while (0)
#define SWRITE_H(bf) do { SWRITE_HV(bf); SWRITE_HK(bf); } while (0)
__device__ __forceinline__ void swa_prime(const BlockRef& cur, char* lds, Seam& S, int tid) {
    const int wid = __builtin_amdgcn_readfirstlane(tid >> 6), lane = tid & 63, r32 = lane & 31, hi = lane >> 5;
    const int sr = tid >> 4, sc = (tid & 15) * 8, kws = KSWZ(sr, sc * 2); char* K_lds = lds + 2 * SHM_V;
    const int kb0 = swa_jlo(cur.P0, cur.W) * KVBLK;
    { const unsigned qoff = ((unsigned)(wid * QBLK + r32) * (unsigned)cur.pq + (unsigned)hi * 8u) * 2u;
      for (int d0 = 0; d0 < 8; ++d0) S.qr[d0] = *(const bf16x8*)((const char*)cur.Q + (size_t)qoff + d0 * 32); }
    SLOAD_H(cur.K, cur.V, kb0, cur.pk); VMW(); SWRITE_HK(0);
    __syncthreads();
}
__device__ __forceinline__ void swa_block(const BlockRef& cur, const BlockRef& nxt, char* lds, Seam& S, int tid) {
    const int wid = __builtin_amdgcn_readfirstlane(tid >> 6), lane = tid & 63, r32 = lane & 31, hi = lane >> 5;
    const int W = cur.W, pk = cur.pk;
    const int j_lo = swa_jlo(cur.P0, W);
    int j_hi = (cur.P0 + QB - 1) / KVBLK + 1; if (j_hi > cur.skv / KVBLK) j_hi = cur.skv / KVBLK;
    const int NT = j_hi - j_lo;
    const int kbn = swa_jlo(nxt.P0, nxt.W) * KVBLK;
    const int qlo = cur.P0 + wid * QBLK, qm = qlo + r32 - 4 * hi;
    char* V_lds = lds; char* K_lds = lds + 2 * SHM_V;
    float* ws = (float*)(lds + 2 * SHM_V + 2 * SHM_K) + wid * 64; float* li_l = ws, * al_l = ws + 32;
    float m_reg = -1e30f, l_reg = 0; f32x16 o[4] = {};
    const int sr = tid >> 4, sc = (tid & 15) * 8, vst0 = v_st(sr, sc), vst1 = v_st(32 + sr, sc), kws = KSWZ(sr, sc * 2);
    const int vb0 = (int)(uintptr_t)V_lds + v_rd_base(lane);
    const bf16_t* Kh = cur.K; const bf16_t* Vh = cur.V;
#define RESC(a) do { if (__any((a) < 1.f)) { if (hi == 0) al_l[r32] = (a); asm volatile("s_waitcnt lgkmcnt(0)" ::: "memory");              \
                     for (int d_ = 0; d_ < 4; ++d_) for (int r = 0; r < 16; ++r) o[d_][r] *= al_l[crow(r, hi)]; } } while (0)
#define KBASE(t) ((j_lo + (t)) * KVBLK)
#define ACT(t) (KBASE(t) <= qlo + QBLK - 1 && KBASE(t) + KVBLK - 1 >= qlo - W + 1)
#define MASKT(P0_, P1_, t) do { const int kb_ = KBASE(t); if (ACT(t) && (kb_ + KVBLK - 1 > qlo || kb_ <= qlo + QBLK - 1 - W)) mask_tile(P0_, P1_, qm - kb_, (unsigned)W); } while (0)
    constexpr int NQL = 8;
#define SEAM_K0() do { VMWN(NQL); SWRITE_HK(0); SBAR(); } while (0)
    f32x16 pA0, pA1, pB0, pB1; float mnA, mnB, alA, alB; bf16x8 pa0, pa1, pa2, pa3;
    SWRITE_HV(0); SBAR();
    if (NT > 1) { SLOAD_H(Kh, Vh, KBASE(1), pk); }
    SBAR(); qkt<0>(pA0, pA1, K_lds, r32, hi, S.qr, ACT(0));
    MASKT(pA0, pA1, 0); partialSM(pA0, pA1, m_reg, mnA, alA);
    if (NT > 1) { VMW(); SWRITE_H(1); }
    __syncthreads();
#define HALF_STEP(PX0, PX1, mnX, alX, PY0, PY1, alY, t, KB, VB, SB) do {                                                      \
        SBAR(); if ((t) + 1 < NT) { SLOAD_H(Kh, Vh, KBASE((t) + 1), pk); SBAR(); }                               \
        qkt<KB>(PX0, PX1, K_lds, r32, hi, S.qr, ACT(t));                                             \
        finishSM(PY0, PY1, alY, l_reg, pa0, pa1, pa2, pa3); SBAR();                                                           \
        pv_tile<VB>(o, vb0, pa0, pa1, pa2, pa3, ACT((t) - 1)); MASKT(PX0, PX1, (t)); partialSM(PX0, PX1, m_reg, mnX, alX);                                        \
        __syncthreads();                                                                                                      \
        if ((t) + 1 < NT) { VMW(); SWRITE_H(SB); }                                                                          \
        RESC(alX); __syncthreads(); } while (0)
    for (int t = 1; t + 1 < NT; t += 2) {
        HALF_STEP(pB0, pB1, mnB, alB, pA0, pA1, alA, t, 1, 0, 0);
        HALF_STEP(pA0, pA1, mnA, alA, pB0, pB1, alB, t + 1, 0, 1, 1);
    }
    const bool even = (NT & 1) == 0;
    if (even) { SBAR(); qkt<1>(pB0, pB1, K_lds, r32, hi, S.qr, ACT(NT - 1)); SBAR(); }
    { SLOAD_H(nxt.K, nxt.V, kbn, nxt.pk); SBAR();
        const unsigned qoff = ((unsigned)(wid * QBLK + r32) * (unsigned)nxt.pq + (unsigned)hi * 8u) * 2u;
#pragma unroll
        for (int d0 = 0; d0 < 8; ++d0) S.qr[d0] = *(const bf16x8*)((const char*)nxt.Q + (size_t)qoff + d0 * 32); }
    SBAR();
    finishSM(pA0, pA1, alA, l_reg, pa0, pa1, pa2, pa3); SBAR();
    pv_tile<0>(o, vb0, pa0, pa1, pa2, pa3, ACT(even ? NT - 2 : NT - 1));
    if (even) { MASKT(pB0, pB1, NT - 1); partialSM(pB0, pB1, m_reg, mnB, alB); __syncthreads(); RESC(alB);
        finishSM(pB0, pB1, alB, l_reg, pa0, pa1, pa2, pa3); SBAR(); pv_tile<1>(o, vb0, pa0, pa1, pa2, pa3, ACT(NT - 1)); }
    SBAR(); SEAM_K0();
    if (hi == 0) li_l[r32] = l_reg; asm volatile("s_waitcnt lgkmcnt(0)" ::: "memory");
    float rli[16];
#pragma unroll
    for (int r = 0; r < 16; ++r) rli[r] = __builtin_amdgcn_rcpf(li_l[crow(r, hi)]);
    int r32e = r32, hie = hi, lne = lane; asm volatile("" : "+v"(r32e), "+v"(hie), "+v"(lne));
    bf16_t* Ow = cur.O + (size_t)(wid * QBLK) * cur.pq;
    const unsigned pqu = (unsigned)cur.pq;
    if (cur.mode == 2) {
        float sink = 0.f;
#pragma unroll
        for (int r = 0; r < 16; ++r)
#pragma unroll
            for (int d0 = 0; d0 < 4; ++d0) sink += o[d0][r] * rli[r];
        asm volatile("" :: "v"(sink), "v"(m_reg));
    } else {
        if (cur.mode == 0 && hie == 0) cur.lse[(size_t)(wid * QBLK + r32e) * cur.lsep] = m_reg * SCALE + __logf(l_reg);
        char* stg = lds + ATT_LDS_BYTES + wid * (32 * 144);
        const unsigned goff = ((unsigned)(lne >> 3) * pqu + (unsigned)(lne & 7) * 8u) * 2u;
#pragma unroll
        for (int h2 = 0; h2 < 2; ++h2) {
#pragma unroll
            for (int r = 0; r < 16; ++r) { const int orow = (r & 3) + 8 * (r >> 2) + 4 * hie;
#pragma unroll
                for (int dd = 0; dd < 2; ++dd) *(bf16_t*)(stg + orow * 144 + (dd * 32 + r32e) * 2) = (bf16_t)(cvtpk(o[2 * h2 + dd][r] * rli[r], 0.f) & 0xffffu); }
            u32x4 ov[4], zv[4];
#pragma unroll
            for (int j = 0; j < 4; ++j) ov[j] = *(const u32x4*)(stg + (j * 8 + (lne >> 3)) * 144 + (lne & 7) * 16);
            char* gp = (char*)Ow + (size_t)goff + h2 * 128;
            if (cur.mode == 1) {
#pragma unroll
                for (int j = 0; j < 4; ++j) zv[j] = *(const u32x4*)(gp + (size_t)(j * 8) * pqu * 2u);
#pragma unroll
                for (int j = 0; j < 4; ++j)
#pragma unroll
                    for (int e = 0; e < 4; ++e) ov[j][e] = cvtpk(__uint_as_float(ov[j][e] << 16) * silu(__uint_as_float(zv[j][e] << 16)), __uint_as_float(ov[j][e] & 0xffff0000u) * silu(__uint_as_float(zv[j][e] & 0xffff0000u)));
            }
#pragma unroll
            for (int j = 0; j < 4; ++j) *(u32x4*)(gp + (size_t)(j * 8) * pqu * 2u) = ov[j];
        }
    }
    __syncthreads();
#undef RESC
#undef KBASE
#undef ACT
#undef MASKT
#undef SEAM_K0
#undef HALF_STEP
}
#undef ROWK
#undef VMW
#undef VMWN
#undef SLOAD_H
#undef SWRITE_HK
#undef SWRITE_HV
#undef SWRITE_H
#undef KSWZ
#undef SBAR
}

typedef GAS unsigned gu32;
#define RLX_AGENT __ATOMIC_RELAXED, __HIP_MEMORY_SCOPE_AGENT
#define XB_TMO      128
#define XB_XCNT(j)  (256  + 64 * (j))
#define XB_XSUB(j)  (1280 + 64 * (j))
#define XB_XGEN(j)  (2304 + 64 * (j))
#define XB_TOP      3328
#define XB_TOPGEN   3392
#define XCD_BAR_WORDS 3456
#define XB_SPIN_CAP (1u << 18)
__device__ __forceinline__ unsigned xb_ld(unsigned* p)              { return __hip_atomic_load(p, __ATOMIC_RELAXED, __HIP_MEMORY_SCOPE_AGENT); }
__device__ __forceinline__ unsigned xb_add(unsigned* p, unsigned v) { return __hip_atomic_fetch_add(p, v, __ATOMIC_RELAXED, __HIP_MEMORY_SCOPE_AGENT); }
__device__ __forceinline__ unsigned xb_xcc_id() { return (unsigned)__builtin_amdgcn_s_getreg((3 << 11) | 20) & 0xFu; }
#define XB_SPIN(cond, bar) do { unsigned _sp = 0; while (cond) { __builtin_amdgcn_s_sleep(1); \
    if ((++_sp & 255u) == 0u) { if (xb_ld(&(bar)[XB_TMO])) break; if (_sp > XB_SPIN_CAP) { atomicAdd(&(bar)[XB_TMO], 1u); break; } } } } while (0)
struct XcdBarrier { unsigned* bar; unsigned x; volatile LAS unsigned* st; };
__device__ __forceinline__ XcdBarrier xcd_barrier_post(unsigned* bar, volatile LAS unsigned* st, int tid) {
    XcdBarrier b; b.bar = bar; b.x = xb_xcc_id(); b.st = st;
    if (tid == 0) (void)xb_add(&bar[XB_XCNT(b.x)], 1u);
    return b;
}
__device__ __forceinline__ void xcd_barrier_complete(unsigned* bar, unsigned x, unsigned& nloc, unsigned& nx) {
    const unsigned G = gridDim.x * gridDim.y * gridDim.z;
    unsigned sum, cnt, mine, sp = 0u;
    for (;;) {
        sum = 0u; cnt = 0u; mine = 0u;
#pragma unroll
        for (unsigned j = 0; j < 16; ++j) { const unsigned c = xb_ld(&bar[XB_XCNT(j)]); sum += c; cnt += (c > 0u) ? 1u : 0u; mine = (j == x) ? c : mine; }
        if (sum == G) break;
        __builtin_amdgcn_s_sleep(1);
        if ((++sp & 255u) == 0u) { if (xb_ld(&bar[XB_TMO])) break; if (sp > XB_SPIN_CAP) { atomicAdd(&bar[XB_TMO], 1u); break; } }
    }
    nloc = mine > 0u ? mine : 1u; nx = cnt > 0u ? cnt : 1u;
}
__device__ __forceinline__ void xcd_barrier(const XcdBarrier& b, int tid) {
    asm volatile("s_waitcnt vmcnt(0)" ::: "memory");
    __syncthreads();
    if (tid == 0) {
        unsigned* bar = b.bar;
        __builtin_amdgcn_s_waitcnt(0);
        unsigned nloc = b.st[0], nx = b.st[1];
        if (nloc == 0u) { xcd_barrier_complete(bar, b.x, nloc, nx); b.st[0] = nloc; b.st[1] = nx; }
        const unsigned old = xb_add(&bar[XB_XSUB(b.x)], 1u);
        const unsigned gen = old / nloc;
        if (old + 1u == (gen + 1u) * nloc) {
            __builtin_amdgcn_fence(__ATOMIC_RELEASE, "agent");
            asm volatile("s_waitcnt vmcnt(0)" ::: "memory");
            const unsigned og = xb_add(&bar[XB_TOP], 1u);
            const unsigned tg = og / nx;
            if (og + 1u == (tg + 1u) * nx) xb_add(&bar[XB_TOPGEN], 1u);
            else XB_SPIN(xb_ld(&bar[XB_TOPGEN]) == tg, bar);
            __builtin_amdgcn_fence(__ATOMIC_ACQUIRE, "agent");
            xb_add(&bar[XB_XGEN(b.x)], 1u);
            asm volatile("s_waitcnt vmcnt(0)" ::: "memory");
        } else {
            XB_SPIN(xb_ld(&bar[XB_XGEN(b.x)]) == gen, bar);
            __builtin_amdgcn_fence(__ATOMIC_ACQUIRE, "agent");
            asm volatile("s_waitcnt vmcnt(0)" ::: "memory");
        }
    }
    __syncthreads();
}

__device__ __forceinline__ int lane_id_opaque() { int l; asm volatile("v_mbcnt_lo_u32_b32 %0, -1, 0\n\tv_mbcnt_hi_u32_b32 %0, -1, %0" : "=v"(l)); return l; }
__device__ __forceinline__ void stagger_wait(unsigned ticks) {
    int bx = blockIdx.x; asm volatile("" : "+s"(bx));
    if ((bx >> 3) & 1) { const unsigned long long t0 = __builtin_amdgcn_s_memrealtime(); while (__builtin_amdgcn_s_memrealtime() - t0 < ticks) __builtin_amdgcn_s_sleep(16); }
}
struct Frame {
    LAS unsigned char* lds;
    int tid, lane, wave, vcu, G;
};

__device__ __forceinline__ void transpose_item(const float* __restrict__ W, int K, int N, bf16_t* WT, int row_off, const float* __restrict__ g, LAS float* scr, int item, int lane, bool dry = false,
                                               const float* __restrict__ wpool = nullptr, const float* __restrict__ pscale = nullptr) {
    const int nblk = N / 32, kb = item / nblk, nb = item % nblk, k0 = 64 * kb, n0 = 32 * nb;
    if (wpool && n0 >= E_XB && n0 < E_XB + 512) return;
    { const int kr = lane >> 3, nq = lane & 7; f32x4 v[8]; float gv[8];
#pragma unroll
      for (int i = 0; i < 8; ++i) { v[i] = *(const f32x4*)(W + (size_t)(k0 + 8 * i + kr) * N + n0 + 4 * nq); gv[i] = g ? g[k0 + 8 * i + kr] : 1.f; }
#pragma unroll
      for (int i = 0; i < 8; ++i)
#pragma unroll
          for (int e = 0; e < 4; ++e) scr[(8 * i + kr) * 33 + 4 * nq + e] = v[i][e] * gv[i]; }
    asm volatile("s_waitcnt lgkmcnt(0)" ::: "memory");
    const int c = lane & 7;
#pragma unroll
    for (int j = 0; j < 4; ++j) { const int n = (lane >> 3) + 8 * j; const LAS float* s = scr + (8 * c) * 33 + n;
        u32x4 o; o.x = pk2(s[0 * 33], s[1 * 33]); o.y = pk2(s[2 * 33], s[3 * 33]); o.z = pk2(s[4 * 33], s[5 * 33]); o.w = pk2(s[6 * 33], s[7 * 33]);
        if (!dry) *(u32x4*)(WT + (size_t)(row_off + n0 + n) * K + k0 + 8 * c) = o; }
    asm volatile("s_waitcnt lgkmcnt(0)" ::: "memory");
}
__device__ __forceinline__ void fold_tile(const float* __restrict__ W, bf16_t* WT, const float* __restrict__ g, const float* __restrict__ wpool, const float* __restrict__ pscale, int item, int lane, bool dry) {
    const int kb = item >> 5, nb = item & 31, k0 = 16 * kb, nn0 = 16 * nb, gi = nn0 >> 7, d0 = nn0 & 127, fr = lane & 15, fq = lane >> 4;
    const float* ap = W + (size_t)(k0 + fr) * EP + E_XB + gi * 128 + fq;
    const float* bp = wpool + (size_t)gi * 128 * 128 + (size_t)fq * 128 + d0 + fr;
    float av[32], bv[32];
#pragma unroll
    for (int ks = 0; ks < 32; ++ks) { av[ks] = ap[4 * ks]; bv[ks] = bp[(size_t)4 * ks * 128]; }
    f32x4 acc = {0.f, 0.f, 0.f, 0.f};
#pragma unroll
    for (int ks = 0; ks < 32; ++ks) acc = __builtin_amdgcn_mfma_f32_16x16x4f32(av[ks], bv[ks], acc, 0, 0, 0);
    const float ps = pscale[gi * 128 + d0 + fr]; const f32x4 gk = *(const f32x4*)(g + k0 + 4 * fq);
    u32x2 o; o.x = pk2(acc[0] * ps * gk[0], acc[1] * ps * gk[1]); o.y = pk2(acc[2] * ps * gk[2], acc[3] * ps * gk[3]);
    if (!dry) *(u32x2*)(WT + (size_t)(E_XB + nn0 + fr) * DM + k0 + 4 * fq) = o;
}
__device__ __forceinline__ void convert_weight(const Frame& F, int gw, int NGW, const float* W, int K, int N, bf16_t* WT, int row_off, const float* g, bool dry = false, const float* wpool = nullptr, const float* pscale = nullptr) {
    LAS float* scr = (LAS float*)(F.lds + F.wave * 16384);
    const int nitems = (K / 64) * (N / 32);
    for (int it = gw; it < nitems; it += NGW) transpose_item(W, K, N, WT, row_off, g, scr, it, F.lane, dry, wpool, pscale);
    if (wpool) for (int it = gw; it < (DM / 16) * 32; it += NGW) fold_tile(W, WT, g, wpool, pscale, it, F.lane, dry);
}

__device__ __forceinline__ att::BlockRef att_item(int L, bool even, bf16_t* proj, const bf16_t* mkv, float* lse, bool dry) {
    att::BlockRef r;
    const int xq = (L & 255) >> 5, jj = L & 31, rd = L >> 8;
    if (even && L < 1536) {
        const int idx = rd * 32 + jj, pair = xq * 4 + idx / 48, kk = idx % 48, g = kk >> 4, x = kk & 15, b = pair >> 2, h = pair & 3;
        const int dsh = 2 * g, dil = 1 << dsh, nqb = 16 >> dsh, rr = x >> (4 - dsh), qb = x & (nqb - 1);
        const size_t tok0 = (size_t)b * SEQ + rr, q0 = tok0 + (size_t)qb * 256 * dil;
        r.Q = pcol(proj, g * 1024 + h * 128) + q0 * PR; r.O = pcol(proj, g * 1024 + h * 128) + q0 * PR;
        r.K = pcol(proj, g * 1024 + 512 + h * 128) + tok0 * PR; r.V = pcol(proj, E_VA + h * 128) + tok0 * PR;
        r.P0 = qb * 256; r.pq = dil * PR; r.pk = dil * PR; r.skv = SEQ >> dsh; r.W = 129; r.mode = 0;
        r.lse = lse + ((size_t)g * NT + tok0 + (size_t)qb * 256 * dil) * 4 + h; r.lsep = dil * 4;
    } else {
        const int idx2 = (even ? rd - 6 : rd) * 32 + jj, pair = xq * 4 + (idx2 >> 4), qb = idx2 & 15, b = pair >> 2, h = pair & 3;
        const int qcol = even ? E_QM : O_QM, zcol = (even ? E_Z : O_Z) + 1024;
        const size_t row0 = (size_t)b * SEQ + qb * 256;
        r.Q = pcol(proj, qcol + h * 128) + row0 * PR; r.O = pcol(proj, zcol + h * 128) + row0 * PR;
        r.K = mkv + (size_t)(b * NMEM) * 4096 + h * 128; r.V = r.K + 512;
        r.P0 = 256; r.pq = PR; r.pk = 4096; r.skv = 256; r.W = 1 << 20; r.mode = 1; r.lse = nullptr; r.lsep = 0;
    }
    if (dry) r.mode = 2;
    return r;
}
__device__ __forceinline__ void attn_phase(char* lds, int vcu, int G, bool even, bf16_t* proj, const bf16_t* mkv, float* lse, int tid_in, bool dry = false, int lo = 0, int hi = 1 << 30) {
    int tid = tid_in; asm volatile("" : "+v"(tid));
    const int total = (even ? 2048 : 512) < hi ? (even ? 2048 : 512) : hi;
    int L = vcu + lo; if (L >= total) return;
    att::BlockRef cur = att_item(L, even, proj, mkv, lse, dry);
    att::Seam S;
    att::swa_prime(cur, lds, S, tid);
    for (;;) {
        const int Ln = L + G; const bool last = Ln >= total;
        const att::BlockRef nxt = last ? cur : att_item(Ln, even, proj, mkv, lse, dry);
        att::swa_block(cur, nxt, lds, S, tid);
        if (last) break;
        cur = nxt; L = Ln;
    }
}
__device__ __forceinline__ void combine_phase(const Frame& F, bf16_t* proj, const float* __restrict__ lse, bool dry = false) {
    const int lane = F.lane, h = lane >> 4, dc = (lane & 15) * 8, NGW = F.G * NWAVES;
    for (int tok0 = (F.vcu * NWAVES + F.wave) * 4; tok0 < NT; tok0 += NGW * 4) {
        u32x4 o0[4], o1[4], o2[4], zz[4]; float w0[4], w1[4], w2[4];
#pragma unroll
        for (int q = 0; q < 4; ++q) { const size_t tok = tok0 + q; const int cc = h * 128 + dc;
            w0[q] = lse[((size_t)0 * NT + tok) * 4 + h]; w1[q] = lse[((size_t)1 * NT + tok) * 4 + h]; w2[q] = lse[((size_t)2 * NT + tok) * 4 + h];
            o0[q] = *(const u32x4*)(pcol(proj, cc) + tok * PR); o1[q] = *(const u32x4*)(pcol(proj, 1024 + cc) + tok * PR); o2[q] = *(const u32x4*)(pcol(proj, 2048 + cc) + tok * PR); zz[q] = *(const u32x4*)(pcol(proj, E_Z + cc) + tok * PR); }
#pragma unroll
        for (int q = 0; q < 4; ++q) { const size_t tok = tok0 + q; bf16_t* zrow = pcol(proj, E_Z + h * 128 + dc) + tok * PR;
            const float M = fmaxf(w0[q], fmaxf(w1[q], w2[q])); float a0 = __expf(w0[q] - M), a1 = __expf(w1[q] - M), a2 = __expf(w2[q] - M);
            const float inv = 1.f / (a0 + a1 + a2); a0 *= inv; a1 *= inv; a2 *= inv;
            u32x4 y;
#pragma unroll
            for (int j = 0; j < 4; ++j) {
                const float a = a0 * __uint_as_float(o0[q][j] << 16) + a1 * __uint_as_float(o1[q][j] << 16) + a2 * __uint_as_float(o2[q][j] << 16);
                const float b = a0 * __uint_as_float(o0[q][j] & 0xffff0000u) + a1 * __uint_as_float(o1[q][j] & 0xffff0000u) + a2 * __uint_as_float(o2[q][j] & 0xffff0000u);
                y[j] = pk2(a * silu(__uint_as_float(zz[q][j] << 16)), b * silu(__uint_as_float(zz[q][j] & 0xffff0000u))); }
            if (!dry) *(u32x4*)zrow = y; }
    }
}
__device__ __forceinline__ void pool_phase(const Frame& F, bf16_t* proj, bool dry = false) {
    const int lane = F.lane, gi = lane >> 4, w = 2 << gi, NGW = F.G * NWAVES;
    for (int run = F.vcu * NWAVES + F.wave; run < NT / 16; run += NGW) {
        const int t0 = run * 16, p0 = t0 % SEQ;
        const bf16_t* xc = pcol(proj, E_XB + lane * 8) + (size_t)t0 * PR; bf16_t* zc = pcol(proj, E_Z + 512 + lane * 8) + (size_t)t0 * PR;
        float sum[8];
#pragma unroll
        for (int e = 0; e < 8; ++e) sum[e] = 0.f;
        { u32x4 h[16];
#pragma unroll
          for (int j = 1; j <= 16; ++j) h[j - 1] = (j <= w && p0 - j >= 0) ? *(const u32x4*)(xc - (long)j * PR) : (u32x4){0u, 0u, 0u, 0u};
#pragma unroll
          for (int j = 0; j < 16; ++j)
#pragma unroll
              for (int e = 0; e < 4; ++e) { sum[2 * e] += __uint_as_float(h[j][e] << 16); sum[2 * e + 1] += __uint_as_float(h[j][e] & 0xffff0000u); } }
#pragma unroll
        for (int bt = 0; bt < 16; bt += 8) { u32x4 xa[8], xs[8], zz[8];
#pragma unroll
            for (int i = 0; i < 8; ++i) { const int p = p0 + bt + i;
                xa[i] = *(const u32x4*)(xc + (long)(bt + i) * PR); zz[i] = *(const u32x4*)(zc + (long)(bt + i) * PR);
                xs[i] = (p >= w) ? *(const u32x4*)(xc + (long)(bt + i - w) * PR) : (u32x4){0u, 0u, 0u, 0u}; }
#pragma unroll
            for (int i = 0; i < 8; ++i) { const int p = p0 + bt + i; const float ic = 1.f / (float)((p + 1 < w) ? p + 1 : w); u32x4 y;
#pragma unroll
                for (int e = 0; e < 4; ++e) { const float x0 = __uint_as_float(xa[i][e] << 16), x1 = __uint_as_float(xa[i][e] & 0xffff0000u);
                    sum[2 * e] += x0 - __uint_as_float(xs[i][e] << 16); sum[2 * e + 1] += x1 - __uint_as_float(xs[i][e] & 0xffff0000u);
                    y[e] = pk2((sum[2 * e] * ic - x0) * silu(__uint_as_float(zz[i][e] << 16)), (sum[2 * e + 1] * ic - x1) * silu(__uint_as_float(zz[i][e] & 0xffff0000u))); }
                if (!dry) *(u32x4*)(zc + (long)(bt + i) * PR) = y; } }
    }
}
__device__ __forceinline__ void cmix_phase(const Frame& F, bf16_t* proj, const float* __restrict__ ln_g, const float* __restrict__ ln_b,
                                           const bf16_t* __restrict__ wsm  , const float* __restrict__ b_s, const float2* __restrict__ lnp, bool dry = false) {
    const int tid = F.tid, lane = F.lane, wv = F.wave, fr = lane & 15, fq = lane >> 4;
    LAS unsigned char* VT = F.lds; LAS float* mu = (LAS float*)(F.lds + 128 * 272); LAS float* rstd = mu + 128;
    for (int ch = F.vcu; ch < NT / 128; ch += F.G) {
        const size_t row0 = (size_t)ch * 128;
        { const int row = tid >> 2, part = tid & 3; const f32x4* pp = (const f32x4*)(lnp + (row0 + row) * 16 + part * 4);
          const f32x4 a = pp[0], b = pp[1]; float s1 = (a[0] + a[2]) + (b[0] + b[2]), s2 = (a[1] + a[3]) + (b[1] + b[3]);
          s1 += __shfl_xor(s1, 1); s1 += __shfl_xor(s1, 2); s2 += __shfl_xor(s2, 1); s2 += __shfl_xor(s2, 2);
          const float m = s1 * (1.f / 1024.f), var = fmaxf(s2 * (1.f / 1024.f) - m * m, 0.f);
          if (part == 0) { mu[row] = m; rstd[row] = rsqrtf(var + EPS); } }
        const int sI = tid >> 2, cq = tid & 3;
        const size_t vro = (row0 + sI) * PR + cq * 8;
        const size_t tro = (row0 + wv * 16 + (lane >> 4)) * PR + (lane & 15) * 8;
        LAS unsigned char* stg = F.lds + 36864 + wv * (16 * 528);
        u32x4 vq[4];
#pragma unroll
        for (int k = 0; k < 4; ++k) vq[k] = *(const u32x4*)(pcol(proj, O_V + k * 32) + vro);
        __syncthreads();
        const float m_s = mu[sI], r_s = rstd[sI];
        for (int g = 0; g < 8; ++g) {
            u32x4 uq[4], zq[4];
#pragma unroll
            for (int j = 0; j < 4; ++j) { uq[j] = *(const u32x4*)(pcol(proj, O_U + g * 128) + tro + (size_t)(4 * j) * PR); zq[j] = *(const u32x4*)(pcol(proj, O_Z + g * 128) + tro + (size_t)(4 * j) * PR); }
            const float bs = b_s[g * 128 + wv * 16 + fr];
#pragma unroll
            for (int k = 0; k < 4; ++k) { const int c0 = k * 32 + cq * 8; const f32x4 g0 = *(const f32x4*)(ln_g + g * 128 + c0), g1 = *(const f32x4*)(ln_g + g * 128 + c0 + 4), b0 = *(const f32x4*)(ln_b + g * 128 + c0), b1 = *(const f32x4*)(ln_b + g * 128 + c0 + 4);
#pragma unroll
                for (int j = 0; j < 4; ++j) { const float gg0 = (j < 2) ? g0[2 * j] : g1[2 * j - 4], gg1 = (j < 2) ? g0[2 * j + 1] : g1[2 * j - 3], bb0 = (j < 2) ? b0[2 * j] : b1[2 * j - 4], bb1 = (j < 2) ? b0[2 * j + 1] : b1[2 * j - 3];
                    const float v0 = (__uint_as_float(vq[k][j] << 16) - m_s) * r_s * gg0 + bb0, v1 = (__uint_as_float(vq[k][j] & 0xffff0000u) - m_s) * r_s * gg1 + bb1;
                    *(LAS bf16_t*)(VT + (c0 + 2 * j) * 272 + sI * 2) = (bf16_t)f2bf(v0); *(LAS bf16_t*)(VT + (c0 + 2 * j + 1) * 272 + sI * 2) = (bf16_t)f2bf(v1); } }
            __syncthreads();
            if (g < 7) {
#pragma unroll
                for (int k = 0; k < 4; ++k) vq[k] = *(const u32x4*)(pcol(proj, O_V + (g + 1) * 128 + k * 32) + vro); }
            f32x4 acc[8];
#pragma unroll
            for (int n = 0; n < 8; ++n) acc[n] = (f32x4){0.f, 0.f, 0.f, 0.f};
            const int ksmax = wv >> 1;
            for (int ks = 0; ks <= ksmax; ++ks) {
                const bf16x8 b = *(const bf16x8*)(wsm + ((size_t)g * 128 + wv * 16 + fr) * 128 + ks * 32 + 8 * fq);
#pragma unroll
                for (int mt = 0; mt < 8; ++mt) { const bf16x8 a = *(const LAS bf16x8*)(VT + (mt * 16 + fr) * 272 + (ks * 32 + 8 * fq) * 2);
                    acc[mt] = __builtin_amdgcn_mfma_f32_16x16x32_bf16(a, b, acc[mt], 0, 0, 0); } }
#pragma unroll
            for (int mt = 0; mt < 8; ++mt) *(LAS f32x4*)(stg + fr * 528 + (mt * 16 + 4 * fq) * 4) = acc[mt] + bs;
#pragma unroll
            for (int j = 0; j < 4; ++j) { const LAS f32x4* mp = (const LAS f32x4*)(stg + (4 * j + (lane >> 4)) * 528 + (lane & 15) * 32); const f32x4 m0 = mp[0], m1 = mp[1]; u32x4 y;
                y.x = pk2(__uint_as_float(uq[j].x << 16) * m0[0] * silu(__uint_as_float(zq[j].x << 16)), __uint_as_float(uq[j].x & 0xffff0000u) * m0[1] * silu(__uint_as_float(zq[j].x & 0xffff0000u)));
                y.y = pk2(__uint_as_float(uq[j].y << 16) * m0[2] * silu(__uint_as_float(zq[j].y << 16)), __uint_as_float(uq[j].y & 0xffff0000u) * m0[3] * silu(__uint_as_float(zq[j].y & 0xffff0000u)));
                y.z = pk2(__uint_as_float(uq[j].z << 16) * m1[0] * silu(__uint_as_float(zq[j].z << 16)), __uint_as_float(uq[j].z & 0xffff0000u) * m1[1] * silu(__uint_as_float(zq[j].z & 0xffff0000u)));
                y.w = pk2(__uint_as_float(uq[j].w << 16) * m1[2] * silu(__uint_as_float(zq[j].w << 16)), __uint_as_float(uq[j].w & 0xffff0000u) * m1[3] * silu(__uint_as_float(zq[j].w & 0xffff0000u)));
                if (!dry) *(u32x4*)(pcol(proj, O_Z + g * 128) + tro + (size_t)(4 * j) * PR) = y; }
            __syncthreads();
        }
    }
}

struct Args { const void* in[19]; float* out; unsigned char* ws; };
__global__ void __launch_bounds__(NTHREADS, 2) mega_fwd(Args args) {
    extern __shared__ __attribute__((aligned(16))) unsigned char lds_raw[];
    Frame F;
    F.lds = (LAS unsigned char*)lds_raw;
    const int wave_s = __builtin_amdgcn_readfirstlane((int)threadIdx.x >> 6);
#define TID() (wave_s * 64 + lane_id_opaque())
    F.tid = TID(); F.lane = F.tid & 63; F.wave = wave_s;
    F.G = gridDim.x; { const int bx = blockIdx.x; F.vcu = (F.G % 8 == 0) ? (bx % 8) * (F.G / 8) + bx / 8 : bx; }
    volatile LAS unsigned* MISC = (volatile LAS unsigned*)(F.lds + MISC_OFF);
    unsigned char* ws = args.ws;
    for (int u = F.tid; u < (LDS_BYTES - LDSCTL_OFF) / 4; u += NTHREADS) ((LAS unsigned*)(F.lds + LDSCTL_OFF))[u] = 0u;
    __syncthreads();
    XcdBarrier bar = xcd_barrier_post((unsigned*)(ws + OFF_CTL) + CW_BAR, MISC + 8, F.tid);
#define GRID_BAR() xcd_barrier(bar, TID())
#define REFRESH() do { int t_ = TID(); asm volatile("" : "+v"(t_)); F.tid = t_; F.lane = t_ & 63; F.wave = wave_s; } while (0)

    const float* x = (const float*)args.in[0]; const float* mem = (const float*)args.in[1]; const int* pos = (const int*)args.in[2]; const float* g_mem = (const float*)args.in[3];
    const float* e_ng = (const float*)args.in[4]; const float* e_win = (const float*)args.in[5]; const float* e_wpool = (const float*)args.in[6]; const float* e_pscale = (const float*)args.in[7];
    const float* e_wmkv = (const float*)args.in[8]; const float* e_wout = (const float*)args.in[9];
    const float* o_ng = (const float*)args.in[10]; const float* o_win = (const float*)args.in[11]; const float* o_lng = (const float*)args.in[12]; const float* o_lnb = (const float*)args.in[13];
    const float* o_ws = (const float*)args.in[14]; const float* o_bs = (const float*)args.in[15]; const float* o_wmkv = (const float*)args.in[16]; const float* o_wout = (const float*)args.in[17];
    const float* f_g = (const float*)args.in[18];
    float* out = args.out;
    bf16_t* proj = (bf16_t*)(ws + OFF_PROJ); bf16_t* xb = (bf16_t*)(ws + OFF_XB); bf16_t* win = (bf16_t*)((unsigned char*)args.out + DO_WIN); bf16_t* wout = (bf16_t*)((unsigned char*)args.out + DO_WOUT);
    bf16_t* memkv = (bf16_t*)(ws + OFF_MEMKV); float* rowss = (float*)(ws + OFF_ROWSS); float2* rope = (float2*)(ws + OFF_ROPE); float* lse = (float*)(ws + OFF_LSE); float2* lnp = (float2*)(ws + OFF_LNP); bf16_t* wpT = (bf16_t*)(ws + OFF_WPT); bf16_t* wsm = (bf16_t*)(ws + OFF_WSM);
    bf16_t* memn = (bf16_t*)((unsigned char*)args.out + DO_MEMN); bf16_t* wmkv = (bf16_t*)((unsigned char*)args.out + DO_WMKV);
    const int NGW = F.G * NWAVES;
    { const int gw = F.vcu * NWAVES + F.wave, lane = F.lane;

#define CONVERT_LAYER(l_, gw_, ngw_) do { const int i_ = (l_) >> 1;        \
        if ((l_) & 1) convert_weight(F, gw_, ngw_, o_win + (size_t)i_ * DM * OP, DM, OP, win + (size_t)(i_ * 20 + 12) * (MiB / 2), 0, o_ng + i_ * DM); \
        else          convert_weight(F, gw_, ngw_, e_win + (size_t)i_ * DM * EP, DM, EP, win + (size_t)(i_ * 20) * (MiB / 2), 0, e_ng + i_ * DM, false, e_wpool + (size_t)i_ * 4 * 128 * 128, e_pscale + i_ * 512); \
        convert_weight(F, gw_, ngw_, (((l_) & 1) ? o_wout : e_wout) + (size_t)i_ * MIX * DM, MIX, DM, wout + (size_t)(l_) * DM * MIX, 0, nullptr); } while (0)
    CONVERT_LAYER(0, gw, NGW);
    for (int l = 0; l < 4; ++l) convert_weight(F, gw, NGW, ((l & 1) ? o_wmkv : e_wmkv) + (size_t)(l >> 1) * DM * 1024, DM, 1024, wmkv, l * 1024, nullptr);
    for (int i = F.vcu * NTHREADS + F.tid; i < 2 * 8 * 128 * 128; i += F.G * NTHREADS) { const int t = (i >> 7) & 127, sI = i & 127; wsm[i] = (sI <= t) ? (bf16_t)f2bf(o_ws[i]) : (bf16_t)0; }
    for (int r0 = gw * 4; r0 < NT; r0 += NGW * 4) {
        f32x4 v[4][4];
#pragma unroll
        for (int q = 0; q < 4; ++q)
#pragma unroll
            for (int j = 0; j < 4; ++j) v[q][j] = *(const f32x4*)(x + (size_t)(r0 + q) * DM + 4 * lane + 256 * j);
#pragma unroll
        for (int q = 0; q < 4; ++q) { float sq = 0.f;
#pragma unroll
            for (int j = 0; j < 4; ++j) { sq += (v[q][j][0] * v[q][j][0] + v[q][j][1] * v[q][j][1]) + (v[q][j][2] * v[q][j][2] + v[q][j][3] * v[q][j][3]);
                u32x2 w; w.x = pk2(v[q][j][0], v[q][j][1]); w.y = pk2(v[q][j][2], v[q][j][3]); *(u32x2*)(xb + (size_t)(r0 + q) * DM + 4 * lane + 256 * j) = w; }
            sq = wave_sum(sq);
            if (lane < 16) rowss[(size_t)(r0 + q) * 16 + lane] = (lane == 0) ? sq : 0.f; }
    }
    for (int r = gw; r < NB * NMEM; r += NGW) {
        const float* xr = mem + (size_t)r * DM; f32x4 v[4]; float s = 0.f;
#pragma unroll
        for (int j = 0; j < 4; ++j) { v[j] = *(const f32x4*)(xr + 4 * lane + 256 * j); s += (v[j][0] * v[j][0] + v[j][1] * v[j][1]) + (v[j][2] * v[j][2] + v[j][3] * v[j][3]); }
        s = wave_sum(s); const float ri = rsqrtf(s * (1.f / DM) + EPS);
#pragma unroll
        for (int j = 0; j < 4; ++j) { const f32x4 gg = *(const f32x4*)(g_mem + 4 * lane + 256 * j);
            u32x2 w; w.x = pk2(v[j][0] * ri * gg[0], v[j][1] * ri * gg[1]); w.y = pk2(v[j][2] * ri * gg[2], v[j][3] * ri * gg[3]); *(u32x2*)(memn + (size_t)r * DM + 4 * lane + 256 * j) = w; }
    }
    for (int i = F.vcu * NTHREADS + F.tid; i < NT * 16; i += F.G * NTHREADS) {
        const int tok = i >> 4, f = i & 15; const float ang = (float)pos[tok] * c_inv_freq[f];
        const double rev = (double)ang * 0.15915494309189535; const float fr = (float)(rev - rint(rev));
        rope[i] = make_float2(__builtin_amdgcn_cosf(fr), __builtin_amdgcn_sinf(fr));
    }
    }
    GRID_BAR();

    { pg8::Gemm g{memn, wmkv, NB * NMEM, 4096, DM, DM}; pg8::StaticOrder S; S.init(NB * NMEM, 4096, F.G, (int)blockIdx.x);
      pg8::EpiIn E{memkv, 4096, nullptr, nullptr, 0};
      pg8::gemm_phase<pg8::EpiIn, pg8::StaticOrder, true, true>(F.lds, g, S, E, TID());
      const int nunits = (NB * NMEM / 256) * (4096 / 256);
      if ((int)blockIdx.x >= nunits && F.G > nunits) { REFRESH(); const int gw2 = ((int)blockIdx.x - nunits) * NWAVES + F.wave, ngw2 = (F.G - nunits) * NWAVES;
          CONVERT_LAYER(1, gw2, ngw2); CONVERT_LAYER(2, gw2, ngw2); CONVERT_LAYER(3, gw2, ngw2); }
      else if (F.G <= nunits) { REFRESH(); const int gw2 = F.vcu * NWAVES + F.wave, ngw2 = F.G * NWAVES; CONVERT_LAYER(1, gw2, ngw2); CONVERT_LAYER(2, gw2, ngw2); CONVERT_LAYER(3, gw2, ngw2); }
      __syncthreads(); }

    for (int l = 0; l < 4; ++l) {
        const int i = l >> 1; const bool odd = l & 1; const int NP = odd ? OP : EP;
        { pg8::Gemm g{xb, win + (size_t)((l >> 1) * 20 + (l & 1) * 12) * (MiB / 2), NT, NP, DM, DM}; pg8::StaticOrder S; S.init(NT, NP, F.G, (int)blockIdx.x);
          pg8::EpiIn E{proj, NP, rowss, rope, odd ? 0 : 12, odd ? lnp : nullptr, 4, PS};
#ifndef STAGGER_TICKS
#define STAGGER_TICKS 0
#endif
          if (STAGGER_TICKS) stagger_wait(STAGGER_TICKS);
          pg8::gemm_phase<pg8::EpiIn, pg8::StaticOrder, true, true>(F.lds, g, S, E, TID()); }
        GRID_BAR();
        REFRESH();
        if (!odd) {
            REFRESH(); pool_phase(F, proj);
            attn_phase((char*)lds_raw, F.vcu, F.G, true, proj, memkv + l * 1024, lse, TID());
            GRID_BAR();
            REFRESH(); combine_phase(F, proj, lse);
        } else {
            REFRESH(); cmix_phase(F, proj, o_lng + i * 1024, o_lnb + i * 1024, wsm + (size_t)i * 8 * 128 * 128, o_bs + i * 8 * 128, lnp);
            attn_phase((char*)lds_raw, F.vcu, F.G, false, proj, memkv + l * 1024, lse, TID());
        }
        GRID_BAR();
        { pg8::Gemm g{pcol(proj, odd ? O_Z : E_Z), wout + (size_t)l * DM * MIX, NT, DM, MIX, PR, PS * 2};   pg8::StaticOrder S; S.init(NT, DM, F.G, (int)blockIdx.x);
          pg8::EpiOut E{l == 0 ? x : nullptr, xb, rowss};
          pg8::gemm_phase<pg8::EpiOut, pg8::StaticOrder, true, true>(F.lds, g, S, E, TID()); }
        GRID_BAR();
    }
    REFRESH();
    for (int r = F.vcu * NWAVES + F.wave; r < NT; r += NGW) { const int lane = F.lane;
        float s = (lane < 16) ? rowss[(size_t)r * 16 + lane] : 0.f; s = wave_sum(s); const float ri = rsqrtf(s * (1.f / DM) + EPS);
        const bf16_t* xr = xb + (size_t)r * DM; float* orow = out + (size_t)r * DM;
#pragma unroll
        for (int j = 0; j < 2; ++j) { const u32x4 q = *(const u32x4*)(xr + 8 * lane + 512 * j); const f32x4 g0 = *(const f32x4*)(f_g + 8 * lane + 512 * j), g1 = *(const f32x4*)(f_g + 8 * lane + 512 * j + 4);
            const f32x4 a = {__uint_as_float(q[0] << 16) * ri * g0[0], __uint_as_float(q[0] & 0xffff0000u) * ri * g0[1], __uint_as_float(q[1] << 16) * ri * g0[2], __uint_as_float(q[1] & 0xffff0000u) * ri * g0[3]};
            const f32x4 b = {__uint_as_float(q[2] << 16) * ri * g1[0], __uint_as_float(q[2] & 0xffff0000u) * ri * g1[1], __uint_as_float(q[3] << 16) * ri * g1[2], __uint_as_float(q[3] & 0xffff0000u) * ri * g1[3]};
            *(f32x4*)(orow + 8 * lane + 512 * j) = a; *(f32x4*)(orow + 8 * lane + 512 * j + 4) = b; }
    }
}

extern "C" void kernel_launch(void* const* d_in, const int* in_sizes, int n_in, void* d_out, int out_size, void* d_ws, size_t ws_size, hipStream_t stream) {
    static int grid = 0;
    if (grid == 0) {
        if (n_in != 19 || in_sizes[0] != NT * DM || out_size != NT * DM || ws_size < WS_END) {
            fprintf(stderr, "kernel_launch: unexpected shapes (n_in %d, in0 %d, out %d, ws %zu; need ws >= %zu)\n", n_in, n_in > 0 ? in_sizes[0] : -1, out_size, ws_size, (size_t)WS_END);
            grid = -1; return; }
        int dev = 0, cus = 0;
        if (hipGetDevice(&dev) != hipSuccess || hipDeviceGetAttribute(&cus, hipDeviceAttributeMultiprocessorCount, dev) != hipSuccess) { grid = -1; return; }
        if (hipFuncSetAttribute((const void*)mega_fwd, hipFuncAttributeMaxDynamicSharedMemorySize, LDS_BYTES) != hipSuccess) { fprintf(stderr, "kernel_launch: hipFuncSetAttribute failed\n"); grid = -1; return; }
        int per_cu = 0;
        if (hipOccupancyMaxActiveBlocksPerMultiprocessor(&per_cu, (const void*)mega_fwd, NTHREADS, LDS_BYTES) != hipSuccess || per_cu < 1)
            fprintf(stderr, "kernel_launch: note: occupancy query reports %d workgroups per CU\n", per_cu);
        (void)hipGetLastError();
        if (cus < 256) { fprintf(stderr, "kernel_launch: this kernel is laid out for 256 CUs (found %d); nothing launched\n", cus); grid = -1; return; }
        grid = 256;
    }
    if (grid < 0) return;
    if (hipMemsetAsync((char*)d_ws + OFF_CTL, 0, CTL_ZERO_BYTES, stream) != hipSuccess) return;
    Args a{};
    for (int i = 0; i < 19; ++i) a.in[i] = d_in[i];
    a.out = (float*)d_out; a.ws = (unsigned char*)d_ws;
    hipLaunchKernelGGL(mega_fwd, dim3(grid), dim3(NTHREADS), LDS_BYTES, stream, a);
}
```

```cpp
#include <hip/hip_runtime.h>
#include <cstdint>
#include <cstdio>

typedef unsigned short bf16_t;
#define LAS __attribute__((address_space(3)))
#define GAS __attribute__((address_space(1)))
typedef short bf16x8 __attribute__((ext_vector_type(8)));
typedef float f32x4 __attribute__((ext_vector_type(4)));
typedef unsigned u32x4 __attribute__((ext_vector_type(4)));
typedef unsigned u32x2 __attribute__((ext_vector_type(2)));

constexpr int NB = 8, SEQ = 4096, DM = 1024, NT = NB * SEQ;
constexpr int HD = 128, NMEM = 256;
constexpr int EP = 6144, OP = 4096, MIX = 1536;
constexpr int E_VA = 3072, E_XB = 3584, E_QM = 4096, E_Z = 4608;
constexpr int O_U = 0, O_V = 1024, O_QM = 2048, O_Z = 2560;
constexpr size_t PS = (size_t)NT * 256;
constexpr int PR = 256;
constexpr float EPS = 1e-6f;
constexpr float ATT_SCALE = 0.08838834764831845f;
constexpr int NWAVES = 8, NTHREADS = 512;

constexpr size_t MiB = 1u << 20;
constexpr size_t OFF_CTL = 0, CTL_ZERO_BYTES = 64 * 1024;
constexpr size_t OFF_PROJ = 1 * MiB;
constexpr size_t OFF_XB = 385 * MiB;
constexpr size_t OFF_WIN = 449 * MiB;
constexpr size_t OFF_WOUT = 461 * MiB;
constexpr size_t OFF_MEMKV = 467 * MiB;
constexpr size_t OFF_ROWSS = 483 * MiB;
constexpr size_t OFF_ROPE = 489 * MiB;
constexpr size_t OFF_LSE = 493 * MiB;
constexpr size_t OFF_WPT = 495 * MiB;
constexpr size_t OFF_WSM = OFF_WPT + 256 * 1024;
constexpr size_t OFF_LNP = 496 * MiB;
constexpr size_t WS_END = 500 * MiB;
constexpr size_t DO_MEMN = 0;
constexpr size_t DO_WMKV = 4 * MiB;
constexpr size_t DO_WIN = 12 * MiB;
constexpr size_t DO_WOUT = 52 * MiB;
constexpr int CW_BAR = 4096;

constexpr int RING_BYTES = 131072, LDSCTL_OFF = RING_BYTES, MISC_OFF = LDSCTL_OFF + 320, LDS_BYTES = 147456;

__device__ __forceinline__ bf16_t* pcol(bf16_t* proj, int col) { return proj + (size_t)(col >> 8) * PS + (col & 255); }
__device__ __forceinline__ float bf2f(bf16_t h) { return __uint_as_float((unsigned)h << 16); }
__device__ __forceinline__ unsigned f2bf(float f) { unsigned u = __float_as_uint(f); return (u + 0x7fffu + ((u >> 16) & 1u)) >> 16; }
__device__ __forceinline__ unsigned pk2(float lo, float hi) { return f2bf(lo) | (f2bf(hi) << 16); }
__device__ __forceinline__ float wave_sum(float v) {
#pragma unroll
    for (int o = 1; o < 64; o <<= 1) v += __shfl_xor(v, o);
    return v;
}
__device__ __forceinline__ float wave_max(float v) {
#pragma unroll
    for (int o = 1; o < 64; o <<= 1) v = fmaxf(v, __shfl_xor(v, o));
    return v;
}
__device__ __forceinline__ float silu(float z) { return z / (1.f + __expf(-z)); }

__constant__ float c_inv_freq[16] = {1.0f, 0.44036659598350525f, 0.1939227432012558f, 0.08539710193872452f, 0.03760603070259094f, 0.01656043902039528f,
    0.007292664609849453f, 0.0032114458736032248f, 0.0014142135623842478f, 0.000622772378847003f, 0.00027424818836152554f, 0.00012076973507646471f,
    5.318296098266728e-05f, 2.34199997066753e-05f, 1.0313386155758053e-05f, 4.541670477919979e-06f};

namespace pg8 {
constexpr int BM = 256, BK = 64, HALF = 128, HTB = HALF * BK * 2, STAGE_BYTES = 8 * HTB, NXCD = 8, WGM = 8;
__host__ __device__ __forceinline__ int lds_byte(int r, int c) { const int st = (r >> 4) * 2 + (c >> 5), rr = r & 15, cc = c & 31, ob = rr * 64 + cc * 2; return st * 1024 + (ob ^ (((ob >> 9) & 1) << 5)); }
__host__ __device__ __forceinline__ void stage_rc(int b, int& R, int& C) { const int st = b / 1024, sb = b % 1024, swz = sb ^ (((sb >> 9) & 1) << 5); R = (st >> 1) * 16 + swz / 64; C = (st & 1) * 32 + (swz % 64) / 2; }
__host__ __device__ __forceinline__ int perm32(int rho) { const int n = rho >> 4, i = rho & 15; return 8 * (i >> 2) + 4 * n + (i & 3); }
struct Unit { int pm, pn; };
struct Gemm { const bf16_t* A; const bf16_t* Bt; int M, N, K, lda; size_t kpA = 512; };
struct StaticOrder {
    int nM, nN, nwg, G, c;
    __host__ __device__ void init(int M, int N, int G_, int c_) { nM = M / BM; nN = N / BM; nwg = nM * nN; G = G_; c = c_; }
    __host__ __device__ bool next(int i, Unit& u) const {
        const long L = (long)i * G + c; if (L >= nwg) return false;
        int wgid = (int)L; { const int q = nwg / NXCD, r = nwg % NXCD, xcd = wgid % NXCD, off = wgid / NXCD; wgid = (xcd < r ? xcd * (q + 1) : r * (q + 1) + (xcd - r) * q) + off; }
        const int nig = WGM * nN, gid = wgid / nig, fm = gid * WGM, gsz = (nM - fm) < WGM ? (nM - fm) : WGM;
        u.pm = fm + ((wgid % nig) % gsz); u.pn = (wgid % nig) / gsz; return true;
    }
    __device__ __forceinline__ void a_ready(const Unit&) const {}
    __device__ __forceinline__ void done(const Unit&) const {}
};
__device__ __forceinline__ unsigned cvt_pk_bf16(float lo, float hi) { unsigned r; asm volatile("v_cvt_pk_bf16_f32 %0, %1, %2" : "=v"(r) : "v"(lo), "v"(hi)); return r; }

struct EpiIn {
    static constexpr bool PERM = true, AFTER_DRAIN = false;
    bf16_t* O; int ldc; const float* rowss; const float2* rope; int nrope; float2* lnp = nullptr; int ln_pn0 = 0; size_t pstride = 0;
    __device__ __forceinline__ void operator()(const f32x4 (&acc)[2][2][4][2], const Unit& u, int wr, int wc, int fr, int fq) const {
        const int row0 = u.pm * BM + wr * 64 + fr, col0 = u.pn * BM + wc * 32 + 8 * fq;
        const bool rp = (u.pn < nrope) && (wc == 0);
        const bool lnst = lnp && u.pn >= ln_pn0 && u.pn < ln_pn0 + 4;
        float rs[2][4];
#pragma unroll
        for (int ai = 0; ai < 2; ++ai)
#pragma unroll
            for (int m = 0; m < 4; ++m) { rs[ai][m] = 1.f;
                if (rowss) { const f32x4 p = *(const f32x4*)(rowss + (size_t)(row0 + ai * HALF + m * 16) * 16 + 4 * fq); rs[ai][m] = (p[0] + p[1]) + (p[2] + p[3]); } }
        if (rowss) {
#pragma unroll
            for (int ai = 0; ai < 2; ++ai)
#pragma unroll
                for (int m = 0; m < 4; ++m) { float s = rs[ai][m]; s += __shfl_xor(s, 16); s += __shfl_xor(s, 32); rs[ai][m] = rsqrtf(s * (1.f / DM) + EPS); } }
        if (rp) {
#pragma unroll
            for (int ai = 0; ai < 2; ++ai) { f32x4 cs[4][4];
#pragma unroll
                for (int m = 0; m < 4; ++m) { const f32x4* cp = (const f32x4*)(rope + (size_t)(row0 + ai * HALF + m * 16) * 16 + 8 * (fq & 1));
#pragma unroll
                    for (int q = 0; q < 4; ++q) cs[m][q] = cp[q]; }
#pragma unroll
                for (int m = 0; m < 4; ++m) { const int row = row0 + ai * HALF + m * 16; const float r = rs[ai][m];
                    bf16_t* rowp = pstride ? O + (size_t)u.pn * pstride + (size_t)row * PR + wc * 32 + 8 * fq : O + (size_t)row * ldc + col0;
#pragma unroll
                    for (int bj = 0; bj < 2; ++bj) { float v[8];
#pragma unroll
                        for (int j = 0; j < 4; ++j) { v[j] = acc[ai][bj][m][0][j] * r; v[4 + j] = acc[ai][bj][m][1][j] * r; }
#pragma unroll
                        for (int j = 0; j < 8; ++j) { const auto sw = __builtin_amdgcn_permlane32_swap(__float_as_uint(v[j]), __float_as_uint(v[j]), false, false);
                            const float pv = __uint_as_float(fq < 2 ? sw[1] : sw[0]); const float c = cs[m][j >> 1][(j & 1) * 2], sn = cs[m][j >> 1][(j & 1) * 2 + 1];
                            v[j] = (fq < 2) ? (v[j] * c - pv * sn) : (v[j] * c + pv * sn); }
                        u32x4 w; w.x = cvt_pk_bf16(v[0], v[1]); w.y = cvt_pk_bf16(v[2], v[3]); w.z = cvt_pk_bf16(v[4], v[5]); w.w = cvt_pk_bf16(v[6], v[7]);
                        *(u32x4*)(rowp + bj * HALF) = w; } } }
        } else {
#pragma unroll
            for (int ai = 0; ai < 2; ++ai)
#pragma unroll
                for (int m = 0; m < 4; ++m) { const int row = row0 + ai * HALF + m * 16; const float r = rs[ai][m];
                    bf16_t* rowp = pstride ? O + (size_t)u.pn * pstride + (size_t)row * PR + wc * 32 + 8 * fq : O + (size_t)row * ldc + col0;
                    float s1 = 0.f, s2 = 0.f;
#pragma unroll
                    for (int bj = 0; bj < 2; ++bj) { const f32x4 a = acc[ai][bj][m][0] * r, b = acc[ai][bj][m][1] * r;
                        s1 += ((a[0] + a[1]) + (a[2] + a[3])) + ((b[0] + b[1]) + (b[2] + b[3]));
                        s2 += ((a[0] * a[0] + a[1] * a[1]) + (a[2] * a[2] + a[3] * a[3])) + ((b[0] * b[0] + b[1] * b[1]) + (b[2] * b[2] + b[3] * b[3]));
                        u32x4 w; w.x = cvt_pk_bf16(a[0], a[1]); w.y = cvt_pk_bf16(a[2], a[3]); w.z = cvt_pk_bf16(b[0], b[1]); w.w = cvt_pk_bf16(b[2], b[3]);
                        *(u32x4*)(rowp + bj * HALF) = w; }
                    if (lnst) { s1 += __shfl_xor(s1, 16); s1 += __shfl_xor(s1, 32); s2 += __shfl_xor(s2, 16); s2 += __shfl_xor(s2, 32);
                        if (fq == 0) lnp[(size_t)row * 16 + (u.pn - ln_pn0) * 4 + wc] = make_float2(s1, s2); } }
        }
    }
};
struct EpiOut {
    static constexpr bool PERM = true, AFTER_DRAIN = false;
    const float* base32; bf16_t* xb; float* rowss;
    __device__ __forceinline__ void operator()(const f32x4 (&acc)[2][2][4][2], const Unit& u, int wr, int wc, int fr, int fq) const {
        const int row0 = u.pm * BM + wr * 64 + fr, col0 = u.pn * BM + wc * 32 + 8 * fq;
#pragma unroll
        for (int ai = 0; ai < 2; ++ai) { f32x4 o[4][2][2];
            if (base32) {
#pragma unroll
                for (int m = 0; m < 4; ++m) { const size_t off = (size_t)(row0 + ai * HALF + m * 16) * DM + col0;
#pragma unroll
                    for (int bj = 0; bj < 2; ++bj)
#pragma unroll
                        for (int n = 0; n < 2; ++n) o[m][bj][n] = *(const f32x4*)(base32 + off + bj * HALF + n * 4); }
            } else {
                u32x4 w[4][2];
#pragma unroll
                for (int m = 0; m < 4; ++m) { const size_t off = (size_t)(row0 + ai * HALF + m * 16) * DM + col0;
#pragma unroll
                    for (int bj = 0; bj < 2; ++bj) w[m][bj] = *(const u32x4*)(xb + off + bj * HALF); }
#pragma unroll
                for (int m = 0; m < 4; ++m)
#pragma unroll
                    for (int bj = 0; bj < 2; ++bj) {
                        o[m][bj][0] = (f32x4){__uint_as_float(w[m][bj].x << 16), __uint_as_float(w[m][bj].x & 0xffff0000u), __uint_as_float(w[m][bj].y << 16), __uint_as_float(w[m][bj].y & 0xffff0000u)};
                        o[m][bj][1] = (f32x4){__uint_as_float(w[m][bj].z << 16), __uint_as_float(w[m][bj].z & 0xffff0000u), __uint_as_float(w[m][bj].w << 16), __uint_as_float(w[m][bj].w & 0xffff0000u)}; }
            }
#pragma unroll
            for (int m = 0; m < 4; ++m) { const int row = row0 + ai * HALF + m * 16; const size_t off = (size_t)row * DM + col0; float ss = 0.f;
#pragma unroll
                for (int bj = 0; bj < 2; ++bj) { const f32x4 v0 = o[m][bj][0] + acc[ai][bj][m][0], v1 = o[m][bj][1] + acc[ai][bj][m][1];
                    ss += ((v0[0] * v0[0] + v0[1] * v0[1]) + (v0[2] * v0[2] + v0[3] * v0[3])) + ((v1[0] * v1[0] + v1[1] * v1[1]) + (v1[2] * v1[2] + v1[3] * v1[3]));
                    u32x4 wv; wv.x = cvt_pk_bf16(v0[0], v0[1]); wv.y = cvt_pk_bf16(v0[2], v0[3]); wv.z = cvt_pk_bf16(v1[0], v1[1]); wv.w = cvt_pk_bf16(v1[2], v1[3]);
                    *(u32x4*)(xb + off + bj * HALF) = wv; }
                ss += __shfl_xor(ss, 16); ss += __shfl_xor(ss, 32);
                if (fq == 0) rowss[(size_t)row * 16 + u.pn * 4 + wc] = ss; } }
    }
};

template <class Epi, class Sched, bool ALIGN_EPI = false, bool SP2 = false>
__device__ __forceinline__ void gemm_phase(LAS unsigned char* lds, const Gemm g, const Sched& S, const Epi& E, int tid_in) {
    int tid_ = tid_in; asm volatile("" : "+v"(tid_));
    const int tid = tid_, wid = __builtin_amdgcn_readfirstlane(tid >> 6), lane = tid & 63, wr = wid >> 2, wc = wid & 3, fr = lane & 15, fq = lane >> 4;
    const int K = g.K, nt = K / BK, lda = g.lda;
    unsigned voffA[2], voffB[2];
#pragma unroll
    for (int i = 0; i < 2; ++i) { int R, C; stage_rc(tid * 16 + i * 8192, R, C); const int Rb = Epi::PERM ? ((R & ~31) + perm32(R & 31)) : R;
        voffA[i] = (unsigned)(R * lda + C) * 2u; voffB[i] = (unsigned)(Rb * K + C) * 2u; }
    const size_t kstep = (size_t)(BK * 2);
    const size_t kpA = g.kpA;
#define PG8_KA(t_) ((size_t)((t_) >> 2) * kpA + (size_t)((t_) & 3) * kstep)
    const size_t hstepA = (size_t)HALF * lda * 2, hstepB = (size_t)HALF * K * 2;
    const size_t tstepA = 2 * hstepA, tstepB = 2 * hstepB;
    const unsigned ldsw = (unsigned)wid * 1024u;
    const int aoff = lds_byte(wr * 64 + fr, fq * 8), boff = lds_byte(wc * 32 + fr, fq * 8);
#define PG8_SA(b, h) (((b) * 2 + (h)) * HTB)
#define PG8_SB(b, h) ((4 + (b) * 2 + (h)) * HTB)
#define PG8_STAGE(bufoff, gbase, voff) do { _Pragma("unroll") for (int _i = 0; _i < 2; ++_i) \
        __builtin_amdgcn_global_load_lds((const unsigned*)((const char*)(gbase) + (voff)[_i]), (LAS unsigned*)(lds + (bufoff) + ldsw + _i * 8192), 16, 0, 0); } while (0)
#define PG8_LDA(dst, b, h) do { _Pragma("unroll") for (int m = 0; m < 4; ++m) _Pragma("unroll") for (int k = 0; k < 2; ++k) dst[m][k] = *(const LAS bf16x8*)(lds + PG8_SA(b, h) + aoff + m * 2048 + k * 1024); } while (0)
#define PG8_LDB(dst, b, h) do { _Pragma("unroll") for (int n = 0; n < 2; ++n) _Pragma("unroll") for (int k = 0; k < 2; ++k) dst[n][k] = *(const LAS bf16x8*)(lds + PG8_SB(b, h) + boff + n * 2048 + k * 1024); } while (0)
#define PG8_MMA(ai, bj, At, Bt) do { __builtin_amdgcn_s_setprio(1); _Pragma("unroll") for (int m = 0; m < 4; ++m) _Pragma("unroll") for (int n = 0; n < 2; ++n) _Pragma("unroll") for (int k = 0; k < 2; ++k) \
        acc[ai][bj][m][n] = __builtin_amdgcn_mfma_f32_16x16x32_bf16(Bt[n][k], At[m][k], acc[ai][bj][m][n], 0, 0, 0); __builtin_amdgcn_s_setprio(0); } while (0)
#define PG8_WAIT_V(n) asm volatile("s_waitcnt vmcnt(" #n ")" ::: "memory")
#define PG8_WAIT_L(n) asm volatile("s_waitcnt lgkmcnt(" #n ")" ::: "memory")
#define PG8_BAR __builtin_amdgcn_s_barrier()
#define PG8_SCHED __builtin_amdgcn_sched_barrier(0)
    Unit cur, nxt; int ui = 0;
    if (!S.next(0, cur)) return;
    f32x4 acc[2][2][4][2];
#pragma unroll
    for (int a = 0; a < 2; ++a)
#pragma unroll
        for (int b = 0; b < 2; ++b)
#pragma unroll
            for (int m = 0; m < 4; ++m)
#pragma unroll
                for (int n = 0; n < 2; ++n) acc[a][b][m][n] = (f32x4){0.f, 0.f, 0.f, 0.f};
    bf16x8 At[4][2], B0[2][2], B1[2][2];
    const char* cA = (const char*)g.A + (size_t)cur.pm * tstepA; const char* cB = (const char*)g.Bt + (size_t)cur.pn * tstepB;
    S.a_ready(cur);
    if constexpr (SP2) {
        PG8_STAGE(PG8_SB(0, 0), cB, voffB); PG8_STAGE(PG8_SB(0, 1), cB + hstepB, voffB); PG8_STAGE(PG8_SA(0, 0), cA, voffA); PG8_STAGE(PG8_SA(0, 1), cA + hstepA, voffA);
        if (wr == 1) PG8_BAR;
        PG8_WAIT_V(2); PG8_BAR;
        PG8_STAGE(PG8_SB(1, 0), cB + kstep, voffB); PG8_STAGE(PG8_SA(1, 0), cA + PG8_KA(1), voffA); PG8_STAGE(PG8_SB(1, 1), cB + hstepB + kstep, voffB);
        PG8_WAIT_V(6); PG8_BAR;
    } else {
        PG8_STAGE(PG8_SB(0, 0), cB, voffB); PG8_STAGE(PG8_SA(0, 0), cA, voffA); PG8_STAGE(PG8_SB(0, 1), cB + hstepB, voffB); PG8_STAGE(PG8_SA(0, 1), cA + hstepA, voffA);
        if (wr == 1) PG8_BAR;
        PG8_WAIT_V(4); PG8_BAR;
        PG8_STAGE(PG8_SB(1, 0), cB + kstep, voffB); PG8_STAGE(PG8_SA(1, 0), cA + PG8_KA(1), voffA); PG8_STAGE(PG8_SB(1, 1), cB + hstepB + kstep, voffB);
        PG8_WAIT_V(6); PG8_BAR;
    }
    for (;;) {
        const bool has_next = S.next(ui + 1, nxt);
        const char* nA = has_next ? (const char*)g.A + (size_t)nxt.pm * tstepA : cA; const char* nB = has_next ? (const char*)g.Bt + (size_t)nxt.pn * tstepB : cB;
        for (int t = 0; t < nt; t += 2) {
            const bool last = (t == nt - 2);
            const char* a1 = cA + PG8_KA(t + 1);
            const char* a2 = last ? nA : cA + PG8_KA(t + 2); const char* b2 = last ? nB : cB + (size_t)(t + 2) * kstep;
            const char* a3 = last ? nA + PG8_KA(1) : cA + PG8_KA(t + 3); const char* b3 = b2 + kstep;
            if (last && has_next) S.a_ready(nxt);
            if constexpr (SP2) {
            PG8_LDB(B0, 0, 0); PG8_LDB(B1, 0, 1); PG8_SCHED; PG8_LDA(At, 0, 0); PG8_STAGE(PG8_SA(1, 1), a1 + hstepA, voffA);
            PG8_WAIT_V(8); PG8_WAIT_L(0); PG8_BAR; PG8_MMA(0, 0, At, B0); PG8_MMA(0, 1, At, B1); PG8_BAR; PG8_SCHED;
            PG8_LDA(At, 0, 1); PG8_STAGE(PG8_SB(0, 0), b2, voffB); PG8_STAGE(PG8_SB(0, 1), b2 + hstepB, voffB); PG8_STAGE(PG8_SA(0, 0), a2, voffA);
            PG8_WAIT_V(8); PG8_WAIT_L(0); PG8_BAR; PG8_MMA(1, 0, At, B0); PG8_MMA(1, 1, At, B1); PG8_BAR; PG8_SCHED;
            PG8_LDB(B0, 1, 0); PG8_LDB(B1, 1, 1); PG8_SCHED; PG8_LDA(At, 1, 0); PG8_STAGE(PG8_SA(0, 1), a2 + hstepA, voffA);
            PG8_WAIT_V(8); PG8_WAIT_L(0); PG8_BAR; PG8_MMA(0, 0, At, B0); PG8_MMA(0, 1, At, B1); PG8_BAR; PG8_SCHED;
            PG8_LDA(At, 1, 1); PG8_STAGE(PG8_SB(1, 0), b3, voffB); PG8_STAGE(PG8_SB(1, 1), b3 + hstepB, voffB); PG8_STAGE(PG8_SA(1, 0), a3, voffA);
            PG8_WAIT_V(8); PG8_WAIT_L(0); PG8_BAR; PG8_MMA(1, 0, At, B0); PG8_MMA(1, 1, At, B1); PG8_BAR; PG8_SCHED;
            } else {
            PG8_LDB(B0, 0, 0); PG8_SCHED; PG8_LDA(At, 0, 0); PG8_STAGE(PG8_SA(1, 1), a1 + hstepA, voffA);
            PG8_WAIT_L(8); PG8_BAR; PG8_WAIT_L(0); PG8_MMA(0, 0, At, B0); PG8_BAR; PG8_SCHED;
            PG8_LDB(B1, 0, 1); PG8_STAGE(PG8_SB(0, 0), b2, voffB);
            PG8_BAR; PG8_WAIT_L(0); PG8_MMA(0, 1, At, B1); PG8_BAR;
            PG8_LDA(At, 0, 1); PG8_STAGE(PG8_SA(0, 0), a2, voffA);
            PG8_BAR; PG8_WAIT_L(0); PG8_MMA(1, 0, At, B0); PG8_BAR; PG8_SCHED;
            PG8_STAGE(PG8_SB(0, 1), b2 + hstepB, voffB);
            PG8_WAIT_V(6); PG8_BAR; PG8_MMA(1, 1, At, B1); PG8_BAR;
            PG8_LDB(B0, 1, 0); PG8_SCHED; PG8_LDA(At, 1, 0); PG8_STAGE(PG8_SA(0, 1), a2 + hstepA, voffA);
            PG8_WAIT_L(8); PG8_BAR; PG8_WAIT_L(0); PG8_MMA(0, 0, At, B0); PG8_BAR; PG8_SCHED;
            PG8_LDB(B1, 1, 1); PG8_STAGE(PG8_SB(1, 0), b3, voffB);
            PG8_BAR; PG8_WAIT_L(0); PG8_MMA(0, 1, At, B1); PG8_BAR;
            PG8_LDA(At, 1, 1); PG8_STAGE(PG8_SA(1, 0), a3, voffA);
            PG8_BAR; PG8_WAIT_L(0); PG8_MMA(1, 0, At, B0); PG8_BAR; PG8_SCHED;
            PG8_STAGE(PG8_SB(1, 1), b3 + hstepB, voffB);
            PG8_WAIT_V(6); PG8_BAR; PG8_MMA(1, 1, At, B1); PG8_BAR;
            }
        }
        if constexpr (ALIGN_EPI) { if (wr == 0) PG8_BAR; }
        if constexpr (!Epi::AFTER_DRAIN) { E(acc, cur, wr, wc, fr, fq); S.done(cur); }
        if (!has_next) break;
#pragma unroll
        for (int a = 0; a < 2; ++a)
#pragma unroll
            for (int b = 0; b < 2; ++b)
#pragma unroll
                for (int m = 0; m < 4; ++m)
#pragma unroll
                    for (int n = 0; n < 2; ++n) acc[a][b][m][n] = (f32x4){0.f, 0.f, 0.f, 0.f};
        cur = nxt; cA = nA; cB = nB; ++ui;
        if constexpr (ALIGN_EPI) { if (wr == 1) PG8_BAR; }
    }
    PG8_WAIT_V(0);
    if constexpr (!ALIGN_EPI) { if (wr == 0) PG8_BAR; }
    PG8_BAR;
#undef PG8_KA
#undef PG8_SA
#undef PG8_SB
#undef PG8_STAGE
#undef PG8_LDA
#undef PG8_LDB
#undef PG8_MMA
#undef PG8_WAIT_V
#undef PG8_WAIT_L
#undef PG8_BAR
#undef PG8_SCHED
}
}


namespace att {
typedef short s16x4 __attribute__((ext_vector_type(4)));
typedef float f32x16 __attribute__((ext_vector_type(16)));
constexpr int D = 128, NW = 8, QBLK = 32, KVBLK = 64, QB = NW * QBLK;
constexpr int SHM_V = KVBLK * D * 2, SHM_K = KVBLK * D * 2;
constexpr int ATT_LDS_BYTES = 2 * SHM_V + 2 * SHM_K + NW * 64 * 4;
constexpr float SCALE = 0.08838834764831845f, THR = 8.f;
#define KSWZ(row, colB) ((row) * 256 + ((colB) ^ (((row) & 7) << 4)))
#define SBAR() __builtin_amdgcn_sched_barrier(0)
__device__ __forceinline__ int v_st(int k, int c) { const int kk = (k & ~0xC) | ((k & 4) << 1) | ((k & 8) >> 1); return ((kk >> 3) * 4 + (c >> 5)) * 512 + ((kk & 7) * 32 + (c & 31)) * 2; }
__device__ __forceinline__ int v_rd_base(int lane) { return ((lane & 3) << 3) | (((lane >> 2) & 3) << 6) | (((lane >> 4) & 1) << 5) | (((lane >> 5) & 1) << 8); }
constexpr int v_rd_off(int d0, int ks, int half) { return d0 * 512 + ks * 4096 + half * 2048; }
__device__ __forceinline__ int crow(int r, int hi) { return (r & 3) + 8 * (r >> 2) + 4 * hi; }
__device__ __forceinline__ unsigned cvtpk(float lo, float hi) { unsigned r; asm volatile("v_cvt_pk_bf16_f32 %0, %1, %2" : "=v"(r) : "v"(lo), "v"(hi)); return r; }
__device__ __forceinline__ bf16x8 load8(const bf16_t* p) { return *reinterpret_cast<const bf16x8*>(p); }
__device__ __forceinline__ void mask_tile(f32x16& p0, f32x16& p1, int dq, unsigned W) {
    const float NEG = -__builtin_inff();
#pragma unroll
    for (int r = 0; r < 16; ++r) { const int c = (r & 3) + 8 * (r >> 2);
        if ((unsigned)(dq - c) >= W) p0[r] = NEG;
        if ((unsigned)(dq - c - 32) >= W) p1[r] = NEG; }
}
__device__ __forceinline__ void partialSM(f32x16& p0, f32x16& p1, float& m_reg, float& mn, float& alpha) {
    float pmax = p0[0]; for (int r = 1; r < 16; ++r) pmax = fmaxf(pmax, p0[r]); for (int r = 0; r < 16; ++r) pmax = fmaxf(pmax, p1[r]);
    { auto rr = __builtin_amdgcn_permlane32_swap(__float_as_uint(pmax), __float_as_uint(pmax), false, false);
      pmax = fmaxf(__uint_as_float(rr[0]), __uint_as_float(rr[1])); }
    constexpr float C2 = 1.4426950408889634f * SCALE;
    if (__builtin_expect(__all((pmax - m_reg) * SCALE <= THR), 1)) { mn = m_reg; alpha = 1.f; }
    else { mn = fmaxf(m_reg, pmax); alpha = __builtin_amdgcn_exp2f((m_reg - mn) * C2); m_reg = mn; }
    const float mnL = -mn * C2;
    for (int r = 0; r < 16; ++r) p0[r] = fmaf(p0[r], C2, mnL); for (int r = 0; r < 16; ++r) p1[r] = fmaf(p1[r], C2, mnL);
    for (int r = 0; r < 16; ++r) p0[r] = __builtin_amdgcn_exp2f(p0[r]);
}
__device__ __forceinline__ void finishSM(f32x16& p0, f32x16& p1, float alpha, float& l_reg, bf16x8& pa0, bf16x8& pa1, bf16x8& pa2, bf16x8& pa3) {
    for (int r = 0; r < 16; ++r) p1[r] = __builtin_amdgcn_exp2f(p1[r]);
    float ps = 0; for (int r = 0; r < 16; ++r) ps += p0[r]; for (int r = 0; r < 16; ++r) ps += p1[r];
    { auto rr = __builtin_amdgcn_permlane32_swap(__float_as_uint(ps), __float_as_uint(ps), false, false);
      ps = __uint_as_float(rr[0]) + __uint_as_float(rr[1]); }
    l_reg = l_reg * alpha + ps;
#define PK4(P, B_, OUT) do { unsigned a0 = cvtpk(P[B_+0], P[B_+1]), a1 = cvtpk(P[B_+2], P[B_+3]);                          \
        unsigned b0 = cvtpk(P[B_+4], P[B_+5]), b1 = cvtpk(P[B_+6], P[B_+7]);                                             \
        auto r0 = __builtin_amdgcn_permlane32_swap(a0, b0, false, false); auto r1 = __builtin_amdgcn_permlane32_swap(a1, b1, false, false); \
        u32x4 w = {r0[0], r1[0], r0[1], r1[1]}; OUT = *reinterpret_cast<bf16x8*>(&w); } while (0)
    PK4(p0, 0, pa0); PK4(p0, 8, pa1); PK4(p1, 0, pa2); PK4(p1, 8, pa3);
#undef PK4
}
template <int KB>
__device__ __forceinline__ void qkt(f32x16& p0, f32x16& p1, const char* K_lds, int r32, int hi, const bf16x8* qr, bool act) {
    if (!act) { const float NEG = -__builtin_inff();
#pragma unroll
        for (int r = 0; r < 16; ++r) { p0[r] = NEG; p1[r] = NEG; } return; }
    p0 = f32x16{}; p1 = f32x16{};
    const char* kb[4];
#pragma unroll
    for (int dd = 0; dd < 4; ++dd) kb[dd] = K_lds + KB * SHM_K + KSWZ(r32, (dd * 16 + hi * 8) * 2);
#pragma unroll
    for (int d0 = 0; d0 < 8; ++d0) { const char* a = kb[d0 & 3] + (d0 >> 2) * 128;
        bf16x8 b0 = *reinterpret_cast<const bf16x8*>(a);
        bf16x8 b1 = *reinterpret_cast<const bf16x8*>(a + 32 * 256);
        p0 = __builtin_amdgcn_mfma_f32_32x32x16_bf16(b0, qr[d0], p0, 0, 0, 0);
        p1 = __builtin_amdgcn_mfma_f32_32x32x16_bf16(b1, qr[d0], p1, 0, 0, 0); }
}
template <int VB>
__device__ __forceinline__ void pv_tile(f32x16* o, int vb0, bf16x8 pa0, bf16x8 pa1, bf16x8 pa2, bf16x8 pa3, bool act) {
    if (!act) return;
#define TRRD(dst, off) asm volatile("ds_read_b64_tr_b16 %0, %1 offset:%2" : "=&v"(dst) : "v"(vb0), "i"(off) : "memory")
#define PV_D0(d0) do { s16x4 l0, l1, l2, l3, h0, h1, h2, h3; constexpr int b_ = VB * SHM_V + v_rd_off(d0, 0, 0); \
        TRRD(l0, b_); TRRD(h0, b_ + 2048); TRRD(l1, b_ + 4096); TRRD(h1, b_ + 6144); TRRD(l2, b_ + 8192); TRRD(h2, b_ + 10240); TRRD(l3, b_ + 12288); TRRD(h3, b_ + 14336); \
        asm volatile("s_waitcnt lgkmcnt(0)" ::: "memory"); SBAR();   \
        o[d0] = __builtin_amdgcn_mfma_f32_32x32x16_bf16(pa0, (bf16x8){l0[0], l0[1], l0[2], l0[3], h0[0], h0[1], h0[2], h0[3]}, o[d0], 0, 0, 0);   \
        o[d0] = __builtin_amdgcn_mfma_f32_32x32x16_bf16(pa1, (bf16x8){l1[0], l1[1], l1[2], l1[3], h1[0], h1[1], h1[2], h1[3]}, o[d0], 0, 0, 0);   \
        o[d0] = __builtin_amdgcn_mfma_f32_32x32x16_bf16(pa2, (bf16x8){l2[0], l2[1], l2[2], l2[3], h2[0], h2[1], h2[2], h2[3]}, o[d0], 0, 0, 0);   \
        o[d0] = __builtin_amdgcn_mfma_f32_32x32x16_bf16(pa3, (bf16x8){l3[0], l3[1], l3[2], l3[3], h3[0], h3[1], h3[2], h3[3]}, o[d0], 0, 0, 0); } while (0)
    PV_D0(0); PV_D0(1); PV_D0(2); PV_D0(3);
#undef PV_D0
#undef TRRD
}
struct BlockRef { const bf16_t* Q; const bf16_t* K; const bf16_t* V; bf16_t* O; float* lse; int P0, pq, pk, skv, W, lsep, mode; };
struct Seam { bf16x8 qr[8]; bf16x8 st_v0, st_v1, st_k0, st_k1; };
__device__ __forceinline__ int swa_jlo(int P0, int W) { const int lowk = P0 - W + 1; return lowk > 0 ? lowk / KVBLK : 0; }
#define ROWK(p, k0, rr, pk_) ((const bf16_t*)((const char*)(p) + (size_t)(unsigned)((((unsigned)((k0) + (rr))) * (unsigned)(pk_) + (unsigned)sc) * 2u)))
#define VMW() asm volatile("s_waitcnt vmcnt(0)" ::: "memory")
#define VMWN(n) asm volatile("s_waitcnt vmcnt(%0)" :: "i"(n) : "memory")
#define SLOAD_H(Kp, Vp, k0, pk_) do { S.st_v0 = load8(ROWK(Vp, k0, sr, pk_)); S.st_v1 = load8(ROWK(Vp, k0, 32 + sr, pk_));              \
                         S.st_k0 = load8(ROWK(Kp, k0, sr, pk_)); S.st_k1 = load8(ROWK(Kp, k0, 32 + sr, pk_)); } while (0)
#define SWRITE_HK(bf) do { *(bf16x8*)(K_lds + (bf) * SHM_K + kws) = S.st_k0; *(bf16x8*)(K_lds + (bf) * SHM_K + kws + 32 * 256) = S.st_k1; } while (0)
#define SWRITE_HV(bf) do { *(bf16x8*)(V_lds + (bf) * SHM_V + vst0) = S.st_v0; *(bf16x8*)(V_lds + (bf) * SHM_V + vst1) = S.st_v1; } while (0)
#define SWRITE_H(bf) do { SWRITE_HV(bf); SWRITE_HK(bf); } while (0)
__device__ __forceinline__ void swa_prime(const BlockRef& cur, char* lds, Seam& S, int tid) {
    const int wid = __builtin_amdgcn_readfirstlane(tid >> 6), lane = tid & 63, r32 = lane & 31, hi = lane >> 5;
    const int sr = tid >> 4, sc = (tid & 15) * 8, kws = KSWZ(sr, sc * 2); char* K_lds = lds + 2 * SHM_V;
    const int kb0 = swa_jlo(cur.P0, cur.W) * KVBLK;
    { const unsigned qoff = ((unsigned)(wid * QBLK + r32) * (unsigned)cur.pq + (unsigned)hi * 8u) * 2u;
      for (int d0 = 0; d0 < 8; ++d0) S.qr[d0] = *(const bf16x8*)((const char*)cur.Q + (size_t)qoff + d0 * 32); }
    SLOAD_H(cur.K, cur.V, kb0, cur.pk); VMW(); SWRITE_HK(0);
    __syncthreads();
}
__device__ __forceinline__ void swa_block(const BlockRef& cur, const BlockRef& nxt, char* lds, Seam& S, int tid) {
    const int wid = __builtin_amdgcn_readfirstlane(tid >> 6), lane = tid & 63, r32 = lane & 31, hi = lane >> 5;
    const int W = cur.W, pk = cur.pk;
    const int j_lo = swa_jlo(cur.P0, W);
    int j_hi = (cur.P0 + QB - 1) / KVBLK + 1; if (j_hi > cur.skv / KVBLK) j_hi = cur.skv / KVBLK;
    const int NT = j_hi - j_lo;
    const int kbn = swa_jlo(nxt.P0, nxt.W) * KVBLK;
    const int qlo = cur.P0 + wid * QBLK, qm = qlo + r32 - 4 * hi;
    char* V_lds = lds; char* K_lds = lds + 2 * SHM_V;
    float* ws = (float*)(lds + 2 * SHM_V + 2 * SHM_K) + wid * 64; float* li_l = ws, * al_l = ws + 32;
    float m_reg = -1e30f, l_reg = 0; f32x16 o[4] = {};
    const int sr = tid >> 4, sc = (tid & 15) * 8, vst0 = v_st(sr, sc), vst1 = v_st(32 + sr, sc), kws = KSWZ(sr, sc * 2);
    const int vb0 = (int)(uintptr_t)V_lds + v_rd_base(lane);
    const bf16_t* Kh = cur.K; const bf16_t* Vh = cur.V;
#define RESC(a) do { if (__any((a) < 1.f)) { if (hi == 0) al_l[r32] = (a); asm volatile("s_waitcnt lgkmcnt(0)" ::: "memory");              \
                     for (int d_ = 0; d_ < 4; ++d_) for (int r = 0; r < 16; ++r) o[d_][r] *= al_l[crow(r, hi)]; } } while (0)
#define KBASE(t) ((j_lo + (t)) * KVBLK)
#define ACT(t) (KBASE(t) <= qlo + QBLK - 1 && KBASE(t) + KVBLK - 1 >= qlo - W + 1)
#define MASKT(P0_, P1_, t) do { const int kb_ = KBASE(t); if (ACT(t) && (kb_ + KVBLK - 1 > qlo || kb_ <= qlo + QBLK - 1 - W)) mask_tile(P0_, P1_, qm - kb_, (unsigned)W); } while (0)
    constexpr int NQL = 8;
#define SEAM_K0() do { VMWN(NQL); SWRITE_HK(0); SBAR(); } while (0)
    f32x16 pA0, pA1, pB0, pB1; float mnA, mnB, alA, alB; bf16x8 pa0, pa1, pa2, pa3;
    SWRITE_HV(0); SBAR();
    if (NT > 1) { SLOAD_H(Kh, Vh, KBASE(1), pk); }
    SBAR(); qkt<0>(pA0, pA1, K_lds, r32, hi, S.qr, ACT(0));
    MASKT(pA0, pA1, 0); partialSM(pA0, pA1, m_reg, mnA, alA);
    if (NT > 1) { VMW(); SWRITE_H(1); }
    __syncthreads();
#define HALF_STEP(PX0, PX1, mnX, alX, PY0, PY1, alY, t, KB, VB, SB) do {                                                      \
        SBAR(); if ((t) + 1 < NT) { SLOAD_H(Kh, Vh, KBASE((t) + 1), pk); SBAR(); }                               \
        qkt<KB>(PX0, PX1, K_lds, r32, hi, S.qr, ACT(t));                                             \
        finishSM(PY0, PY1, alY, l_reg, pa0, pa1, pa2, pa3); SBAR();                                                           \
        pv_tile<VB>(o, vb0, pa0, pa1, pa2, pa3, ACT((t) - 1)); MASKT(PX0, PX1, (t)); partialSM(PX0, PX1, m_reg, mnX, alX);                                        \
        __syncthreads();                                                                                                      \
        if ((t) + 1 < NT) { VMW(); SWRITE_H(SB); }                                                                          \
        RESC(alX); __syncthreads(); } while (0)
    for (int t = 1; t + 1 < NT; t += 2) {
        HALF_STEP(pB0, pB1, mnB, alB, pA0, pA1, alA, t, 1, 0, 0);
        HALF_STEP(pA0, pA1, mnA, alA, pB0, pB1, alB, t + 1, 0, 1, 1);
    }
    const bool even = (NT & 1) == 0;
    if (even) { SBAR(); qkt<1>(pB0, pB1, K_lds, r32, hi, S.qr, ACT(NT - 1)); SBAR(); }
    { SLOAD_H(nxt.K, nxt.V, kbn, nxt.pk); SBAR();
        const unsigned qoff = ((unsigned)(wid * QBLK + r32) * (unsigned)nxt.pq + (unsigned)hi * 8u) * 2u;
#pragma unroll
        for (int d0 = 0; d0 < 8; ++d0) S.qr[d0] = *(const bf16x8*)((const char*)nxt.Q + (size_t)qoff + d0 * 32); }
    SBAR();
    finishSM(pA0, pA1, alA, l_reg, pa0, pa1, pa2, pa3); SBAR();
    pv_tile<0>(o, vb0, pa0, pa1, pa2, pa3, ACT(even ? NT - 2 : NT - 1));
    if (even) { MASKT(pB0, pB1, NT - 1); partialSM(pB0, pB1, m_reg, mnB, alB); __syncthreads(); RESC(alB);
        finishSM(pB0, pB1, alB, l_reg, pa0, pa1, pa2, pa3); SBAR(); pv_tile<1>(o, vb0, pa0, pa1, pa2, pa3, ACT(NT - 1)); }
    SBAR(); SEAM_K0();
    if (hi == 0) li_l[r32] = l_reg; asm volatile("s_waitcnt lgkmcnt(0)" ::: "memory");
    float rli[16];
#pragma unroll
    for (int r = 0; r < 16; ++r) rli[r] = __builtin_amdgcn_rcpf(li_l[crow(r, hi)]);
    int r32e = r32, hie = hi, lne = lane; asm volatile("" : "+v"(r32e), "+v"(hie), "+v"(lne));
    bf16_t* Ow = cur.O + (size_t)(wid * QBLK) * cur.pq;
    const unsigned pqu = (unsigned)cur.pq;
    if (cur.mode == 2) {
        float sink = 0.f;
#pragma unroll
        for (int r = 0; r < 16; ++r)
#pragma unroll
            for (int d0 = 0; d0 < 4; ++d0) sink += o[d0][r] * rli[r];
        asm volatile("" :: "v"(sink), "v"(m_reg));
    } else {
        if (cur.mode == 0 && hie == 0) cur.lse[(size_t)(wid * QBLK + r32e) * cur.lsep] = m_reg * SCALE + __logf(l_reg);
        char* stg = lds + ATT_LDS_BYTES + wid * (32 * 144);
        const unsigned goff = ((unsigned)(lne >> 3) * pqu + (unsigned)(lne & 7) * 8u) * 2u;
#pragma unroll
        for (int h2 = 0; h2 < 2; ++h2) {
#pragma unroll
            for (int r = 0; r < 16; ++r) { const int orow = (r & 3) + 8 * (r >> 2) + 4 * hie;
#pragma unroll
                for (int dd = 0; dd < 2; ++dd) *(bf16_t*)(stg + orow * 144 + (dd * 32 + r32e) * 2) = (bf16_t)(cvtpk(o[2 * h2 + dd][r] * rli[r], 0.f) & 0xffffu); }
            u32x4 ov[4], zv[4];
#pragma unroll
            for (int j = 0; j < 4; ++j) ov[j] = *(const u32x4*)(stg + (j * 8 + (lne >> 3)) * 144 + (lne & 7) * 16);
            char* gp = (char*)Ow + (size_t)goff + h2 * 128;
            if (cur.mode == 1) {
#pragma unroll
                for (int j = 0; j < 4; ++j) zv[j] = *(const u32x4*)(gp + (size_t)(j * 8) * pqu * 2u);
#pragma unroll
                for (int j = 0; j < 4; ++j)
#pragma unroll
                    for (int e = 0; e < 4; ++e) ov[j][e] = cvtpk(__uint_as_float(ov[j][e] << 16) * silu(__uint_as_float(zv[j][e] << 16)), __uint_as_float(ov[j][e] & 0xffff0000u) * silu(__uint_as_float(zv[j][e] & 0xffff0000u)));
            }
#pragma unroll
            for (int j = 0; j < 4; ++j) *(u32x4*)(gp + (size_t)(j * 8) * pqu * 2u) = ov[j];
        }
    }
    __syncthreads();
#undef RESC
#undef KBASE
#undef ACT
#undef MASKT
#undef SEAM_K0
#undef HALF_STEP
}
#undef ROWK
#undef VMW
#undef VMWN
#undef SLOAD_H
#undef SWRITE_HK
#undef SWRITE_HV
#undef SWRITE_H
#undef KSWZ
#undef SBAR
}

typedef GAS unsigned gu32;
#define RLX_AGENT __ATOMIC_RELAXED, __HIP_MEMORY_SCOPE_AGENT
#define XB_TMO      128
#define XB_XCNT(j)  (256  + 64 * (j))
#define XB_XSUB(j)  (1280 + 64 * (j))
#define XB_XGEN(j)  (2304 + 64 * (j))
#define XB_TOP      3328
#define XB_TOPGEN   3392
#define XCD_BAR_WORDS 3456
#define XB_SPIN_CAP (1u << 18)
__device__ __forceinline__ unsigned xb_ld(unsigned* p)              { return __hip_atomic_load(p, __ATOMIC_RELAXED, __HIP_MEMORY_SCOPE_AGENT); }
__device__ __forceinline__ unsigned xb_add(unsigned* p, unsigned v) { return __hip_atomic_fetch_add(p, v, __ATOMIC_RELAXED, __HIP_MEMORY_SCOPE_AGENT); }
__device__ __forceinline__ unsigned xb_xcc_id() { return (unsigned)__builtin_amdgcn_s_getreg((3 << 11) | 20) & 0xFu; }
#define XB_SPIN(cond, bar) do { unsigned _sp = 0; while (cond) { __builtin_amdgcn_s_sleep(1); \
    if ((++_sp & 255u) == 0u) { if (xb_ld(&(bar)[XB_TMO])) break; if (_sp > XB_SPIN_CAP) { atomicAdd(&(bar)[XB_TMO], 1u); break; } } } } while (0)
struct XcdBarrier { unsigned* bar; unsigned x; volatile LAS unsigned* st; };
__device__ __forceinline__ XcdBarrier xcd_barrier_post(unsigned* bar, volatile LAS unsigned* st, int tid) {
    XcdBarrier b; b.bar = bar; b.x = xb_xcc_id(); b.st = st;
    if (tid == 0) (void)xb_add(&bar[XB_XCNT(b.x)], 1u);
    return b;
}
__device__ __forceinline__ void xcd_barrier_complete(unsigned* bar, unsigned x, unsigned& nloc, unsigned& nx) {
    const unsigned G = gridDim.x * gridDim.y * gridDim.z;
    unsigned sum, cnt, mine, sp = 0u;
    for (;;) {
        sum = 0u; cnt = 0u; mine = 0u;
#pragma unroll
        for (unsigned j = 0; j < 16; ++j) { const unsigned c = xb_ld(&bar[XB_XCNT(j)]); sum += c; cnt += (c > 0u) ? 1u : 0u; mine = (j == x) ? c : mine; }
        if (sum == G) break;
        __builtin_amdgcn_s_sleep(1);
        if ((++sp & 255u) == 0u) { if (xb_ld(&bar[XB_TMO])) break; if (sp > XB_SPIN_CAP) { atomicAdd(&bar[XB_TMO], 1u); break; } }
    }
    nloc = mine > 0u ? mine : 1u; nx = cnt > 0u ? cnt : 1u;
}
__device__ __forceinline__ void xcd_barrier(const XcdBarrier& b, int tid) {
    asm volatile("s_waitcnt vmcnt(0)" ::: "memory");
    __syncthreads();
    if (tid == 0) {
        unsigned* bar = b.bar;
        __builtin_amdgcn_s_waitcnt(0);
        unsigned nloc = b.st[0], nx = b.st[1];
        if (nloc == 0u) { xcd_barrier_complete(bar, b.x, nloc, nx); b.st[0] = nloc; b.st[1] = nx; }
        const unsigned old = xb_add(&bar[XB_XSUB(b.x)], 1u);
        const unsigned gen = old / nloc;
        if (old + 1u == (gen + 1u) * nloc) {
            __builtin_amdgcn_fence(__ATOMIC_RELEASE, "agent");
            asm volatile("s_waitcnt vmcnt(0)" ::: "memory");
            const unsigned og = xb_add(&bar[XB_TOP], 1u);
            const unsigned tg = og / nx;
            if (og + 1u == (tg + 1u) * nx) xb_add(&bar[XB_TOPGEN], 1u);
            else XB_SPIN(xb_ld(&bar[XB_TOPGEN]) == tg, bar);
            __builtin_amdgcn_fence(__ATOMIC_ACQUIRE, "agent");
            xb_add(&bar[XB_XGEN(b.x)], 1u);
            asm volatile("s_waitcnt vmcnt(0)" ::: "memory");
        } else {
            XB_SPIN(xb_ld(&bar[XB_XGEN(b.x)]) == gen, bar);
            __builtin_amdgcn_fence(__ATOMIC_ACQUIRE, "agent");
            asm volatile("s_waitcnt vmcnt(0)" ::: "memory");
        }
    }
    __syncthreads();
}

__device__ __forceinline__ int lane_id_opaque() { int l; asm volatile("v_mbcnt_lo_u32_b32 %0, -1, 0\n\tv_mbcnt_hi_u32_b32 %0, -1, %0" : "=v"(l)); return l; }
__device__ __forceinline__ void stagger_wait(unsigned ticks) {
    int bx = blockIdx.x; asm volatile("" : "+s"(bx));
    if ((bx >> 3) & 1) { const unsigned long long t0 = __builtin_amdgcn_s_memrealtime(); while (__builtin_amdgcn_s_memrealtime() - t0 < ticks) __builtin_amdgcn_s_sleep(16); }
}
struct Frame {
    LAS unsigned char* lds;
    int tid, lane, wave, vcu, G;
};

__device__ __forceinline__ void transpose_item(const float* __restrict__ W, int K, int N, bf16_t* WT, int row_off, const float* __restrict__ g, LAS float* scr, int item, int lane, bool dry = false,
                                               const float* __restrict__ wpool = nullptr, const float* __restrict__ pscale = nullptr) {
    const int nblk = N / 32, kb = item / nblk, nb = item % nblk, k0 = 64 * kb, n0 = 32 * nb;
    if (wpool && n0 >= E_XB && n0 < E_XB + 512) return;
    { const int kr = lane >> 3, nq = lane & 7; f32x4 v[8]; float gv[8];
#pragma unroll
      for (int i = 0; i < 8; ++i) { v[i] = *(const f32x4*)(W + (size_t)(k0 + 8 * i + kr) * N + n0 + 4 * nq); gv[i] = g ? g[k0 + 8 * i + kr] : 1.f; }
#pragma unroll
      for (int i = 0; i < 8; ++i)
#pragma unroll
          for (int e = 0; e < 4; ++e) scr[(8 * i + kr) * 33 + 4 * nq + e] = v[i][e] * gv[i]; }
    asm volatile("s_waitcnt lgkmcnt(0)" ::: "memory");
    const int c = lane & 7;
#pragma unroll
    for (int j = 0; j < 4; ++j) { const int n = (lane >> 3) + 8 * j; const LAS float* s = scr + (8 * c) * 33 + n;
        u32x4 o; o.x = pk2(s[0 * 33], s[1 * 33]); o.y = pk2(s[2 * 33], s[3 * 33]); o.z = pk2(s[4 * 33], s[5 * 33]); o.w = pk2(s[6 * 33], s[7 * 33]);
        if (!dry) *(u32x4*)(WT + (size_t)(row_off + n0 + n) * K + k0 + 8 * c) = o; }
    asm volatile("s_waitcnt lgkmcnt(0)" ::: "memory");
}
__device__ __forceinline__ void fold_tile(const float* __restrict__ W, bf16_t* WT, const float* __restrict__ g, const float* __restrict__ wpool, const float* __restrict__ pscale, int item, int lane, bool dry) {
    const int kb = item >> 5, nb = item & 31, k0 = 16 * kb, nn0 = 16 * nb, gi = nn0 >> 7, d0 = nn0 & 127, fr = lane & 15, fq = lane >> 4;
    const float* ap = W + (size_t)(k0 + fr) * EP + E_XB + gi * 128 + fq;
    const float* bp = wpool + (size_t)gi * 128 * 128 + (size_t)fq * 128 + d0 + fr;
    float av[32], bv[32];
#pragma unroll
    for (int ks = 0; ks < 32; ++ks) { av[ks] = ap[4 * ks]; bv[ks] = bp[(size_t)4 * ks * 128]; }
    f32x4 acc = {0.f, 0.f, 0.f, 0.f};
#pragma unroll
    for (int ks = 0; ks < 32; ++ks) acc = __builtin_amdgcn_mfma_f32_16x16x4f32(av[ks], bv[ks], acc, 0, 0, 0);
    const float ps = pscale[gi * 128 + d0 + fr]; const f32x4 gk = *(const f32x4*)(g + k0 + 4 * fq);
    u32x2 o; o.x = pk2(acc[0] * ps * gk[0], acc[1] * ps * gk[1]); o.y = pk2(acc[2] * ps * gk[2], acc[3] * ps * gk[3]);
    if (!dry) *(u32x2*)(WT + (size_t)(E_XB + nn0 + fr) * DM + k0 + 4 * fq) = o;
}
__device__ __forceinline__ void convert_weight(const Frame& F, int gw, int NGW, const float* W, int K, int N, bf16_t* WT, int row_off, const float* g, bool dry = false, const float* wpool = nullptr, const float* pscale = nullptr) {
    LAS float* scr = (LAS float*)(F.lds + F.wave * 16384);
    const int nitems = (K / 64) * (N / 32);
    for (int it = gw; it < nitems; it += NGW) transpose_item(W, K, N, WT, row_off, g, scr, it, F.lane, dry, wpool, pscale);
    if (wpool) for (int it = gw; it < (DM / 16) * 32; it += NGW) fold_tile(W, WT, g, wpool, pscale, it, F.lane, dry);
}

__device__ __forceinline__ att::BlockRef att_item(int L, bool even, bf16_t* proj, const bf16_t* mkv, float* lse, bool dry) {
    att::BlockRef r;
    const int xq = (L & 255) >> 5, jj = L & 31, rd = L >> 8;
    if (even && L < 1536) {
        const int idx = rd * 32 + jj, pair = xq * 4 + idx / 48, kk = idx % 48, g = kk >> 4, x = 15 - (kk & 15), b = pair >> 2, h = pair & 3;
        const int dsh = 2 * g, dil = 1 << dsh, nqb = 16 >> dsh, rr = x >> (4 - dsh), qb = x & (nqb - 1);
        const size_t tok0 = (size_t)b * SEQ + rr, q0 = tok0 + (size_t)qb * 256 * dil;
        r.Q = pcol(proj, g * 1024 + h * 128) + q0 * PR; r.O = pcol(proj, g * 1024 + h * 128) + q0 * PR;
        r.K = pcol(proj, g * 1024 + 512 + h * 128) + tok0 * PR; r.V = pcol(proj, E_VA + h * 128) + tok0 * PR;
        r.P0 = qb * 256; r.pq = dil * PR; r.pk = dil * PR; r.skv = SEQ >> dsh; r.W = 129; r.mode = 0;
        r.lse = lse + ((size_t)g * NT + tok0 + (size_t)qb * 256 * dil) * 4 + h; r.lsep = dil * 4;
    } else {
        const int idx2 = (even ? rd - 6 : rd) * 32 + jj, pair = xq * 4 + (idx2 >> 4), qb = 15 - (idx2 & 15), b = pair >> 2, h = pair & 3;
        const int qcol = even ? E_QM : O_QM, zcol = (even ? E_Z : O_Z) + 1024;
        const size_t row0 = (size_t)b * SEQ + qb * 256;
        r.Q = pcol(proj, qcol + h * 128) + row0 * PR; r.O = pcol(proj, zcol + h * 128) + row0 * PR;
        r.K = mkv + (size_t)(b * NMEM) * 4096 + h * 128; r.V = r.K + 512;
        r.P0 = 256; r.pq = PR; r.pk = 4096; r.skv = 256; r.W = 1 << 20; r.mode = 1; r.lse = nullptr; r.lsep = 0;
    }
    if (dry) r.mode = 2;
    return r;
}
__device__ __forceinline__ void attn_phase(char* lds, int vcu, int G, bool even, bf16_t* proj, const bf16_t* mkv, float* lse, int tid_in, bool dry = false, int lo = 0, int hi = 1 << 30) {
    int tid = tid_in; asm volatile("" : "+v"(tid));
    const int total = (even ? 2048 : 512) < hi ? (even ? 2048 : 512) : hi;
    int L = vcu + lo; if (L >= total) return;
    att::BlockRef cur = att_item(L, even, proj, mkv, lse, dry);
    att::Seam S;
    att::swa_prime(cur, lds, S, tid);
    for (;;) {
        const int Ln = L + G; const bool last = Ln >= total;
        const att::BlockRef nxt = last ? cur : att_item(Ln, even, proj, mkv, lse, dry);
        att::swa_block(cur, nxt, lds, S, tid);
        if (last) break;
        cur = nxt; L = Ln;
    }
}
__device__ __forceinline__ void combine_phase(const Frame& F, bf16_t* proj, const float* __restrict__ lse, bool dry = false) {
    const int lane = F.lane, h = lane >> 4, dc = (lane & 15) * 8, NGW = F.G * NWAVES;
    for (int tok0 = (F.vcu * NWAVES + F.wave) * 4; tok0 < NT; tok0 += NGW * 4) {
        u32x4 o0[4], o1[4], o2[4], zz[4]; float w0[4], w1[4], w2[4];
#pragma unroll
        for (int q = 0; q < 4; ++q) { const size_t tok = tok0 + q; const int cc = h * 128 + dc;
            w0[q] = lse[((size_t)0 * NT + tok) * 4 + h]; w1[q] = lse[((size_t)1 * NT + tok) * 4 + h]; w2[q] = lse[((size_t)2 * NT + tok) * 4 + h];
            o0[q] = *(const u32x4*)(pcol(proj, cc) + tok * PR); o1[q] = *(const u32x4*)(pcol(proj, 1024 + cc) + tok * PR); o2[q] = *(const u32x4*)(pcol(proj, 2048 + cc) + tok * PR); zz[q] = *(const u32x4*)(pcol(proj, E_Z + cc) + tok * PR); }
#pragma unroll
        for (int q = 0; q < 4; ++q) { const size_t tok = tok0 + q; bf16_t* zrow = pcol(proj, E_Z + h * 128 + dc) + tok * PR;
            const float M = fmaxf(w0[q], fmaxf(w1[q], w2[q])); float a0 = __expf(w0[q] - M), a1 = __expf(w1[q] - M), a2 = __expf(w2[q] - M);
            const float inv = 1.f / (a0 + a1 + a2); a0 *= inv; a1 *= inv; a2 *= inv;
            u32x4 y;
#pragma unroll
            for (int j = 0; j < 4; ++j) {
                const float a = a0 * __uint_as_float(o0[q][j] << 16) + a1 * __uint_as_float(o1[q][j] << 16) + a2 * __uint_as_float(o2[q][j] << 16);
                const float b = a0 * __uint_as_float(o0[q][j] & 0xffff0000u) + a1 * __uint_as_float(o1[q][j] & 0xffff0000u) + a2 * __uint_as_float(o2[q][j] & 0xffff0000u);
                y[j] = pk2(a * silu(__uint_as_float(zz[q][j] << 16)), b * silu(__uint_as_float(zz[q][j] & 0xffff0000u))); }
            if (!dry) *(u32x4*)zrow = y; }
    }
}
__device__ __forceinline__ void pool_phase(const Frame& F, bf16_t* proj, bool dry = false) {
    const int lane = F.lane, gi = lane >> 4, w = 2 << gi, NGW = F.G * NWAVES;
    for (int run = F.vcu * NWAVES + F.wave; run < NT / 16; run += NGW) {
        const int t0 = run * 16, p0 = t0 % SEQ;
        const bf16_t* xc = pcol(proj, E_XB + lane * 8) + (size_t)t0 * PR; bf16_t* zc = pcol(proj, E_Z + 512 + lane * 8) + (size_t)t0 * PR;
        float sum[8];
#pragma unroll
        for (int e = 0; e < 8; ++e) sum[e] = 0.f;
        { u32x4 h[16];
#pragma unroll
          for (int j = 1; j <= 16; ++j) h[j - 1] = (j <= w && p0 - j >= 0) ? *(const u32x4*)(xc - (long)j * PR) : (u32x4){0u, 0u, 0u, 0u};
#pragma unroll
          for (int j = 0; j < 16; ++j)
#pragma unroll
              for (int e = 0; e < 4; ++e) { sum[2 * e] += __uint_as_float(h[j][e] << 16); sum[2 * e + 1] += __uint_as_float(h[j][e] & 0xffff0000u); } }
#pragma unroll
        for (int bt = 0; bt < 16; bt += 8) { u32x4 xa[8], xs[8], zz[8];
#pragma unroll
            for (int i = 0; i < 8; ++i) { const int p = p0 + bt + i;
                xa[i] = *(const u32x4*)(xc + (long)(bt + i) * PR); zz[i] = *(const u32x4*)(zc + (long)(bt + i) * PR);
                xs[i] = (p >= w) ? *(const u32x4*)(xc + (long)(bt + i - w) * PR) : (u32x4){0u, 0u, 0u, 0u}; }
#pragma unroll
            for (int i = 0; i < 8; ++i) { const int p = p0 + bt + i; const float ic = 1.f / (float)((p + 1 < w) ? p + 1 : w); u32x4 y;
#pragma unroll
                for (int e = 0; e < 4; ++e) { const float x0 = __uint_as_float(xa[i][e] << 16), x1 = __uint_as_float(xa[i][e] & 0xffff0000u);
                    sum[2 * e] += x0 - __uint_as_float(xs[i][e] << 16); sum[2 * e + 1] += x1 - __uint_as_float(xs[i][e] & 0xffff0000u);
                    y[e] = pk2((sum[2 * e] * ic - x0) * silu(__uint_as_float(zz[i][e] << 16)), (sum[2 * e + 1] * ic - x1) * silu(__uint_as_float(zz[i][e] & 0xffff0000u))); }
                if (!dry) *(u32x4*)(zc + (long)(bt + i) * PR) = y; } }
    }
}
__device__ __forceinline__ void cmix_phase(const Frame& F, bf16_t* proj, const float* __restrict__ ln_g, const float* __restrict__ ln_b,
                                           const bf16_t* __restrict__ wsm  , const float* __restrict__ b_s, const float2* __restrict__ lnp, bool dry = false) {
    const int tid = F.tid, lane = F.lane, wv = F.wave, fr = lane & 15, fq = lane >> 4;
    LAS unsigned char* VT = F.lds; LAS float* mu = (LAS float*)(F.lds + 128 * 272); LAS float* rstd = mu + 128;
    for (int ch = F.vcu; ch < NT / 128; ch += F.G) {
        const size_t row0 = (size_t)ch * 128;
        { const int row = tid >> 2, part = tid & 3; const f32x4* pp = (const f32x4*)(lnp + (row0 + row) * 16 + part * 4);
          const f32x4 a = pp[0], b = pp[1]; float s1 = (a[0] + a[2]) + (b[0] + b[2]), s2 = (a[1] + a[3]) + (b[1] + b[3]);
          s1 += __shfl_xor(s1, 1); s1 += __shfl_xor(s1, 2); s2 += __shfl_xor(s2, 1); s2 += __shfl_xor(s2, 2);
          const float m = s1 * (1.f / 1024.f), var = fmaxf(s2 * (1.f / 1024.f) - m * m, 0.f);
          if (part == 0) { mu[row] = m; rstd[row] = rsqrtf(var + EPS); } }
        const int sI = tid >> 2, cq = tid & 3;
        const size_t vro = (row0 + sI) * PR + cq * 8;
        const size_t tro = (row0 + wv * 16 + (lane >> 4)) * PR + (lane & 15) * 8;
        LAS unsigned char* stg = F.lds + 36864 + wv * (16 * 528);
        u32x4 vq[4];
#pragma unroll
        for (int k = 0; k < 4; ++k) vq[k] = *(const u32x4*)(pcol(proj, O_V + k * 32) + vro);
        __syncthreads();
        const float m_s = mu[sI], r_s = rstd[sI];
        for (int g = 0; g < 8; ++g) {
            u32x4 uq[4], zq[4];
#pragma unroll
            for (int j = 0; j < 4; ++j) { uq[j] = *(const u32x4*)(pcol(proj, O_U + g * 128) + tro + (size_t)(4 * j) * PR); zq[j] = *(const u32x4*)(pcol(proj, O_Z + g * 128) + tro + (size_t)(4 * j) * PR); }
            const float bs = b_s[g * 128 + wv * 16 + fr];
#pragma unroll
            for (int k = 0; k < 4; ++k) { const int c0 = k * 32 + cq * 8; const f32x4 g0 = *(const f32x4*)(ln_g + g * 128 + c0), g1 = *(const f32x4*)(ln_g + g * 128 + c0 + 4), b0 = *(const f32x4*)(ln_b + g * 128 + c0), b1 = *(const f32x4*)(ln_b + g * 128 + c0 + 4);
#pragma unroll
                for (int j = 0; j < 4; ++j) { const float gg0 = (j < 2) ? g0[2 * j] : g1[2 * j - 4], gg1 = (j < 2) ? g0[2 * j + 1] : g1[2 * j - 3], bb0 = (j < 2) ? b0[2 * j] : b1[2 * j - 4], bb1 = (j < 2) ? b0[2 * j + 1] : b1[2 * j - 3];
                    const float v0 = (__uint_as_float(vq[k][j] << 16) - m_s) * r_s * gg0 + bb0, v1 = (__uint_as_float(vq[k][j] & 0xffff0000u) - m_s) * r_s * gg1 + bb1;
                    *(LAS bf16_t*)(VT + (c0 + 2 * j) * 272 + sI * 2) = (bf16_t)f2bf(v0); *(LAS bf16_t*)(VT + (c0 + 2 * j + 1) * 272 + sI * 2) = (bf16_t)f2bf(v1); } }
            __syncthreads();
            if (g < 7) {
#pragma unroll
                for (int k = 0; k < 4; ++k) vq[k] = *(const u32x4*)(pcol(proj, O_V + (g + 1) * 128 + k * 32) + vro); }
            f32x4 acc[8];
#pragma unroll
            for (int n = 0; n < 8; ++n) acc[n] = (f32x4){0.f, 0.f, 0.f, 0.f};
            const int ksmax = wv >> 1;
            for (int ks = 0; ks <= ksmax; ++ks) {
                const bf16x8 b = *(const bf16x8*)(wsm + ((size_t)g * 128 + wv * 16 + fr) * 128 + ks * 32 + 8 * fq);
#pragma unroll
                for (int mt = 0; mt < 8; ++mt) { const bf16x8 a = *(const LAS bf16x8*)(VT + (mt * 16 + fr) * 272 + (ks * 32 + 8 * fq) * 2);
                    acc[mt] = __builtin_amdgcn_mfma_f32_16x16x32_bf16(a, b, acc[mt], 0, 0, 0); } }
#pragma unroll
            for (int mt = 0; mt < 8; ++mt) *(LAS f32x4*)(stg + fr * 528 + (mt * 16 + 4 * fq) * 4) = acc[mt] + bs;
#pragma unroll
            for (int j = 0; j < 4; ++j) { const LAS f32x4* mp = (const LAS f32x4*)(stg + (4 * j + (lane >> 4)) * 528 + (lane & 15) * 32); const f32x4 m0 = mp[0], m1 = mp[1]; u32x4 y;
                y.x = pk2(__uint_as_float(uq[j].x << 16) * m0[0] * silu(__uint_as_float(zq[j].x << 16)), __uint_as_float(uq[j].x & 0xffff0000u) * m0[1] * silu(__uint_as_float(zq[j].x & 0xffff0000u)));
                y.y = pk2(__uint_as_float(uq[j].y << 16) * m0[2] * silu(__uint_as_float(zq[j].y << 16)), __uint_as_float(uq[j].y & 0xffff0000u) * m0[3] * silu(__uint_as_float(zq[j].y & 0xffff0000u)));
                y.z = pk2(__uint_as_float(uq[j].z << 16) * m1[0] * silu(__uint_as_float(zq[j].z << 16)), __uint_as_float(uq[j].z & 0xffff0000u) * m1[1] * silu(__uint_as_float(zq[j].z & 0xffff0000u)));
                y.w = pk2(__uint_as_float(uq[j].w << 16) * m1[2] * silu(__uint_as_float(zq[j].w << 16)), __uint_as_float(uq[j].w & 0xffff0000u) * m1[3] * silu(__uint_as_float(zq[j].w & 0xffff0000u)));
                if (!dry) *(u32x4*)(pcol(proj, O_Z + g * 128) + tro + (size_t)(4 * j) * PR) = y; }
            __syncthreads();
        }
    }
}

struct Args { const void* in[19]; float* out; unsigned char* ws; };
__global__ void __launch_bounds__(NTHREADS, 2) mega_fwd(Args args) {
    extern __shared__ __attribute__((aligned(16))) unsigned char lds_raw[];
    Frame F;
    F.lds = (LAS unsigned char*)lds_raw;
    const int wave_s = __builtin_amdgcn_readfirstlane((int)threadIdx.x >> 6);
#define TID() (wave_s * 64 + lane_id_opaque())
    F.tid = TID(); F.lane = F.tid & 63; F.wave = wave_s;
    F.G = gridDim.x; { const int bx = blockIdx.x; F.vcu = (F.G % 8 == 0) ? (bx % 8) * (F.G / 8) + bx / 8 : bx; }
    volatile LAS unsigned* MISC = (volatile LAS unsigned*)(F.lds + MISC_OFF);
    unsigned char* ws = args.ws;
    for (int u = F.tid; u < (LDS_BYTES - LDSCTL_OFF) / 4; u += NTHREADS) ((LAS unsigned*)(F.lds + LDSCTL_OFF))[u] = 0u;
    __syncthreads();
    XcdBarrier bar = xcd_barrier_post((unsigned*)(ws + OFF_CTL) + CW_BAR, MISC + 8, F.tid);
#define GRID_BAR() xcd_barrier(bar, TID())
#define REFRESH() do { int t_ = TID(); asm volatile("" : "+v"(t_)); F.tid = t_; F.lane = t_ & 63; F.wave = wave_s; } while (0)

    const float* x = (const float*)args.in[0]; const float* mem = (const float*)args.in[1]; const int* pos = (const int*)args.in[2]; const float* g_mem = (const float*)args.in[3];
    const float* e_ng = (const float*)args.in[4]; const float* e_win = (const float*)args.in[5]; const float* e_wpool = (const float*)args.in[6]; const float* e_pscale = (const float*)args.in[7];
    const float* e_wmkv = (const float*)args.in[8]; const float* e_wout = (const float*)args.in[9];
    const float* o_ng = (const float*)args.in[10]; const float* o_win = (const float*)args.in[11]; const float* o_lng = (const float*)args.in[12]; const float* o_lnb = (const float*)args.in[13];
    const float* o_ws = (const float*)args.in[14]; const float* o_bs = (const float*)args.in[15]; const float* o_wmkv = (const float*)args.in[16]; const float* o_wout = (const float*)args.in[17];
    const float* f_g = (const float*)args.in[18];
    float* out = args.out;
    bf16_t* proj = (bf16_t*)(ws + OFF_PROJ); bf16_t* xb = (bf16_t*)(ws + OFF_XB); bf16_t* win = (bf16_t*)((unsigned char*)args.out + DO_WIN); bf16_t* wout = (bf16_t*)((unsigned char*)args.out + DO_WOUT);
    bf16_t* memkv = (bf16_t*)(ws + OFF_MEMKV); float* rowss = (float*)(ws + OFF_ROWSS); float2* rope = (float2*)(ws + OFF_ROPE); float* lse = (float*)(ws + OFF_LSE); float2* lnp = (float2*)(ws + OFF_LNP); bf16_t* wpT = (bf16_t*)(ws + OFF_WPT); bf16_t* wsm = (bf16_t*)(ws + OFF_WSM);
    bf16_t* memn = (bf16_t*)((unsigned char*)args.out + DO_MEMN); bf16_t* wmkv = (bf16_t*)((unsigned char*)args.out + DO_WMKV);
    const int NGW = F.G * NWAVES;
    { const int gw = F.vcu * NWAVES + F.wave, lane = F.lane;

#define CONVERT_LAYER(l_, gw_, ngw_) do { const int i_ = (l_) >> 1;        \
        if ((l_) & 1) convert_weight(F, gw_, ngw_, o_win + (size_t)i_ * DM * OP, DM, OP, win + (size_t)(i_ * 20 + 12) * (MiB / 2), 0, o_ng + i_ * DM); \
        else          convert_weight(F, gw_, ngw_, e_win + (size_t)i_ * DM * EP, DM, EP, win + (size_t)(i_ * 20) * (MiB / 2), 0, e_ng + i_ * DM, false, e_wpool + (size_t)i_ * 4 * 128 * 128, e_pscale + i_ * 512); \
        convert_weight(F, gw_, ngw_, (((l_) & 1) ? o_wout : e_wout) + (size_t)i_ * MIX * DM, MIX, DM, wout + (size_t)(l_) * DM * MIX, 0, nullptr); } while (0)
    CONVERT_LAYER(0, gw, NGW);
    for (int l = 0; l < 4; ++l) convert_weight(F, gw, NGW, ((l & 1) ? o_wmkv : e_wmkv) + (size_t)(l >> 1) * DM * 1024, DM, 1024, wmkv, l * 1024, nullptr);
    for (int i = F.vcu * NTHREADS + F.tid; i < 2 * 8 * 128 * 128; i += F.G * NTHREADS) { const int t = (i >> 7) & 127, sI = i & 127; wsm[i] = (sI <= t) ? (bf16_t)f2bf(o_ws[i]) : (bf16_t)0; }
    for (int r0 = gw * 4; r0 < NT; r0 += NGW * 4) {
        f32x4 v[4][4];
#pragma unroll
        for (int q = 0; q < 4; ++q)
#pragma unroll
            for (int j = 0; j < 4; ++j) v[q][j] = *(const f32x4*)(x + (size_t)(r0 + q) * DM + 4 * lane + 256 * j);
#pragma unroll
        for (int q = 0; q < 4; ++q) { float sq = 0.f;
#pragma unroll
            for (int j = 0; j < 4; ++j) { sq += (v[q][j][0] * v[q][j][0] + v[q][j][1] * v[q][j][1]) + (v[q][j][2] * v[q][j][2] + v[q][j][3] * v[q][j][3]);
                u32x2 w; w.x = pk2(v[q][j][0], v[q][j][1]); w.y = pk2(v[q][j][2], v[q][j][3]); *(u32x2*)(xb + (size_t)(r0 + q) * DM + 4 * lane + 256 * j) = w; }
            sq = wave_sum(sq);
            if (lane < 16) rowss[(size_t)(r0 + q) * 16 + lane] = (lane == 0) ? sq : 0.f; }
    }
    for (int r = gw; r < NB * NMEM; r += NGW) {
        const float* xr = mem + (size_t)r * DM; f32x4 v[4]; float s = 0.f;
#pragma unroll
        for (int j = 0; j < 4; ++j) { v[j] = *(const f32x4*)(xr + 4 * lane + 256 * j); s += (v[j][0] * v[j][0] + v[j][1] * v[j][1]) + (v[j][2] * v[j][2] + v[j][3] * v[j][3]); }
        s = wave_sum(s); const float ri = rsqrtf(s * (1.f / DM) + EPS);
#pragma unroll
        for (int j = 0; j < 4; ++j) { const f32x4 gg = *(const f32x4*)(g_mem + 4 * lane + 256 * j);
            u32x2 w; w.x = pk2(v[j][0] * ri * gg[0], v[j][1] * ri * gg[1]); w.y = pk2(v[j][2] * ri * gg[2], v[j][3] * ri * gg[3]); *(u32x2*)(memn + (size_t)r * DM + 4 * lane + 256 * j) = w; }
    }
    for (int i = F.vcu * NTHREADS + F.tid; i < NT * 16; i += F.G * NTHREADS) {
        const int tok = i >> 4, f = i & 15; const float ang = (float)pos[tok] * c_inv_freq[f];
        const double rev = (double)ang * 0.15915494309189535; const float fr = (float)(rev - rint(rev));
        rope[i] = make_float2(__builtin_amdgcn_cosf(fr), __builtin_amdgcn_sinf(fr));
    }
    }
    GRID_BAR();

    { pg8::Gemm g{memn, wmkv, NB * NMEM, 4096, DM, DM}; pg8::StaticOrder S; S.init(NB * NMEM, 4096, F.G, (int)blockIdx.x);
      pg8::EpiIn E{memkv, 4096, nullptr, nullptr, 0};
      pg8::gemm_phase<pg8::EpiIn, pg8::StaticOrder, true, true>(F.lds, g, S, E, TID());
      const int nunits = (NB * NMEM / 256) * (4096 / 256);
      if ((int)blockIdx.x >= nunits && F.G > nunits) { REFRESH(); const int gw2 = ((int)blockIdx.x - nunits) * NWAVES + F.wave, ngw2 = (F.G - nunits) * NWAVES;
          CONVERT_LAYER(1, gw2, ngw2); CONVERT_LAYER(2, gw2, ngw2); CONVERT_LAYER(3, gw2, ngw2); }
      else if (F.G <= nunits) { REFRESH(); const int gw2 = F.vcu * NWAVES + F.wave, ngw2 = F.G * NWAVES; CONVERT_LAYER(1, gw2, ngw2); CONVERT_LAYER(2, gw2, ngw2); CONVERT_LAYER(3, gw2, ngw2); }
      __syncthreads(); }

    for (int l = 0; l < 4; ++l) {
        const int i = l >> 1; const bool odd = l & 1; const int NP = odd ? OP : EP;
        { pg8::Gemm g{xb, win + (size_t)((l >> 1) * 20 + (l & 1) * 12) * (MiB / 2), NT, NP, DM, DM}; pg8::StaticOrder S; S.init(NT, NP, F.G, (int)blockIdx.x);
          pg8::EpiIn E{proj, NP, rowss, rope, odd ? 0 : 12, odd ? lnp : nullptr, 4, PS};
#ifndef STAGGER_TICKS
#define STAGGER_TICKS 0
#endif
          if (STAGGER_TICKS) stagger_wait(STAGGER_TICKS);
          pg8::gemm_phase<pg8::EpiIn, pg8::StaticOrder, true, true>(F.lds, g, S, E, TID()); }
        GRID_BAR();
        REFRESH();
        if (!odd) {
            REFRESH(); pool_phase(F, proj);
            attn_phase((char*)lds_raw, F.vcu, F.G, true, proj, memkv + l * 1024, lse, TID());
            GRID_BAR();
            REFRESH(); combine_phase(F, proj, lse);
        } else {
            REFRESH(); cmix_phase(F, proj, o_lng + i * 1024, o_lnb + i * 1024, wsm + (size_t)i * 8 * 128 * 128, o_bs + i * 8 * 128, lnp);
            attn_phase((char*)lds_raw, F.vcu, F.G, false, proj, memkv + l * 1024, lse, TID());
        }
        GRID_BAR();
        { pg8::Gemm g{pcol(proj, odd ? O_Z : E_Z), wout + (size_t)l * DM * MIX, NT, DM, MIX, PR, PS * 2};   pg8::StaticOrder S; S.init(NT, DM, F.G, (int)blockIdx.x);
          pg8::EpiOut E{l == 0 ? x : nullptr, xb, rowss};
          pg8::gemm_phase<pg8::EpiOut, pg8::StaticOrder, true, true>(F.lds, g, S, E, TID()); }
        GRID_BAR();
    }
    REFRESH();
    for (int r = F.vcu * NWAVES + F.wave; r < NT; r += NGW) { const int lane = F.lane;
        float s = (lane < 16) ? rowss[(size_t)r * 16 + lane] : 0.f; s = wave_sum(s); const float ri = rsqrtf(s * (1.f / DM) + EPS);
        const bf16_t* xr = xb + (size_t)r * DM; float* orow = out + (size_t)r * DM;
#pragma unroll
        for (int j = 0; j < 2; ++j) { const u32x4 q = *(const u32x4*)(xr + 8 * lane + 512 * j); const f32x4 g0 = *(const f32x4*)(f_g + 8 * lane + 512 * j), g1 = *(const f32x4*)(f_g + 8 * lane + 512 * j + 4);
            const f32x4 a = {__uint_as_float(q[0] << 16) * ri * g0[0], __uint_as_float(q[0] & 0xffff0000u) * ri * g0[1], __uint_as_float(q[1] << 16) * ri * g0[2], __uint_as_float(q[1] & 0xffff0000u) * ri * g0[3]};
            const f32x4 b = {__uint_as_float(q[2] << 16) * ri * g1[0], __uint_as_float(q[2] & 0xffff0000u) * ri * g1[1], __uint_as_float(q[3] << 16) * ri * g1[2], __uint_as_float(q[3] & 0xffff0000u) * ri * g1[3]};
            *(f32x4*)(orow + 8 * lane + 512 * j) = a; *(f32x4*)(orow + 8 * lane + 512 * j + 4) = b; }
    }
}

extern "C" void kernel_launch(void* const* d_in, const int* in_sizes, int n_in, void* d_out, int out_size, void* d_ws, size_t ws_size, hipStream_t stream) {
    static int grid = 0;
    if (grid == 0) {
        if (n_in != 19 || in_sizes[0] != NT * DM || out_size != NT * DM || ws_size < WS_END) {
            fprintf(stderr, "kernel_launch: unexpected shapes (n_in %d, in0 %d, out %d, ws %zu; need ws >= %zu)\n", n_in, n_in > 0 ? in_sizes[0] : -1, out_size, ws_size, (size_t)WS_END);
            grid = -1; return; }
        int dev = 0, cus = 0;
        if (hipGetDevice(&dev) != hipSuccess || hipDeviceGetAttribute(&cus, hipDeviceAttributeMultiprocessorCount, dev) != hipSuccess) { grid = -1; return; }
        if (hipFuncSetAttribute((const void*)mega_fwd, hipFuncAttributeMaxDynamicSharedMemorySize, LDS_BYTES) != hipSuccess) { fprintf(stderr, "kernel_launch: hipFuncSetAttribute failed\n"); grid = -1; return; }
        int per_cu = 0;
        if (hipOccupancyMaxActiveBlocksPerMultiprocessor(&per_cu, (const void*)mega_fwd, NTHREADS, LDS_BYTES) != hipSuccess || per_cu < 1)
            fprintf(stderr, "kernel_launch: note: occupancy query reports %d workgroups per CU\n", per_cu);
        (void)hipGetLastError();
        if (cus < 256) { fprintf(stderr, "kernel_launch: this kernel is laid out for 256 CUs (found %d); nothing launched\n", cus); grid = -1; return; }
        grid = 256;
    }
    if (grid < 0) return;
    if (hipMemsetAsync((char*)d_ws + OFF_CTL, 0, CTL_ZERO_BYTES, stream) != hipSuccess) return;
    Args a{};
    for (int i = 0; i < 19; ++i) a.in[i] = d_in[i];
    a.out = (float*)d_out; a.ws = (unsigned char*)d_ws;
    hipLaunchKernelGGL(mega_fwd, dim3(grid), dim3(NTHREADS), LDS_BYTES, stream, a);
}
```

```cpp
#include <hip/hip_runtime.h>
#include <cstdint>
#include <cstdio>

typedef unsigned short bf16_t;
#define LAS __attribute__((address_space(3)))
#define GAS __attribute__((address_space(1)))
typedef short bf16x8 __attribute__((ext_vector_type(8)));
typedef float f32x4 __attribute__((ext_vector_type(4)));
typedef unsigned u32x4 __attribute__((ext_vector_type(4)));
typedef unsigned u32x2 __attribute__((ext_vector_type(2)));

constexpr int NB = 8, SEQ = 4096, DM = 1024, NT = NB * SEQ;
constexpr int HD = 128, NMEM = 256;
constexpr int EP = 6144, OP = 4096, MIX = 1536;
constexpr int E_VA = 3072, E_XB = 3584, E_QM = 4096, E_Z = 4608;
constexpr int O_U = 0, O_V = 1024, O_QM = 2048, O_Z = 2560;
constexpr size_t PS = (size_t)NT * 256;
constexpr int PR = 256;
constexpr float EPS = 1e-6f;
constexpr float ATT_SCALE = 0.08838834764831845f;
constexpr int NWAVES = 8, NTHREADS = 512;

constexpr size_t MiB = 1u << 20;
constexpr size_t OFF_CTL = 0, CTL_ZERO_BYTES = 64 * 1024;
constexpr size_t OFF_PROJ = 1 * MiB;
constexpr size_t OFF_XB = 385 * MiB;
constexpr size_t OFF_WIN = 449 * MiB;
constexpr size_t OFF_WOUT = 461 * MiB;
constexpr size_t OFF_MEMKV = 467 * MiB;
constexpr size_t OFF_ROWSS = 483 * MiB;
constexpr size_t OFF_ROPE = 489 * MiB;
constexpr size_t OFF_LSE = 493 * MiB;
constexpr size_t OFF_WPT = 495 * MiB;
constexpr size_t OFF_WSM = OFF_WPT + 256 * 1024;
constexpr size_t OFF_LNP = 496 * MiB;
constexpr size_t WS_END = 500 * MiB;
constexpr size_t DO_MEMN = 0;
constexpr size_t DO_WMKV = 4 * MiB;
constexpr size_t DO_WIN = 12 * MiB;
constexpr size_t DO_WOUT = 52 * MiB;
constexpr int CW_BAR = 4096;

constexpr int RING_BYTES = 131072, LDSCTL_OFF = RING_BYTES, MISC_OFF = LDSCTL_OFF + 320, EPI_STG_OFF = LDSCTL_OFF + 1024, EPI_STG_WAVE = 16 * 144, LDS_BYTES = 151552;

__device__ __forceinline__ bf16_t* pcol(bf16_t* proj, int col) { return proj + (size_t)(col >> 8) * PS + (col & 255); }
__device__ __forceinline__ float bf2f(bf16_t h) { return __uint_as_float((unsigned)h << 16); }
__device__ __forceinline__ unsigned f2bf(float f) { unsigned u = __float_as_uint(f); return (u + 0x7fffu + ((u >> 16) & 1u)) >> 16; }
__device__ __forceinline__ unsigned pk2(float lo, float hi) { return f2bf(lo) | (f2bf(hi) << 16); }
__device__ __forceinline__ float wave_sum(float v) {
#pragma unroll
    for (int o = 1; o < 64; o <<= 1) v += __shfl_xor(v, o);
    return v;
}
__device__ __forceinline__ float wave_max(float v) {
#pragma unroll
    for (int o = 1; o < 64; o <<= 1) v = fmaxf(v, __shfl_xor(v, o));
    return v;
}
__device__ __forceinline__ float silu(float z) { return z / (1.f + __expf(-z)); }

__constant__ float c_inv_freq[16] = {1.0f, 0.44036659598350525f, 0.1939227432012558f, 0.08539710193872452f, 0.03760603070259094f, 0.01656043902039528f,
    0.007292664609849453f, 0.0032114458736032248f, 0.0014142135623842478f, 0.000622772378847003f, 0.00027424818836152554f, 0.00012076973507646471f,
    5.318296098266728e-05f, 2.34199997066753e-05f, 1.0313386155758053e-05f, 4.541670477919979e-06f};

namespace pg8 {
constexpr int BM = 256, BK = 64, HALF = 128, HTB = HALF * BK * 2, STAGE_BYTES = 8 * HTB, NXCD = 8, WGM = 8;
__host__ __device__ __forceinline__ int lds_byte(int r, int c) { const int st = (r >> 4) * 2 + (c >> 5), rr = r & 15, cc = c & 31, ob = rr * 64 + cc * 2; return st * 1024 + (ob ^ (((ob >> 9) & 1) << 5)); }
__host__ __device__ __forceinline__ void stage_rc(int b, int& R, int& C) { const int st = b / 1024, sb = b % 1024, swz = sb ^ (((sb >> 9) & 1) << 5); R = (st >> 1) * 16 + swz / 64; C = (st & 1) * 32 + (swz % 64) / 2; }
__host__ __device__ __forceinline__ int perm32(int rho) { const int n = rho >> 4, i = rho & 15; return 8 * (i >> 2) + 4 * n + (i & 3); }
struct Unit { int pm, pn; };
struct Gemm { const bf16_t* A; const bf16_t* Bt; int M, N, K, lda; size_t kpA = 512; };
struct StaticOrder {
    int nM, nN, nwg, G, c;
    __host__ __device__ void init(int M, int N, int G_, int c_) { nM = M / BM; nN = N / BM; nwg = nM * nN; G = G_; c = c_; }
    __host__ __device__ bool next(int i, Unit& u) const {
        const long L = (long)i * G + c; if (L >= nwg) return false;
        int wgid = (int)L; { const int q = nwg / NXCD, r = nwg % NXCD, xcd = wgid % NXCD, off = wgid / NXCD; wgid = (xcd < r ? xcd * (q + 1) : r * (q + 1) + (xcd - r) * q) + off; }
        const int nig = WGM * nN, gid = wgid / nig, fm = gid * WGM, gsz = (nM - fm) < WGM ? (nM - fm) : WGM;
        u.pm = fm + ((wgid % nig) % gsz); u.pn = (wgid % nig) / gsz; return true;
    }
    __device__ __forceinline__ void a_ready(const Unit&) const {}
    __device__ __forceinline__ void done(const Unit&) const {}
};
__device__ __forceinline__ unsigned cvt_pk_bf16(float lo, float hi) { unsigned r; asm volatile("v_cvt_pk_bf16_f32 %0, %1, %2" : "=v"(r) : "v"(lo), "v"(hi)); return r; }

struct EpiIn {
    static constexpr bool PERM = true, AFTER_DRAIN = false;
    bf16_t* O; int ldc; const float* rowss; const float2* rope; int nrope; float2* lnp = nullptr; int ln_pn0 = 0; size_t pstride = 0;
    LAS unsigned char* stg0 = nullptr;
    __device__ __forceinline__ void operator()(const f32x4 (&acc)[2][2][4][2], const Unit& u, int wr, int wc, int fr, int fq) const {
        const int row0 = u.pm * BM + wr * 64 + fr, lane = fr + 16 * fq;
        const bool rp = (u.pn < nrope) && ((wc & 1) == 0);
        const bool lnst = lnp && u.pn >= ln_pn0 && u.pn < ln_pn0 + 4;
        LAS unsigned char* stg = stg0 + (wr * 4 + wc) * EPI_STG_WAVE;
        float rs[2][4];
#pragma unroll
        for (int ai = 0; ai < 2; ++ai)
#pragma unroll
            for (int m = 0; m < 4; ++m) { rs[ai][m] = 1.f;
                if (rowss) { const f32x4 p = *(const f32x4*)(rowss + (size_t)(row0 + ai * HALF + m * 16) * 16 + 4 * fq); rs[ai][m] = (p[0] + p[1]) + (p[2] + p[3]); } }
        if (rowss) {
#pragma unroll
            for (int ai = 0; ai < 2; ++ai)
#pragma unroll
                for (int m = 0; m < 4; ++m) { float s = rs[ai][m]; s += __shfl_xor(s, 16); s += __shfl_xor(s, 32); rs[ai][m] = rsqrtf(s * (1.f / DM) + EPS); } }
#pragma unroll
        for (int ai = 0; ai < 2; ++ai) { f32x4 cs[4][4];
            if (rp) {
#pragma unroll
                for (int m = 0; m < 4; ++m) { const f32x4* cp = (const f32x4*)(rope + (size_t)(row0 + ai * HALF + m * 16) * 16 + 8 * (fq & 1));
#pragma unroll
                    for (int q = 0; q < 4; ++q) cs[m][q] = cp[q]; } }
#pragma unroll
            for (int m = 0; m < 4; ++m) { const float r = rs[ai][m]; float s1 = 0.f, s2 = 0.f;
#pragma unroll
                for (int bj = 0; bj < 2; ++bj) { float v[8];
#pragma unroll
                    for (int j = 0; j < 4; ++j) { v[j] = acc[ai][bj][m][0][j] * r; v[4 + j] = acc[ai][bj][m][1][j] * r; }
                    if (rp && bj == 0) {
#pragma unroll
                        for (int j = 0; j < 8; ++j) { const auto sw = __builtin_amdgcn_permlane32_swap(__float_as_uint(v[j]), __float_as_uint(v[j]), false, false);
                            const float pv = __uint_as_float(fq < 2 ? sw[1] : sw[0]); const float c = cs[m][j >> 1][(j & 1) * 2], sn = cs[m][j >> 1][(j & 1) * 2 + 1];
                            v[j] = (fq < 2) ? (v[j] * c - pv * sn) : (v[j] * c + pv * sn); } }
                    if (lnst) {
#pragma unroll
                        for (int j = 0; j < 8; ++j) { s1 += v[j]; s2 += v[j] * v[j]; } }
                    u32x4 w; w.x = cvt_pk_bf16(v[0], v[1]); w.y = cvt_pk_bf16(v[2], v[3]); w.z = cvt_pk_bf16(v[4], v[5]); w.w = cvt_pk_bf16(v[6], v[7]);
                    *(LAS u32x4*)(stg + fr * 144 + bj * 64 + fq * 16) = w; }
                if (lnst) { s1 += __shfl_xor(s1, 16); s1 += __shfl_xor(s1, 32); s2 += __shfl_xor(s2, 16); s2 += __shfl_xor(s2, 32);
                    if (fq == 0) lnp[(size_t)(row0 + ai * HALF + m * 16) * 16 + (u.pn - ln_pn0) * 4 + wc] = make_float2(s1, s2); }
#pragma unroll
                for (int q = 0; q < 2; ++q) { const int rr = q * 8 + (lane >> 3), ch = lane & 7; const u32x4 t = *(const LAS u32x4*)(stg + rr * 144 + ch * 16);
                    const size_t grow = (size_t)(u.pm * BM + wr * 64 + ai * HALF + m * 16 + rr);
                    bf16_t* dst = pstride ? O + (size_t)u.pn * pstride + grow * PR + wc * 64 + ch * 8 : O + grow * ldc + u.pn * BM + wc * 64 + ch * 8;
                    *(u32x4*)dst = t; } } }
    }
};
struct EpiOut {
    static constexpr bool PERM = true, AFTER_DRAIN = false;
    const float* base32; bf16_t* xb; float* rowss;
    __device__ __forceinline__ void operator()(const f32x4 (&acc)[2][2][4][2], const Unit& u, int wr, int wc, int fr, int fq) const {
        const int row0 = u.pm * BM + wr * 64 + fr, col0 = u.pn * BM + wc * 64 + 8 * fq;
#pragma unroll
        for (int ai = 0; ai < 2; ++ai) { f32x4 o[4][2][2];
            if (base32) {
#pragma unroll
                for (int m = 0; m < 4; ++m) { const size_t off = (size_t)(row0 + ai * HALF + m * 16) * DM + col0;
#pragma unroll
                    for (int bj = 0; bj < 2; ++bj)
#pragma unroll
                        for (int n = 0; n < 2; ++n) o[m][bj][n] = *(const f32x4*)(base32 + off + bj * 32 + n * 4); }
            } else {
                u32x4 w[4][2];
#pragma unroll
                for (int m = 0; m < 4; ++m) { const size_t off = (size_t)(row0 + ai * HALF + m * 16) * DM + col0;
#pragma unroll
                    for (int bj = 0; bj < 2; ++bj) w[m][bj] = *(const u32x4*)(xb + off + bj * 32); }
#pragma unroll
                for (int m = 0; m < 4; ++m)
#pragma unroll
                    for (int bj = 0; bj < 2; ++bj) {
                        o[m][bj][0] = (f32x4){__uint_as_float(w[m][bj].x << 16), __uint_as_float(w[m][bj].x & 0xffff0000u), __uint_as_float(w[m][bj].y << 16), __uint_as_float(w[m][bj].y & 0xffff0000u)};
                        o[m][bj][1] = (f32x4){__uint_as_float(w[m][bj].z << 16), __uint_as_float(w[m][bj].z & 0xffff0000u), __uint_as_float(w[m][bj].w << 16), __uint_as_float(w[m][bj].w & 0xffff0000u)}; }
            }
#pragma unroll
            for (int m = 0; m < 4; ++m) { const int row = row0 + ai * HALF + m * 16; const size_t off = (size_t)row * DM + col0; float ss = 0.f;
#pragma unroll
                for (int bj = 0; bj < 2; ++bj) { const f32x4 v0 = o[m][bj][0] + acc[ai][bj][m][0], v1 = o[m][bj][1] + acc[ai][bj][m][1];
                    ss += ((v0[0] * v0[0] + v0[1] * v0[1]) + (v0[2] * v0[2] + v0[3] * v0[3])) + ((v1[0] * v1[0] + v1[1] * v1[1]) + (v1[2] * v1[2] + v1[3] * v1[3]));
                    u32x4 wv; wv.x = cvt_pk_bf16(v0[0], v0[1]); wv.y = cvt_pk_bf16(v0[2], v0[3]); wv.z = cvt_pk_bf16(v1[0], v1[1]); wv.w = cvt_pk_bf16(v1[2], v1[3]);
                    *(u32x4*)(xb + off + bj * 32) = wv; }
                ss += __shfl_xor(ss, 16); ss += __shfl_xor(ss, 32);
                if (fq == 0) rowss[(size_t)row * 16 + u.pn * 4 + wc] = ss; } }
    }
};

template <class Epi, class Sched, bool ALIGN_EPI = false, bool SP2 = false>
__device__ __forceinline__ void gemm_phase(LAS unsigned char* lds, const Gemm g, const Sched& S, const Epi& E, int tid_in) {
    int tid_ = tid_in; asm volatile("" : "+v"(tid_));
    const int tid = tid_, wid = __builtin_amdgcn_readfirstlane(tid >> 6), lane = tid & 63, wr = wid >> 2, wc = wid & 3, fr = lane & 15, fq = lane >> 4;
    const int K = g.K, nt = K / BK, lda = g.lda;
    unsigned voffA[2], voffB[2];
#pragma unroll
    for (int i = 0; i < 2; ++i) { int R, C; stage_rc(tid * 16 + i * 8192, R, C); const int Rb = Epi::PERM ? ((R >> 5) * 64 + perm32(R & 31)) : R;
        voffA[i] = (unsigned)(R * lda + C) * 2u; voffB[i] = (unsigned)(Rb * K + C) * 2u; }
    const size_t kstep = (size_t)(BK * 2);
    const size_t kpA = g.kpA;
#define PG8_KA(t_) ((size_t)((t_) >> 2) * kpA + (size_t)((t_) & 3) * kstep)
    const size_t hstepA = (size_t)HALF * lda * 2, hstepB = (size_t)(Epi::PERM ? 32 : HALF) * K * 2;
    const size_t tstepA = 2 * hstepA, tstepB = (size_t)BM * K * 2;
    const unsigned ldsw = (unsigned)wid * 1024u;
    const int aoff = lds_byte(wr * 64 + fr, fq * 8), boff = lds_byte(wc * 32 + fr, fq * 8);
#define PG8_SA(b, h) (((b) * 2 + (h)) * HTB)
#define PG8_SB(b, h) ((4 + (b) * 2 + (h)) * HTB)
#define PG8_STAGE(bufoff, gbase, voff) do { _Pragma("unroll") for (int _i = 0; _i < 2; ++_i) \
        __builtin_amdgcn_global_load_lds((const unsigned*)((const char*)(gbase) + (voff)[_i]), (LAS unsigned*)(lds + (bufoff) + ldsw + _i * 8192), 16, 0, 0); } while (0)
#define PG8_LDA(dst, b, h) do { _Pragma("unroll") for (int m = 0; m < 4; ++m) _Pragma("unroll") for (int k = 0; k < 2; ++k) dst[m][k] = *(const LAS bf16x8*)(lds + PG8_SA(b, h) + aoff + m * 2048 + k * 1024); } while (0)
#define PG8_LDB(dst, b, h) do { _Pragma("unroll") for (int n = 0; n < 2; ++n) _Pragma("unroll") for (int k = 0; k < 2; ++k) dst[n][k] = *(const LAS bf16x8*)(lds + PG8_SB(b, h) + boff + n * 2048 + k * 1024); } while (0)
#define PG8_MMA(ai, bj, At, Bt) do { __builtin_amdgcn_s_setprio(1); _Pragma("unroll") for (int m = 0; m < 4; ++m) _Pragma("unroll") for (int n = 0; n < 2; ++n) _Pragma("unroll") for (int k = 0; k < 2; ++k) \
        acc[ai][bj][m][n] = __builtin_amdgcn_mfma_f32_16x16x32_bf16(Bt[n][k], At[m][k], acc[ai][bj][m][n], 0, 0, 0); __builtin_amdgcn_s_setprio(0); } while (0)
#define PG8_WAIT_V(n) asm volatile("s_waitcnt vmcnt(" #n ")" ::: "memory")
#define PG8_WAIT_L(n) asm volatile("s_waitcnt lgkmcnt(" #n ")" ::: "memory")
#define PG8_BAR __builtin_amdgcn_s_barrier()
#define PG8_SCHED __builtin_amdgcn_sched_barrier(0)
    Unit cur, nxt; int ui = 0;
    if (!S.next(0, cur)) return;
    f32x4 acc[2][2][4][2];
#pragma unroll
    for (int a = 0; a < 2; ++a)
#pragma unroll
        for (int b = 0; b < 2; ++b)
#pragma unroll
            for (int m = 0; m < 4; ++m)
#pragma unroll
                for (int n = 0; n < 2; ++n) acc[a][b][m][n] = (f32x4){0.f, 0.f, 0.f, 0.f};
    bf16x8 At[4][2], B0[2][2], B1[2][2];
    const char* cA = (const char*)g.A + (size_t)cur.pm * tstepA; const char* cB = (const char*)g.Bt + (size_t)cur.pn * tstepB;
    S.a_ready(cur);
    if constexpr (SP2) {
        PG8_STAGE(PG8_SB(0, 0), cB, voffB); PG8_STAGE(PG8_SB(0, 1), cB + hstepB, voffB); PG8_STAGE(PG8_SA(0, 0), cA, voffA); PG8_STAGE(PG8_SA(0, 1), cA + hstepA, voffA);
        if (wr == 1) PG8_BAR;
        PG8_WAIT_V(2); PG8_BAR;
        PG8_STAGE(PG8_SB(1, 0), cB + kstep, voffB); PG8_STAGE(PG8_SA(1, 0), cA + PG8_KA(1), voffA); PG8_STAGE(PG8_SB(1, 1), cB + hstepB + kstep, voffB);
        PG8_WAIT_V(6); PG8_BAR;
    } else {
        PG8_STAGE(PG8_SB(0, 0), cB, voffB); PG8_STAGE(PG8_SA(0, 0), cA, voffA); PG8_STAGE(PG8_SB(0, 1), cB + hstepB, voffB); PG8_STAGE(PG8_SA(0, 1), cA + hstepA, voffA);
        if (wr == 1) PG8_BAR;
        PG8_WAIT_V(4); PG8_BAR;
        PG8_STAGE(PG8_SB(1, 0), cB + kstep, voffB); PG8_STAGE(PG8_SA(1, 0), cA + PG8_KA(1), voffA); PG8_STAGE(PG8_SB(1, 1), cB + hstepB + kstep, voffB);
        PG8_WAIT_V(6); PG8_BAR;
    }
    for (;;) {
        const bool has_next = S.next(ui + 1, nxt);
        const char* nA = has_next ? (const char*)g.A + (size_t)nxt.pm * tstepA : cA; const char* nB = has_next ? (const char*)g.Bt + (size_t)nxt.pn * tstepB : cB;
        for (int t = 0; t < nt; t += 2) {
            const bool last = (t == nt - 2);
            const char* a1 = cA + PG8_KA(t + 1);
            const char* a2 = last ? nA : cA + PG8_KA(t + 2); const char* b2 = last ? nB : cB + (size_t)(t + 2) * kstep;
            const char* a3 = last ? nA + PG8_KA(1) : cA + PG8_KA(t + 3); const char* b3 = b2 + kstep;
            if (last && has_next) S.a_ready(nxt);
            if constexpr (SP2) {
            PG8_LDB(B0, 0, 0); PG8_LDB(B1, 0, 1); PG8_SCHED; PG8_LDA(At, 0, 0); PG8_STAGE(PG8_SA(1, 1), a1 + hstepA, voffA);
            PG8_WAIT_V(8); PG8_WAIT_L(0); PG8_BAR; PG8_MMA(0, 0, At, B0); PG8_MMA(0, 1, At, B1); PG8_BAR; PG8_SCHED;
            PG8_LDA(At, 0, 1); PG8_STAGE(PG8_SB(0, 0), b2, voffB); PG8_STAGE(PG8_SB(0, 1), b2 + hstepB, voffB); PG8_STAGE(PG8_SA(0, 0), a2, voffA);
            PG8_WAIT_V(8); PG8_WAIT_L(0); PG8_BAR; PG8_MMA(1, 0, At, B0); PG8_MMA(1, 1, At, B1); PG8_BAR; PG8_SCHED;
            PG8_LDB(B0, 1, 0); PG8_LDB(B1, 1, 1); PG8_SCHED; PG8_LDA(At, 1, 0); PG8_STAGE(PG8_SA(0, 1), a2 + hstepA, voffA);
            PG8_WAIT_V(8); PG8_WAIT_L(0); PG8_BAR; PG8_MMA(0, 0, At, B0); PG8_MMA(0, 1, At, B1); PG8_BAR; PG8_SCHED;
            PG8_LDA(At, 1, 1); PG8_STAGE(PG8_SB(1, 0), b3, voffB); PG8_STAGE(PG8_SB(1, 1), b3 + hstepB, voffB); PG8_STAGE(PG8_SA(1, 0), a3, voffA);
            PG8_WAIT_V(8); PG8_WAIT_L(0); PG8_BAR; PG8_MMA(1, 0, At, B0); PG8_MMA(1, 1, At, B1); PG8_BAR; PG8_SCHED;
            } else {
            PG8_LDB(B0, 0, 0); PG8_SCHED; PG8_LDA(At, 0, 0); PG8_STAGE(PG8_SA(1, 1), a1 + hstepA, voffA);
            PG8_WAIT_L(8); PG8_BAR; PG8_WAIT_L(0); PG8_MMA(0, 0, At, B0); PG8_BAR; PG8_SCHED;
            PG8_LDB(B1, 0, 1); PG8_STAGE(PG8_SB(0, 0), b2, voffB);
            PG8_BAR; PG8_WAIT_L(0); PG8_MMA(0, 1, At, B1); PG8_BAR;
            PG8_LDA(At, 0, 1); PG8_STAGE(PG8_SA(0, 0), a2, voffA);
            PG8_BAR; PG8_WAIT_L(0); PG8_MMA(1, 0, At, B0); PG8_BAR; PG8_SCHED;
            PG8_STAGE(PG8_SB(0, 1), b2 + hstepB, voffB);
            PG8_WAIT_V(6); PG8_BAR; PG8_MMA(1, 1, At, B1); PG8_BAR;
            PG8_LDB(B0, 1, 0); PG8_SCHED; PG8_LDA(At, 1, 0); PG8_STAGE(PG8_SA(0, 1), a2 + hstepA, voffA);
            PG8_WAIT_L(8); PG8_BAR; PG8_WAIT_L(0); PG8_MMA(0, 0, At, B0); PG8_BAR; PG8_SCHED;
            PG8_LDB(B1, 1, 1); PG8_STAGE(PG8_SB(1, 0), b3, voffB);
            PG8_BAR; PG8_WAIT_L(0); PG8_MMA(0, 1, At, B1); PG8_BAR;
            PG8_LDA(At, 1, 1); PG8_STAGE(PG8_SA(1, 0), a3, voffA);
            PG8_BAR; PG8_WAIT_L(0); PG8_MMA(1, 0, At, B0); PG8_BAR; PG8_SCHED;
            PG8_STAGE(PG8_SB(1, 1), b3 + hstepB, voffB);
            PG8_WAIT_V(6); PG8_BAR; PG8_MMA(1, 1, At, B1); PG8_BAR;
            }
        }
        if constexpr (ALIGN_EPI) { if (wr == 0) PG8_BAR; }
        if constexpr (!Epi::AFTER_DRAIN) { E(acc, cur, wr, wc, fr, fq); S.done(cur); }
        if (!has_next) break;
#pragma unroll
        for (int a = 0; a < 2; ++a)
#pragma unroll
            for (int b = 0; b < 2; ++b)
#pragma unroll
                for (int m = 0; m < 4; ++m)
#pragma unroll
                    for (int n = 0; n < 2; ++n) acc[a][b][m][n] = (f32x4){0.f, 0.f, 0.f, 0.f};
        cur = nxt; cA = nA; cB = nB; ++ui;
        if constexpr (ALIGN_EPI) { if (wr == 1) PG8_BAR; }
    }
    PG8_WAIT_V(0);
    if constexpr (!ALIGN_EPI) { if (wr == 0) PG8_BAR; }
    PG8_BAR;
#undef PG8_KA
#undef PG8_SA
#undef PG8_SB
#undef PG8_STAGE
#undef PG8_LDA
#undef PG8_LDB
#undef PG8_MMA
#undef PG8_WAIT_V
#undef PG8_WAIT_L
#undef PG8_BAR
#undef PG8_SCHED
}
}


namespace att {
typedef short s16x4 __attribute__((ext_vector_type(4)));
typedef float f32x16 __attribute__((ext_vector_type(16)));
constexpr int D = 128, NW = 8, QBLK = 32, KVBLK = 64, QB = NW * QBLK;
constexpr int SHM_V = KVBLK * D * 2, SHM_K = KVBLK * D * 2;
constexpr int ATT_LDS_BYTES = 2 * SHM_V + 2 * SHM_K + NW * 64 * 4;
constexpr float SCALE = 0.08838834764831845f, THR = 8.f;
#define KSWZ(row, colB) ((row) * 256 + ((colB) ^ (((row) & 7) << 4)))
#define SBAR() __builtin_amdgcn_sched_barrier(0)
__device__ __forceinline__ int v_st(int k, int c) { const int kk = (k & ~0xC) | ((k & 4) << 1) | ((k & 8) >> 1); return ((kk >> 3) * 4 + (c >> 5)) * 512 + ((kk & 7) * 32 + (c & 31)) * 2; }
__device__ __forceinline__ int v_rd_base(int lane) { return ((lane & 3) << 3) | (((lane >> 2) & 3) << 6) | (((lane >> 4) & 1) << 5) | (((lane >> 5) & 1) << 8); }
constexpr int v_rd_off(int d0, int ks, int half) { return d0 * 512 + ks * 4096 + half * 2048; }
__device__ __forceinline__ int crow(int r, int hi) { return (r & 3) + 8 * (r >> 2) + 4 * hi; }
__device__ __forceinline__ unsigned cvtpk(float lo, float hi) { unsigned r; asm volatile("v_cvt_pk_bf16_f32 %0, %1, %2" : "=v"(r) : "v"(lo), "v"(hi)); return r; }
__device__ __forceinline__ bf16x8 load8(const bf16_t* p) { return *reinterpret_cast<const bf16x8*>(p); }
__device__ __forceinline__ void mask_tile(f32x16& p0, f32x16& p1, int dq, unsigned W) {
    const float NEG = -__builtin_inff();
#pragma unroll
    for (int r = 0; r < 16; ++r) { const int c = (r & 3) + 8 * (r >> 2);
        if ((unsigned)(dq - c) >= W) p0[r] = NEG;
        if ((unsigned)(dq - c - 32) >= W) p1[r] = NEG; }
}
__device__ __forceinline__ void partialSM(f32x16& p0, f32x16& p1, float& m_reg, float& mn, float& alpha) {
    float pmax = p0[0]; for (int r = 1; r < 16; ++r) pmax = fmaxf(pmax, p0[r]); for (int r = 0; r < 16; ++r) pmax = fmaxf(pmax, p1[r]);
    { auto rr = __builtin_amdgcn_permlane32_swap(__float_as_uint(pmax), __float_as_uint(pmax), false, false);
      pmax = fmaxf(__uint_as_float(rr[0]), __uint_as_float(rr[1])); }
    constexpr float C2 = 1.4426950408889634f * SCALE;
    if (__builtin_expect(__all((pmax - m_reg) * SCALE <= THR), 1)) { mn = m_reg; alpha = 1.f; }
    else { mn = fmaxf(m_reg, pmax); alpha = __builtin_amdgcn_exp2f((m_reg - mn) * C2); m_reg = mn; }
    const float mnL = -mn * C2;
    for (int r = 0; r < 16; ++r) p0[r] = fmaf(p0[r], C2, mnL); for (int r = 0; r < 16; ++r) p1[r] = fmaf(p1[r], C2, mnL);
    for (int r = 0; r < 16; ++r) p0[r] = __builtin_amdgcn_exp2f(p0[r]);
}
__device__ __forceinline__ void finishSM(f32x16& p0, f32x16& p1, float alpha, float& l_reg, bf16x8& pa0, bf16x8& pa1, bf16x8& pa2, bf16x8& pa3) {
    for (int r = 0; r < 16; ++r) p1[r] = __builtin_amdgcn_exp2f(p1[r]);
    float ps = 0; for (int r = 0; r < 16; ++r) ps += p0[r]; for (int r = 0; r < 16; ++r) ps += p1[r];
    { auto rr = __builtin_amdgcn_permlane32_swap(__float_as_uint(ps), __float_as_uint(ps), false, false);
      ps = __uint_as_float(rr[0]) + __uint_as_float(rr[1]); }
    l_reg = l_reg * alpha + ps;
#define PK4(P, B_, OUT) do { unsigned a0 = cvtpk(P[B_+0], P[B_+1]), a1 = cvtpk(P[B_+2], P[B_+3]);                          \
        unsigned b0 = cvtpk(P[B_+4], P[B_+5]), b1 = cvtpk(P[B_+6], P[B_+7]);                                             \
        auto r0 = __builtin_amdgcn_permlane32_swap(a0, b0, false, false); auto r1 = __builtin_amdgcn_permlane32_swap(a1, b1, false, false); \
        u32x4 w = {r0[0], r1[0], r0[1], r1[1]}; OUT = *reinterpret_cast<bf16x8*>(&w); } while (0)
    PK4(p0, 0, pa0); PK4(p0, 8, pa1); PK4(p1, 0, pa2); PK4(p1, 8, pa3);
#undef PK4
}
template <int KB>
__device__ __forceinline__ void qkt(f32x16& p0, f32x16& p1, const char* K_lds, int r32, int hi, const bf16x8* qr, bool act) {
    if (!act) { const float NEG = -__builtin_inff();
#pragma unroll
        for (int r = 0; r < 16; ++r) { p0[r] = NEG; p1[r] = NEG; } return; }
    p0 = f32x16{}; p1 = f32x16{};
    const char* kb[4];
#pragma unroll
    for (int dd = 0; dd < 4; ++dd) kb[dd] = K_lds + KB * SHM_K + KSWZ(r32, (dd * 16 + hi * 8) * 2);
#pragma unroll
    for (int d0 = 0; d0 < 8; ++d0) { const char* a = kb[d0 & 3] + (d0 >> 2) * 128;
        bf16x8 b0 = *reinterpret_cast<const bf16x8*>(a);
        bf16x8 b1 = *reinterpret_cast<const bf16x8*>(a + 32 * 256);
        p0 = __builtin_amdgcn_mfma_f32_32x32x16_bf16(b0, qr[d0], p0, 0, 0, 0);
        p1 = __builtin_amdgcn_mfma_f32_32x32x16_bf16(b1, qr[d0], p1, 0, 0, 0); }
}
template <int VB>
__device__ __forceinline__ void pv_tile(f32x16* o, int vb0, bf16x8 pa0, bf16x8 pa1, bf16x8 pa2, bf16x8 pa3, bool act) {
    if (!act) return;
#define TRRD(dst, off) asm volatile("ds_read_b64_tr_b16 %0, %1 offset:%2" : "=&v"(dst) : "v"(vb0), "i"(off) : "memory")
#define PV_D0(d0) do { s16x4 l0, l1, l2, l3, h0, h1, h2, h3; constexpr int b_ = VB * SHM_V + v_rd_off(d0, 0, 0); \
        TRRD(l0, b_); TRRD(h0, b_ + 2048); TRRD(l1, b_ + 4096); TRRD(h1, b_ + 6144); TRRD(l2, b_ + 8192); TRRD(h2, b_ + 10240); TRRD(l3, b_ + 12288); TRRD(h3, b_ + 14336); \
        asm volatile("s_waitcnt lgkmcnt(0)" ::: "memory"); SBAR();   \
        o[d0] = __builtin_amdgcn_mfma_f32_32x32x16_bf16(pa0, (bf16x8){l0[0], l0[1], l0[2], l0[3], h0[0], h0[1], h0[2], h0[3]}, o[d0], 0, 0, 0);   \
        o[d0] = __builtin_amdgcn_mfma_f32_32x32x16_bf16(pa1, (bf16x8){l1[0], l1[1], l1[2], l1[3], h1[0], h1[1], h1[2], h1[3]}, o[d0], 0, 0, 0);   \
        o[d0] = __builtin_amdgcn_mfma_f32_32x32x16_bf16(pa2, (bf16x8){l2[0], l2[1], l2[2], l2[3], h2[0], h2[1], h2[2], h2[3]}, o[d0], 0, 0, 0);   \
        o[d0] = __builtin_amdgcn_mfma_f32_32x32x16_bf16(pa3, (bf16x8){l3[0], l3[1], l3[2], l3[3], h3[0], h3[1], h3[2], h3[3]}, o[d0], 0, 0, 0); } while (0)
    PV_D0(0); PV_D0(1); PV_D0(2); PV_D0(3);
#undef PV_D0
#undef TRRD
}
struct BlockRef { const bf16_t* Q; const bf16_t* K; const bf16_t* V; bf16_t* O; float* lse; int P0, pq, pk, skv, W, lsep, mode; };
struct Seam { bf16x8 qr[8]; bf16x8 st_v0, st_v1, st_k0, st_k1; };
__device__ __forceinline__ int swa_jlo(int P0, int W) { const int lowk = P0 - W + 1; return lowk > 0 ? lowk / KVBLK : 0; }
#define ROWK(p, k0, rr, pk_) ((const bf16_t*)((const char*)(p) + (size_t)(unsigned)((((unsigned)((k0) + (rr))) * (unsigned)(pk_) + (unsigned)sc) * 2u)))
#define VMW() asm volatile("s_waitcnt vmcnt(0)" ::: "memory")
#define VMWN(n) asm volatile("s_waitcnt vmcnt(%0)" :: "i"(n) : "memory")
#define SLOAD_H(Kp, Vp, k0, pk_) do { S.st_v0 = load8(ROWK(Vp, k0, sr, pk_)); S.st_v1 = load8(ROWK(Vp, k0, 32 + sr, pk_));              \
                         S.st_k0 = load8(ROWK(Kp, k0, sr, pk_)); S.st_k1 = load8(ROWK(Kp, k0, 32 + sr, pk_)); } while (0)
#define SWRITE_HK(bf) do { *(bf16x8*)(K_lds + (bf) * SHM_K + kws) = S.st_k0; *(bf16x8*)(K_lds + (bf) * SHM_K + kws + 32 * 256) = S.st_k1; } while (0)
#define SWRITE_HV(bf) do { *(bf16x8*)(V_lds + (bf) * SHM_V + vst0) = S.st_v0; *(bf16x8*)(V_lds + (bf) * SHM_V + vst1) = S.st_v1; } while (0)
#define SWRITE_H(bf) do { SWRITE_HV(bf); SWRITE_HK(bf); } while (0)
__device__ __forceinline__ void swa_prime(const BlockRef& cur, char* lds, Seam& S, int tid) {
    const int wid = __builtin_amdgcn_readfirstlane(tid >> 6), lane = tid & 63, r32 = lane & 31, hi = lane >> 5;
    const int sr = tid >> 4, sc = (tid & 15) * 8, kws = KSWZ(sr, sc * 2); char* K_lds = lds + 2 * SHM_V;
    const int kb0 = swa_jlo(cur.P0, cur.W) * KVBLK;
    { const unsigned qoff = ((unsigned)(wid * QBLK + r32) * (unsigned)cur.pq + (unsigned)hi * 8u) * 2u;
      for (int d0 = 0; d0 < 8; ++d0) S.qr[d0] = *(const bf16x8*)((const char*)cur.Q + (size_t)qoff + d0 * 32); }
    SLOAD_H(cur.K, cur.V, kb0, cur.pk); VMW(); SWRITE_HK(0);
    __syncthreads();
}
__device__ __forceinline__ void swa_block(const BlockRef& cur, const BlockRef& nxt, char* lds, Seam& S, int tid) {
    const int wid = __builtin_amdgcn_readfirstlane(tid >> 6), lane = tid & 63, r32 = lane & 31, hi = lane >> 5;
    const int W = cur.W, pk = cur.pk;
    const int j_lo = swa_jlo(cur.P0, W);
    int j_hi = (cur.P0 + QB - 1) / KVBLK + 1; if (j_hi > cur.skv / KVBLK) j_hi = cur.skv / KVBLK;
    const int NT = j_hi - j_lo;
    const int kbn = swa_jlo(nxt.P0, nxt.W) * KVBLK;
    const int qlo = cur.P0 + wid * QBLK, qm = qlo + r32 - 4 * hi;
    char* V_lds = lds; char* K_lds = lds + 2 * SHM_V;
    float* ws = (float*)(lds + 2 * SHM_V + 2 * SHM_K) + wid * 64; float* li_l = ws, * al_l = ws + 32;
    float m_reg = -1e30f, l_reg = 0; f32x16 o[4] = {};
    const int sr = tid >> 4, sc = (tid & 15) * 8, vst0 = v_st(sr, sc), vst1 = v_st(32 + sr, sc), kws = KSWZ(sr, sc * 2);
    const int vb0 = (int)(uintptr_t)V_lds + v_rd_base(lane);
    const bf16_t* Kh = cur.K; const bf16_t* Vh = cur.V;
#define RESC(a) do { if (__any((a) < 1.f)) { if (hi == 0) al_l[r32] = (a); asm volatile("s_waitcnt lgkmcnt(0)" ::: "memory");              \
                     for (int d_ = 0; d_ < 4; ++d_) for (int r = 0; r < 16; ++r) o[d_][r] *= al_l[crow(r, hi)]; } } while (0)
#define KBASE(t) ((j_lo + (t)) * KVBLK)
#define ACT(t) (KBASE(t) <= qlo + QBLK - 1 && KBASE(t) + KVBLK - 1 >= qlo - W + 1)
#define MASKT(P0_, P1_, t) do { const int kb_ = KBASE(t); if (ACT(t) && (kb_ + KVBLK - 1 > qlo || kb_ <= qlo + QBLK - 1 - W)) mask_tile(P0_, P1_, qm - kb_, (unsigned)W); } while (0)
    constexpr int NQL = 8;
#define SEAM_K0() do { VMWN(NQL); SWRITE_HK(0); SBAR(); } while (0)
    f32x16 pA0, pA1, pB0, pB1; float mnA, mnB, alA, alB; bf16x8 pa0, pa1, pa2, pa3;
    SWRITE_HV(0); SBAR();
    if (NT > 1) { SLOAD_H(Kh, Vh, KBASE(1), pk); }
    SBAR(); qkt<0>(pA0, pA1, K_lds, r32, hi, S.qr, ACT(0));
    MASKT(pA0, pA1, 0); partialSM(pA0, pA1, m_reg, mnA, alA);
    if (NT > 1) { VMW(); SWRITE_H(1); }
    __syncthreads();
#define HALF_STEP(PX0, PX1, mnX, alX, PY0, PY1, alY, t, KB, VB, SB) do {                                                      \
        SBAR(); if ((t) + 1 < NT) { SLOAD_H(Kh, Vh, KBASE((t) + 1), pk); SBAR(); }                               \
        qkt<KB>(PX0, PX1, K_lds, r32, hi, S.qr, ACT(t));                                             \
        finishSM(PY0, PY1, alY, l_reg, pa0, pa1, pa2, pa3); SBAR();                                                           \
        pv_tile<VB>(o, vb0, pa0, pa1, pa2, pa3, ACT((t) - 1)); MASKT(PX0, PX1, (t)); partialSM(PX0, PX1, m_reg, mnX, alX);                                        \
        __syncthreads();                                                                                                      \
        if ((t) + 1 < NT) { VMW(); SWRITE_H(SB); }                                                                          \
        RESC(alX); __syncthreads(); } while (0)
    for (int t = 1; t + 1 < NT; t += 2) {
        HALF_STEP(pB0, pB1, mnB, alB, pA0, pA1, alA, t, 1, 0, 0);
        HALF_STEP(pA0, pA1, mnA, alA, pB0, pB1, alB, t + 1, 0, 1, 1);
    }
    const bool even = (NT & 1) == 0;
    if (even) { SBAR(); qkt<1>(pB0, pB1, K_lds, r32, hi, S.qr, ACT(NT - 1)); SBAR(); }
    { SLOAD_H(nxt.K, nxt.V, kbn, nxt.pk); SBAR();
        const unsigned qoff = ((unsigned)(wid * QBLK + r32) * (unsigned)nxt.pq + (unsigned)hi * 8u) * 2u;
#pragma unroll
        for (int d0 = 0; d0 < 8; ++d0) S.qr[d0] = *(const bf16x8*)((const char*)nxt.Q + (size_t)qoff + d0 * 32); }
    SBAR();
    finishSM(pA0, pA1, alA, l_reg, pa0, pa1, pa2, pa3); SBAR();
    pv_tile<0>(o, vb0, pa0, pa1, pa2, pa3, ACT(even ? NT - 2 : NT - 1));
    if (even) { MASKT(pB0, pB1, NT - 1); partialSM(pB0, pB1, m_reg, mnB, alB); __syncthreads(); RESC(alB);
        finishSM(pB0, pB1, alB, l_reg, pa0, pa1, pa2, pa3); SBAR(); pv_tile<1>(o, vb0, pa0, pa1, pa2, pa3, ACT(NT - 1)); }
    SBAR(); SEAM_K0();
    if (hi == 0) li_l[r32] = l_reg; asm volatile("s_waitcnt lgkmcnt(0)" ::: "memory");
    float rli[16];
#pragma unroll
    for (int r = 0; r < 16; ++r) rli[r] = __builtin_amdgcn_rcpf(li_l[crow(r, hi)]);
    int r32e = r32, hie = hi, lne = lane; asm volatile("" : "+v"(r32e), "+v"(hie), "+v"(lne));
    bf16_t* Ow = cur.O + (size_t)(wid * QBLK) * cur.pq;
    const unsigned pqu = (unsigned)cur.pq;
    if (cur.mode == 2) {
        float sink = 0.f;
#pragma unroll
        for (int r = 0; r < 16; ++r)
#pragma unroll
            for (int d0 = 0; d0 < 4; ++d0) sink += o[d0][r] * rli[r];
        asm volatile("" :: "v"(sink), "v"(m_reg));
    } else {
        if (cur.mode == 0 && hie == 0) cur.lse[(size_t)(wid * QBLK + r32e) * cur.lsep] = m_reg * SCALE + __logf(l_reg);
        char* stg = lds + ATT_LDS_BYTES + wid * (32 * 144);
        const unsigned goff = ((unsigned)(lne >> 3) * pqu + (unsigned)(lne & 7) * 8u) * 2u;
#pragma unroll
        for (int h2 = 0; h2 < 2; ++h2) {
#pragma unroll
            for (int r = 0; r < 16; ++r) { const int orow = (r & 3) + 8 * (r >> 2) + 4 * hie;
#pragma unroll
                for (int dd = 0; dd < 2; ++dd) *(bf16_t*)(stg + orow * 144 + (dd * 32 + r32e) * 2) = (bf16_t)(cvtpk(o[2 * h2 + dd][r] * rli[r], 0.f) & 0xffffu); }
            u32x4 ov[4], zv[4];
#pragma unroll
            for (int j = 0; j < 4; ++j) ov[j] = *(const u32x4*)(stg + (j * 8 + (lne >> 3)) * 144 + (lne & 7) * 16);
            char* gp = (char*)Ow + (size_t)goff + h2 * 128;
            if (cur.mode == 1) {
#pragma unroll
                for (int j = 0; j < 4; ++j) zv[j] = *(const u32x4*)(gp + (size_t)(j * 8) * pqu * 2u);
#pragma unroll
                for (int j = 0; j < 4; ++j)
#pragma unroll
                    for (int e = 0; e < 4; ++e) ov[j][e] = cvtpk(__uint_as_float(ov[j][e] << 16) * silu(__uint_as_float(zv[j][e] << 16)), __uint_as_float(ov[j][e] & 0xffff0000u) * silu(__uint_as_float(zv[j][e] & 0xffff0000u)));
            }
#pragma unroll
            for (int j = 0; j < 4; ++j) *(u32x4*)(gp + (size_t)(j * 8) * pqu * 2u) = ov[j];
        }
    }
    __syncthreads();
#undef RESC
#undef KBASE
#undef ACT
#undef MASKT
#undef SEAM_K0
#undef HALF_STEP
}
#undef ROWK
#undef VMW
#undef VMWN
#undef SLOAD_H
#undef SWRITE_HK
#undef SWRITE_HV
#undef SWRITE_H
#undef KSWZ
#undef SBAR
}

typedef GAS unsigned gu32;
#define RLX_AGENT __ATOMIC_RELAXED, __HIP_MEMORY_SCOPE_AGENT
#define XB_TMO      128
#define XB_XCNT(j)  (256  + 64 * (j))
#define XB_XSUB(j)  (1280 + 64 * (j))
#define XB_XGEN(j)  (2304 + 64 * (j))
#define XB_TOP      3328
#define XB_TOPGEN   3392
#define XCD_BAR_WORDS 3456
#define XB_SPIN_CAP (1u << 18)
__device__ __forceinline__ unsigned xb_ld(unsigned* p)              { return __hip_atomic_load(p, __ATOMIC_RELAXED, __HIP_MEMORY_SCOPE_AGENT); }
__device__ __forceinline__ unsigned xb_add(unsigned* p, unsigned v) { return __hip_atomic_fetch_add(p, v, __ATOMIC_RELAXED, __HIP_MEMORY_SCOPE_AGENT); }
__device__ __forceinline__ unsigned xb_xcc_id() { return (unsigned)__builtin_amdgcn_s_getreg((3 << 11) | 20) & 0xFu; }
#define XB_SPIN(cond, bar) do { unsigned _sp = 0; while (cond) { __builtin_amdgcn_s_sleep(1); \
    if ((++_sp & 255u) == 0u) { if (xb_ld(&(bar)[XB_TMO])) break; if (_sp > XB_SPIN_CAP) { atomicAdd(&(bar)[XB_TMO], 1u); break; } } } } while (0)
struct XcdBarrier { unsigned* bar; unsigned x; volatile LAS unsigned* st; };
__device__ __forceinline__ XcdBarrier xcd_barrier_post(unsigned* bar, volatile LAS unsigned* st, int tid) {
    XcdBarrier b; b.bar = bar; b.x = xb_xcc_id(); b.st = st;
    if (tid == 0) (void)xb_add(&bar[XB_XCNT(b.x)], 1u);
    return b;
}
__device__ __forceinline__ void xcd_barrier_complete(unsigned* bar, unsigned x, unsigned& nloc, unsigned& nx) {
    const unsigned G = gridDim.x * gridDim.y * gridDim.z;
    unsigned sum, cnt, mine, sp = 0u;
    for (;;) {
        sum = 0u; cnt = 0u; mine = 0u;
#pragma unroll
        for (unsigned j = 0; j < 16; ++j) { const unsigned c = xb_ld(&bar[XB_XCNT(j)]); sum += c; cnt += (c > 0u) ? 1u : 0u; mine = (j == x) ? c : mine; }
        if (sum == G) break;
        __builtin_amdgcn_s_sleep(1);
        if ((++sp & 255u) == 0u) { if (xb_ld(&bar[XB_TMO])) break; if (sp > XB_SPIN_CAP) { atomicAdd(&bar[XB_TMO], 1u); break; } }
    }
    nloc = mine > 0u ? mine : 1u; nx = cnt > 0u ? cnt : 1u;
}
__device__ __forceinline__ void xcd_barrier(const XcdBarrier& b, int tid) {
    asm volatile("s_waitcnt vmcnt(0)" ::: "memory");
    __syncthreads();
    if (tid == 0) {
        unsigned* bar = b.bar;
        __builtin_amdgcn_s_waitcnt(0);
        unsigned nloc = b.st[0], nx = b.st[1];
        if (nloc == 0u) { xcd_barrier_complete(bar, b.x, nloc, nx); b.st[0] = nloc; b.st[1] = nx; }
        const unsigned old = xb_add(&bar[XB_XSUB(b.x)], 1u);
        const unsigned gen = old / nloc;
        if (old + 1u == (gen + 1u) * nloc) {
            __builtin_amdgcn_fence(__ATOMIC_RELEASE, "agent");
            asm volatile("s_waitcnt vmcnt(0)" ::: "memory");
            const unsigned og = xb_add(&bar[XB_TOP], 1u);
            const unsigned tg = og / nx;
            if (og + 1u == (tg + 1u) * nx) xb_add(&bar[XB_TOPGEN], 1u);
            else XB_SPIN(xb_ld(&bar[XB_TOPGEN]) == tg, bar);
            __builtin_amdgcn_fence(__ATOMIC_ACQUIRE, "agent");
            xb_add(&bar[XB_XGEN(b.x)], 1u);
            asm volatile("s_waitcnt vmcnt(0)" ::: "memory");
        } else {
            XB_SPIN(xb_ld(&bar[XB_XGEN(b.x)]) == gen, bar);
            __builtin_amdgcn_fence(__ATOMIC_ACQUIRE, "agent");
            asm volatile("s_waitcnt vmcnt(0)" ::: "memory");
        }
    }
    __syncthreads();
}

__device__ __forceinline__ int lane_id_opaque() { int l; asm volatile("v_mbcnt_lo_u32_b32 %0, -1, 0\n\tv_mbcnt_hi_u32_b32 %0, -1, %0" : "=v"(l)); return l; }
__device__ __forceinline__ void stagger_wait(unsigned ticks) {
    int bx = blockIdx.x; asm volatile("" : "+s"(bx));
    if ((bx >> 3) & 1) { const unsigned long long t0 = __builtin_amdgcn_s_memrealtime(); while (__builtin_amdgcn_s_memrealtime() - t0 < ticks) __builtin_amdgcn_s_sleep(16); }
}
struct Frame {
    LAS unsigned char* lds;
    int tid, lane, wave, vcu, G;
};

__device__ __forceinline__ void transpose_item(const float* __restrict__ W, int K, int N, bf16_t* WT, int row_off, const float* __restrict__ g, LAS float* scr, int item, int lane, bool dry = false,
                                               const float* __restrict__ wpool = nullptr, const float* __restrict__ pscale = nullptr) {
    const int nblk = N / 32, kb = item / nblk, nb = item % nblk, k0 = 64 * kb, n0 = 32 * nb;
    if (wpool && n0 >= E_XB && n0 < E_XB + 512) return;
    { const int kr = lane >> 3, nq = lane & 7; f32x4 v[8]; float gv[8];
#pragma unroll
      for (int i = 0; i < 8; ++i) { v[i] = *(const f32x4*)(W + (size_t)(k0 + 8 * i + kr) * N + n0 + 4 * nq); gv[i] = g ? g[k0 + 8 * i + kr] : 1.f; }
#pragma unroll
      for (int i = 0; i < 8; ++i)
#pragma unroll
          for (int e = 0; e < 4; ++e) scr[(8 * i + kr) * 33 + 4 * nq + e] = v[i][e] * gv[i]; }
    asm volatile("s_waitcnt lgkmcnt(0)" ::: "memory");
    const int c = lane & 7;
#pragma unroll
    for (int j = 0; j < 4; ++j) { const int n = (lane >> 3) + 8 * j; const LAS float* s = scr + (8 * c) * 33 + n;
        u32x4 o; o.x = pk2(s[0 * 33], s[1 * 33]); o.y = pk2(s[2 * 33], s[3 * 33]); o.z = pk2(s[4 * 33], s[5 * 33]); o.w = pk2(s[6 * 33], s[7 * 33]);
        if (!dry) *(u32x4*)(WT + (size_t)(row_off + n0 + n) * K + k0 + 8 * c) = o; }
    asm volatile("s_waitcnt lgkmcnt(0)" ::: "memory");
}
__device__ __forceinline__ void fold_tile(const float* __restrict__ W, bf16_t* WT, const float* __restrict__ g, const float* __restrict__ wpool, const float* __restrict__ pscale, int item, int lane, bool dry) {
    const int kb = item >> 5, nb = item & 31, k0 = 16 * kb, nn0 = 16 * nb, gi = nn0 >> 7, d0 = nn0 & 127, fr = lane & 15, fq = lane >> 4;
    const float* ap = W + (size_t)(k0 + fr) * EP + E_XB + gi * 128 + fq;
    const float* bp = wpool + (size_t)gi * 128 * 128 + (size_t)fq * 128 + d0 + fr;
    float av[32], bv[32];
#pragma unroll
    for (int ks = 0; ks < 32; ++ks) { av[ks] = ap[4 * ks]; bv[ks] = bp[(size_t)4 * ks * 128]; }
    f32x4 acc = {0.f, 0.f, 0.f, 0.f};
#pragma unroll
    for (int ks = 0; ks < 32; ++ks) acc = __builtin_amdgcn_mfma_f32_16x16x4f32(av[ks], bv[ks], acc, 0, 0, 0);
    const float ps = pscale[gi * 128 + d0 + fr]; const f32x4 gk = *(const f32x4*)(g + k0 + 4 * fq);
    u32x2 o; o.x = pk2(acc[0] * ps * gk[0], acc[1] * ps * gk[1]); o.y = pk2(acc[2] * ps * gk[2], acc[3] * ps * gk[3]);
    if (!dry) *(u32x2*)(WT + (size_t)(E_XB + nn0 + fr) * DM + k0 + 4 * fq) = o;
}
__device__ __forceinline__ void convert_weight(const Frame& F, int gw, int NGW, const float* W, int K, int N, bf16_t* WT, int row_off, const float* g, bool dry = false, const float* wpool = nullptr, const float* pscale = nullptr) {
    LAS float* scr = (LAS float*)(F.lds + F.wave * 16384);
    const int nitems = (K / 64) * (N / 32);
    for (int it = gw; it < nitems; it += NGW) transpose_item(W, K, N, WT, row_off, g, scr, it, F.lane, dry, wpool, pscale);
    if (wpool) for (int it = gw; it < (DM / 16) * 32; it += NGW) fold_tile(W, WT, g, wpool, pscale, it, F.lane, dry);
}

__device__ __forceinline__ att::BlockRef att_item(int L, bool even, bf16_t* proj, const bf16_t* mkv, float* lse, bool dry) {
    att::BlockRef r;
    const int xq = (L & 255) >> 5, jj = L & 31, rd = L >> 8;
    if (even && L < 1536) {
        const int idx = rd * 32 + jj, pair = xq * 4 + idx / 48, kk = idx % 48, g = kk >> 4, x = kk & 15, b = pair >> 2, h = pair & 3;
        const int dsh = 2 * g, dil = 1 << dsh, nqb = 16 >> dsh, rr = x >> (4 - dsh), qb = x & (nqb - 1);
        const size_t tok0 = (size_t)b * SEQ + rr, q0 = tok0 + (size_t)qb * 256 * dil;
        r.Q = pcol(proj, g * 1024 + h * 128) + q0 * PR; r.O = pcol(proj, g * 1024 + h * 128) + q0 * PR;
        r.K = pcol(proj, g * 1024 + 512 + h * 128) + tok0 * PR; r.V = pcol(proj, E_VA + h * 128) + tok0 * PR;
        r.P0 = qb * 256; r.pq = dil * PR; r.pk = dil * PR; r.skv = SEQ >> dsh; r.W = 129; r.mode = 0;
        r.lse = lse + ((size_t)g * NT + tok0 + (size_t)qb * 256 * dil) * 4 + h; r.lsep = dil * 4;
    } else {
        const int idx2 = (even ? rd - 6 : rd) * 32 + jj, pair = xq * 4 + (idx2 >> 4), qb = idx2 & 15, b = pair >> 2, h = pair & 3;
        const int qcol = even ? E_QM : O_QM, zcol = (even ? E_Z : O_Z) + 1024;
        const size_t row0 = (size_t)b * SEQ + qb * 256;
        r.Q = pcol(proj, qcol + h * 128) + row0 * PR; r.O = pcol(proj, zcol + h * 128) + row0 * PR;
        r.K = mkv + (size_t)(b * NMEM) * 4096 + h * 128; r.V = r.K + 512;
        r.P0 = 256; r.pq = PR; r.pk = 4096; r.skv = 256; r.W = 1 << 20; r.mode = 1; r.lse = nullptr; r.lsep = 0;
    }
    if (dry) r.mode = 2;
    return r;
}
__device__ __forceinline__ void attn_phase(char* lds, int vcu, int G, bool even, bf16_t* proj, const bf16_t* mkv, float* lse, int tid_in, bool dry = false, int lo = 0, int hi = 1 << 30) {
    int tid = tid_in; asm volatile("" : "+v"(tid));
    const int total = (even ? 2048 : 512) < hi ? (even ? 2048 : 512) : hi;
    int L = vcu + lo; if (L >= total) return;
    att::BlockRef cur = att_item(L, even, proj, mkv, lse, dry);
    att::Seam S;
    att::swa_prime(cur, lds, S, tid);
    for (;;) {
        const int Ln = L + G; const bool last = Ln >= total;
        const att::BlockRef nxt = last ? cur : att_item(Ln, even, proj, mkv, lse, dry);
        att::swa_block(cur, nxt, lds, S, tid);
        if (last) break;
        cur = nxt; L = Ln;
    }
}
__device__ __forceinline__ void combine_phase(const Frame& F, bf16_t* proj, const float* __restrict__ lse, bool dry = false) {
    const int lane = F.lane, h = lane >> 4, dc = (lane & 15) * 8, NGW = F.G * NWAVES;
    for (int tok0 = (F.vcu * NWAVES + F.wave) * 4; tok0 < NT; tok0 += NGW * 4) {
        u32x4 o0[4], o1[4], o2[4], zz[4]; float w0[4], w1[4], w2[4];
#pragma unroll
        for (int q = 0; q < 4; ++q) { const size_t tok = tok0 + q; const int cc = h * 128 + dc;
            w0[q] = lse[((size_t)0 * NT + tok) * 4 + h]; w1[q] = lse[((size_t)1 * NT + tok) * 4 + h]; w2[q] = lse[((size_t)2 * NT + tok) * 4 + h];
            o0[q] = *(const u32x4*)(pcol(proj, cc) + tok * PR); o1[q] = *(const u32x4*)(pcol(proj, 1024 + cc) + tok * PR); o2[q] = *(const u32x4*)(pcol(proj, 2048 + cc) + tok * PR); zz[q] = *(const u32x4*)(pcol(proj, E_Z + cc) + tok * PR); }
#pragma unroll
        for (int q = 0; q < 4; ++q) { const size_t tok = tok0 + q; bf16_t* zrow = pcol(proj, E_Z + h * 128 + dc) + tok * PR;
            const float M = fmaxf(w0[q], fmaxf(w1[q], w2[q])); float a0 = __expf(w0[q] - M), a1 = __expf(w1[q] - M), a2 = __expf(w2[q] - M);
            const float inv = 1.f / (a0 + a1 + a2); a0 *= inv; a1 *= inv; a2 *= inv;
            u32x4 y;
#pragma unroll
            for (int j = 0; j < 4; ++j) {
                const float a = a0 * __uint_as_float(o0[q][j] << 16) + a1 * __uint_as_float(o1[q][j] << 16) + a2 * __uint_as_float(o2[q][j] << 16);
                const float b = a0 * __uint_as_float(o0[q][j] & 0xffff0000u) + a1 * __uint_as_float(o1[q][j] & 0xffff0000u) + a2 * __uint_as_float(o2[q][j] & 0xffff0000u);
                y[j] = pk2(a * silu(__uint_as_float(zz[q][j] << 16)), b * silu(__uint_as_float(zz[q][j] & 0xffff0000u))); }
            if (!dry) *(u32x4*)zrow = y; }
    }
}
__device__ __forceinline__ void pool_phase(const Frame& F, bf16_t* proj, bool dry = false) {
    const int lane = F.lane, gi = lane >> 4, w = 2 << gi, NGW = F.G * NWAVES;
    for (int run = F.vcu * NWAVES + F.wave; run < NT / 16; run += NGW) {
        const int t0 = run * 16, p0 = t0 % SEQ;
        const bf16_t* xc = pcol(proj, E_XB + lane * 8) + (size_t)t0 * PR; bf16_t* zc = pcol(proj, E_Z + 512 + lane * 8) + (size_t)t0 * PR;
        float sum[8];
#pragma unroll
        for (int e = 0; e < 8; ++e) sum[e] = 0.f;
        { u32x4 h[16];
#pragma unroll
          for (int j = 1; j <= 16; ++j) h[j - 1] = (j <= w && p0 - j >= 0) ? *(const u32x4*)(xc - (long)j * PR) : (u32x4){0u, 0u, 0u, 0u};
#pragma unroll
          for (int j = 0; j < 16; ++j)
#pragma unroll
              for (int e = 0; e < 4; ++e) { sum[2 * e] += __uint_as_float(h[j][e] << 16); sum[2 * e + 1] += __uint_as_float(h[j][e] & 0xffff0000u); } }
#pragma unroll
        for (int bt = 0; bt < 16; bt += 8) { u32x4 xa[8], xs[8], zz[8];
#pragma unroll
            for (int i = 0; i < 8; ++i) { const int p = p0 + bt + i;
                xa[i] = *(const u32x4*)(xc + (long)(bt + i) * PR); zz[i] = *(const u32x4*)(zc + (long)(bt + i) * PR);
                xs[i] = (p >= w) ? *(const u32x4*)(xc + (long)(bt + i - w) * PR) : (u32x4){0u, 0u, 0u, 0u}; }
#pragma unroll
            for (int i = 0; i < 8; ++i) { const int p = p0 + bt + i; const float ic = 1.f / (float)((p + 1 < w) ? p + 1 : w); u32x4 y;
#pragma unroll
                for (int e = 0; e < 4; ++e) { const float x0 = __uint_as_float(xa[i][e] << 16), x1 = __uint_as_float(xa[i][e] & 0xffff0000u);
                    sum[2 * e] += x0 - __uint_as_float(xs[i][e] << 16); sum[2 * e + 1] += x1 - __uint_as_float(xs[i][e] & 0xffff0000u);
                    y[e] = pk2((sum[2 * e] * ic - x0) * silu(__uint_as_float(zz[i][e] << 16)), (sum[2 * e + 1] * ic - x1) * silu(__uint_as_float(zz[i][e] & 0xffff0000u))); }
                if (!dry) *(u32x4*)(zc + (long)(bt + i) * PR) = y; } }
    }
}
__device__ __forceinline__ void cmix_phase(const Frame& F, bf16_t* proj, const float* __restrict__ ln_g, const float* __restrict__ ln_b,
                                           const bf16_t* __restrict__ wsm  , const float* __restrict__ b_s, const float2* __restrict__ lnp, bool dry = false) {
    const int tid = F.tid, lane = F.lane, wv = F.wave, fr = lane & 15, fq = lane >> 4;
    LAS unsigned char* VT = F.lds; LAS float* mu = (LAS float*)(F.lds + 128 * 272); LAS float* rstd = mu + 128;
    for (int ch = F.vcu; ch < NT / 128; ch += F.G) {
        const size_t row0 = (size_t)ch * 128;
        { const int row = tid >> 2, part = tid & 3; const f32x4* pp = (const f32x4*)(lnp + (row0 + row) * 16 + part * 4);
          const f32x4 a = pp[0], b = pp[1]; float s1 = (a[0] + a[2]) + (b[0] + b[2]), s2 = (a[1] + a[3]) + (b[1] + b[3]);
          s1 += __shfl_xor(s1, 1); s1 += __shfl_xor(s1, 2); s2 += __shfl_xor(s2, 1); s2 += __shfl_xor(s2, 2);
          const float m = s1 * (1.f / 1024.f), var = fmaxf(s2 * (1.f / 1024.f) - m * m, 0.f);
          if (part == 0) { mu[row] = m; rstd[row] = rsqrtf(var + EPS); } }
        const int sI = tid >> 2, cq = tid & 3;
        const size_t vro = (row0 + sI) * PR + cq * 8;
        const size_t tro = (row0 + wv * 16 + (lane >> 4)) * PR + (lane & 15) * 8;
        LAS unsigned char* stg = F.lds + 36864 + wv * (16 * 528);
        u32x4 vq[4];
#pragma unroll
        for (int k = 0; k < 4; ++k) vq[k] = *(const u32x4*)(pcol(proj, O_V + k * 32) + vro);
        __syncthreads();
        const float m_s = mu[sI], r_s = rstd[sI];
        for (int g = 0; g < 8; ++g) {
            u32x4 uq[4], zq[4];
#pragma unroll
            for (int j = 0; j < 4; ++j) { uq[j] = *(const u32x4*)(pcol(proj, O_U + g * 128) + tro + (size_t)(4 * j) * PR); zq[j] = *(const u32x4*)(pcol(proj, O_Z + g * 128) + tro + (size_t)(4 * j) * PR); }
            const float bs = b_s[g * 128 + wv * 16 + fr];
#pragma unroll
            for (int k = 0; k < 4; ++k) { const int c0 = k * 32 + cq * 8; const f32x4 g0 = *(const f32x4*)(ln_g + g * 128 + c0), g1 = *(const f32x4*)(ln_g + g * 128 + c0 + 4), b0 = *(const f32x4*)(ln_b + g * 128 + c0), b1 = *(const f32x4*)(ln_b + g * 128 + c0 + 4);
#pragma unroll
                for (int j = 0; j < 4; ++j) { const float gg0 = (j < 2) ? g0[2 * j] : g1[2 * j - 4], gg1 = (j < 2) ? g0[2 * j + 1] : g1[2 * j - 3], bb0 = (j < 2) ? b0[2 * j] : b1[2 * j - 4], bb1 = (j < 2) ? b0[2 * j + 1] : b1[2 * j - 3];
                    const float v0 = (__uint_as_float(vq[k][j] << 16) - m_s) * r_s * gg0 + bb0, v1 = (__uint_as_float(vq[k][j] & 0xffff0000u) - m_s) * r_s * gg1 + bb1;
                    *(LAS bf16_t*)(VT + (c0 + 2 * j) * 272 + sI * 2) = (bf16_t)f2bf(v0); *(LAS bf16_t*)(VT + (c0 + 2 * j + 1) * 272 + sI * 2) = (bf16_t)f2bf(v1); } }
            __syncthreads();
            if (g < 7) {
#pragma unroll
                for (int k = 0; k < 4; ++k) vq[k] = *(const u32x4*)(pcol(proj, O_V + (g + 1) * 128 + k * 32) + vro); }
            f32x4 acc[8];
#pragma unroll
            for (int n = 0; n < 8; ++n) acc[n] = (f32x4){0.f, 0.f, 0.f, 0.f};
            const int ksmax = wv >> 1;
            for (int ks = 0; ks <= ksmax; ++ks) {
                const bf16x8 b = *(const bf16x8*)(wsm + ((size_t)g * 128 + wv * 16 + fr) * 128 + ks * 32 + 8 * fq);
#pragma unroll
                for (int mt = 0; mt < 8; ++mt) { const bf16x8 a = *(const LAS bf16x8*)(VT + (mt * 16 + fr) * 272 + (ks * 32 + 8 * fq) * 2);
                    acc[mt] = __builtin_amdgcn_mfma_f32_16x16x32_bf16(a, b, acc[mt], 0, 0, 0); } }
#pragma unroll
            for (int mt = 0; mt < 8; ++mt) *(LAS f32x4*)(stg + fr * 528 + (mt * 16 + 4 * fq) * 4) = acc[mt] + bs;
#pragma unroll
            for (int j = 0; j < 4; ++j) { const LAS f32x4* mp = (const LAS f32x4*)(stg + (4 * j + (lane >> 4)) * 528 + (lane & 15) * 32); const f32x4 m0 = mp[0], m1 = mp[1]; u32x4 y;
                y.x = pk2(__uint_as_float(uq[j].x << 16) * m0[0] * silu(__uint_as_float(zq[j].x << 16)), __uint_as_float(uq[j].x & 0xffff0000u) * m0[1] * silu(__uint_as_float(zq[j].x & 0xffff0000u)));
                y.y = pk2(__uint_as_float(uq[j].y << 16) * m0[2] * silu(__uint_as_float(zq[j].y << 16)), __uint_as_float(uq[j].y & 0xffff0000u) * m0[3] * silu(__uint_as_float(zq[j].y & 0xffff0000u)));
                y.z = pk2(__uint_as_float(uq[j].z << 16) * m1[0] * silu(__uint_as_float(zq[j].z << 16)), __uint_as_float(uq[j].z & 0xffff0000u) * m1[1] * silu(__uint_as_float(zq[j].z & 0xffff0000u)));
                y.w = pk2(__uint_as_float(uq[j].w << 16) * m1[2] * silu(__uint_as_float(zq[j].w << 16)), __uint_as_float(uq[j].w & 0xffff0000u) * m1[3] * silu(__uint_as_float(zq[j].w & 0xffff0000u)));
                if (!dry) *(u32x4*)(pcol(proj, O_Z + g * 128) + tro + (size_t)(4 * j) * PR) = y; }
            __syncthreads();
        }
    }
}

struct Args { const void* in[19]; float* out; unsigned char* ws; };
__global__ void __launch_bounds__(NTHREADS, 2) mega_fwd(Args args) {
    extern __shared__ __attribute__((aligned(16))) unsigned char lds_raw[];
    Frame F;
    F.lds = (LAS unsigned char*)lds_raw;
    const int wave_s = __builtin_amdgcn_readfirstlane((int)threadIdx.x >> 6);
#define TID() (wave_s * 64 + lane_id_opaque())
    F.tid = TID(); F.lane = F.tid & 63; F.wave = wave_s;
    F.G = gridDim.x; { const int bx = blockIdx.x; F.vcu = (F.G % 8 == 0) ? (bx % 8) * (F.G / 8) + bx / 8 : bx; }
    volatile LAS unsigned* MISC = (volatile LAS unsigned*)(F.lds + MISC_OFF);
    unsigned char* ws = args.ws;
    for (int u = F.tid; u < (LDS_BYTES - LDSCTL_OFF) / 4; u += NTHREADS) ((LAS unsigned*)(F.lds + LDSCTL_OFF))[u] = 0u;
    __syncthreads();
    XcdBarrier bar = xcd_barrier_post((unsigned*)(ws + OFF_CTL) + CW_BAR, MISC + 8, F.tid);
#define GRID_BAR() xcd_barrier(bar, TID())
#define REFRESH() do { int t_ = TID(); asm volatile("" : "+v"(t_)); F.tid = t_; F.lane = t_ & 63; F.wave = wave_s; } while (0)

    const float* x = (const float*)args.in[0]; const float* mem = (const float*)args.in[1]; const int* pos = (const int*)args.in[2]; const float* g_mem = (const float*)args.in[3];
    const float* e_ng = (const float*)args.in[4]; const float* e_win = (const float*)args.in[5]; const float* e_wpool = (const float*)args.in[6]; const float* e_pscale = (const float*)args.in[7];
    const float* e_wmkv = (const float*)args.in[8]; const float* e_wout = (const float*)args.in[9];
    const float* o_ng = (const float*)args.in[10]; const float* o_win = (const float*)args.in[11]; const float* o_lng = (const float*)args.in[12]; const float* o_lnb = (const float*)args.in[13];
    const float* o_ws = (const float*)args.in[14]; const float* o_bs = (const float*)args.in[15]; const float* o_wmkv = (const float*)args.in[16]; const float* o_wout = (const float*)args.in[17];
    const float* f_g = (const float*)args.in[18];
    float* out = args.out;
    bf16_t* proj = (bf16_t*)(ws + OFF_PROJ); bf16_t* xb = (bf16_t*)(ws + OFF_XB); bf16_t* win = (bf16_t*)((unsigned char*)args.out + DO_WIN); bf16_t* wout = (bf16_t*)((unsigned char*)args.out + DO_WOUT);
    bf16_t* memkv = (bf16_t*)(ws + OFF_MEMKV); float* rowss = (float*)(ws + OFF_ROWSS); float2* rope = (float2*)(ws + OFF_ROPE); float* lse = (float*)(ws + OFF_LSE); float2* lnp = (float2*)(ws + OFF_LNP); bf16_t* wpT = (bf16_t*)(ws + OFF_WPT); bf16_t* wsm = (bf16_t*)(ws + OFF_WSM);
    bf16_t* memn = (bf16_t*)((unsigned char*)args.out + DO_MEMN); bf16_t* wmkv = (bf16_t*)((unsigned char*)args.out + DO_WMKV);
    const int NGW = F.G * NWAVES;
    { const int gw = F.vcu * NWAVES + F.wave, lane = F.lane;

#define CONVERT_LAYER(l_, gw_, ngw_) do { const int i_ = (l_) >> 1;        \
        if ((l_) & 1) convert_weight(F, gw_, ngw_, o_win + (size_t)i_ * DM * OP, DM, OP, win + (size_t)(i_ * 20 + 12) * (MiB / 2), 0, o_ng + i_ * DM); \
        else          convert_weight(F, gw_, ngw_, e_win + (size_t)i_ * DM * EP, DM, EP, win + (size_t)(i_ * 20) * (MiB / 2), 0, e_ng + i_ * DM, false, e_wpool + (size_t)i_ * 4 * 128 * 128, e_pscale + i_ * 512); \
        convert_weight(F, gw_, ngw_, (((l_) & 1) ? o_wout : e_wout) + (size_t)i_ * MIX * DM, MIX, DM, wout + (size_t)(l_) * DM * MIX, 0, nullptr); } while (0)
    CONVERT_LAYER(0, gw, NGW);
    for (int l = 0; l < 4; ++l) convert_weight(F, gw, NGW, ((l & 1) ? o_wmkv : e_wmkv) + (size_t)(l >> 1) * DM * 1024, DM, 1024, wmkv, l * 1024, nullptr);
    for (int i = F.vcu * NTHREADS + F.tid; i < 2 * 8 * 128 * 128; i += F.G * NTHREADS) { const int t = (i >> 7) & 127, sI = i & 127; wsm[i] = (sI <= t) ? (bf16_t)f2bf(o_ws[i]) : (bf16_t)0; }
    for (int r0 = gw * 4; r0 < NT; r0 += NGW * 4) {
        f32x4 v[4][4];
#pragma unroll
        for (int q = 0; q < 4; ++q)
#pragma unroll
            for (int j = 0; j < 4; ++j) v[q][j] = *(const f32x4*)(x + (size_t)(r0 + q) * DM + 4 * lane + 256 * j);
#pragma unroll
        for (int q = 0; q < 4; ++q) { float sq = 0.f;
#pragma unroll
            for (int j = 0; j < 4; ++j) { sq += (v[q][j][0] * v[q][j][0] + v[q][j][1] * v[q][j][1]) + (v[q][j][2] * v[q][j][2] + v[q][j][3] * v[q][j][3]);
                u32x2 w; w.x = pk2(v[q][j][0], v[q][j][1]); w.y = pk2(v[q][j][2], v[q][j][3]); *(u32x2*)(xb + (size_t)(r0 + q) * DM + 4 * lane + 256 * j) = w; }
            sq = wave_sum(sq);
            if (lane < 16) rowss[(size_t)(r0 + q) * 16 + lane] = (lane == 0) ? sq : 0.f; }
    }
    for (int r = gw; r < NB * NMEM; r += NGW) {
        const float* xr = mem + (size_t)r * DM; f32x4 v[4]; float s = 0.f;
#pragma unroll
        for (int j = 0; j < 4; ++j) { v[j] = *(const f32x4*)(xr + 4 * lane + 256 * j); s += (v[j][0] * v[j][0] + v[j][1] * v[j][1]) + (v[j][2] * v[j][2] + v[j][3] * v[j][3]); }
        s = wave_sum(s); const float ri = rsqrtf(s * (1.f / DM) + EPS);
#pragma unroll
        for (int j = 0; j < 4; ++j) { const f32x4 gg = *(const f32x4*)(g_mem + 4 * lane + 256 * j);
            u32x2 w; w.x = pk2(v[j][0] * ri * gg[0], v[j][1] * ri * gg[1]); w.y = pk2(v[j][2] * ri * gg[2], v[j][3] * ri * gg[3]); *(u32x2*)(memn + (size_t)r * DM + 4 * lane + 256 * j) = w; }
    }
    for (int i = F.vcu * NTHREADS + F.tid; i < NT * 16; i += F.G * NTHREADS) {
        const int tok = i >> 4, f = i & 15; const float ang = (float)pos[tok] * c_inv_freq[f];
        const double rev = (double)ang * 0.15915494309189535; const float fr = (float)(rev - rint(rev));
        rope[i] = make_float2(__builtin_amdgcn_cosf(fr), __builtin_amdgcn_sinf(fr));
    }
    }
    GRID_BAR();

    { pg8::Gemm g{memn, wmkv, NB * NMEM, 4096, DM, DM}; pg8::StaticOrder S; S.init(NB * NMEM, 4096, F.G, (int)blockIdx.x);
      pg8::EpiIn E{memkv, 4096, nullptr, nullptr, 0, nullptr, 0, 0, F.lds + EPI_STG_OFF};
      pg8::gemm_phase<pg8::EpiIn, pg8::StaticOrder, true, true>(F.lds, g, S, E, TID());
      const int nunits = (NB * NMEM / 256) * (4096 / 256);
      if ((int)blockIdx.x >= nunits && F.G > nunits) { REFRESH(); const int gw2 = ((int)blockIdx.x - nunits) * NWAVES + F.wave, ngw2 = (F.G - nunits) * NWAVES;
          CONVERT_LAYER(1, gw2, ngw2); CONVERT_LAYER(2, gw2, ngw2); CONVERT_LAYER(3, gw2, ngw2); }
      else if (F.G <= nunits) { REFRESH(); const int gw2 = F.vcu * NWAVES + F.wave, ngw2 = F.G * NWAVES; CONVERT_LAYER(1, gw2, ngw2); CONVERT_LAYER(2, gw2, ngw2); CONVERT_LAYER(3, gw2, ngw2); }
      __syncthreads(); }

    for (int l = 0; l < 4; ++l) {
        const int i = l >> 1; const bool odd = l & 1; const int NP = odd ? OP : EP;
        { pg8::Gemm g{xb, win + (size_t)((l >> 1) * 20 + (l & 1) * 12) * (MiB / 2), NT, NP, DM, DM}; pg8::StaticOrder S; S.init(NT, NP, F.G, (int)blockIdx.x);
          pg8::EpiIn E{proj, NP, rowss, rope, odd ? 0 : 12, odd ? lnp : nullptr, 4, PS, F.lds + EPI_STG_OFF};
#ifndef STAGGER_TICKS
#define STAGGER_TICKS 0
#endif
          if (STAGGER_TICKS) stagger_wait(STAGGER_TICKS);
          pg8::gemm_phase<pg8::EpiIn, pg8::StaticOrder, true, true>(F.lds, g, S, E, TID()); }
        GRID_BAR();
        REFRESH();
        if (!odd) {
            REFRESH(); pool_phase(F, proj);
            attn_phase((char*)lds_raw, F.vcu, F.G, true, proj, memkv + l * 1024, lse, TID());
            GRID_BAR();
            REFRESH(); combine_phase(F, proj, lse);
        } else {
            REFRESH(); cmix_phase(F, proj, o_lng + i * 1024, o_lnb + i * 1024, wsm + (size_t)i * 8 * 128 * 128, o_bs + i * 8 * 128, lnp);
            attn_phase((char*)lds_raw, F.vcu, F.G, false, proj, memkv + l * 1024, lse, TID());
        }
        GRID_BAR();
        { pg8::Gemm g{pcol(proj, odd ? O_Z : E_Z), wout + (size_t)l * DM * MIX, NT, DM, MIX, PR, PS * 2};   pg8::StaticOrder S; S.init(NT, DM, F.G, (int)blockIdx.x);
          pg8::EpiOut E{l == 0 ? x : nullptr, xb, rowss};
          pg8::gemm_phase<pg8::EpiOut, pg8::StaticOrder, true, true>(F.lds, g, S, E, TID()); }
        GRID_BAR();
    }
    REFRESH();
    for (int r = F.vcu * NWAVES + F.wave; r < NT; r += NGW) { const int lane = F.lane;
        float s = (lane < 16) ? rowss[(size_t)r * 16 + lane] : 0.f; s = wave_sum(s); const float ri = rsqrtf(s * (1.f / DM) + EPS);
        const bf16_t* xr = xb + (size_t)r * DM; float* orow = out + (size_t)r * DM;
#pragma unroll
        for (int j = 0; j < 2; ++j) { const u32x4 q = *(const u32x4*)(xr + 8 * lane + 512 * j); const f32x4 g0 = *(const f32x4*)(f_g + 8 * lane + 512 * j), g1 = *(const f32x4*)(f_g + 8 * lane + 512 * j + 4);
            const f32x4 a = {__uint_as_float(q[0] << 16) * ri * g0[0], __uint_as_float(q[0] & 0xffff0000u) * ri * g0[1], __uint_as_float(q[1] << 16) * ri * g0[2], __uint_as_float(q[1] & 0xffff0000u) * ri * g0[3]};
            const f32x4 b = {__uint_as_float(q[2] << 16) * ri * g1[0], __uint_as_float(q[2] & 0xffff0000u) * ri * g1[1], __uint_as_float(q[3] << 16) * ri * g1[2], __uint_as_float(q[3] & 0xffff0000u) * ri * g1[3]};
            *(f32x4*)(orow + 8 * lane + 512 * j) = a; *(f32x4*)(orow + 8 * lane + 512 * j + 4) = b; }
    }
}

extern "C" void kernel_launch(void* const* d_in, const int* in_sizes, int n_in, void* d_out, int out_size, void* d_ws, size_t ws_size, hipStream_t stream) {
    static int grid = 0;
    if (grid == 0) {
        if (n_in != 19 || in_sizes[0] != NT * DM || out_size != NT * DM || ws_size < WS_END) {
            fprintf(stderr, "kernel_launch: unexpected shapes (n_in %d, in0 %d, out %d, ws %zu; need ws >= %zu)\n", n_in, n_in > 0 ? in_sizes[0] : -1, out_size, ws_size, (size_t)WS_END);
            grid = -1; return; }
        int dev = 0, cus = 0;
        if (hipGetDevice(&dev) != hipSuccess || hipDeviceGetAttribute(&cus, hipDeviceAttributeMultiprocessorCount, dev) != hipSuccess) { grid = -1; return; }
        if (hipFuncSetAttribute((const void*)mega_fwd, hipFuncAttributeMaxDynamicSharedMemorySize, LDS_BYTES) != hipSuccess) { fprintf(stderr, "kernel_launch: hipFuncSetAttribute failed\n"); grid = -1; return; }
        int per_cu = 0;
        if (hipOccupancyMaxActiveBlocksPerMultiprocessor(&per_cu, (const void*)mega_fwd, NTHREADS, LDS_BYTES) != hipSuccess || per_cu < 1)
            fprintf(stderr, "kernel_launch: note: occupancy query reports %d workgroups per CU\n", per_cu);
        (void)hipGetLastError();
        if (cus < 256) { fprintf(stderr, "kernel_launch: this kernel is laid out for 256 CUs (found %d); nothing launched\n", cus); grid = -1; return; }
        grid = 256;
    }
    if (grid < 0) return;
    if (hipMemsetAsync((char*)d_ws + OFF_CTL, 0, CTL_ZERO_BYTES, stream) != hipSuccess) return;
    Args a{};
    for (int i = 0; i < 19; ++i) a.in[i] = d_in[i];
    a.out = (float*)d_out; a.ws = (unsigned char*)d_ws;
    hipLaunchKernelGGL(mega_fwd, dim3(grid), dim3(NTHREADS), LDS_BYTES, stream, a);
}
```

```cpp
#include <hip/hip_runtime.h>
#include <cstdint>
#include <cstdio>

typedef unsigned short bf16_t;
#define LAS __attribute__((address_space(3)))
#define GAS __attribute__((address_space(1)))
typedef short bf16x8 __attribute__((ext_vector_type(8)));
typedef float f32x4 __attribute__((ext_vector_type(4)));
typedef unsigned u32x4 __attribute__((ext_vector_type(4)));
typedef unsigned u32x2 __attribute__((ext_vector_type(2)));

constexpr int NB = 8, SEQ = 4096, DM = 1024, NT = NB * SEQ;
constexpr int HD = 128, NMEM = 256;
constexpr int EP = 6144, OP = 4096, MIX = 1536;
constexpr int E_VA = 3072, E_XB = 3584, E_QM = 4096, E_Z = 4608;
constexpr int O_U = 0, O_V = 1024, O_QM = 2048, O_Z = 2560;
constexpr size_t PS = (size_t)NT * 256;
constexpr int PR = 256;
constexpr float EPS = 1e-6f;
constexpr float ATT_SCALE = 0.08838834764831845f;
constexpr int NWAVES = 8, NTHREADS = 512;

constexpr size_t MiB = 1u << 20;
constexpr size_t OFF_CTL = 0, CTL_ZERO_BYTES = 64 * 1024;
constexpr size_t OFF_PROJ = 1 * MiB;
constexpr size_t OFF_XB = 385 * MiB;
constexpr size_t OFF_WIN = 449 * MiB;
constexpr size_t OFF_WOUT = 461 * MiB;
constexpr size_t OFF_MEMKV = 467 * MiB;
constexpr size_t OFF_ROWSS = 483 * MiB;
constexpr size_t OFF_ROPE = 489 * MiB;
constexpr size_t OFF_LSE = 493 * MiB;
constexpr size_t OFF_WPT = 495 * MiB;
constexpr size_t OFF_WSM = OFF_WPT + 256 * 1024;
constexpr size_t OFF_LNP = 496 * MiB;
constexpr size_t WS_END = 500 * MiB;
constexpr size_t DO_MEMN = 0;
constexpr size_t DO_WMKV = 4 * MiB;
constexpr size_t DO_WIN = 12 * MiB;
constexpr size_t DO_WOUT = 52 * MiB;
constexpr int CW_BAR = 4096;

constexpr int RING_BYTES = 131072, LDSCTL_OFF = RING_BYTES, MISC_OFF = LDSCTL_OFF + 320, EPI_STG_OFF = LDSCTL_OFF + 1024, EPI_STG_WAVE = 16 * 144, RINV_OFF = EPI_STG_OFF + 8 * EPI_STG_WAVE, LDS_BYTES = RINV_OFF + 2048;

__device__ __forceinline__ bf16_t* pcol(bf16_t* proj, int col) { return proj + (size_t)(col >> 8) * PS + (col & 255); }
__device__ __forceinline__ u32x4 ldnt4(const void* p) { return __builtin_nontemporal_load((const u32x4*)p); }
__device__ __forceinline__ f32x4 ldntf4(const void* p) { return __builtin_nontemporal_load((const f32x4*)p); }
__device__ __forceinline__ void stnt4(void* p, u32x4 v) { __builtin_nontemporal_store(v, (u32x4*)p); }
__device__ __forceinline__ void stntf4(void* p, f32x4 v) { __builtin_nontemporal_store(v, (f32x4*)p); }
__device__ __forceinline__ float bf2f(bf16_t h) { return __uint_as_float((unsigned)h << 16); }
__device__ __forceinline__ unsigned f2bf(float f) { unsigned u = __float_as_uint(f); return (u + 0x7fffu + ((u >> 16) & 1u)) >> 16; }
__device__ __forceinline__ unsigned pk2(float lo, float hi) { return f2bf(lo) | (f2bf(hi) << 16); }
__device__ __forceinline__ float wave_sum(float v) {
#pragma unroll
    for (int o = 1; o < 64; o <<= 1) v += __shfl_xor(v, o);
    return v;
}
__device__ __forceinline__ float wave_max(float v) {
#pragma unroll
    for (int o = 1; o < 64; o <<= 1) v = fmaxf(v, __shfl_xor(v, o));
    return v;
}
__device__ __forceinline__ float silu(float z) { return z / (1.f + __expf(-z)); }

__constant__ float c_inv_freq[16] = {1.0f, 0.44036659598350525f, 0.1939227432012558f, 0.08539710193872452f, 0.03760603070259094f, 0.01656043902039528f,
    0.007292664609849453f, 0.0032114458736032248f, 0.0014142135623842478f, 0.000622772378847003f, 0.00027424818836152554f, 0.00012076973507646471f,
    5.318296098266728e-05f, 2.34199997066753e-05f, 1.0313386155758053e-05f, 4.541670477919979e-06f};

namespace pg8 {
constexpr int BM = 256, BK = 64, HALF = 128, HTB = HALF * BK * 2, STAGE_BYTES = 8 * HTB, NXCD = 8, WGM = 8;
__host__ __device__ __forceinline__ int lds_byte(int r, int c) { const int st = (r >> 4) * 2 + (c >> 5), rr = r & 15, cc = c & 31, ob = rr * 64 + cc * 2; return st * 1024 + (ob ^ (((ob >> 9) & 1) << 5)); }
__host__ __device__ __forceinline__ void stage_rc(int b, int& R, int& C) { const int st = b / 1024, sb = b % 1024, swz = sb ^ (((sb >> 9) & 1) << 5); R = (st >> 1) * 16 + swz / 64; C = (st & 1) * 32 + (swz % 64) / 2; }
__host__ __device__ __forceinline__ int perm32(int rho) { const int n = rho >> 4, i = rho & 15; return 8 * (i >> 2) + 4 * n + (i & 3); }
struct Unit { int pm, pn; };
struct Gemm { const bf16_t* A; const bf16_t* Bt; int M, N, K, lda; size_t kpA = 512; };
struct StaticOrder {
    int nM, nN, nwg, G, c;
    __host__ __device__ void init(int M, int N, int G_, int c_) { nM = M / BM; nN = N / BM; nwg = nM * nN; G = G_; c = c_; }
    __host__ __device__ bool next(int i, Unit& u) const {
        const long L = (long)i * G + c; if (L >= nwg) return false;
        int wgid = (int)L; { const int q = nwg / NXCD, r = nwg % NXCD, xcd = wgid % NXCD, off = wgid / NXCD; wgid = (xcd < r ? xcd * (q + 1) : r * (q + 1) + (xcd - r) * q) + off; }
        const int nig = WGM * nN, gid = wgid / nig, fm = gid * WGM, gsz = (nM - fm) < WGM ? (nM - fm) : WGM;
        u.pm = fm + ((wgid % nig) % gsz); u.pn = (wgid % nig) / gsz; return true;
    }
    __device__ __forceinline__ void a_ready(const Unit&) const {}
    __device__ __forceinline__ void done(const Unit&) const {}
};
__device__ __forceinline__ unsigned cvt_pk_bf16(float lo, float hi) { unsigned r; asm volatile("v_cvt_pk_bf16_f32 %0, %1, %2" : "=v"(r) : "v"(lo), "v"(hi)); return r; }

template <bool SCALE>
struct EpiIn {
    static constexpr bool PERM = true, AFTER_DRAIN = false, PREP = SCALE, RESID = false;
    bf16_t* O; int ldc; const float* rowss; const unsigned* rope; int nrope; float2* lnp = nullptr; int ln_pn0 = 0; size_t pstride = 0;
    LAS unsigned char* stg0 = nullptr;
    LAS float* rinv = nullptr;
    __device__ __forceinline__ void prep(int slot, int pm, int tid) const {
        const int row = tid >> 1, part = tid & 1; const f32x4* pp = (const f32x4*)(rowss + ((size_t)pm * BM + row) * 16 + part * 8);
        const f32x4 a = pp[0], b = pp[1]; float sq = ((a[0] + a[1]) + (a[2] + a[3])) + ((b[0] + b[1]) + (b[2] + b[3]));
        sq += __shfl_xor(sq, 1);
        if (part == 0) rinv[slot * 256 + row] = rsqrtf(sq * (1.f / DM) + EPS);
    }
    __device__ __forceinline__ void operator()(const f32x4 (&acc)[2][2][4][2], const Unit& u, int wr, int wc, int fr, int fq, int slot) const {
        const int row0 = u.pm * BM + wr * 64 + fr, lane = fr + 16 * fq;
        const bool rp = (u.pn < nrope) && ((wc & 1) == 0);
        const bool lnst = lnp && u.pn >= ln_pn0 && u.pn < ln_pn0 + 4;
        LAS unsigned char* stg = stg0 + (wr * 4 + wc) * EPI_STG_WAVE;
        float rs[2][4]; u32x4 cs[2][4];
#define EPI_CS_LOAD(ai_) do { _Pragma("unroll") for (int m = 0; m < 4; ++m) { if (rp) cs[ai_][m] = *(const u32x4*)(rope + (size_t)(row0 + (ai_) * HALF + m * 16) * 16 + 8 * (fq & 1) + 4 * (fq >> 1)); else cs[ai_][m] = (u32x4){0u, 0u, 0u, 0u}; } } while (0)
        EPI_CS_LOAD(0); EPI_CS_LOAD(1);
#pragma unroll
        for (int ai = 0; ai < 2; ++ai)
#pragma unroll
            for (int m = 0; m < 4; ++m) rs[ai][m] = SCALE ? rinv[slot * 256 + wr * 64 + ai * HALF + m * 16 + fr] : 1.f;
#undef EPI_CS_LOAD
#pragma unroll
        for (int ai = 0; ai < 2; ++ai) {
#pragma unroll
            for (int m = 0; m < 4; ++m) { const float r = rs[ai][m]; float s1 = 0.f, s2 = 0.f;
#pragma unroll
                for (int bj = 0; bj < 2; ++bj) { float v[8];
#pragma unroll
                    for (int j = 0; j < 4; ++j) { v[j] = acc[ai][bj][m][0][j] * r; v[4 + j] = acc[ai][bj][m][1][j] * r; }
                    if (rp && bj == 0) { unsigned cw8[8];
#pragma unroll
                        for (int j = 0; j < 4; ++j) { const auto sc = __builtin_amdgcn_permlane32_swap(cs[ai][m][j], cs[ai][m][j], false, false); cw8[j] = sc[0]; cw8[4 + j] = sc[1]; }
#pragma unroll
                        for (int j = 0; j < 8; ++j) { const auto sw = __builtin_amdgcn_permlane32_swap(__float_as_uint(v[j]), __float_as_uint(v[j]), false, false);
                            const float pv = __uint_as_float(fq < 2 ? sw[1] : sw[0]); const unsigned cw = cw8[j]; const float c = (float)__builtin_bit_cast(_Float16, (unsigned short)(cw & 0xffffu)), sn = (float)__builtin_bit_cast(_Float16, (unsigned short)(cw >> 16));
                            v[j] = (fq < 2) ? (v[j] * c - pv * sn) : (v[j] * c + pv * sn); } }
                    if (lnst) {
#pragma unroll
                        for (int j = 0; j < 8; ++j) { s1 += v[j]; s2 += v[j] * v[j]; } }
                    u32x4 w; w.x = cvt_pk_bf16(v[0], v[1]); w.y = cvt_pk_bf16(v[2], v[3]); w.z = cvt_pk_bf16(v[4], v[5]); w.w = cvt_pk_bf16(v[6], v[7]);
                    *(LAS u32x4*)(stg + fr * 144 + bj * 64 + fq * 16) = w; }
                if (lnst) { s1 += __shfl_xor(s1, 16); s1 += __shfl_xor(s1, 32); s2 += __shfl_xor(s2, 16); s2 += __shfl_xor(s2, 32);
                    if (fq == 0) lnp[(size_t)(row0 + ai * HALF + m * 16) * 16 + (u.pn - ln_pn0) * 4 + wc] = make_float2(s1, s2); }
#pragma unroll
                for (int q = 0; q < 2; ++q) { const int rr = q * 8 + (lane >> 3), ch = lane & 7; const u32x4 t = *(const LAS u32x4*)(stg + rr * 144 + ch * 16);
                    const size_t grow = (size_t)(u.pm * BM + wr * 64 + ai * HALF + m * 16 + rr);
                    bf16_t* dst = pstride ? O + (size_t)u.pn * pstride + grow * PR + wc * 64 + ch * 8 : O + grow * ldc + u.pn * BM + wc * 64 + ch * 8;
                    stnt4(dst, t); } } }
    }
};
struct EpiOut {
    static constexpr bool PERM = true, AFTER_DRAIN = false, PREP = false, RESID = true;
    bf16_t* xb; float* rowss; LAS unsigned char* stg0 = nullptr;
    __device__ __forceinline__ void resid_load(u32x4 (&w)[2][4][2], const Unit& u, int wr, int wc, int fr, int fq) const {
        const int row0 = u.pm * BM + wr * 64 + fr, col0 = u.pn * BM + wc * 64 + 8 * fq;
#pragma unroll
        for (int ai = 0; ai < 2; ++ai)
#pragma unroll
            for (int m = 0; m < 4; ++m) { const size_t off = (size_t)(row0 + ai * HALF + m * 16) * DM + col0;
#pragma unroll
                for (int bj = 0; bj < 2; ++bj) w[ai][m][bj] = *(const u32x4*)(xb + off + bj * 32); }
    }
    __device__ static __forceinline__ void resid_init(f32x4 (&acc)[2][2][4][2], const u32x4 (&w)[2][4][2]) {
#pragma unroll
        for (int ai = 0; ai < 2; ++ai)
#pragma unroll
            for (int m = 0; m < 4; ++m)
#pragma unroll
                for (int bj = 0; bj < 2; ++bj) { const u32x4 q = w[ai][m][bj];
                    acc[ai][bj][m][0] = (f32x4){__uint_as_float(q.x << 16), __uint_as_float(q.x & 0xffff0000u), __uint_as_float(q.y << 16), __uint_as_float(q.y & 0xffff0000u)};
                    acc[ai][bj][m][1] = (f32x4){__uint_as_float(q.z << 16), __uint_as_float(q.z & 0xffff0000u), __uint_as_float(q.w << 16), __uint_as_float(q.w & 0xffff0000u)}; }
    }
    __device__ __forceinline__ void operator()(const f32x4 (&acc)[2][2][4][2], const Unit& u, int wr, int wc, int fr, int fq, int) const {
        const int row0 = u.pm * BM + wr * 64 + fr, lane = fr + 16 * fq;
        LAS unsigned char* stg = stg0 + (wr * 4 + wc) * EPI_STG_WAVE;
#pragma unroll
        for (int ai = 0; ai < 2; ++ai) {
#pragma unroll
            for (int m = 0; m < 4; ++m) { const int row = row0 + ai * HALF + m * 16; float ss = 0.f;
#pragma unroll
                for (int bj = 0; bj < 2; ++bj) { const f32x4 v0 = acc[ai][bj][m][0], v1 = acc[ai][bj][m][1];
                    ss += ((v0[0] * v0[0] + v0[1] * v0[1]) + (v0[2] * v0[2] + v0[3] * v0[3])) + ((v1[0] * v1[0] + v1[1] * v1[1]) + (v1[2] * v1[2] + v1[3] * v1[3]));
                    u32x4 wv; wv.x = cvt_pk_bf16(v0[0], v0[1]); wv.y = cvt_pk_bf16(v0[2], v0[3]); wv.z = cvt_pk_bf16(v1[0], v1[1]); wv.w = cvt_pk_bf16(v1[2], v1[3]);
                    *(LAS u32x4*)(stg + fr * 144 + bj * 64 + fq * 16) = wv; }
#pragma unroll
                for (int q = 0; q < 2; ++q) { const int rr = q * 8 + (lane >> 3), ch = lane & 7;
                    *(u32x4*)(xb + (size_t)(u.pm * BM + wr * 64 + ai * HALF + m * 16 + rr) * DM + u.pn * BM + wc * 64 + ch * 8) = *(const LAS u32x4*)(stg + rr * 144 + ch * 16); }
                ss += __shfl_xor(ss, 16); ss += __shfl_xor(ss, 32);
                if (fq == 0) rowss[(size_t)row * 16 + u.pn * 4 + wc] = ss; } }
    }
};

template <class Epi, class Sched, bool ALIGN_EPI = false, bool SP2 = false>
__device__ __forceinline__ void gemm_phase(LAS unsigned char* lds, const Gemm g, const Sched& S, const Epi& E, int tid_in) {
    int tid_ = tid_in; asm volatile("" : "+v"(tid_));
    const int tid = tid_, wid = __builtin_amdgcn_readfirstlane(tid >> 6), lane = tid & 63, wr = wid >> 2, wc = wid & 3, fr = lane & 15, fq = lane >> 4;
    const int K = g.K, nt = K / BK, lda = g.lda;
    unsigned voffA[2], voffB[2];
#pragma unroll
    for (int i = 0; i < 2; ++i) { int R, C; stage_rc(tid * 16 + i * 8192, R, C); const int Rb = Epi::PERM ? ((R >> 5) * 64 + perm32(R & 31)) : R;
        voffA[i] = (unsigned)(R * lda + C) * 2u; voffB[i] = (unsigned)(Rb * K + C) * 2u; }
    const size_t kstep = (size_t)(BK * 2);
    const size_t kpA = g.kpA;
#define PG8_KA(t_) ((size_t)((t_) >> 2) * kpA + (size_t)((t_) & 3) * kstep)
    const size_t hstepA = (size_t)HALF * lda * 2, hstepB = (size_t)(Epi::PERM ? 32 : HALF) * K * 2;
    const size_t tstepA = 2 * hstepA, tstepB = (size_t)BM * K * 2;
    const unsigned ldsw = (unsigned)wid * 1024u;
    const int aoff = lds_byte(wr * 64 + fr, fq * 8), boff = lds_byte(wc * 32 + fr, fq * 8);
#define PG8_SA(b, h) (((b) * 2 + (h)) * HTB)
#define PG8_SB(b, h) ((4 + (b) * 2 + (h)) * HTB)
#define PG8_STAGE(bufoff, gbase, voff) do { _Pragma("unroll") for (int _i = 0; _i < 2; ++_i) \
        __builtin_amdgcn_global_load_lds((const unsigned*)((const char*)(gbase) + (voff)[_i]), (LAS unsigned*)(lds + (bufoff) + ldsw + _i * 8192), 16, 0, 0); } while (0)
#define PG8_LDA(dst, b, h) do { _Pragma("unroll") for (int m = 0; m < 4; ++m) _Pragma("unroll") for (int k = 0; k < 2; ++k) dst[m][k] = *(const LAS bf16x8*)(lds + PG8_SA(b, h) + aoff + m * 2048 + k * 1024); } while (0)
#define PG8_LDB(dst, b, h) do { _Pragma("unroll") for (int n = 0; n < 2; ++n) _Pragma("unroll") for (int k = 0; k < 2; ++k) dst[n][k] = *(const LAS bf16x8*)(lds + PG8_SB(b, h) + boff + n * 2048 + k * 1024); } while (0)
#define PG8_MMA(ai, bj, At, Bt) do { __builtin_amdgcn_s_setprio(1); _Pragma("unroll") for (int m = 0; m < 4; ++m) _Pragma("unroll") for (int n = 0; n < 2; ++n) _Pragma("unroll") for (int k = 0; k < 2; ++k) \
        acc[ai][bj][m][n] = __builtin_amdgcn_mfma_f32_16x16x32_bf16(Bt[n][k], At[m][k], acc[ai][bj][m][n], 0, 0, 0); __builtin_amdgcn_s_setprio(0); } while (0)
#define PG8_WAIT_V(n) asm volatile("s_waitcnt vmcnt(" #n ")" ::: "memory")
#define PG8_WAIT_L(n) asm volatile("s_waitcnt lgkmcnt(" #n ")" ::: "memory")
#define PG8_BAR __builtin_amdgcn_s_barrier()
#define PG8_SCHED __builtin_amdgcn_sched_barrier(0)
    Unit cur, nxt; int ui = 0;
    if (!S.next(0, cur)) return;
    int c0 = -1, c1 = -1, cslot = 0;
#define PG8_PREP(u_, prev_pm_) do { if constexpr (Epi::PREP) { { if ((u_).pm != c0 && (u_).pm != c1) { const int sl_ = (c0 == (prev_pm_)) ? 1 : 0;     \
        int l_; asm volatile("v_mbcnt_lo_u32_b32 %0, -1, 0\n\tv_mbcnt_hi_u32_b32 %0, -1, %0" : "=v"(l_)); E.prep(sl_, (u_).pm, wid * 64 + l_); if (sl_) c1 = (u_).pm; else c0 = (u_).pm; } cslot = ((u_).pm == c0) ? 0 : 1; } } } while (0)
    PG8_PREP(cur, -1);
    f32x4 acc[2][2][4][2]; u32x4 rz[2][4][2];
    if constexpr (!Epi::RESID) {
#pragma unroll
    for (int a = 0; a < 2; ++a)
#pragma unroll
        for (int b = 0; b < 2; ++b)
#pragma unroll
            for (int m = 0; m < 4; ++m)
#pragma unroll
                for (int n = 0; n < 2; ++n) acc[a][b][m][n] = (f32x4){0.f, 0.f, 0.f, 0.f};
    }
    bf16x8 At[4][2], B0[2][2], B1[2][2];
    const char* cA = (const char*)g.A + (size_t)cur.pm * tstepA; const char* cB = (const char*)g.Bt + (size_t)cur.pn * tstepB;
    S.a_ready(cur);
    if constexpr (SP2) {
        PG8_STAGE(PG8_SB(0, 0), cB, voffB); PG8_STAGE(PG8_SB(0, 1), cB + hstepB, voffB); PG8_STAGE(PG8_SA(0, 0), cA, voffA); PG8_STAGE(PG8_SA(0, 1), cA + hstepA, voffA);
        if (wr == 1) PG8_BAR;
        PG8_WAIT_V(2); PG8_BAR;
        PG8_STAGE(PG8_SB(1, 0), cB + kstep, voffB); PG8_STAGE(PG8_SA(1, 0), cA + PG8_KA(1), voffA); PG8_STAGE(PG8_SB(1, 1), cB + hstepB + kstep, voffB);
        if constexpr (Epi::RESID) { E.resid_load(rz, cur, wr, wc, fr, fq); Epi::resid_init(acc, rz); }
        PG8_WAIT_V(6); PG8_BAR;
    } else {
        PG8_STAGE(PG8_SB(0, 0), cB, voffB); PG8_STAGE(PG8_SA(0, 0), cA, voffA); PG8_STAGE(PG8_SB(0, 1), cB + hstepB, voffB); PG8_STAGE(PG8_SA(0, 1), cA + hstepA, voffA);
        if (wr == 1) PG8_BAR;
        PG8_WAIT_V(4); PG8_BAR;
        PG8_STAGE(PG8_SB(1, 0), cB + kstep, voffB); PG8_STAGE(PG8_SA(1, 0), cA + PG8_KA(1), voffA); PG8_STAGE(PG8_SB(1, 1), cB + hstepB + kstep, voffB);
        if constexpr (Epi::RESID) { E.resid_load(rz, cur, wr, wc, fr, fq); Epi::resid_init(acc, rz); }
        PG8_WAIT_V(6); PG8_BAR;
    }
    for (;;) {
        const bool has_next = S.next(ui + 1, nxt);
        const char* nA = has_next ? (const char*)g.A + (size_t)nxt.pm * tstepA : cA; const char* nB = has_next ? (const char*)g.Bt + (size_t)nxt.pn * tstepB : cB;
        for (int t = 0; t < nt; t += 2) {
            const bool last = (t == nt - 2);
            const char* a1 = cA + PG8_KA(t + 1);
            const char* a2 = last ? nA : cA + PG8_KA(t + 2); const char* b2 = last ? nB : cB + (size_t)(t + 2) * kstep;
            const char* a3 = last ? nA + PG8_KA(1) : cA + PG8_KA(t + 3); const char* b3 = b2 + kstep;
            if (last && has_next) S.a_ready(nxt);
            if constexpr (SP2) {
            const int seam = __builtin_amdgcn_readfirstlane(((t == 0) && (ui > 0)) ? 1 : 0);
#define PG8_WAIT_V8_UNLESS(f_) asm volatile("s_cmp_lg_u32 %0, 0\n\ts_cbranch_scc1 1f\n\ts_waitcnt vmcnt(8)\n1:" :: "s"(f_) : "scc", "memory")
            PG8_LDB(B0, 0, 0); PG8_LDB(B1, 0, 1); PG8_SCHED; PG8_LDA(At, 0, 0); PG8_STAGE(PG8_SA(1, 1), a1 + hstepA, voffA);
            PG8_WAIT_V8_UNLESS(seam); PG8_WAIT_L(0); PG8_BAR; PG8_MMA(0, 0, At, B0); PG8_MMA(0, 1, At, B1); PG8_BAR; PG8_SCHED;
            PG8_LDA(At, 0, 1); PG8_STAGE(PG8_SB(0, 0), b2, voffB); PG8_STAGE(PG8_SB(0, 1), b2 + hstepB, voffB); PG8_STAGE(PG8_SA(0, 0), a2, voffA);
            PG8_WAIT_V8_UNLESS(seam); PG8_WAIT_L(0); PG8_BAR; PG8_MMA(1, 0, At, B0); PG8_MMA(1, 1, At, B1); PG8_BAR; PG8_SCHED;
            PG8_LDB(B0, 1, 0); PG8_LDB(B1, 1, 1); PG8_SCHED; PG8_LDA(At, 1, 0); PG8_STAGE(PG8_SA(0, 1), a2 + hstepA, voffA);
            PG8_WAIT_V8_UNLESS(seam); PG8_WAIT_L(0); PG8_BAR; PG8_MMA(0, 0, At, B0); PG8_MMA(0, 1, At, B1); PG8_BAR; PG8_SCHED;
            PG8_LDA(At, 1, 1); PG8_STAGE(PG8_SB(1, 0), b3, voffB); PG8_STAGE(PG8_SB(1, 1), b3 + hstepB, voffB); PG8_STAGE(PG8_SA(1, 0), a3, voffA);
            PG8_WAIT_V(8); PG8_WAIT_L(0); PG8_BAR; PG8_MMA(1, 0, At, B0); PG8_MMA(1, 1, At, B1); PG8_BAR; PG8_SCHED;
            } else {
            PG8_LDB(B0, 0, 0); PG8_SCHED; PG8_LDA(At, 0, 0); PG8_STAGE(PG8_SA(1, 1), a1 + hstepA, voffA);
            PG8_WAIT_L(8); PG8_BAR; PG8_WAIT_L(0); PG8_MMA(0, 0, At, B0); PG8_BAR; PG8_SCHED;
            PG8_LDB(B1, 0, 1); PG8_STAGE(PG8_SB(0, 0), b2, voffB);
            PG8_BAR; PG8_WAIT_L(0); PG8_MMA(0, 1, At, B1); PG8_BAR;
            PG8_LDA(At, 0, 1); PG8_STAGE(PG8_SA(0, 0), a2, voffA);
            PG8_BAR; PG8_WAIT_L(0); PG8_MMA(1, 0, At, B0); PG8_BAR; PG8_SCHED;
            PG8_STAGE(PG8_SB(0, 1), b2 + hstepB, voffB);
            PG8_WAIT_V(6); PG8_BAR; PG8_MMA(1, 1, At, B1); PG8_BAR;
            PG8_LDB(B0, 1, 0); PG8_SCHED; PG8_LDA(At, 1, 0); PG8_STAGE(PG8_SA(0, 1), a2 + hstepA, voffA);
            PG8_WAIT_L(8); PG8_BAR; PG8_WAIT_L(0); PG8_MMA(0, 0, At, B0); PG8_BAR; PG8_SCHED;
            PG8_LDB(B1, 1, 1); PG8_STAGE(PG8_SB(1, 0), b3, voffB);
            PG8_BAR; PG8_WAIT_L(0); PG8_MMA(0, 1, At, B1); PG8_BAR;
            PG8_LDA(At, 1, 1); PG8_STAGE(PG8_SA(1, 0), a3, voffA);
            PG8_BAR; PG8_WAIT_L(0); PG8_MMA(1, 0, At, B0); PG8_BAR; PG8_SCHED;
            PG8_STAGE(PG8_SB(1, 1), b3 + hstepB, voffB);
            PG8_WAIT_V(6); PG8_BAR; PG8_MMA(1, 1, At, B1); PG8_BAR;
            }
        }
        if constexpr (ALIGN_EPI) { if (wr == 0) PG8_BAR; }
        if constexpr (Epi::RESID) { if (has_next) E.resid_load(rz, nxt, wr, wc, fr, fq);
            else {
#pragma unroll
                for (int a = 0; a < 2; ++a)
#pragma unroll
                    for (int m = 0; m < 4; ++m)
#pragma unroll
                        for (int b = 0; b < 2; ++b) rz[a][m][b] = (u32x4){0u, 0u, 0u, 0u}; } }
        if constexpr (!Epi::AFTER_DRAIN) { E(acc, cur, wr, wc, fr, fq, cslot); S.done(cur); }
        if (!has_next) break;
        __builtin_amdgcn_s_waitcnt(0x4F70);
        PG8_PREP(nxt, cur.pm);
        if constexpr (Epi::RESID) Epi::resid_init(acc, rz); else {
#pragma unroll
        for (int a = 0; a < 2; ++a)
#pragma unroll
            for (int b = 0; b < 2; ++b)
#pragma unroll
                for (int m = 0; m < 4; ++m)
#pragma unroll
                    for (int n = 0; n < 2; ++n) acc[a][b][m][n] = (f32x4){0.f, 0.f, 0.f, 0.f};
        }
        cur = nxt; cA = nA; cB = nB; ++ui;
        if constexpr (ALIGN_EPI) { if (wr == 1) PG8_BAR; }
    }
    PG8_WAIT_V(0);
    if constexpr (!ALIGN_EPI) { if (wr == 0) PG8_BAR; }
    PG8_BAR;
#undef PG8_KA
#undef PG8_WAIT_V8_UNLESS
#undef PG8_PREP
#undef PG8_SA
#undef PG8_SB
#undef PG8_STAGE
#undef PG8_LDA
#undef PG8_LDB
#undef PG8_MMA
#undef PG8_WAIT_V
#undef PG8_WAIT_L
#undef PG8_BAR
#undef PG8_SCHED
}
}


namespace att {
typedef short s16x4 __attribute__((ext_vector_type(4)));
typedef float f32x16 __attribute__((ext_vector_type(16)));
constexpr int D = 128, NW = 8, QBLK = 32, KVBLK = 64, QB = NW * QBLK;
constexpr int SHM_V = KVBLK * D * 2, SHM_K = KVBLK * D * 2;
constexpr int ATT_LDS_BYTES = 2 * SHM_V + 2 * SHM_K + NW * 64 * 4;
constexpr float SCALE = 0.08838834764831845f, THR = 8.f;
#define KSWZ(row, colB) ((row) * 256 + ((colB) ^ (((row) & 7) << 4)))
#define SBAR() __builtin_amdgcn_sched_barrier(0)
__device__ __forceinline__ int v_st(int k, int c) { const int kk = (k & ~0xC) | ((k & 4) << 1) | ((k & 8) >> 1); return ((kk >> 3) * 4 + (c >> 5)) * 512 + ((kk & 7) * 32 + (c & 31)) * 2; }
__device__ __forceinline__ int v_rd_base(int lane) { return ((lane & 3) << 3) | (((lane >> 2) & 3) << 6) | (((lane >> 4) & 1) << 5) | (((lane >> 5) & 1) << 8); }
constexpr int v_rd_off(int d0, int ks, int half) { return d0 * 512 + ks * 4096 + half * 2048; }
__device__ __forceinline__ int crow(int r, int hi) { return (r & 3) + 8 * (r >> 2) + 4 * hi; }
__device__ __forceinline__ unsigned cvtpk(float lo, float hi) { unsigned r; asm volatile("v_cvt_pk_bf16_f32 %0, %1, %2" : "=v"(r) : "v"(lo), "v"(hi)); return r; }
__device__ __forceinline__ bf16x8 load8(const bf16_t* p) { return *reinterpret_cast<const bf16x8*>(p); }
__device__ __forceinline__ void mask_tile(f32x16& p0, f32x16& p1, int dq, unsigned W) {
    const float NEG = -__builtin_inff();
#pragma unroll
    for (int r = 0; r < 16; ++r) { const int c = (r & 3) + 8 * (r >> 2);
        if ((unsigned)(dq - c) >= W) p0[r] = NEG;
        if ((unsigned)(dq - c - 32) >= W) p1[r] = NEG; }
}
__device__ __forceinline__ void partialSM(f32x16& p0, f32x16& p1, float& m_reg, float& mn, float& alpha, bool act) {
    if (!act) { mn = m_reg; alpha = 1.f; return; }
    float pmax = p0[0]; for (int r = 1; r < 16; ++r) pmax = fmaxf(pmax, p0[r]); for (int r = 0; r < 16; ++r) pmax = fmaxf(pmax, p1[r]);
    { auto rr = __builtin_amdgcn_permlane32_swap(__float_as_uint(pmax), __float_as_uint(pmax), false, false);
      pmax = fmaxf(__uint_as_float(rr[0]), __uint_as_float(rr[1])); }
    constexpr float C2 = 1.4426950408889634f * SCALE;
    if (__builtin_expect(__all((pmax - m_reg) * SCALE <= THR), 1)) { mn = m_reg; alpha = 1.f; }
    else { mn = fmaxf(m_reg, pmax); alpha = __builtin_amdgcn_exp2f((m_reg - mn) * C2); m_reg = mn; }
    const float mnL = -mn * C2;
    for (int r = 0; r < 16; ++r) p0[r] = fmaf(p0[r], C2, mnL); for (int r = 0; r < 16; ++r) p1[r] = fmaf(p1[r], C2, mnL);
    for (int r = 0; r < 16; ++r) p0[r] = __builtin_amdgcn_exp2f(p0[r]);
}
__device__ __forceinline__ void finishSM(f32x16& p0, f32x16& p1, float alpha, float& l_reg, bf16x8& pa0, bf16x8& pa1, bf16x8& pa2, bf16x8& pa3, bool act) {
    if (!act) return;
    for (int r = 0; r < 16; ++r) p1[r] = __builtin_amdgcn_exp2f(p1[r]);
    float ps = 0; for (int r = 0; r < 16; ++r) ps += p0[r]; for (int r = 0; r < 16; ++r) ps += p1[r];
    { auto rr = __builtin_amdgcn_permlane32_swap(__float_as_uint(ps), __float_as_uint(ps), false, false);
      ps = __uint_as_float(rr[0]) + __uint_as_float(rr[1]); }
    l_reg = l_reg * alpha + ps;
#define PK4(P, B_, OUT) do { unsigned a0 = cvtpk(P[B_+0], P[B_+1]), a1 = cvtpk(P[B_+2], P[B_+3]);                          \
        unsigned b0 = cvtpk(P[B_+4], P[B_+5]), b1 = cvtpk(P[B_+6], P[B_+7]);                                             \
        auto r0 = __builtin_amdgcn_permlane32_swap(a0, b0, false, false); auto r1 = __builtin_amdgcn_permlane32_swap(a1, b1, false, false); \
        u32x4 w = {r0[0], r1[0], r0[1], r1[1]}; OUT = *reinterpret_cast<bf16x8*>(&w); } while (0)
    PK4(p0, 0, pa0); PK4(p0, 8, pa1); PK4(p1, 0, pa2); PK4(p1, 8, pa3);
#undef PK4
}
template <int KB>
__device__ __forceinline__ void qkt(f32x16& p0, f32x16& p1, const char* K_lds, int r32, int hi, const bf16x8* qr, bool act) {
    if (!act) return;
    p0 = f32x16{}; p1 = f32x16{};
    const char* kb[4];
#pragma unroll
    for (int dd = 0; dd < 4; ++dd) kb[dd] = K_lds + KB * SHM_K + KSWZ(r32, (dd * 16 + hi * 8) * 2);
#pragma unroll
    for (int d0 = 0; d0 < 8; ++d0) { const char* a = kb[d0 & 3] + (d0 >> 2) * 128;
        bf16x8 b0 = *reinterpret_cast<const bf16x8*>(a);
        bf16x8 b1 = *reinterpret_cast<const bf16x8*>(a + 32 * 256);
        p0 = __builtin_amdgcn_mfma_f32_32x32x16_bf16(b0, qr[d0], p0, 0, 0, 0);
        p1 = __builtin_amdgcn_mfma_f32_32x32x16_bf16(b1, qr[d0], p1, 0, 0, 0); }
}
template <int VB>
__device__ __forceinline__ void pv_tile(f32x16* o, int vb0, bf16x8 pa0, bf16x8 pa1, bf16x8 pa2, bf16x8 pa3, bool act) {
    if (!act) return;
#define TRRD(dst, off) asm volatile("ds_read_b64_tr_b16 %0, %1 offset:%2" : "=&v"(dst) : "v"(vb0), "i"(off) : "memory")
#define PV_D0(d0) do { s16x4 l0, l1, l2, l3, h0, h1, h2, h3; constexpr int b_ = VB * SHM_V + v_rd_off(d0, 0, 0); \
        TRRD(l0, b_); TRRD(h0, b_ + 2048); TRRD(l1, b_ + 4096); TRRD(h1, b_ + 6144); TRRD(l2, b_ + 8192); TRRD(h2, b_ + 10240); TRRD(l3, b_ + 12288); TRRD(h3, b_ + 14336); \
        asm volatile("s_waitcnt lgkmcnt(0)" ::: "memory"); SBAR();   \
        o[d0] = __builtin_amdgcn_mfma_f32_32x32x16_bf16(pa0, (bf16x8){l0[0], l0[1], l0[2], l0[3], h0[0], h0[1], h0[2], h0[3]}, o[d0], 0, 0, 0);   \
        o[d0] = __builtin_amdgcn_mfma_f32_32x32x16_bf16(pa1, (bf16x8){l1[0], l1[1], l1[2], l1[3], h1[0], h1[1], h1[2], h1[3]}, o[d0], 0, 0, 0);   \
        o[d0] = __builtin_amdgcn_mfma_f32_32x32x16_bf16(pa2, (bf16x8){l2[0], l2[1], l2[2], l2[3], h2[0], h2[1], h2[2], h2[3]}, o[d0], 0, 0, 0);   \
        o[d0] = __builtin_amdgcn_mfma_f32_32x32x16_bf16(pa3, (bf16x8){l3[0], l3[1], l3[2], l3[3], h3[0], h3[1], h3[2], h3[3]}, o[d0], 0, 0, 0); } while (0)
    PV_D0(0); PV_D0(1); PV_D0(2); PV_D0(3);
#undef PV_D0
#undef TRRD
}
struct BlockRef { const bf16_t* Q; const bf16_t* K; const bf16_t* V; bf16_t* O; float* lse; int P0, pq, pk, skv, W, lsep, mode; };
struct Seam { bf16x8 qr[8]; bf16x8 st_v0, st_v1, st_k0, st_k1; bf16x8 n_v0, n_v1, n_k0, n_k1; };
__device__ __forceinline__ int swa_jlo(int P0, int W) { const int lowk = P0 - W + 1; return lowk > 0 ? lowk / KVBLK : 0; }
#define ROWK(p, k0, rr, pk_) ((const bf16_t*)((const char*)(p) + (size_t)(unsigned)((((unsigned)((k0) + (rr))) * (unsigned)(pk_) + (unsigned)sc) * 2u)))
#define VMW() asm volatile("s_waitcnt vmcnt(0)" ::: "memory")
#define VMWN(n) asm volatile("s_waitcnt vmcnt(%0)" :: "i"(n) : "memory")
#define SLOAD_H(Kp, Vp, k0, pk_) do { S.st_v0 = load8(ROWK(Vp, k0, sr, pk_)); S.st_v1 = load8(ROWK(Vp, k0, 32 + sr, pk_));              \
                         S.st_k0 = load8(ROWK(Kp, k0, sr, pk_)); S.st_k1 = load8(ROWK(Kp, k0, 32 + sr, pk_)); } while (0)
#define SLOAD_N(Kp, Vp, k0, pk_) do { S.n_v0 = load8(ROWK(Vp, k0, sr, pk_)); S.n_v1 = load8(ROWK(Vp, k0, 32 + sr, pk_));              \
                         S.n_k0 = load8(ROWK(Kp, k0, sr, pk_)); S.n_k1 = load8(ROWK(Kp, k0, 32 + sr, pk_)); } while (0)
#define SWRITE_N(bf) do { *(bf16x8*)(V_lds + (bf) * SHM_V + vst0) = S.n_v0; *(bf16x8*)(V_lds + (bf) * SHM_V + vst1) = S.n_v1; *(bf16x8*)(K_lds + (bf) * SHM_K + kws) = S.n_k0; *(bf16x8*)(K_lds + (bf) * SHM_K + kws + 32 * 256) = S.n_k1; } while (0)
#define SWRITE_HK(bf) do { *(bf16x8*)(K_lds + (bf) * SHM_K + kws) = S.st_k0; *(bf16x8*)(K_lds + (bf) * SHM_K + kws + 32 * 256) = S.st_k1; } while (0)
#define SWRITE_HV(bf) do { *(bf16x8*)(V_lds + (bf) * SHM_V + vst0) = S.st_v0; *(bf16x8*)(V_lds + (bf) * SHM_V + vst1) = S.st_v1; } while (0)
#define SWRITE_H(bf) do { SWRITE_HV(bf); SWRITE_HK(bf); } while (0)
__device__ __forceinline__ void swa_prime(const BlockRef& cur, char* lds, Seam& S, int tid) {
    const int wid = __builtin_amdgcn_readfirstlane(tid >> 6), lane = tid & 63, r32 = lane & 31, hi = lane >> 5;
    const int sr = tid >> 4, sc = (tid & 15) * 8, kws = KSWZ(sr, sc * 2); char* K_lds = lds + 2 * SHM_V;
    const int kb0 = swa_jlo(cur.P0, cur.W) * KVBLK;
    { const unsigned qoff = ((unsigned)(wid * QBLK + r32) * (unsigned)cur.pq + (unsigned)hi * 8u) * 2u;
      for (int d0 = 0; d0 < 8; ++d0) S.qr[d0] = *(const bf16x8*)((const char*)cur.Q + (size_t)qoff + d0 * 32); }
    SLOAD_H(cur.K, cur.V, kb0, cur.pk);
    SLOAD_N(cur.K, cur.V, kb0 + KVBLK, cur.pk);
    VMW(); SWRITE_HK(0);
    __syncthreads();
}
__device__ __forceinline__ void swa_block(const BlockRef& cur, const BlockRef& nxt, char* lds, Seam& S, int tid) {
    const int wid = __builtin_amdgcn_readfirstlane(tid >> 6), lane = tid & 63, r32 = lane & 31, hi = lane >> 5;
    const int W = cur.W, pk = cur.pk;
    const int j_lo = swa_jlo(cur.P0, W);
    int j_hi = (cur.P0 + QB - 1) / KVBLK + 1; if (j_hi > cur.skv / KVBLK) j_hi = cur.skv / KVBLK;
    const int NT = j_hi - j_lo;
    const int kbn = swa_jlo(nxt.P0, nxt.W) * KVBLK;
    const int qlo = cur.P0 + wid * QBLK, qm = qlo + r32 - 4 * hi;
    char* V_lds = lds; char* K_lds = lds + 2 * SHM_V;
    float* ws = (float*)(lds + 2 * SHM_V + 2 * SHM_K) + wid * 64; float* li_l = ws, * al_l = ws + 32;
    float m_reg = -1e30f, l_reg = 0; f32x16 o[4] = {};
    const int sr = tid >> 4, sc = (tid & 15) * 8, vst0 = v_st(sr, sc), vst1 = v_st(32 + sr, sc), kws = KSWZ(sr, sc * 2);
    const int vb0 = (int)(uintptr_t)V_lds + v_rd_base(lane);
    const bf16_t* Kh = cur.K; const bf16_t* Vh = cur.V;
#define RESC(a) do { if (__any((a) < 1.f)) { if (hi == 0) al_l[r32] = (a); asm volatile("s_waitcnt lgkmcnt(0)" ::: "memory");              \
                     for (int d_ = 0; d_ < 4; ++d_) for (int r = 0; r < 16; ++r) o[d_][r] *= al_l[crow(r, hi)]; } } while (0)
#define KBASE(t) ((j_lo + (t)) * KVBLK)
#define ACT(t) (KBASE(t) <= qlo + QBLK - 1 && KBASE(t) + KVBLK - 1 >= qlo - W + 1)
#define MASKT(P0_, P1_, t) do { const int kb_ = KBASE(t); if (ACT(t) && (kb_ + KVBLK - 1 > qlo || kb_ <= qlo + QBLK - 1 - W)) mask_tile(P0_, P1_, qm - kb_, (unsigned)W); } while (0)
    constexpr int NQL = 8;
#define SEAM_K0() do { VMWN(NQL); SWRITE_HK(0); SBAR(); } while (0)
    f32x16 pA0, pA1, pB0, pB1; float mnA, mnB, alA, alB; bf16x8 pa0, pa1, pa2, pa3;
    SWRITE_HV(0); SBAR();
    SBAR(); qkt<0>(pA0, pA1, K_lds, r32, hi, S.qr, ACT(0));
    MASKT(pA0, pA1, 0); partialSM(pA0, pA1, m_reg, mnA, alA, ACT(0));
    if (NT > 1) { VMW(); SWRITE_N(1); }
    __syncthreads();
#define HALF_STEP(PX0, PX1, mnX, alX, PY0, PY1, alY, t, KB, VB, SB) do {                                                      \
        SBAR(); if ((t) + 1 < NT) { SLOAD_H(Kh, Vh, KBASE((t) + 1), pk); SBAR(); }                               \
        qkt<KB>(PX0, PX1, K_lds, r32, hi, S.qr, ACT(t));                                             \
        finishSM(PY0, PY1, alY, l_reg, pa0, pa1, pa2, pa3, ACT((t) - 1)); SBAR();                                                           \
        pv_tile<VB>(o, vb0, pa0, pa1, pa2, pa3, ACT((t) - 1)); MASKT(PX0, PX1, (t)); partialSM(PX0, PX1, m_reg, mnX, alX, ACT(t));                                        \
        __syncthreads();                                                                                                      \
        if ((t) + 1 < NT) { VMW(); SWRITE_H(SB); }                                                                          \
        RESC(alX); __syncthreads(); } while (0)
    for (int t = 1; t + 1 < NT; t += 2) {
        HALF_STEP(pB0, pB1, mnB, alB, pA0, pA1, alA, t, 1, 0, 0);
        HALF_STEP(pA0, pA1, mnA, alA, pB0, pB1, alB, t + 1, 0, 1, 1);
    }
    const bool even = (NT & 1) == 0;
    if (even) { SBAR(); qkt<1>(pB0, pB1, K_lds, r32, hi, S.qr, ACT(NT - 1)); SBAR(); }
    { SLOAD_H(nxt.K, nxt.V, kbn, nxt.pk); SBAR();
        const unsigned qoff = ((unsigned)(wid * QBLK + r32) * (unsigned)nxt.pq + (unsigned)hi * 8u) * 2u;
#pragma unroll
        for (int d0 = 0; d0 < 8; ++d0) S.qr[d0] = *(const bf16x8*)((const char*)nxt.Q + (size_t)qoff + d0 * 32); }
    SBAR();
    finishSM(pA0, pA1, alA, l_reg, pa0, pa1, pa2, pa3, ACT(even ? NT - 2 : NT - 1)); SBAR();
    pv_tile<0>(o, vb0, pa0, pa1, pa2, pa3, ACT(even ? NT - 2 : NT - 1));
    if (even) { MASKT(pB0, pB1, NT - 1); partialSM(pB0, pB1, m_reg, mnB, alB, ACT(NT - 1)); __syncthreads(); RESC(alB);
        finishSM(pB0, pB1, alB, l_reg, pa0, pa1, pa2, pa3, ACT(NT - 1)); SBAR(); pv_tile<1>(o, vb0, pa0, pa1, pa2, pa3, ACT(NT - 1)); }
    SBAR(); SEAM_K0();
    SLOAD_N(nxt.K, nxt.V, kbn + KVBLK, nxt.pk); SBAR();
    if (hi == 0) li_l[r32] = l_reg; asm volatile("s_waitcnt lgkmcnt(0)" ::: "memory");
    float rli[16];
#pragma unroll
    for (int r = 0; r < 16; ++r) rli[r] = __builtin_amdgcn_rcpf(li_l[crow(r, hi)]);
    int r32e = r32, hie = hi, lne = lane; asm volatile("" : "+v"(r32e), "+v"(hie), "+v"(lne));
    bf16_t* Ow = cur.O + (size_t)(wid * QBLK) * cur.pq;
    const unsigned pqu = (unsigned)cur.pq;
    if (cur.mode == 2) {
        float sink = 0.f;
#pragma unroll
        for (int r = 0; r < 16; ++r)
#pragma unroll
            for (int d0 = 0; d0 < 4; ++d0) sink += o[d0][r] * rli[r];
        asm volatile("" :: "v"(sink), "v"(m_reg));
    } else {
        if (cur.mode == 0 && hie == 0) cur.lse[(size_t)(wid * QBLK + r32e) * cur.lsep] = m_reg * SCALE + __logf(l_reg);
        char* stg = lds + ATT_LDS_BYTES + wid * (32 * 144);
        const unsigned goff = ((unsigned)(lne >> 3) * pqu + (unsigned)(lne & 7) * 8u) * 2u;
#pragma unroll
        for (int h2 = 0; h2 < 2; ++h2) {
#pragma unroll
            for (int r = 0; r < 16; ++r) { const int orow = (r & 3) + 8 * (r >> 2) + 4 * hie;
#pragma unroll
                for (int dd = 0; dd < 2; ++dd) *(bf16_t*)(stg + orow * 144 + (dd * 32 + r32e) * 2) = (bf16_t)(cvtpk(o[2 * h2 + dd][r] * rli[r], 0.f) & 0xffffu); }
            u32x4 ov[4], zv[4];
#pragma unroll
            for (int j = 0; j < 4; ++j) ov[j] = *(const u32x4*)(stg + (j * 8 + (lne >> 3)) * 144 + (lne & 7) * 16);
            char* gp = (char*)Ow + (size_t)goff + h2 * 128;
            if (cur.mode == 1) {
#pragma unroll
                for (int j = 0; j < 4; ++j) zv[j] = __builtin_nontemporal_load((const u32x4*)(gp + (size_t)(j * 8) * pqu * 2u));
#pragma unroll
                for (int j = 0; j < 4; ++j)
#pragma unroll
                    for (int e = 0; e < 4; ++e) ov[j][e] = cvtpk(__uint_as_float(ov[j][e] << 16) * silu(__uint_as_float(zv[j][e] << 16)), __uint_as_float(ov[j][e] & 0xffff0000u) * silu(__uint_as_float(zv[j][e] & 0xffff0000u)));
            }
#pragma unroll
            for (int j = 0; j < 4; ++j) *(u32x4*)(gp + (size_t)(j * 8) * pqu * 2u) = ov[j];
        }
    }
    __syncthreads();
#undef RESC
#undef KBASE
#undef ACT
#undef MASKT
#undef SEAM_K0
#undef HALF_STEP
}
#undef ROWK
#undef VMW
#undef VMWN
#undef SLOAD_H
#undef SLOAD_N
#undef SWRITE_N
#undef SWRITE_HK
#undef SWRITE_HV
#undef SWRITE_H
#undef KSWZ
#undef SBAR
}

typedef GAS unsigned gu32;
#define RLX_AGENT __ATOMIC_RELAXED, __HIP_MEMORY_SCOPE_AGENT
#define XB_TMO      128
#define XB_XCNT(j)  (256  + 64 * (j))
#define XB_XSUB(j)  (1280 + 64 * (j))
#define XB_XGEN(j)  (2304 + 64 * (j))
#define XB_TOP      3328
#define XB_TOPGEN   3392
#define XCD_BAR_WORDS 3456
#define XB_SPIN_CAP (1u << 18)
__device__ __forceinline__ unsigned xb_ld(unsigned* p)              { return __hip_atomic_load(p, __ATOMIC_RELAXED, __HIP_MEMORY_SCOPE_AGENT); }
__device__ __forceinline__ unsigned xb_add(unsigned* p, unsigned v) { return __hip_atomic_fetch_add(p, v, __ATOMIC_RELAXED, __HIP_MEMORY_SCOPE_AGENT); }
__device__ __forceinline__ unsigned xb_xcc_id() { return (unsigned)__builtin_amdgcn_s_getreg((3 << 11) | 20) & 0xFu; }
#define XB_SPIN(cond, bar) do { unsigned _sp = 0; while (cond) { __builtin_amdgcn_s_sleep(1); \
    if ((++_sp & 255u) == 0u) { if (xb_ld(&(bar)[XB_TMO])) break; if (_sp > XB_SPIN_CAP) { atomicAdd(&(bar)[XB_TMO], 1u); break; } } } } while (0)
struct XcdBarrier { unsigned* bar; unsigned x; volatile LAS unsigned* st; };
__device__ __forceinline__ XcdBarrier xcd_barrier_post(unsigned* bar, volatile LAS unsigned* st, int tid) {
    XcdBarrier b; b.bar = bar; b.x = xb_xcc_id(); b.st = st;
    if (tid == 0) (void)xb_add(&bar[XB_XCNT(b.x)], 1u);
    return b;
}
__device__ __forceinline__ void xcd_barrier_complete(unsigned* bar, unsigned x, unsigned& nloc, unsigned& nx) {
    const unsigned G = gridDim.x * gridDim.y * gridDim.z;
    unsigned sum, cnt, mine, sp = 0u;
    for (;;) {
        sum = 0u; cnt = 0u; mine = 0u;
#pragma unroll
        for (unsigned j = 0; j < 16; ++j) { const unsigned c = xb_ld(&bar[XB_XCNT(j)]); sum += c; cnt += (c > 0u) ? 1u : 0u; mine = (j == x) ? c : mine; }
        if (sum == G) break;
        __builtin_amdgcn_s_sleep(1);
        if ((++sp & 255u) == 0u) { if (xb_ld(&bar[XB_TMO])) break; if (sp > XB_SPIN_CAP) { atomicAdd(&bar[XB_TMO], 1u); break; } }
    }
    nloc = mine > 0u ? mine : 1u; nx = cnt > 0u ? cnt : 1u;
}
__device__ __forceinline__ void xcd_barrier(const XcdBarrier& b, int tid) {
    asm volatile("s_waitcnt vmcnt(0)" ::: "memory");
    __syncthreads();
    if (tid == 0) {
        unsigned* bar = b.bar;
        __builtin_amdgcn_s_waitcnt(0);
        unsigned nloc = b.st[0], nx = b.st[1];
        if (nloc == 0u) { xcd_barrier_complete(bar, b.x, nloc, nx); b.st[0] = nloc; b.st[1] = nx; }
        const unsigned old = xb_add(&bar[XB_XSUB(b.x)], 1u);
        const unsigned gen = old / nloc;
        if (old + 1u == (gen + 1u) * nloc) {
            __builtin_amdgcn_fence(__ATOMIC_RELEASE, "agent");
            asm volatile("s_waitcnt vmcnt(0)" ::: "memory");
            const unsigned og = xb_add(&bar[XB_TOP], 1u);
            const unsigned tg = og / nx;
            if (og + 1u == (tg + 1u) * nx) xb_add(&bar[XB_TOPGEN], 1u);
            else XB_SPIN(xb_ld(&bar[XB_TOPGEN]) == tg, bar);
            __builtin_amdgcn_fence(__ATOMIC_ACQUIRE, "agent");
            xb_add(&bar[XB_XGEN(b.x)], 1u);
            asm volatile("s_waitcnt vmcnt(0)" ::: "memory");
        } else {
            XB_SPIN(xb_ld(&bar[XB_XGEN(b.x)]) == gen, bar);
            __builtin_amdgcn_fence(__ATOMIC_ACQUIRE, "agent");
            asm volatile("s_waitcnt vmcnt(0)" ::: "memory");
        }
    }
    __syncthreads();
}

#define GB_CNT(g) (8192 + 64 * (g))
#define GB_GEN(g) (8704 + 64 * (g))
#define GB_XCC    9216
struct GroupBarrier { unsigned* bar; unsigned g; unsigned same_xcd; };
__device__ __forceinline__ void group_barrier(const GroupBarrier& gbr, int tid) {
    asm volatile("s_waitcnt vmcnt(0)" ::: "memory");
    __syncthreads();
    if (tid == 0) {
        unsigned* bar = gbr.bar;
        __builtin_amdgcn_s_waitcnt(0);
        if (!gbr.same_xcd) { __builtin_amdgcn_fence(__ATOMIC_RELEASE, "agent"); asm volatile("s_waitcnt vmcnt(0)" ::: "memory"); }
        if (gbr.same_xcd) asm volatile("buffer_inv sc1" ::: "memory");
        const unsigned old = xb_add(&bar[GB_CNT(gbr.g)], 1u);
        const unsigned gen = old >> 5;
        if ((old & 31u) == 31u) xb_add(&bar[GB_GEN(gbr.g)], 1u);
        else XB_SPIN(xb_ld(&bar[GB_GEN(gbr.g)]) == gen, bar);
        if (!gbr.same_xcd) __builtin_amdgcn_fence(__ATOMIC_ACQUIRE, "agent");
        asm volatile("s_waitcnt vmcnt(0)" ::: "memory");
    }
    __syncthreads();
}

__device__ __forceinline__ int lane_id_opaque() { int l; asm volatile("v_mbcnt_lo_u32_b32 %0, -1, 0\n\tv_mbcnt_hi_u32_b32 %0, -1, %0" : "=v"(l)); return l; }
__device__ __forceinline__ void stagger_wait(unsigned ticks) {
    int bx = blockIdx.x; asm volatile("" : "+s"(bx));
    if ((bx >> 3) & 1) { const unsigned long long t0 = __builtin_amdgcn_s_memrealtime(); while (__builtin_amdgcn_s_memrealtime() - t0 < ticks) __builtin_amdgcn_s_sleep(16); }
}
struct Frame {
    LAS unsigned char* lds;
    int tid, lane, wave, vcu, G;
};

struct TItem { f32x4 v[8]; float gv[8]; };
__device__ __forceinline__ void titem_load(TItem& t, const float* __restrict__ W, int N, const float* __restrict__ g, int item, int lane) {
    const int nblk = N / 32, kb = item / nblk, nb = item % nblk, k0 = 64 * kb, n0 = 32 * nb, kr = lane >> 3, nq = lane & 7;
#pragma unroll
    for (int i = 0; i < 8; ++i) { t.v[i] = ldntf4(W + (size_t)(k0 + 8 * i + kr) * N + n0 + 4 * nq); t.gv[i] = g ? g[k0 + 8 * i + kr] : 1.f; }
}
__device__ __forceinline__ void titem_finish(const TItem& t, int K, int N, bf16_t* WT, int row_off, LAS float* scr, int item, int lane, bool dry, bool folded_skip) {
    const int nblk = N / 32, kb = item / nblk, nb = item % nblk, k0 = 64 * kb, n0 = 32 * nb;
    if (folded_skip && n0 >= E_XB && n0 < E_XB + 512) return;
    { const int kr = lane >> 3, nq = lane & 7;
#pragma unroll
      for (int i = 0; i < 8; ++i)
#pragma unroll
          for (int e = 0; e < 4; ++e) scr[(8 * i + kr) * 33 + 4 * nq + e] = t.v[i][e] * t.gv[i]; }
    asm volatile("s_waitcnt lgkmcnt(0)" ::: "memory");
    const int c = lane & 7;
#pragma unroll
    for (int j = 0; j < 4; ++j) { const int n = (lane >> 3) + 8 * j; const LAS float* sp = scr + (8 * c) * 33 + n;
        u32x4 o; o.x = pk2(sp[0 * 33], sp[1 * 33]); o.y = pk2(sp[2 * 33], sp[3 * 33]); o.z = pk2(sp[4 * 33], sp[5 * 33]); o.w = pk2(sp[6 * 33], sp[7 * 33]);
        if (!dry) *(u32x4*)(WT + (size_t)(row_off + n0 + n) * K + k0 + 8 * c) = o; }
    asm volatile("s_waitcnt lgkmcnt(0)" ::: "memory");
}
__device__ __forceinline__ void fold_tile(const float* __restrict__ W, bf16_t* WT, const float* __restrict__ g, const float* __restrict__ wpool, const float* __restrict__ pscale, int item, int lane, bool dry) {
    const int kb = item >> 5, nb = item & 31, k0 = 16 * kb, nn0 = 16 * nb, gi = nn0 >> 7, d0 = nn0 & 127, fr = lane & 15, fq = lane >> 4;
    const float* ap = W + (size_t)(k0 + fr) * EP + E_XB + gi * 128 + fq;
    const float* bp = wpool + (size_t)gi * 128 * 128 + (size_t)fq * 128 + d0 + fr;
    float av[32], bv[32];
#pragma unroll
    for (int ks = 0; ks < 32; ++ks) { av[ks] = ap[4 * ks]; bv[ks] = bp[(size_t)4 * ks * 128]; }
    f32x4 acc = {0.f, 0.f, 0.f, 0.f};
#pragma unroll
    for (int ks = 0; ks < 32; ++ks) acc = __builtin_amdgcn_mfma_f32_16x16x4f32(av[ks], bv[ks], acc, 0, 0, 0);
    const float ps = pscale[gi * 128 + d0 + fr]; const f32x4 gk = *(const f32x4*)(g + k0 + 4 * fq);
    u32x2 o; o.x = pk2(acc[0] * ps * gk[0], acc[1] * ps * gk[1]); o.y = pk2(acc[2] * ps * gk[2], acc[3] * ps * gk[3]);
    if (!dry) *(u32x2*)(WT + (size_t)(E_XB + nn0 + fr) * DM + k0 + 4 * fq) = o;
}
__device__ __forceinline__ void convert_weight(const Frame& F, int gw, int NGW, const float* W, int K, int N, bf16_t* WT, int row_off, const float* g, bool dry = false, const float* wpool = nullptr, const float* pscale = nullptr) {
    LAS float* scr = (LAS float*)(F.lds + F.wave * 16384);
    const int nitems = (K / 64) * (N / 32);
    { int it = gw; TItem cur;
      if (it < nitems) titem_load(cur, W, N, g, it, F.lane);
      for (; it < nitems; it += NGW) { TItem nxt; const int nit = it + NGW;
          if (nit < nitems) titem_load(nxt, W, N, g, nit, F.lane);
          else {
#pragma unroll
              for (int q = 0; q < 8; ++q) { nxt.v[q] = (f32x4){0.f, 0.f, 0.f, 0.f}; nxt.gv[q] = 0.f; } }
          titem_finish(cur, K, N, WT, row_off, scr, it, F.lane, dry, wpool != nullptr);
          cur = nxt; } }
    if (wpool) for (int it = gw; it < (DM / 16) * 32; it += NGW) fold_tile(W, WT, g, wpool, pscale, it, F.lane, dry);
}

__device__ __forceinline__ att::BlockRef att_item(int L, bool even, bf16_t* proj, const bf16_t* mkv, float* lse, bool dry) {
    att::BlockRef r;
    const int xq = (L & 255) >> 5, jj = L & 31, rd = L >> 8;
    if (even && L < 1536) {
        const int idx = rd * 32 + jj, pair = xq * 4 + idx / 48, kk = idx % 48, g = kk >> 4, x = kk & 15, b = pair >> 2, h = pair & 3;
        const int dsh = 2 * g, dil = 1 << dsh, nqb = 16 >> dsh, rr = x >> (4 - dsh), qb = x & (nqb - 1);
        const size_t tok0 = (size_t)b * SEQ + rr, q0 = tok0 + (size_t)qb * 256 * dil;
        r.Q = pcol(proj, g * 1024 + h * 128) + q0 * PR; r.O = pcol(proj, g * 1024 + h * 128) + q0 * PR;
        r.K = pcol(proj, g * 1024 + 512 + h * 128) + tok0 * PR; r.V = pcol(proj, E_VA + h * 128) + tok0 * PR;
        r.P0 = qb * 256; r.pq = dil * PR; r.pk = dil * PR; r.skv = SEQ >> dsh; r.W = 129; r.mode = 0;
        r.lse = lse + (size_t)(g * 4 + h) * NT + tok0 + (size_t)qb * 256 * dil; r.lsep = dil;
    } else {
        const int idx2 = (even ? rd - 6 : rd) * 32 + jj, pair = xq * 4 + (idx2 >> 4), qb = idx2 & 15, b = pair >> 2, h = pair & 3;
        const int qcol = even ? E_QM : O_QM, zcol = (even ? E_Z : O_Z) + 1024;
        const size_t row0 = (size_t)b * SEQ + qb * 256;
        r.Q = pcol(proj, qcol + h * 128) + row0 * PR; r.O = pcol(proj, zcol + h * 128) + row0 * PR;
        r.K = mkv + (size_t)(b * NMEM) * 4096 + h * 128; r.V = r.K + 512;
        r.P0 = 256; r.pq = PR; r.pk = 4096; r.skv = 256; r.W = 1 << 20; r.mode = 1; r.lse = nullptr; r.lsep = 0;
    }
    if (dry) r.mode = 2;
    return r;
}
__device__ __forceinline__ void attn_phase(char* lds, int vcu, int G, bool even, bf16_t* proj, const bf16_t* mkv, float* lse, int tid_in, bool dry = false, int lo = 0, int hi = 1 << 30) {
    int tid = tid_in; asm volatile("" : "+v"(tid));
    const int total = (even ? 2048 : 512) < hi ? (even ? 2048 : 512) : hi;
    int L = vcu + lo; if (L >= total) return;
    att::BlockRef cur = att_item(L, even, proj, mkv, lse, dry);
    att::Seam S;
    att::swa_prime(cur, lds, S, tid);
    for (;;) {
        const int Ln = L + G; const bool last = Ln >= total;
        const att::BlockRef nxt = last ? cur : att_item(Ln, even, proj, mkv, lse, dry);
        att::swa_block(cur, nxt, lds, S, tid);
        if (last) break;
        cur = nxt; L = Ln;
    }
}
__device__ __forceinline__ void combine_phase(const Frame& F, bf16_t* proj, const float* __restrict__ lse, bool dry = false) {
    const int lane = F.lane, h = lane >> 4, dc = (lane & 15) * 8, NGW = F.G * NWAVES;
    for (int tok0 = F.vcu * 128 + F.wave * 16, tk = 0; tk < 4; ++tk, tok0 += 4) {
        u32x4 o0[4], o1[4], o2[4], zz[4]; float w0[4], w1[4], w2[4];
#pragma unroll
        for (int q = 0; q < 4; ++q) { const size_t tok = tok0 + q; const int cc = h * 128 + dc;
            w0[q] = lse[(size_t)(0 * 4 + h) * NT + tok]; w1[q] = lse[(size_t)(1 * 4 + h) * NT + tok]; w2[q] = lse[(size_t)(2 * 4 + h) * NT + tok];
            o0[q] = ldnt4(pcol(proj, cc) + tok * PR); o1[q] = ldnt4(pcol(proj, 1024 + cc) + tok * PR); o2[q] = ldnt4(pcol(proj, 2048 + cc) + tok * PR); zz[q] = ldnt4(pcol(proj, E_Z + cc) + tok * PR); }
#pragma unroll
        for (int q = 0; q < 4; ++q) { const size_t tok = tok0 + q; bf16_t* zrow = pcol(proj, E_Z + h * 128 + dc) + tok * PR;
            const float M = fmaxf(w0[q], fmaxf(w1[q], w2[q])); float a0 = __expf(w0[q] - M), a1 = __expf(w1[q] - M), a2 = __expf(w2[q] - M);
            const float inv = 1.f / (a0 + a1 + a2); a0 *= inv; a1 *= inv; a2 *= inv;
            u32x4 y;
#pragma unroll
            for (int j = 0; j < 4; ++j) {
                const float a = a0 * __uint_as_float(o0[q][j] << 16) + a1 * __uint_as_float(o1[q][j] << 16) + a2 * __uint_as_float(o2[q][j] << 16);
                const float b = a0 * __uint_as_float(o0[q][j] & 0xffff0000u) + a1 * __uint_as_float(o1[q][j] & 0xffff0000u) + a2 * __uint_as_float(o2[q][j] & 0xffff0000u);
                y[j] = pk2(a * silu(__uint_as_float(zz[q][j] << 16)), b * silu(__uint_as_float(zz[q][j] & 0xffff0000u))); }
            if (!dry) *(u32x4*)zrow = y; }
    }
}
__device__ __forceinline__ void pool_phase(const Frame& F, bf16_t* proj, bool dry = false) {
    const int lane = F.lane, gi = lane >> 4, w = 2 << gi, NGW = F.G * NWAVES;
    for (int run = F.vcu * NWAVES + F.wave; run < NT / 16; run += NGW) {
        const int t0 = run * 16, p0 = t0 % SEQ;
        const bf16_t* xc = pcol(proj, E_XB + lane * 8) + (size_t)t0 * PR; bf16_t* zc = pcol(proj, E_Z + 512 + lane * 8) + (size_t)t0 * PR;
        float sum[8];
#pragma unroll
        for (int e = 0; e < 8; ++e) sum[e] = 0.f;
        { u32x4 h[16];
#pragma unroll
          for (int j = 1; j <= 16; ++j) h[j - 1] = (j <= w && p0 - j >= 0) ? *(const u32x4*)(xc - (long)j * PR) : (u32x4){0u, 0u, 0u, 0u};
#pragma unroll
          for (int j = 0; j < 16; ++j)
#pragma unroll
              for (int e = 0; e < 4; ++e) { sum[2 * e] += __uint_as_float(h[j][e] << 16); sum[2 * e + 1] += __uint_as_float(h[j][e] & 0xffff0000u); } }
#pragma unroll
        for (int bt = 0; bt < 16; bt += 4) { u32x4 xa[4], xs[4], zz[4];
#pragma unroll
            for (int i = 0; i < 4; ++i) { const int p = p0 + bt + i;
                xa[i] = *(const u32x4*)(xc + (long)(bt + i) * PR); zz[i] = ldnt4(zc + (long)(bt + i) * PR);
                xs[i] = (p >= w) ? *(const u32x4*)(xc + (long)(bt + i - w) * PR) : (u32x4){0u, 0u, 0u, 0u}; }
#pragma unroll
            for (int i = 0; i < 4; ++i) { const int p = p0 + bt + i; const float ic = 1.f / (float)((p + 1 < w) ? p + 1 : w); u32x4 y;
#pragma unroll
                for (int e = 0; e < 4; ++e) { const float x0 = __uint_as_float(xa[i][e] << 16), x1 = __uint_as_float(xa[i][e] & 0xffff0000u);
                    sum[2 * e] += x0 - __uint_as_float(xs[i][e] << 16); sum[2 * e + 1] += x1 - __uint_as_float(xs[i][e] & 0xffff0000u);
                    y[e] = pk2((sum[2 * e] * ic - x0) * silu(__uint_as_float(zz[i][e] << 16)), (sum[2 * e + 1] * ic - x1) * silu(__uint_as_float(zz[i][e] & 0xffff0000u))); }
                if (!dry) *(u32x4*)(zc + (long)(bt + i) * PR) = y; } }
    }
}
__device__ __forceinline__ void cmix_phase(const Frame& F, bf16_t* proj, const float* __restrict__ ln_g, const float* __restrict__ ln_b,
                                           const bf16_t* __restrict__ wsm  , const float* __restrict__ b_s, const float2* __restrict__ lnp, bool dry = false) {
    const int tid = F.tid, lane = F.lane, wv = F.wave, fr = lane & 15, fq = lane >> 4;
    LAS unsigned char* VT = F.lds; LAS float* mu = (LAS float*)(F.lds + 128 * 272); LAS float* rstd = mu + 128;
    for (int ch = F.vcu; ch < NT / 128; ch += F.G) {
        const size_t row0 = (size_t)ch * 128;
        { const int row = tid >> 2, part = tid & 3; const f32x4* pp = (const f32x4*)(lnp + (row0 + row) * 16 + part * 4);
          const f32x4 a = pp[0], b = pp[1]; float s1 = (a[0] + a[2]) + (b[0] + b[2]), s2 = (a[1] + a[3]) + (b[1] + b[3]);
          s1 += __shfl_xor(s1, 1); s1 += __shfl_xor(s1, 2); s2 += __shfl_xor(s2, 1); s2 += __shfl_xor(s2, 2);
          const float m = s1 * (1.f / 1024.f), var = fmaxf(s2 * (1.f / 1024.f) - m * m, 0.f);
          if (part == 0) { mu[row] = m; rstd[row] = rsqrtf(var + EPS); } }
        const int sI = tid >> 2, cq = tid & 3;
        const size_t vro = (row0 + sI) * PR + cq * 8;
        const size_t tro = (row0 + wv * 16 + (lane >> 4)) * PR + (lane & 15) * 8;
        LAS unsigned char* stg = F.lds + 36864 + wv * (16 * 528);
        u32x4 vq[4];
#pragma unroll
        for (int k = 0; k < 4; ++k) vq[k] = *(const u32x4*)(pcol(proj, O_V + k * 32) + vro);
        __syncthreads();
        const float m_s = mu[sI], r_s = rstd[sI];
        for (int g = 0; g < 8; ++g) {
            u32x4 uq[4], zq[4];
#pragma unroll
            for (int j = 0; j < 4; ++j) { uq[j] = ldnt4(pcol(proj, O_U + g * 128) + tro + (size_t)(4 * j) * PR); zq[j] = ldnt4(pcol(proj, O_Z + g * 128) + tro + (size_t)(4 * j) * PR); }
            const float bs = b_s[g * 128 + wv * 16 + fr];
            bf16x8 bw[4];
#pragma unroll
            for (int ks = 0; ks < 4; ++ks) bw[ks] = *(const bf16x8*)(wsm + ((size_t)g * 128 + wv * 16 + fr) * 128 + ks * 32 + 8 * fq);
#pragma unroll
            for (int k = 0; k < 4; ++k) { const int c0 = k * 32 + cq * 8; const f32x4 g0 = *(const f32x4*)(ln_g + g * 128 + c0), g1 = *(const f32x4*)(ln_g + g * 128 + c0 + 4), b0 = *(const f32x4*)(ln_b + g * 128 + c0), b1 = *(const f32x4*)(ln_b + g * 128 + c0 + 4);
#pragma unroll
                for (int j = 0; j < 4; ++j) { const float gg0 = (j < 2) ? g0[2 * j] : g1[2 * j - 4], gg1 = (j < 2) ? g0[2 * j + 1] : g1[2 * j - 3], bb0 = (j < 2) ? b0[2 * j] : b1[2 * j - 4], bb1 = (j < 2) ? b0[2 * j + 1] : b1[2 * j - 3];
                    const float v0 = (__uint_as_float(vq[k][j] << 16) - m_s) * r_s * gg0 + bb0, v1 = (__uint_as_float(vq[k][j] & 0xffff0000u) - m_s) * r_s * gg1 + bb1;
                    *(LAS bf16_t*)(VT + (c0 + 2 * j) * 272 + sI * 2) = (bf16_t)f2bf(v0); *(LAS bf16_t*)(VT + (c0 + 2 * j + 1) * 272 + sI * 2) = (bf16_t)f2bf(v1); } }
            __syncthreads();
            if (g < 7) {
#pragma unroll
                for (int k = 0; k < 4; ++k) vq[k] = *(const u32x4*)(pcol(proj, O_V + (g + 1) * 128 + k * 32) + vro); }
            f32x4 acc[8];
#pragma unroll
            for (int n = 0; n < 8; ++n) acc[n] = (f32x4){0.f, 0.f, 0.f, 0.f};
            const int ksmax = wv >> 1;
#pragma unroll
            for (int ks = 0; ks < 4; ++ks) { if (ks <= ksmax) {
#pragma unroll
                for (int mt = 0; mt < 8; ++mt) { const bf16x8 a = *(const LAS bf16x8*)(VT + (mt * 16 + fr) * 272 + (ks * 32 + 8 * fq) * 2);
                    acc[mt] = __builtin_amdgcn_mfma_f32_16x16x32_bf16(a, bw[ks], acc[mt], 0, 0, 0); } } }
#pragma unroll
            for (int mt = 0; mt < 8; ++mt) *(LAS f32x4*)(stg + fr * 528 + (mt * 16 + 4 * fq) * 4) = acc[mt] + bs;
#pragma unroll
            for (int j = 0; j < 4; ++j) { const LAS f32x4* mp = (const LAS f32x4*)(stg + (4 * j + (lane >> 4)) * 528 + (lane & 15) * 32); const f32x4 m0 = mp[0], m1 = mp[1]; u32x4 y;
                y.x = pk2(__uint_as_float(uq[j].x << 16) * m0[0] * silu(__uint_as_float(zq[j].x << 16)), __uint_as_float(uq[j].x & 0xffff0000u) * m0[1] * silu(__uint_as_float(zq[j].x & 0xffff0000u)));
                y.y = pk2(__uint_as_float(uq[j].y << 16) * m0[2] * silu(__uint_as_float(zq[j].y << 16)), __uint_as_float(uq[j].y & 0xffff0000u) * m0[3] * silu(__uint_as_float(zq[j].y & 0xffff0000u)));
                y.z = pk2(__uint_as_float(uq[j].z << 16) * m1[0] * silu(__uint_as_float(zq[j].z << 16)), __uint_as_float(uq[j].z & 0xffff0000u) * m1[1] * silu(__uint_as_float(zq[j].z & 0xffff0000u)));
                y.w = pk2(__uint_as_float(uq[j].w << 16) * m1[2] * silu(__uint_as_float(zq[j].w << 16)), __uint_as_float(uq[j].w & 0xffff0000u) * m1[3] * silu(__uint_as_float(zq[j].w & 0xffff0000u)));
                if (!dry) *(u32x4*)(pcol(proj, O_Z + g * 128) + tro + (size_t)(4 * j) * PR) = y; }
            __syncthreads();
        }
    }
}

struct Args { const void* in[19]; float* out; unsigned char* ws; };
__global__ void __launch_bounds__(NTHREADS, 2) mega_fwd(Args args) {
    extern __shared__ __attribute__((aligned(16))) unsigned char lds_raw[];
    Frame F;
    F.lds = (LAS unsigned char*)lds_raw;
    const int wave_s = __builtin_amdgcn_readfirstlane((int)threadIdx.x >> 6);
#define TID() (wave_s * 64 + lane_id_opaque())
    F.tid = TID(); F.lane = F.tid & 63; F.wave = wave_s;
    F.G = gridDim.x; { const int bx = blockIdx.x; F.vcu = (F.G % 8 == 0) ? (bx % 8) * (F.G / 8) + bx / 8 : bx; }
    volatile LAS unsigned* MISC = (volatile LAS unsigned*)(F.lds + MISC_OFF);
    unsigned char* ws = args.ws;
    for (int u = F.tid; u < (LDS_BYTES - LDSCTL_OFF) / 4; u += NTHREADS) ((LAS unsigned*)(F.lds + LDSCTL_OFF))[u] = 0u;
    __syncthreads();
    XcdBarrier bar = xcd_barrier_post((unsigned*)(ws + OFF_CTL) + CW_BAR, MISC + 8, F.tid);
#define GRID_BAR() xcd_barrier(bar, TID())
    GroupBarrier gbar; gbar.bar = (unsigned*)(ws + OFF_CTL) + CW_BAR; gbar.g = (unsigned)blockIdx.x & 7u; gbar.same_xcd = 0u;
    if (F.tid == 0) ((unsigned*)(ws + OFF_CTL))[CW_BAR + GB_XCC + blockIdx.x] = xb_xcc_id() + 1u;
#define GROUP_BAR() group_barrier(gbar, TID())
#define REFRESH() do { int t_ = TID(); asm volatile("" : "+v"(t_)); F.tid = t_; F.lane = t_ & 63; F.wave = wave_s; } while (0)

    const float* x = (const float*)args.in[0]; const float* mem = (const float*)args.in[1]; const int* pos = (const int*)args.in[2]; const float* g_mem = (const float*)args.in[3];
    const float* e_ng = (const float*)args.in[4]; const float* e_win = (const float*)args.in[5]; const float* e_wpool = (const float*)args.in[6]; const float* e_pscale = (const float*)args.in[7];
    const float* e_wmkv = (const float*)args.in[8]; const float* e_wout = (const float*)args.in[9];
    const float* o_ng = (const float*)args.in[10]; const float* o_win = (const float*)args.in[11]; const float* o_lng = (const float*)args.in[12]; const float* o_lnb = (const float*)args.in[13];
    const float* o_ws = (const float*)args.in[14]; const float* o_bs = (const float*)args.in[15]; const float* o_wmkv = (const float*)args.in[16]; const float* o_wout = (const float*)args.in[17];
    const float* f_g = (const float*)args.in[18];
    float* out = args.out;
    bf16_t* proj = (bf16_t*)(ws + OFF_PROJ); bf16_t* xb = (bf16_t*)(ws + OFF_XB); bf16_t* win = (bf16_t*)((unsigned char*)args.out + DO_WIN); bf16_t* wout = (bf16_t*)((unsigned char*)args.out + DO_WOUT);
    bf16_t* memkv = (bf16_t*)(ws + OFF_MEMKV); float* rowss = (float*)(ws + OFF_ROWSS); unsigned* rope = (unsigned*)(ws + OFF_ROPE); float* lse = (float*)(ws + OFF_LSE); float2* lnp = (float2*)(ws + OFF_LNP); bf16_t* wpT = (bf16_t*)(ws + OFF_WPT); bf16_t* wsm = (bf16_t*)(ws + OFF_WSM);
    bf16_t* memn = (bf16_t*)((unsigned char*)args.out + DO_MEMN); bf16_t* wmkv = (bf16_t*)((unsigned char*)args.out + DO_WMKV);
    const int NGW = F.G * NWAVES;
    { const int gw = F.vcu * NWAVES + F.wave, lane = F.lane;

#define CONVERT_IN(l_, gw_, ngw_) do { const int i_ = (l_) >> 1;        \
        if ((l_) & 1) convert_weight(F, gw_, ngw_, o_win + (size_t)i_ * DM * OP, DM, OP, win + (size_t)(i_ * 20 + 12) * (MiB / 2), 0, o_ng + i_ * DM); \
        else          convert_weight(F, gw_, ngw_, e_win + (size_t)i_ * DM * EP, DM, EP, win + (size_t)(i_ * 20) * (MiB / 2), 0, e_ng + i_ * DM, false, e_wpool + (size_t)i_ * 4 * 128 * 128, e_pscale + i_ * 512); } while (0)
#define CONVERT_OUT(l_, gw_, ngw_) do { const int i_ = (l_) >> 1; convert_weight(F, gw_, ngw_, (((l_) & 1) ? o_wout : e_wout) + (size_t)i_ * MIX * DM, MIX, DM, wout + (size_t)(l_) * DM * MIX, 0, nullptr); } while (0)
    CONVERT_IN(0, gw, NGW);
    { LAS float* scr = (LAS float*)(F.lds + F.wave * 16384);
      for (int it = gw; it < 4 * 512; it += NGW) { const int l = it >> 9; const float* Wm = ((l & 1) ? o_wmkv : e_wmkv) + (size_t)(l >> 1) * DM * 1024;
          TItem t; titem_load(t, Wm, 1024, nullptr, it & 511, lane); titem_finish(t, DM, 1024, wmkv, l * 1024, scr, it & 511, lane, false, false); } }
    for (int i = F.vcu * NTHREADS + F.tid; i < 2 * 8 * 128 * 128; i += F.G * NTHREADS) { const int t = (i >> 7) & 127, sI = i & 127; wsm[i] = (sI <= t) ? (bf16_t)f2bf(o_ws[i]) : (bf16_t)0; }
    for (int r0 = gw * 4; r0 < NT; r0 += NGW * 4) {
        f32x4 v[4][4];
#pragma unroll
        for (int q = 0; q < 4; ++q)
#pragma unroll
            for (int j = 0; j < 4; ++j) v[q][j] = ldntf4(x + (size_t)(r0 + q) * DM + 4 * lane + 256 * j);
#pragma unroll
        for (int q = 0; q < 4; ++q) { float sq = 0.f;
#pragma unroll
            for (int j = 0; j < 4; ++j) { sq += (v[q][j][0] * v[q][j][0] + v[q][j][1] * v[q][j][1]) + (v[q][j][2] * v[q][j][2] + v[q][j][3] * v[q][j][3]);
                u32x2 w; w.x = pk2(v[q][j][0], v[q][j][1]); w.y = pk2(v[q][j][2], v[q][j][3]); *(u32x2*)(xb + (size_t)(r0 + q) * DM + 4 * lane + 256 * j) = w; }
            sq = wave_sum(sq);
            if (lane < 16) rowss[(size_t)(r0 + q) * 16 + lane] = (lane == 0) ? sq : 0.f; }
    }
    for (int r = gw; r < NB * NMEM; r += NGW) {
        const float* xr = mem + (size_t)r * DM; f32x4 v[4]; float s = 0.f;
#pragma unroll
        for (int j = 0; j < 4; ++j) { v[j] = *(const f32x4*)(xr + 4 * lane + 256 * j); s += (v[j][0] * v[j][0] + v[j][1] * v[j][1]) + (v[j][2] * v[j][2] + v[j][3] * v[j][3]); }
        s = wave_sum(s); const float ri = rsqrtf(s * (1.f / DM) + EPS);
#pragma unroll
        for (int j = 0; j < 4; ++j) { const f32x4 gg = *(const f32x4*)(g_mem + 4 * lane + 256 * j);
            u32x2 w; w.x = pk2(v[j][0] * ri * gg[0], v[j][1] * ri * gg[1]); w.y = pk2(v[j][2] * ri * gg[2], v[j][3] * ri * gg[3]); *(u32x2*)(memn + (size_t)r * DM + 4 * lane + 256 * j) = w; }
    }
    { const int i0 = F.vcu * NTHREADS + F.tid, st = F.G * NTHREADS; int pv[4];
#pragma unroll
      for (int k = 0; k < 4; ++k) { const int i = i0 + k * st; pv[k] = (i < NT * 16) ? pos[i >> 4] : 0; }
#pragma unroll
      for (int k = 0; k < 4; ++k) { const int i = i0 + k * st; if (i < NT * 16) { const int f = i & 15; const float ang = (float)pv[k] * c_inv_freq[f];
          const double rev = (double)ang * 0.15915494309189535; const float fr = (float)(rev - rint(rev));
          rope[i] = (unsigned)__builtin_bit_cast(unsigned short, (_Float16)__builtin_amdgcn_cosf(fr)) | ((unsigned)__builtin_bit_cast(unsigned short, (_Float16)__builtin_amdgcn_sinf(fr)) << 16); } }
      for (int i = i0 + 4 * st; i < NT * 16; i += st) { const int tok = i >> 4, f = i & 15; const float ang = (float)pos[tok] * c_inv_freq[f];
          const double rev = (double)ang * 0.15915494309189535; const float fr = (float)(rev - rint(rev));
          rope[i] = (unsigned)__builtin_bit_cast(unsigned short, (_Float16)__builtin_amdgcn_cosf(fr)) | ((unsigned)__builtin_bit_cast(unsigned short, (_Float16)__builtin_amdgcn_sinf(fr)) << 16); }
    }
    }
    GRID_BAR();
    { if (TID() == 0) { const unsigned* xt = (const unsigned*)(ws + OFF_CTL) + CW_BAR + GB_XCC; const unsigned g8 = (unsigned)blockIdx.x & 7u; const unsigned x0 = xb_ld((unsigned*)&xt[g8]); unsigned same = (x0 != 0u) ? 1u : 0u;
          for (unsigned k = 1; k < 32; ++k) same &= (xb_ld((unsigned*)&xt[g8 + 8u * k]) == x0) ? 1u : 0u;
          MISC[2] = same; }
      __syncthreads(); gbar.same_xcd = __builtin_amdgcn_readfirstlane((int)MISC[2]); }

    { pg8::Gemm g{memn, wmkv, NB * NMEM, 4096, DM, DM}; pg8::StaticOrder S; S.init(NB * NMEM, 4096, F.G, (int)blockIdx.x);
      pg8::EpiIn<false> E{memkv, 4096, nullptr, nullptr, 0, nullptr, 0, 0, F.lds + EPI_STG_OFF, nullptr};
      pg8::gemm_phase<pg8::EpiIn<false>, pg8::StaticOrder, true, true>(F.lds, g, S, E, TID());
      { REFRESH(); const int nunits = (NB * NMEM / 256) * (4096 / 256); const bool has_tile = (int)blockIdx.x < nunits; const int nslot = has_tile ? 1 : 2;
        for (int sidx = 0; sidx < nslot; ++sidx) {
            const int gw2 = has_tile ? 2048 + (int)blockIdx.x * NWAVES + F.wave : ((int)blockIdx.x - nunits) * NWAVES + F.wave + sidx * 1024; const int ngw2 = 3072;
            CONVERT_OUT(0, gw2, ngw2);
            for (int cl = 1; cl < 4; ++cl) { CONVERT_IN(cl, gw2, ngw2); CONVERT_OUT(cl, gw2, ngw2); } } }
      __syncthreads(); }

    for (int l = 0; l < 4; ++l) {
        const int i = l >> 1; const bool odd = l & 1; const int NP = odd ? OP : EP;
        { pg8::Gemm g{xb, win + (size_t)((l >> 1) * 20 + (l & 1) * 12) * (MiB / 2), NT, NP, DM, DM}; pg8::StaticOrder S; S.init(NT, NP, F.G, (int)blockIdx.x);
          pg8::EpiIn<true> E{proj, NP, rowss, rope, odd ? 0 : 12, odd ? lnp : nullptr, 4, PS, F.lds + EPI_STG_OFF, (LAS float*)(F.lds + RINV_OFF)};
#ifndef STAGGER_TICKS
#define STAGGER_TICKS 0
#endif
          if (STAGGER_TICKS) stagger_wait(STAGGER_TICKS);
          pg8::gemm_phase<pg8::EpiIn<true>, pg8::StaticOrder, true, true>(F.lds, g, S, E, TID()); }
        if (l == 0) GRID_BAR(); else GROUP_BAR();
        REFRESH();
        if (!odd) {
            REFRESH(); pool_phase(F, proj);
            attn_phase((char*)lds_raw, F.vcu, F.G, true, proj, memkv + l * 1024, lse, TID());
            GROUP_BAR();
            REFRESH(); combine_phase(F, proj, lse);
        } else {
            const int flip = ((int)blockIdx.x >> 3) & 1;
            for (int step = 0; step < 2; ++step) {
                if ((step ^ flip) == 0) { REFRESH(); cmix_phase(F, proj, o_lng + i * 1024, o_lnb + i * 1024, wsm + (size_t)i * 8 * 128 * 128, o_bs + i * 8 * 128, lnp); __syncthreads(); }
                else { attn_phase((char*)lds_raw, F.vcu, F.G, false, proj, memkv + l * 1024, lse, TID()); __syncthreads(); }
            }
        }
        GROUP_BAR();
        { pg8::Gemm g{pcol(proj, odd ? O_Z : E_Z), wout + (size_t)l * DM * MIX, NT, DM, MIX, PR, PS * 2};   pg8::StaticOrder S; S.init(NT, DM, F.G, (int)blockIdx.x);
          pg8::EpiOut E{xb, rowss, F.lds + EPI_STG_OFF};
          pg8::gemm_phase<pg8::EpiOut, pg8::StaticOrder, true, true>(F.lds, g, S, E, TID()); }
        if (l == 3) GRID_BAR(); else GROUP_BAR();
    }
    REFRESH();
    { const int lane = F.lane;
      f32x4 gg[4];
#pragma unroll
      for (int j = 0; j < 4; ++j) gg[j] = *(const f32x4*)(f_g + 4 * lane + 256 * j);
      for (int r = F.vcu * 128 + F.wave * 16, rk = 0; rk < 4; ++rk, r += 4) {
        u32x2 q[4][4]; float sv[4];
#pragma unroll
        for (int t = 0; t < 4; ++t) { sv[t] = (lane < 16) ? rowss[(size_t)(r + t) * 16 + lane] : 0.f;
#pragma unroll
            for (int j = 0; j < 4; ++j) q[t][j] = __builtin_nontemporal_load((const u32x2*)(xb + (size_t)(r + t) * DM + 4 * lane + 256 * j)); }
#pragma unroll
        for (int t = 0; t < 4; ++t) { const float ri = rsqrtf(wave_sum(sv[t]) * (1.f / DM) + EPS); float* orow = out + (size_t)(r + t) * DM;
#pragma unroll
            for (int j = 0; j < 4; ++j) { const u32x2 w = q[t][j]; const f32x4 g0 = gg[j];
                const f32x4 a = {__uint_as_float(w[0] << 16) * ri * g0[0], __uint_as_float(w[0] & 0xffff0000u) * ri * g0[1], __uint_as_float(w[1] << 16) * ri * g0[2], __uint_as_float(w[1] & 0xffff0000u) * ri * g0[3]};
                stntf4(orow + 4 * lane + 256 * j, a); } }
      } }
}

extern "C" void kernel_launch(void* const* d_in, const int* in_sizes, int n_in, void* d_out, int out_size, void* d_ws, size_t ws_size, hipStream_t stream) {
    static int grid = 0;
    if (grid == 0) {
        if (n_in != 19 || in_sizes[0] != NT * DM || out_size != NT * DM || ws_size < WS_END) {
            fprintf(stderr, "kernel_launch: unexpected shapes (n_in %d, in0 %d, out %d, ws %zu; need ws >= %zu)\n", n_in, n_in > 0 ? in_sizes[0] : -1, out_size, ws_size, (size_t)WS_END);
            grid = -1; return; }
        int dev = 0, cus = 0;
        if (hipGetDevice(&dev) != hipSuccess || hipDeviceGetAttribute(&cus, hipDeviceAttributeMultiprocessorCount, dev) != hipSuccess) { grid = -1; return; }
        if (hipFuncSetAttribute((const void*)mega_fwd, hipFuncAttributeMaxDynamicSharedMemorySize, LDS_BYTES) != hipSuccess) { fprintf(stderr, "kernel_launch: hipFuncSetAttribute failed\n"); grid = -1; return; }
        int per_cu = 0;
        if (hipOccupancyMaxActiveBlocksPerMultiprocessor(&per_cu, (const void*)mega_fwd, NTHREADS, LDS_BYTES) != hipSuccess || per_cu < 1)
            fprintf(stderr, "kernel_launch: note: occupancy query reports %d workgroups per CU\n", per_cu);
        (void)hipGetLastError();
        if (cus < 256) { fprintf(stderr, "kernel_launch: this kernel is laid out for 256 CUs (found %d); nothing launched\n", cus); grid = -1; return; }
        grid = 256;
    }
    if (grid < 0) return;
    if (hipMemsetAsync((char*)d_ws + OFF_CTL, 0, CTL_ZERO_BYTES, stream) != hipSuccess) return;
    Args a{};
    for (int i = 0; i < 19; ++i) a.in[i] = d_in[i];
    a.out = (float*)d_out; a.ws = (unsigned char*)d_ws;
    hipLaunchKernelGGL(mega_fwd, dim3(grid), dim3(NTHREADS), LDS_BYTES, stream, a);
}
```
